# Optimizing an MI355X kernel written in HIP

```python
import math
import functools
import jax
import jax.numpy as jnp
from jax import lax
import numpy as np

D_MODEL = 1024
BATCH = 8
SEQ = 8192
DEPTH = 2

F32 = jnp.float32
GRID_W = 64
CTX_LEN = 256
HEAD_DIM = 64
ATTN_SCALE = HEAD_DIM ** -0.5
ROPE_AXIS_DIM = HEAD_DIM // 2
ROPE_BASE = 10000.0
EPS = 1e-6
NEG_INF = -1e30

MLSTM_HEADS = 8
MLSTM_CHUNK = 64
SWA_HEADS = 8
SWA_KV_HEADS = 2
SWA_WINDOW = 128
SWA_BLOCK = 128
S5_CHANNELS = 256
S5_GROUP = 16
S5_GROUPS = S5_CHANNELS // S5_GROUP
S5_STATE = 64
ATT_HEADS = 12
ATT_KV_HEADS = 3
ATT_QBLOCK = 128
N_EXPERTS = 32
TOP_K = 4
EXPERT_FF = 1024
SWIGLU_LIMIT = 7.0
SWIGLU_ALPHA = 1.702
MOE_BLOCK = 256

MIX_WIDTH = MLSTM_HEADS * HEAD_DIM + SWA_HEADS * HEAD_DIM
EVEN_SPLIT_SIZES = (MLSTM_HEADS * HEAD_DIM,) * 4 + (4 * MLSTM_HEADS, SWA_HEADS * HEAD_DIM, SWA_KV_HEADS * HEAD_DIM, SWA_KV_HEADS * HEAD_DIM)
ODD_SPLIT_SIZES = (S5_CHANNELS, ATT_HEADS * HEAD_DIM, ATT_KV_HEADS * HEAD_DIM, ATT_KV_HEADS * HEAD_DIM)
EVEN_IN = sum(EVEN_SPLIT_SIZES)
ODD_IN = sum(ODD_SPLIT_SIZES)

kernel_name = 'hybrid_mlstm_swa_s5_axial_moe_dit'


def rmsnorm(x, g):
    xf = x.astype(F32)
    y = xf * lax.rsqrt(jnp.mean(xf * xf, axis=-1, keepdims=True) + EPS)
    return (y * g.astype(F32)).astype(x.dtype)


def split_cols(p, sizes):
    return jnp.split(p, np.cumsum(sizes)[:-1].tolist(), axis=-1)


def to_heads(t, n_heads):
    return t.reshape(t.shape[0], t.shape[1], n_heads, HEAD_DIM)


def axial_rope_tables(n_tokens):
    rows = n_tokens // GRID_W
    row = jnp.repeat(jnp.arange(rows, dtype=jnp.int32), GRID_W)
    col = jnp.tile(jnp.arange(GRID_W, dtype=jnp.int32), rows)
    inv = ROPE_BASE ** (-jnp.arange(0, ROPE_AXIS_DIM, 2, dtype=F32) / ROPE_AXIS_DIM)
    ang_r = row.astype(F32)[:, None] * inv
    ang_c = col.astype(F32)[:, None] * inv
    return (jnp.cos(ang_r), jnp.sin(ang_r), jnp.cos(ang_c), jnp.sin(ang_c))


def apply_axial_rope(x, rope):
    cr, sr, cc, sc = [t[:, None, :] for t in rope]

    def rot(t, cos, sin):
        t1, t2 = jnp.split(t, 2, axis=-1)
        return jnp.concatenate([t1 * cos - t2 * sin, t2 * cos + t1 * sin], axis=-1)

    xf = x.astype(F32)
    out = jnp.concatenate([rot(xf[..., :ROPE_AXIS_DIM], cr, sr), rot(xf[..., ROPE_AXIS_DIM:], cc, sc)], axis=-1)
    return out.astype(x.dtype)


def context_attention(q, k, v, sink):
    B, L, H, _ = q.shape
    hkv = k.shape[2]
    qg = q.reshape(B, L, hkv, H // hkv, HEAD_DIM)
    s = jnp.einsum('bqhgd,bkhd->bhgqk', qg, k).astype(F32) * ATTN_SCALE
    if sink is not None:
        s_sink = jnp.broadcast_to(sink.astype(F32).reshape(hkv, H // hkv, 1, 1), s.shape[:-1] + (1,))
        p = jax.nn.softmax(jnp.concatenate([s, s_sink], axis=-1), axis=-1)[..., :-1]
    else:
        p = jax.nn.softmax(s, axis=-1)
    o = jnp.einsum('bhgqk,bkhd->bqhgd', p.astype(v.dtype), v)
    return o.reshape(B, L, H * HEAD_DIM)


def window_attention(q, k, v, k_ctx, v_ctx, sink):
    B, S, H, _ = q.shape
    hkv = k.shape[2]
    G = H // hkv
    W = SWA_BLOCK
    nb = S // W
    L = k_ctx.shape[1]
    qb = q.reshape(B, nb, W, hkv, G, HEAD_DIM)

    def band(t):
        tp = jnp.pad(t, ((0, 0), (W, W), (0, 0), (0, 0))).reshape(B, nb + 2, W, hkv, HEAD_DIM)
        return jnp.concatenate([tp[:, :-2], tp[:, 1:-1], tp[:, 2:]], axis=2)

    k_band, v_band = band(k), band(v)
    s_loc = jnp.einsum('bnqhgd,bnkhd->bnhgqk', qb, k_band).astype(F32) * ATTN_SCALE
    blk = jnp.arange(nb)[:, None, None] * W
    qpos = blk + jnp.arange(W)[None, :, None]
    kpos = blk - W + jnp.arange(3 * W)[None, None, :]
    valid = (jnp.abs(qpos - kpos) <= SWA_WINDOW) & (kpos >= 0) & (kpos < S)
    s_loc = jnp.where(valid[None, :, None, None], s_loc, NEG_INF)
    s_ctx = jnp.einsum('bnqhgd,bkhd->bnhgqk', qb, k_ctx).astype(F32) * ATTN_SCALE
    s_sink = jnp.broadcast_to(sink.astype(F32).reshape(hkv, G, 1, 1), s_ctx.shape[:-1] + (1,))
    p = jax.nn.softmax(jnp.concatenate([s_ctx, s_loc, s_sink], axis=-1), axis=-1).astype(v.dtype)
    out = (jnp.einsum('bnhgqk,bkhd->bnqhgd', p[..., :L], v_ctx)
           + jnp.einsum('bnhgqk,bnkhd->bnqhgd', p[..., L:L + 3 * W], v_band))
    return out.reshape(B, S, H * HEAD_DIM)


def dense_block_attention(q, k, v, k_ctx, v_ctx):
    B, S, H, _ = q.shape
    hkv = k.shape[2]
    G = H // hkv
    nb = S // ATT_QBLOCK
    k_all = jnp.concatenate([k_ctx, k], axis=1)
    v_all = jnp.concatenate([v_ctx, v], axis=1)
    qb = q.reshape(B, nb, ATT_QBLOCK, hkv, G, HEAD_DIM).transpose(1, 0, 2, 3, 4, 5)

    def one_block(q_blk):
        s = jnp.einsum('bqhgd,bkhd->bhgqk', q_blk, k_all).astype(F32) * ATTN_SCALE
        p = jax.nn.softmax(s, axis=-1).astype(v_all.dtype)
        return jnp.einsum('bhgqk,bkhd->bqhgd', p, v_all)

    out = lax.map(one_block, qb)
    return out.transpose(1, 0, 2, 3, 4, 5).reshape(B, S, H * HEAD_DIM)


def mlstm_zero_state(batch):
    return (jnp.zeros((batch, MLSTM_HEADS, HEAD_DIM, HEAD_DIM), F32),
            jnp.zeros((batch, MLSTM_HEADS, HEAD_DIM), F32),
            jnp.full((batch, MLSTM_HEADS), NEG_INF, F32))


def mlstm_chunkwise(q, k, v, log_i, log_f, state):
    B, H, T, _ = q.shape
    CH = MLSTM_CHUNK
    nc = T // CH
    q = q.reshape(B, H, nc, CH, HEAD_DIM)
    k = k.reshape(B, H, nc, CH, HEAD_DIM)
    v = v.reshape(B, H, nc, CH, HEAD_DIM)
    log_i = log_i.reshape(B, H, nc, CH)
    b = jnp.cumsum(log_f.reshape(B, H, nc, CH), axis=-1)
    b_last = b[..., -1]
    w_log = b_last[..., None] - b + log_i
    m_loc = jnp.max(w_log, axis=-1)
    w = jnp.exp(w_log - m_loc[..., None])
    c_loc = jnp.einsum('bhcs,bhcsk,bhcsv->bhckv', w, k, v)
    n_loc = jnp.einsum('bhcs,bhcsk->bhck', w, k)

    def step(carry, inp):
        c_prev, n_prev, m_prev = carry
        c_l, n_l, m_l, bl = inp
        m_new = jnp.maximum(bl + m_prev, m_l)
        decay = jnp.exp(bl + m_prev - m_new)
        fresh = jnp.exp(m_l - m_new)
        c_new = decay[..., None, None] * c_prev + fresh[..., None, None] * c_l
        n_new = decay[..., None] * n_prev + fresh[..., None] * n_l
        return (c_new, n_new, m_new), (c_prev, n_prev, m_prev)

    chunk_major = lambda t: jnp.moveaxis(t, 2, 0)
    final, (c_s, n_s, m_s) = lax.scan(step, state, (chunk_major(c_loc), chunk_major(n_loc), chunk_major(m_loc), chunk_major(b_last)))
    c_s, n_s, m_s = jnp.moveaxis(c_s, 0, 2), jnp.moveaxis(n_s, 0, 2), jnp.moveaxis(m_s, 0, 2)
    causal = jnp.tril(jnp.ones((CH, CH), dtype=bool))
    d_log = jnp.where(causal, b[..., :, None] - b[..., None, :] + log_i[..., None, :], NEG_INF)
    inter_log = b + m_s[..., None]
    m_t = jnp.maximum(inter_log, jnp.max(d_log, axis=-1))
    s = jnp.einsum('bhctd,bhcsd->bhcts', q, k) * jnp.exp(d_log - m_t[..., None])
    inter = jnp.exp(inter_log - m_t)
    num = inter[..., None] * jnp.einsum('bhctk,bhckv->bhctv', q, c_s) + jnp.einsum('bhcts,bhcsv->bhctv', s, v)
    den = jnp.maximum(jnp.abs(inter * jnp.einsum('bhctk,bhck->bhct', q, n_s) + jnp.sum(s, axis=-1)), jnp.exp(-m_t))
    return (num / den[..., None]).reshape(B, H, T, HEAD_DIM), final


def mlstm_inputs(q, k, v, g, gate_bias):
    B, T, _ = q.shape
    heads = lambda t: t.reshape(B, T, MLSTM_HEADS, HEAD_DIM).transpose(0, 2, 1, 3).astype(F32)
    gates = (g.reshape(B, T, 4, MLSTM_HEADS).astype(F32) + gate_bias.astype(F32)).transpose(2, 0, 3, 1)
    return heads(q), heads(k) * ATTN_SCALE, heads(v), gates


def mlstm_bidir(q, k, v, gates, st_f, st_b):
    flip = lambda t: jnp.flip(t, axis=2)
    h_f, fin_f = mlstm_chunkwise(q, k, v, gates[0], jax.nn.log_sigmoid(gates[1]), st_f)
    h_b, fin_b = mlstm_chunkwise(flip(q), flip(k), flip(v), flip(gates[2]), flip(jax.nn.log_sigmoid(gates[3])), st_b)
    return h_f + flip(h_b), fin_f, fin_b


def mlstm_output(h, o, norm):
    B, H, T, _ = h.shape
    hn = rmsnorm(h.transpose(0, 2, 1, 3), norm).reshape(B, T, H * HEAD_DIM)
    return (jax.nn.sigmoid(o.astype(F32)) * hn).astype(o.dtype)


def s5_discretise(lam_re, lam_im, log_dt, b_re, b_im):
    lam = lax.complex(lam_re.astype(F32), lam_im.astype(F32))
    dt = jnp.exp(log_dt.astype(F32))[..., None]
    a_bar = jnp.exp(lam * dt)
    b_scale = (a_bar - 1.0) / lam
    b_mat = lax.complex(b_re.astype(F32), b_im.astype(F32))
    return a_bar, b_scale, b_mat


def s5_drive(u, b_mat):
    B, T, _ = u.shape
    ug = u.astype(F32).reshape(B, T, S5_GROUPS, S5_GROUP).astype(jnp.complex64)
    return jnp.einsum('gpc,btgc->btgp', b_mat, ug)


def s5_combine(e1, e2):
    a1, b1 = e1
    a2, b2 = e2
    return a1 * a2, a2 * b1 + b2


def s5_scan(bu, a, x0):
    T = bu.shape[1]
    bu = bu.at[:, 0].add(a * x0)
    a_t = jnp.broadcast_to(a, (1, T) + a.shape)
    _, xs = lax.associative_scan(s5_combine, (a_t, bu), axis=1)
    return xs, xs[:, -1]


def s5_readout(states, u, c_mat, d_skip, w_glu, b_glu):
    B, T, _ = u.shape
    uf = u.astype(F32)
    y = jnp.real(jnp.einsum('gcp,btgp->btgc', c_mat, states)).reshape(B, T, S5_CHANNELS) + d_skip.astype(F32) * uf
    y = jax.nn.gelu(y)
    y = y * jax.nn.sigmoid(y @ w_glu.astype(F32) + b_glu.astype(F32))
    return y.astype(u.dtype)


def mixer_even(px, pc, rope, last, gate_bias, mlstm_norm, sink):
    qa_x, ka_x, va_x, oa_x, ga_x, qb_x, kb_x, vb_x = split_cols(px, EVEN_SPLIT_SIZES)
    qa_c, ka_c, va_c, oa_c, ga_c, qb_c, kb_c, vb_c = split_cols(pc, EVEN_SPLIT_SIZES)
    zero = mlstm_zero_state(px.shape[0])
    h_c, st_f, st_b = mlstm_bidir(*mlstm_inputs(qa_c, ka_c, va_c, ga_c, gate_bias), zero, zero)
    h_x, _, _ = mlstm_bidir(*mlstm_inputs(qa_x, ka_x, va_x, ga_x, gate_bias), st_f, st_b)
    k_c = to_heads(kb_c, SWA_KV_HEADS)
    v_c = to_heads(vb_c, SWA_KV_HEADS)
    q_x = apply_axial_rope(to_heads(qb_x, SWA_HEADS), rope)
    k_x = apply_axial_rope(to_heads(kb_x, SWA_KV_HEADS), rope)
    out_x = jnp.concatenate([mlstm_output(h_x, oa_x, mlstm_norm),
                             window_attention(q_x, k_x, to_heads(vb_x, SWA_KV_HEADS), k_c, v_c, sink)], axis=-1)
    if last:
        return out_x, None
    out_c = jnp.concatenate([mlstm_output(h_c, oa_c, mlstm_norm),
                             context_attention(to_heads(qb_c, SWA_HEADS), k_c, v_c, sink)], axis=-1)
    return out_x, out_c


def mixer_odd(px, pc, rope, last, lam_re, lam_im, log_dt, b_re, b_im, c_re, c_im, d_skip, w_glu, b_glu, q_norm, k_norm):
    u_x, q_x, k_x, v_x = split_cols(px, ODD_SPLIT_SIZES)
    u_c, q_c, k_c, v_c = split_cols(pc, ODD_SPLIT_SIZES)
    a_bar, b_scale, b_mat = s5_discretise(lam_re, lam_im, log_dt, b_re, b_im)
    c_mat = lax.complex(c_re.astype(F32), c_im.astype(F32))
    bu_c = s5_drive(u_c, b_mat)
    bu_x = s5_drive(u_x, b_mat)
    zero = jnp.zeros((px.shape[0], S5_GROUPS, S5_STATE), jnp.complex64)
    flip = lambda t: jnp.flip(t, axis=1)
    xc_f, fin_f = s5_scan(bu_c * b_scale[0], a_bar[0], zero)
    xc_b, fin_b = s5_scan(flip(bu_c * b_scale[1]), a_bar[1], zero)
    xx_f, _ = s5_scan(bu_x * b_scale[0], a_bar[0], fin_f)
    xx_b, _ = s5_scan(flip(bu_x * b_scale[1]), a_bar[1], fin_b)
    s5_x = s5_readout(xx_f + flip(xx_b), u_x, c_mat, d_skip, w_glu, b_glu)
    kc = rmsnorm(to_heads(k_c, ATT_KV_HEADS), k_norm)
    vc = to_heads(v_c, ATT_KV_HEADS)
    qx = apply_axial_rope(rmsnorm(to_heads(q_x, ATT_HEADS), q_norm), rope)
    kx = apply_axial_rope(rmsnorm(to_heads(k_x, ATT_KV_HEADS), k_norm), rope)
    att_x = dense_block_attention(qx, kx, to_heads(v_x, ATT_KV_HEADS), kc, vc)
    out_x = jnp.concatenate([s5_x, att_x], axis=-1)
    if last:
        return out_x, None
    out_c = jnp.concatenate([s5_readout(xc_f + flip(xc_b), u_c, c_mat, d_skip, w_glu, b_glu),
                             context_attention(rmsnorm(to_heads(q_c, ATT_HEADS), q_norm), kc, vc, None)], axis=-1)
    return out_x, out_c


def moe(xt, w_router, b_router, w_gate_up, b_gate_up, w_down, b_down):
    N, D = xt.shape
    logits = xt.astype(F32) @ w_router.astype(F32) + b_router.astype(F32)
    top_val, top_idx = lax.top_k(logits, TOP_K)
    gates = jax.nn.softmax(top_val, axis=-1)
    flat_e = top_idx.reshape(-1)
    order = jnp.argsort(flat_e)
    sorted_e = flat_e[order]
    tok = order // TOP_K
    counts = jnp.bincount(flat_e, length=N_EXPERTS)
    padded = (counts + MOE_BLOCK - 1) // MOE_BLOCK * MOE_BLOCK
    pad_end = jnp.cumsum(padded)
    pad_start = pad_end - padded
    grp_start = jnp.cumsum(counts) - counts
    dest = pad_start[sorted_e] + jnp.arange(N * TOP_K) - grp_start[sorted_e]
    n_blocks = -(-N * TOP_K // MOE_BLOCK) + N_EXPERTS
    buf = jnp.zeros((n_blocks * MOE_BLOCK, D), xt.dtype).at[dest].set(xt[tok])
    blk_e = jnp.minimum(jnp.searchsorted(pad_end, jnp.arange(n_blocks) * MOE_BLOCK, side='right'), N_EXPERTS - 1)

    def expert_block(args):
        xb, e = args
        h = xb @ w_gate_up[e] + b_gate_up[e]
        glu = jnp.minimum(h[:, 0::2], SWIGLU_LIMIT)
        lin = jnp.clip(h[:, 1::2], -SWIGLU_LIMIT, SWIGLU_LIMIT)
        act = glu * jax.nn.sigmoid(SWIGLU_ALPHA * glu) * (lin + 1.0)
        return act @ w_down[e] + b_down[e]

    out = lax.map(expert_block, (buf.reshape(n_blocks, MOE_BLOCK, D), blk_e)).reshape(-1, D)
    y_sorted = out[dest] * gates.reshape(-1)[order][:, None].astype(xt.dtype)
    return jnp.zeros_like(xt).at[tok].add(y_sorted)


def adaln(cond, w_mod, b_mod):
    return jnp.split(jax.nn.silu(cond) @ w_mod + b_mod, 6, axis=-1)


def run_layer(x, h_ctx, c, c_ctx, w_mod, b_mod, g_mix, g_ffn, w_in, w_out, moe_params, mixer, rope, last):
    B, S, D = x.shape
    L = h_ctx.shape[1]
    sh1, sc1, gt1, sh2, sc2, gt2 = [m[:, None, :] for m in adaln(c, w_mod, b_mod)]
    csh1, csc1, cgt1, csh2, csc2, cgt2 = adaln(c_ctx, w_mod, b_mod)
    xn = rmsnorm(x, g_mix) * (1.0 + sc1) + sh1
    cn = rmsnorm(h_ctx, g_mix) * (1.0 + csc1) + csh1
    out_x, out_c = mixer(xn @ w_in, cn @ w_in, rope, last)
    x = x + gt1 * (out_x @ w_out)
    xn2 = rmsnorm(x, g_ffn) * (1.0 + sc2) + sh2
    if last:
        return x + gt2 * moe(xn2.reshape(B * S, D), *moe_params).reshape(B, S, D), h_ctx
    h_ctx = h_ctx + cgt1 * (out_c @ w_out)
    cn2 = rmsnorm(h_ctx, g_ffn) * (1.0 + csc2) + csh2
    y = moe(jnp.concatenate([cn2.reshape(B * L, D), xn2.reshape(B * S, D)], axis=0), *moe_params)
    return x + gt2 * y[B * L:].reshape(B, S, D), h_ctx + cgt2 * y[:B * L].reshape(B, L, D)


def setup_inputs(seed: int = 0) -> dict:
    key = jax.random.key(seed)
    keys = iter(jax.random.split(key, 64))
    D = D_MODEL

    def nrm(shape, scale=1.0):
        return scale * jax.random.normal(next(keys), shape, F32)

    def gain(shape):
        return 1.0 + nrm(shape, 0.02)

    inp = {'x': nrm((BATCH, SEQ, D)), 'c': nrm((BATCH, D)), 'ctx': nrm((BATCH, CTX_LEN, D)), 'c_ctx': nrm((D,))}

    def add_common(p, in_width):
        inp[p + 'w_mod'] = nrm((D, 6 * D), 0.5 * D ** -0.5)
        inp[p + 'b_mod'] = nrm((6 * D,), 0.02)
        inp[p + 'g_mix'] = gain((D,))
        inp[p + 'g_ffn'] = gain((D,))
        inp[p + 'w_in'] = nrm((D, in_width), D ** -0.5)
        inp[p + 'w_out'] = nrm((MIX_WIDTH, D), MIX_WIDTH ** -0.5)

    def add_moe(p):
        inp[p + 'w_router'] = nrm((D, N_EXPERTS), D ** -0.5)
        inp[p + 'b_router'] = nrm((N_EXPERTS,), 0.01)
        inp[p + 'w_gate_up'] = nrm((N_EXPERTS, D, 2 * EXPERT_FF), D ** -0.5)
        inp[p + 'b_gate_up'] = nrm((N_EXPERTS, 2 * EXPERT_FF), 0.02)
        inp[p + 'w_down'] = nrm((N_EXPERTS, EXPERT_FF, D), EXPERT_FF ** -0.5)
        inp[p + 'b_down'] = nrm((N_EXPERTS, D), 0.02)

    add_common('l0_', EVEN_IN)
    f_bias = jnp.linspace(3.0, 6.0, MLSTM_HEADS, dtype=F32)
    zeros_h = jnp.zeros((MLSTM_HEADS,), F32)
    inp['l0_gate_bias'] = nrm((4, MLSTM_HEADS), 0.1) + jnp.stack([zeros_h, f_bias, zeros_h, f_bias])
    inp['l0_mlstm_norm'] = gain((MLSTM_HEADS, HEAD_DIM))
    inp['l0_sink'] = nrm((SWA_HEADS,), 0.5)
    add_moe('l0_')

    add_common('l1_', ODD_IN)
    inp['l1_lam_re'] = -0.5 + nrm((2, S5_GROUPS, S5_STATE), 0.01)
    inp['l1_lam_im'] = math.pi * jnp.arange(S5_STATE, dtype=F32) + nrm((2, S5_GROUPS, S5_STATE), 0.01)
    inp['l1_log_dt'] = jax.random.uniform(next(keys), (2, S5_GROUPS), F32, math.log(1e-3), math.log(1e-1))
    inp['l1_b_re'] = nrm((S5_GROUPS, S5_STATE, S5_GROUP), (2 * S5_GROUP) ** -0.5)
    inp['l1_b_im'] = nrm((S5_GROUPS, S5_STATE, S5_GROUP), (2 * S5_GROUP) ** -0.5)
    inp['l1_c_re'] = nrm((S5_GROUPS, S5_GROUP, S5_STATE), S5_STATE ** -0.5)
    inp['l1_c_im'] = nrm((S5_GROUPS, S5_GROUP, S5_STATE), S5_STATE ** -0.5)
    inp['l1_d_skip'] = nrm((S5_CHANNELS,), 0.5)
    inp['l1_w_glu'] = nrm((S5_CHANNELS, S5_CHANNELS), S5_CHANNELS ** -0.5)
    inp['l1_b_glu'] = nrm((S5_CHANNELS,), 0.02)
    inp['l1_q_norm'] = gain((HEAD_DIM,))
    inp['l1_k_norm'] = gain((HEAD_DIM,))
    add_moe('l1_')

    inp['g_final'] = gain((D,))
    return inp


def reference(x, c, ctx, c_ctx,
              l0_w_mod, l0_b_mod, l0_g_mix, l0_g_ffn, l0_w_in, l0_w_out,
              l0_gate_bias, l0_mlstm_norm, l0_sink,
              l0_w_router, l0_b_router, l0_w_gate_up, l0_b_gate_up, l0_w_down, l0_b_down,
              l1_w_mod, l1_b_mod, l1_g_mix, l1_g_ffn, l1_w_in, l1_w_out,
              l1_lam_re, l1_lam_im, l1_log_dt, l1_b_re, l1_b_im, l1_c_re, l1_c_im,
              l1_d_skip, l1_w_glu, l1_b_glu, l1_q_norm, l1_k_norm,
              l1_w_router, l1_b_router, l1_w_gate_up, l1_b_gate_up, l1_w_down, l1_b_down,
              g_final):
    rope = axial_rope_tables(x.shape[1])
    layers = [
        (functools.partial(mixer_even, gate_bias=l0_gate_bias, mlstm_norm=l0_mlstm_norm, sink=l0_sink),
         (l0_w_mod, l0_b_mod, l0_g_mix, l0_g_ffn, l0_w_in, l0_w_out),
         (l0_w_router, l0_b_router, l0_w_gate_up, l0_b_gate_up, l0_w_down, l0_b_down)),
        (functools.partial(mixer_odd, lam_re=l1_lam_re, lam_im=l1_lam_im, log_dt=l1_log_dt, b_re=l1_b_re, b_im=l1_b_im,
                           c_re=l1_c_re, c_im=l1_c_im, d_skip=l1_d_skip, w_glu=l1_w_glu, b_glu=l1_b_glu,
                           q_norm=l1_q_norm, k_norm=l1_k_norm),
         (l1_w_mod, l1_b_mod, l1_g_mix, l1_g_ffn, l1_w_in, l1_w_out),
         (l1_w_router, l1_b_router, l1_w_gate_up, l1_b_gate_up, l1_w_down, l1_b_down)),
    ]
    h_ctx = ctx
    for i in range(DEPTH):
        mixer, common, moe_params = layers[i]
        x, h_ctx = run_layer(x, h_ctx, c, c_ctx, *common, moe_params, mixer, rope, i == DEPTH - 1)
    return rmsnorm(x, g_final)
```

```cpp
#include <hip/hip_runtime.h>
#include <cstdio>
#include <cstdint>

#ifndef DBG_SKIP
#define DBG_SKIP 0
#endif
#ifndef DBG_REP
#define DBG_REP 0ull
#endif
#define REP(k) ((((DBG_REP) >> (k)) & 1ull) != 0ull)
#ifndef MK_MULTI
#define MK_MULTI 0
#endif

#define LAS __attribute__((address_space(3)))
typedef unsigned short bf16_t;
typedef short bf16x8 __attribute__((ext_vector_type(8)));
typedef short bf16x4 __attribute__((ext_vector_type(4)));
typedef float f32x4 __attribute__((ext_vector_type(4)));
typedef float f32x2 __attribute__((ext_vector_type(2)));
typedef float f32x16 __attribute__((ext_vector_type(16)));
typedef unsigned u32x4 __attribute__((ext_vector_type(4)));
typedef unsigned u32x2 __attribute__((ext_vector_type(2)));
typedef int i32x8 __attribute__((ext_vector_type(8)));

constexpr int NB = 8, SEQ = 8192, DM = 1024, CTXL = 256;
constexpr int NCTX = NB * CTXL;
constexpr int NLAT = NB * SEQ;
constexpr int NTOK = NCTX + NLAT;
constexpr int NCH = 132;
constexpr int NKEY = CTXL + SEQ;
constexpr int NEXP = 32;
constexpr int MAXRB = 1088;
constexpr int NTHREADS = 512;
constexpr int LDS_STAGE = 131072;
constexpr int LDS_MISC = 16384;
constexpr int LDS_BYTES = LDS_STAGE + LDS_MISC;

__device__ __forceinline__ unsigned f2bf(float f) { unsigned u = __builtin_bit_cast(unsigned, f); return (u + 0x7fffu + ((u >> 16) & 1u)) >> 16; }
__device__ __forceinline__ unsigned pk2(float lo, float hi) { unsigned r; asm("v_cvt_pk_bf16_f32 %0, %1, %2" : "=v"(r) : "v"(lo), "v"(hi)); return r; }
__device__ __forceinline__ float bf2f(unsigned short b) { return __builtin_bit_cast(float, ((unsigned)b) << 16); }
__device__ __forceinline__ float bflo(unsigned w) { return __builtin_bit_cast(float, w << 16); }
__device__ __forceinline__ float bfhi(unsigned w) { return __builtin_bit_cast(float, w & 0xffff0000u); }
__device__ __forceinline__ float wave_sum(float v) {
#pragma unroll
    for (int o = 32; o >= 1; o >>= 1) v += __shfl_xor(v, o);
    return v;
}
__device__ __forceinline__ float wave_max(float v) {
#pragma unroll
    for (int o = 32; o >= 1; o >>= 1) v = fmaxf(v, __shfl_xor(v, o));
    return v;
}

__device__ __forceinline__ float clamp448(float x) { return __builtin_amdgcn_fmed3f(x, -448.f, 448.f); }
__device__ __forceinline__ unsigned pk4_fp8(float a, float b, float c, float d) {
    int w = 0; w = __builtin_amdgcn_cvt_pk_fp8_f32(clamp448(a), clamp448(b), w, false); w = __builtin_amdgcn_cvt_pk_fp8_f32(clamp448(c), clamp448(d), w, true); return (unsigned)w;
}
__device__ __forceinline__ unsigned pk4_fp8_nc(float a, float b, float c, float d) {
    int w = 0; w = __builtin_amdgcn_cvt_pk_fp8_f32(a, b, w, false); w = __builtin_amdgcn_cvt_pk_fp8_f32(c, d, w, true); return (unsigned)w;
}
__device__ __forceinline__ f32x4 fma4(const f32x4 a, const float s, const f32x4 b) { f32x4 r; r.x = __builtin_fmaf(a.x, s, b.x); r.y = __builtin_fmaf(a.y, s, b.y); r.z = __builtin_fmaf(a.z, s, b.z); r.w = __builtin_fmaf(a.w, s, b.w); return r; }
__device__ __forceinline__ u32x2 bf8_to_fp8(const u32x4 w) { u32x2 o; o.x = pk4_fp8(bflo(w.x), bfhi(w.x), bflo(w.y), bfhi(w.y)); o.y = pk4_fp8(bflo(w.z), bfhi(w.z), bflo(w.w), bfhi(w.w)); return o; }
constexpr float W8_SCALE = 32.f, W8_INV = 1.f / 32.f;
__device__ __forceinline__ float sigmoidf_(float x) { return __builtin_amdgcn_rcpf(1.f + __builtin_amdgcn_exp2f(-1.4426950408889634f * x)); }
__device__ __forceinline__ float logsigmoidf_(float x) { return fminf(x, 0.f) - log1pf(__expf(-fabsf(x))); }

#define XB_TMO      128
#define XB_XCNT(j)  (256  + 64 * (j))
#define XB_XSUB(j)  (1280 + 64 * (j))
#define XB_XGEN(j)  (2304 + 64 * (j))
#define XB_TOP      3328
#define XB_TOPGEN   3392
#define XCD_BAR_WORDS 3456
#define XB_SPIN_CAP (1u << 22)

__device__ __forceinline__ unsigned xb_ld(unsigned* p)              { return __hip_atomic_load(p, __ATOMIC_RELAXED, __HIP_MEMORY_SCOPE_AGENT); }
__device__ __forceinline__ unsigned xb_add(unsigned* p, unsigned v) { return __hip_atomic_fetch_add(p, v, __ATOMIC_RELAXED, __HIP_MEMORY_SCOPE_AGENT); }
__device__ __forceinline__ unsigned xb_xcc_id() { return (unsigned)__builtin_amdgcn_s_getreg((3 << 11) | 20) & 0xFu; }
#define XB_SPIN(cond, bar) do { unsigned _sp = 0; while (cond) { __builtin_amdgcn_s_sleep(1); \
    if ((++_sp & 255u) == 0u) { if (xb_ld(&(bar)[XB_TMO])) break; if (_sp > XB_SPIN_CAP) { atomicAdd(&(bar)[XB_TMO], 1u); break; } } } } while (0)

struct XcdBarrier { unsigned* bar; unsigned x; volatile LAS unsigned* st; };

__device__ __forceinline__ XcdBarrier xcd_barrier_post(unsigned* bar, volatile LAS unsigned* st) {
    XcdBarrier b; b.bar = bar; b.x = xb_xcc_id(); b.st = st;
    if (threadIdx.x == 0) (void)xb_add(&bar[XB_XCNT(b.x)], 1u);
    return b;
}
__device__ __forceinline__ void xcd_barrier_complete(unsigned* bar, unsigned x, unsigned& nloc, unsigned& nx) {
    const unsigned G = gridDim.x * gridDim.y * gridDim.z;
    unsigned sum, cnt, mine, sp = 0u;
    for (;;) {
        sum = 0u; cnt = 0u; mine = 0u;
#pragma unroll
        for (unsigned j = 0; j < 16; ++j) { const unsigned c = xb_ld(&bar[XB_XCNT(j)]); sum += c; cnt += (c > 0u) ? 1u : 0u; mine = (j == x) ? c : mine; }
        if (sum == G) break;
        __builtin_amdgcn_s_sleep(1);
        if ((++sp & 255u) == 0u) { if (xb_ld(&bar[XB_TMO])) break; if (sp > XB_SPIN_CAP) { atomicAdd(&bar[XB_TMO], 1u); break; } }
    }
    nloc = mine > 0u ? mine : 1u; nx = cnt > 0u ? cnt : 1u;
}
__device__ __forceinline__ void xcd_barrier(const XcdBarrier& b) {
    asm volatile("s_waitcnt vmcnt(0)" ::: "memory");
    __syncthreads();
    if (threadIdx.x == 0) {
        unsigned* bar = b.bar;
        __builtin_amdgcn_s_waitcnt(0);
        unsigned nloc = b.st[0], nx = b.st[1];
        if (nloc == 0u) { xcd_barrier_complete(bar, b.x, nloc, nx); b.st[0] = nloc; b.st[1] = nx; }
        const unsigned old = xb_add(&bar[XB_XSUB(b.x)], 1u);
        const unsigned gen = old / nloc;
        if (old + 1u == (gen + 1u) * nloc) {
            __builtin_amdgcn_fence(__ATOMIC_RELEASE, "agent");
            asm volatile("s_waitcnt vmcnt(0)" ::: "memory");
            const unsigned og = xb_add(&bar[XB_TOP], 1u);
            const unsigned tg = og / nx;
            if (og + 1u == (tg + 1u) * nx) xb_add(&bar[XB_TOPGEN], 1u);
            else XB_SPIN(xb_ld(&bar[XB_TOPGEN]) == tg, bar);
            __builtin_amdgcn_fence(__ATOMIC_ACQUIRE, "agent");
            xb_add(&bar[XB_XGEN(b.x)], 1u);
            asm volatile("s_waitcnt vmcnt(0)" ::: "memory");
        } else {
            XB_SPIN(xb_ld(&bar[XB_XGEN(b.x)]) == gen, bar);
            __builtin_amdgcn_fence(__ATOMIC_ACQUIRE, "agent");
            asm volatile("s_waitcnt vmcnt(0)" ::: "memory");
        }
    }
    __syncthreads();
}

constexpr size_t al256(size_t x) { return (x + 255) & ~(size_t)255; }
constexpr size_t WS_CTL    = 0;
constexpr size_t CTL_BYTES = 65536;
constexpr size_t WS_MODS   = WS_CTL + CTL_BYTES;
constexpr size_t MODS_BYTES = al256((size_t)2 * 9 * 6144 * 4);
constexpr size_t WS_ZERO_BYTES = WS_MODS + MODS_BYTES;
constexpr size_t WS_GW     = WS_ZERO_BYTES;
constexpr size_t WS_CB     = WS_GW + (size_t)2 * 9 * 1024 * 32 * 4;
constexpr size_t WS_S5K    = al256(WS_CB + 2 * 9 * 32 * 4);
constexpr size_t WS_S5A64  = WS_S5K + (size_t)16 * 2 * 64 * 256 * 4;
constexpr size_t WS_WIN0T  = al256(WS_S5A64 + 2 * 16 * 64 * 2 * 4);
constexpr size_t WS_WOUT0T = WS_WIN0T + (size_t)3072 * 1024 * 2;
constexpr size_t WS_WIN1T  = WS_WOUT0T + (size_t)1024 * 1024 * 2;
constexpr size_t WS_WOUT1T = WS_WIN1T + (size_t)1536 * 1024 * 2;
constexpr size_t WS_WGLUT  = WS_WOUT1T + (size_t)1024 * 1024 * 2;
constexpr size_t WS_S5TE   = WS_WGLUT + (size_t)256 * 256 * 2;
constexpr size_t WS_S5F    = WS_S5TE + (size_t)16 * 1024 * 1280 * 2;
constexpr size_t WS_WGU    = WS_S5F + (size_t)16 * 256 * 1024 * 2;
constexpr size_t WS_WD     = WS_WGU + (size_t)32 * 2048 * 1024;
constexpr size_t WS_HCTX   = WS_WD + (size_t)32 * 1024 * 1024;
constexpr size_t WS_TOPE   = WS_HCTX + (size_t)NCTX * 1024 * 4;
constexpr size_t WS_TOPG   = WS_TOPE + (size_t)NTOK * 4 * 4;
constexpr size_t WS_RANK   = WS_TOPG + (size_t)NTOK * 4 * 4;
constexpr size_t WS_ROWTOK = WS_RANK + (size_t)NTOK * 4 * 4;
constexpr size_t WS_XN     = al256(WS_ROWTOK + (size_t)MAXRB * 256 * 4);
constexpr size_t WS_R      = WS_XN + (size_t)NTOK * 1024 * 2;
constexpr size_t WS_ACT8   = WS_XN + (size_t)NTOK * 1024;
constexpr size_t WS_OUT    = WS_ACT8 + (size_t)MAXRB * 256 * 1024;
constexpr size_t WS_MOE_END = WS_OUT + (size_t)MAXRB * 256 * 1024 * 2;
constexpr size_t PROJ512   = (size_t)NTOK * 512 * 2;
constexpr size_t R_QA = 0, R_KA = R_QA + PROJ512, R_VA = R_KA + PROJ512, R_OA = R_VA + PROJ512, R_QB = R_OA + PROJ512;
constexpr size_t R_KBR = R_QB + PROJ512;
constexpr size_t R_VBR = R_KBR + (size_t)NTOK * 128 * 2;
constexpr size_t R_G   = R_VBR + (size_t)NTOK * 128 * 2;
constexpr size_t R_KC0 = R_G + (size_t)NTOK * 32 * 4;
constexpr size_t R_VT0 = R_KC0 + (size_t)NB * 2 * NKEY * 64 * 2;
constexpr size_t R_CS  = R_VT0 + (size_t)NB * 2 * NKEY * 64 * 2;
constexpr size_t NSEQ_M = (size_t)NB * 8 * 2 * NCH;
constexpr size_t R_NS  = R_CS + NSEQ_M * 8192;
constexpr size_t R_ML  = R_NS + NSEQ_M * 256;
constexpr size_t R_BL  = R_ML + NSEQ_M * 4;
constexpr size_t R_MP  = R_BL + NSEQ_M * 4;
constexpr size_t R_BT  = R_MP + NSEQ_M * 4;
constexpr size_t R_PM  = R_BT + NSEQ_M * 256;
constexpr size_t R_GC  = R_PM + NSEQ_M * 256;
constexpr size_t R_L0_END = R_GC + NSEQ_M * 256;
constexpr size_t R_UX  = 0;
constexpr size_t R_Q1  = R_UX + (size_t)16 * 1280 * 1280 * 2;
constexpr size_t R_KV1 = R_Q1 + (size_t)NTOK * 768 * 2;
constexpr size_t R_KC1 = R_KV1 + (size_t)NTOK * 384 * 2;
constexpr size_t R_VT1 = R_KC1 + (size_t)NB * 3 * NKEY * 64 * 2;
constexpr size_t R_SLOC = R_VT1 + (size_t)NB * 3 * NKEY * 64 * 2;
constexpr size_t R_YG  = R_SLOC + (size_t)16 * 1280 * 256 * 4;
constexpr size_t R_Q8  = R_YG + (size_t)NLAT * 256 * 2;
constexpr size_t R_K8  = R_Q8 + (size_t)NLAT * 768;
constexpr size_t R_VT8 = R_K8 + (size_t)NB * 3 * NKEY * 64;
constexpr size_t R_L1_END = R_VT8 + (size_t)NB * 3 * NKEY * 64;
constexpr size_t R_BYTES = (R_L0_END > R_L1_END ? R_L0_END : R_L1_END);
constexpr size_t WS_END = (WS_R + R_BYTES > WS_MOE_END ? WS_R + R_BYTES : WS_MOE_END);

constexpr int CW_Q0 = 4096;
constexpr int CW_CNT = 8192;
constexpr int CW_TRIP = 8192 + 128;

struct Params {
    const float* in[44];
    float* out;
    unsigned char* ws;
    int ph_lo, ph_hi;
};

namespace pg8 {
constexpr int BM = 256, BK = 64, HALF = 128, HTB = HALF * BK * 2, NXCD = 8, WGM = 8;
__host__ __device__ __forceinline__ int lds_byte(int r, int c) { const int st = (r >> 4) * 2 + (c >> 5), rr = r & 15, cc = c & 31, ob = rr * 64 + cc * 2; return st * 1024 + (ob ^ (((ob >> 9) & 1) << 5)); }
__host__ __device__ __forceinline__ void stage_rc(int b, int& R, int& C) { const int st = b / 1024, sb = b % 1024, swz = sb ^ (((sb >> 9) & 1) << 5); R = (st >> 1) * 16 + swz / 64; C = (st & 1) * 32 + (swz % 64) / 2; }
__host__ __device__ __forceinline__ int perm32(int rho) { const int n = rho >> 4, i = rho & 15; return 8 * (i >> 2) + 4 * n + (i & 3); }

struct Unit { int pm, pn, g; };

__device__ __forceinline__ unsigned cvt_pk_bf16(float lo, float hi) { unsigned r; asm volatile("v_cvt_pk_bf16_f32 %0, %1, %2" : "=v"(r) : "v"(lo), "v"(hi)); return r; }

template <class Epi, class Sched>
__device__ __forceinline__ void gemm_phase(LAS unsigned char* lds, const Sched& S, const Epi& E, int K) {
    asm volatile("" : "+s"(K));
    const int tid = threadIdx.x, wid = __builtin_amdgcn_readfirstlane(tid >> 6), lane = tid & 63, wr = wid >> 2, wc = wid & 3, fr = lane & 15, fq = lane >> 4;
    const int nt = K / BK;
    int Rr[2], Cc[2]; unsigned voffB[2];
#pragma unroll
    for (int i = 0; i < 2; ++i) { int R, C; stage_rc(tid * 16 + i * 8192, R, C); const int Rb = Epi::PERM ? ((R & ~31) + perm32(R & 31)) : R;
        Rr[i] = R; Cc[i] = C; voffB[i] = (unsigned)Rb * (unsigned)S.ldb_bytes + (unsigned)C * 2u; }
    const size_t kstep = (size_t)(BK * 2);
    const size_t hstepB = (size_t)HALF * S.ldb_bytes;
    const unsigned ldsw = (unsigned)wid * 1024u;
    const int aoff = lds_byte(wr * 64 + fr, fq * 8), boff = lds_byte(wc * 32 + fr, fq * 8);
#define PG8_SA(b, h) (((b) * 2 + (h)) * HTB)
#define PG8_SB(b, h) ((4 + (b) * 2 + (h)) * HTB)
#define PG8_STAGE_B(bufoff, gbase) do { _Pragma("unroll") for (int _i = 0; _i < 2; ++_i) \
        __builtin_amdgcn_global_load_lds((const unsigned*)((const char*)(gbase) + voffB[_i]), (LAS unsigned*)(lds + (bufoff) + ldsw + _i * 8192), 16, 0, 0); } while (0)
#define PG8_STAGE_A(bufoff, gbase, o0, o1) do { \
        __builtin_amdgcn_global_load_lds((const unsigned*)((const char*)(gbase) + (o0)), (LAS unsigned*)(lds + (bufoff) + ldsw), 16, 0, 0); \
        __builtin_amdgcn_global_load_lds((const unsigned*)((const char*)(gbase) + (o1)), (LAS unsigned*)(lds + (bufoff) + ldsw + 8192), 16, 0, 0); } while (0)
#define PG8_LDA(dst, b, h) do { _Pragma("unroll") for (int m = 0; m < 4; ++m) _Pragma("unroll") for (int k = 0; k < 2; ++k) dst[m][k] = *(const LAS bf16x8*)(lds + PG8_SA(b, h) + aoff + m * 2048 + k * 1024); } while (0)
#define PG8_LDB(dst, b, h) do { _Pragma("unroll") for (int n = 0; n < 2; ++n) _Pragma("unroll") for (int k = 0; k < 2; ++k) dst[n][k] = *(const LAS bf16x8*)(lds + PG8_SB(b, h) + boff + n * 2048 + k * 1024); } while (0)
#define PG8_MMA(ai, bj, At, Bt) do { __builtin_amdgcn_s_setprio(1); _Pragma("unroll") for (int m = 0; m < 4; ++m) _Pragma("unroll") for (int n = 0; n < 2; ++n) _Pragma("unroll") for (int k = 0; k < 2; ++k) \
        acc[ai][bj][m][n] = __builtin_amdgcn_mfma_f32_16x16x32_bf16(Bt[n][k], At[m][k], acc[ai][bj][m][n], 0, 0, 0); __builtin_amdgcn_s_setprio(0); } while (0)
#define PG8_WAIT_V(n) asm volatile("s_waitcnt vmcnt(" #n ")" ::: "memory")
#define PG8_WAIT_L(n) asm volatile("s_waitcnt lgkmcnt(" #n ")" ::: "memory")
#define PG8_BAR __builtin_amdgcn_s_barrier()
#define PG8_SCHED __builtin_amdgcn_sched_barrier(0)
    Unit cur, nxt; int ui = 0;
    if (!S.next(0, cur)) return;
    f32x4 acc[2][2][4][2];
#pragma unroll
    for (int a = 0; a < 2; ++a)
#pragma unroll
        for (int b = 0; b < 2; ++b)
#pragma unroll
            for (int m = 0; m < 4; ++m)
#pragma unroll
                for (int n = 0; n < 2; ++n) acc[a][b][m][n] = (f32x4){0.f, 0.f, 0.f, 0.f};
    bf16x8 At[4][2], B0[2][2], B1[2][2];
    const char* cA = S.a_base(cur); const char* cB = S.b_base(cur);
    unsigned c00 = S.a_off(cur, Rr[0]) + Cc[0] * 2u, c01 = S.a_off(cur, Rr[1]) + Cc[1] * 2u, c10 = S.a_off(cur, HALF + Rr[0]) + Cc[0] * 2u, c11 = S.a_off(cur, HALF + Rr[1]) + Cc[1] * 2u;
    PG8_STAGE_B(PG8_SB(0, 0), cB); PG8_STAGE_B(PG8_SB(0, 1), cB + hstepB); PG8_STAGE_A(PG8_SA(0, 0), cA, c00, c01); PG8_STAGE_A(PG8_SA(0, 1), cA, c10, c11);
    if (wr == 1) PG8_BAR;
    PG8_WAIT_V(2); PG8_BAR;
    PG8_STAGE_B(PG8_SB(1, 0), cB + kstep); PG8_STAGE_A(PG8_SA(1, 0), cA + kstep, c00, c01); PG8_STAGE_B(PG8_SB(1, 1), cB + hstepB + kstep);
    PG8_WAIT_V(6); PG8_BAR;
    for (;;) {
        const bool has_next = S.next(ui + 1, nxt);
        const char* nA = has_next ? S.a_base(nxt) : cA; const char* nB = has_next ? S.b_base(nxt) : cB;
        unsigned n00 = c00, n01 = c01, n10 = c10, n11 = c11;
        if (has_next) { n00 = S.a_off(nxt, Rr[0]) + Cc[0] * 2u; n01 = S.a_off(nxt, Rr[1]) + Cc[1] * 2u; n10 = S.a_off(nxt, HALF + Rr[0]) + Cc[0] * 2u; n11 = S.a_off(nxt, HALF + Rr[1]) + Cc[1] * 2u; }
        for (int t = 0; t < nt; t += 2) {
            const bool last = (t == nt - 2);
            const char* a1 = cA + (size_t)(t + 1) * kstep;
            const char* a2 = last ? nA : cA + (size_t)(t + 2) * kstep; const char* b2 = last ? nB : cB + (size_t)(t + 2) * kstep;
            const char* a3 = a2 + kstep; const char* b3 = b2 + kstep;
            const unsigned x00 = last ? n00 : c00, x01 = last ? n01 : c01, x10 = last ? n10 : c10, x11 = last ? n11 : c11;
            PG8_LDB(B0, 0, 0); PG8_LDB(B1, 0, 1); PG8_SCHED; PG8_LDA(At, 0, 0); PG8_STAGE_A(PG8_SA(1, 1), a1, c10, c11);
            PG8_WAIT_V(8); PG8_WAIT_L(0); PG8_BAR; PG8_MMA(0, 0, At, B0); PG8_MMA(0, 1, At, B1); PG8_BAR; PG8_SCHED;
            PG8_LDA(At, 0, 1); PG8_STAGE_B(PG8_SB(0, 0), b2); PG8_STAGE_B(PG8_SB(0, 1), b2 + hstepB); PG8_STAGE_A(PG8_SA(0, 0), a2, x00, x01);
            PG8_WAIT_V(8); PG8_WAIT_L(0); PG8_BAR; PG8_MMA(1, 0, At, B0); PG8_MMA(1, 1, At, B1); PG8_BAR; PG8_SCHED;
            PG8_LDB(B0, 1, 0); PG8_LDB(B1, 1, 1); PG8_SCHED; PG8_LDA(At, 1, 0); PG8_STAGE_A(PG8_SA(0, 1), a2, x10, x11);
            PG8_WAIT_V(8); PG8_WAIT_L(0); PG8_BAR; PG8_MMA(0, 0, At, B0); PG8_MMA(0, 1, At, B1); PG8_BAR; PG8_SCHED;
            PG8_LDA(At, 1, 1); PG8_STAGE_B(PG8_SB(1, 0), b3); PG8_STAGE_B(PG8_SB(1, 1), b3 + hstepB); PG8_STAGE_A(PG8_SA(1, 0), a3, x00, x01);
            PG8_WAIT_V(8); PG8_WAIT_L(0); PG8_BAR; PG8_MMA(1, 0, At, B0); PG8_MMA(1, 1, At, B1); PG8_BAR; PG8_SCHED;
        }
        if (wr == 0) PG8_BAR;
        E(acc, cur, wr, wc, fr, fq);
        if (!has_next) break;
#pragma unroll
        for (int a = 0; a < 2; ++a)
#pragma unroll
            for (int b = 0; b < 2; ++b)
#pragma unroll
                for (int m = 0; m < 4; ++m)
#pragma unroll
                    for (int n = 0; n < 2; ++n) acc[a][b][m][n] = (f32x4){0.f, 0.f, 0.f, 0.f};
        cur = nxt; cA = nA; cB = nB; c00 = n00; c01 = n01; c10 = n10; c11 = n11; ++ui;
        if (wr == 1) PG8_BAR;
    }
    PG8_WAIT_V(0);
    PG8_BAR;
#undef PG8_SA
#undef PG8_SB
#undef PG8_STAGE_A
#undef PG8_STAGE_B
#undef PG8_LDA
#undef PG8_LDB
#undef PG8_MMA
#undef PG8_WAIT_V
#undef PG8_WAIT_L
#undef PG8_BAR
#undef PG8_SCHED
}

template <class Epi, class Sched>
__device__ __forceinline__ void gemm_phase8(LAS unsigned char* lds, const Sched& S, const Epi& E, int K) {
    asm volatile("" : "+s"(K));
    const int tid = threadIdx.x, wid = __builtin_amdgcn_readfirstlane(tid >> 6), lane = tid & 63, wr = wid >> 2, wc = wid & 3, fr = lane & 15, fq = lane >> 4;
    const int nt = K / BK;
    int Rr[2], Cc[2]; unsigned voffB[2];
#pragma unroll
    for (int i = 0; i < 2; ++i) { int R, C; stage_rc(tid * 16 + i * 8192, R, C); const int Rb = Epi::PERM ? ((R & ~31) + perm32(R & 31)) : R;
        Rr[i] = R; Cc[i] = C; voffB[i] = (unsigned)Rb * (unsigned)S.ldb_bytes + (unsigned)C * 2u; }
    const size_t kstep = (size_t)(BK * 2);
    const size_t hstepB = (size_t)HALF * S.ldb_bytes;
    const unsigned ldsw = (unsigned)wid * 1024u;
    const int sl0 = 2 * fq + (fq >> 1), sl1 = 2 * fq + (1 ^ (fq >> 1));
    const int aoff0 = lds_byte(wr * 64 + fr, sl0 * 8), aoff1 = lds_byte(wr * 64 + fr, sl1 * 8), boff0 = lds_byte(wc * 32 + fr, sl0 * 8), boff1 = lds_byte(wc * 32 + fr, sl1 * 8);
#define PG8_SA(b, h) (((b) * 2 + (h)) * HTB)
#define PG8_SB(b, h) ((4 + (b) * 2 + (h)) * HTB)
#define PG8_STAGE_B(bufoff, gbase) do { _Pragma("unroll") for (int _i = 0; _i < 2; ++_i) \
        __builtin_amdgcn_global_load_lds((const unsigned*)((const char*)(gbase) + voffB[_i]), (LAS unsigned*)(lds + (bufoff) + ldsw + _i * 8192), 16, 0, 0); } while (0)
#define PG8_STAGE_A(bufoff, gbase, o0, o1) do { \
        __builtin_amdgcn_global_load_lds((const unsigned*)((const char*)(gbase) + (o0)), (LAS unsigned*)(lds + (bufoff) + ldsw), 16, 0, 0); \
        __builtin_amdgcn_global_load_lds((const unsigned*)((const char*)(gbase) + (o1)), (LAS unsigned*)(lds + (bufoff) + ldsw + 8192), 16, 0, 0); } while (0)
#define PG8_LDA(dst, b, h) do { _Pragma("unroll") for (int m = 0; m < 4; ++m) { const u32x4 p0_ = *(const LAS u32x4*)(lds + PG8_SA(b, h) + aoff0 + m * 2048), p1_ = *(const LAS u32x4*)(lds + PG8_SA(b, h) + aoff1 + m * 2048); \
        dst[m] = __builtin_bit_cast(i32x8, __builtin_shufflevector(p0_, p1_, 0, 1, 2, 3, 4, 5, 6, 7)); } } while (0)
#define PG8_LDB(dst, b, h) do { _Pragma("unroll") for (int n = 0; n < 2; ++n) { const u32x4 p0_ = *(const LAS u32x4*)(lds + PG8_SB(b, h) + boff0 + n * 2048), p1_ = *(const LAS u32x4*)(lds + PG8_SB(b, h) + boff1 + n * 2048); \
        dst[n] = __builtin_bit_cast(i32x8, __builtin_shufflevector(p0_, p1_, 0, 1, 2, 3, 4, 5, 6, 7)); } } while (0)
#define PG8_MMA(ai, bj, At, Bt) do { __builtin_amdgcn_s_setprio(1); _Pragma("unroll") for (int m = 0; m < 4; ++m) _Pragma("unroll") for (int n = 0; n < 2; ++n) \
        asm volatile("v_mfma_scale_f32_16x16x128_f8f6f4 %0, %1, %2, %0, %3, %3 op_sel_hi:[0,0,0]" : "+v"(acc[ai][bj][m][n]) : "v"(Bt[n]), "v"(At[m]), "v"(sc8)); __builtin_amdgcn_s_setprio(0); } while (0)
#define PG8_WAIT_V(n) asm volatile("s_waitcnt vmcnt(" #n ")" ::: "memory")
#define PG8_WAIT_L(n) asm volatile("s_waitcnt lgkmcnt(" #n ")" ::: "memory")
#define PG8_BAR __builtin_amdgcn_s_barrier()
#define PG8_SCHED __builtin_amdgcn_sched_barrier(0)
    Unit cur, nxt; int ui = 0;
    if (!S.next(0, cur)) return;
    f32x4 acc[2][2][4][2];
#pragma unroll
    for (int a = 0; a < 2; ++a)
#pragma unroll
        for (int b = 0; b < 2; ++b)
#pragma unroll
            for (int m = 0; m < 4; ++m)
#pragma unroll
                for (int n = 0; n < 2; ++n) acc[a][b][m][n] = (f32x4){0.f, 0.f, 0.f, 0.f};
    i32x8 At[4], B0[2], B1[2]; const int sc8 = 0x7F7F7F7F;

    const char* cA = S.a_base(cur); const char* cB = S.b_base(cur);
    unsigned c00 = S.a_off(cur, Rr[0]) + Cc[0] * 2u, c01 = S.a_off(cur, Rr[1]) + Cc[1] * 2u, c10 = S.a_off(cur, HALF + Rr[0]) + Cc[0] * 2u, c11 = S.a_off(cur, HALF + Rr[1]) + Cc[1] * 2u;
    PG8_STAGE_B(PG8_SB(0, 0), cB); PG8_STAGE_B(PG8_SB(0, 1), cB + hstepB); PG8_STAGE_A(PG8_SA(0, 0), cA, c00, c01); PG8_STAGE_A(PG8_SA(0, 1), cA, c10, c11);
    if (wr == 1) PG8_BAR;
    PG8_WAIT_V(2); PG8_BAR;
    PG8_STAGE_B(PG8_SB(1, 0), cB + kstep); PG8_STAGE_A(PG8_SA(1, 0), cA + kstep, c00, c01); PG8_STAGE_B(PG8_SB(1, 1), cB + hstepB + kstep);
    PG8_WAIT_V(6); PG8_BAR;
    for (;;) {
        const bool has_next = S.next(ui + 1, nxt);
        const char* nA = has_next ? S.a_base(nxt) : cA; const char* nB = has_next ? S.b_base(nxt) : cB;
        unsigned n00 = c00, n01 = c01, n10 = c10, n11 = c11;
        if (has_next) { n00 = S.a_off(nxt, Rr[0]) + Cc[0] * 2u; n01 = S.a_off(nxt, Rr[1]) + Cc[1] * 2u; n10 = S.a_off(nxt, HALF + Rr[0]) + Cc[0] * 2u; n11 = S.a_off(nxt, HALF + Rr[1]) + Cc[1] * 2u; }
        for (int t = 0; t < nt; t += 2) {
            const bool last = (t == nt - 2);
            const char* a1 = cA + (size_t)(t + 1) * kstep;
            const char* a2 = last ? nA : cA + (size_t)(t + 2) * kstep; const char* b2 = last ? nB : cB + (size_t)(t + 2) * kstep;
            const char* a3 = a2 + kstep; const char* b3 = b2 + kstep;
            const unsigned x00 = last ? n00 : c00, x01 = last ? n01 : c01, x10 = last ? n10 : c10, x11 = last ? n11 : c11;
            PG8_LDB(B0, 0, 0); PG8_LDB(B1, 0, 1); PG8_SCHED; PG8_LDA(At, 0, 0); PG8_STAGE_A(PG8_SA(1, 1), a1, c10, c11);
            PG8_WAIT_V(8); PG8_WAIT_L(0); PG8_BAR; PG8_MMA(0, 0, At, B0); PG8_MMA(0, 1, At, B1); PG8_BAR; PG8_SCHED;
            PG8_LDA(At, 0, 1); PG8_STAGE_B(PG8_SB(0, 0), b2); PG8_STAGE_B(PG8_SB(0, 1), b2 + hstepB); PG8_STAGE_A(PG8_SA(0, 0), a2, x00, x01);
            PG8_WAIT_V(8); PG8_WAIT_L(0); PG8_BAR; PG8_MMA(1, 0, At, B0); PG8_MMA(1, 1, At, B1); PG8_BAR; PG8_SCHED;
            PG8_LDB(B0, 1, 0); PG8_LDB(B1, 1, 1); PG8_SCHED; PG8_LDA(At, 1, 0); PG8_STAGE_A(PG8_SA(0, 1), a2, x10, x11);
            PG8_WAIT_V(8); PG8_WAIT_L(0); PG8_BAR; PG8_MMA(0, 0, At, B0); PG8_MMA(0, 1, At, B1); PG8_BAR; PG8_SCHED;
            PG8_LDA(At, 1, 1); PG8_STAGE_B(PG8_SB(1, 0), b3); PG8_STAGE_B(PG8_SB(1, 1), b3 + hstepB); PG8_STAGE_A(PG8_SA(1, 0), a3, x00, x01);
            PG8_WAIT_V(8); PG8_WAIT_L(0); PG8_BAR; PG8_MMA(1, 0, At, B0); PG8_MMA(1, 1, At, B1); PG8_BAR; PG8_SCHED;
        }
        asm volatile("s_nop 15\n\ts_nop 15" : "+v"(acc[1][1][0][0]), "+v"(acc[1][1][0][1]), "+v"(acc[1][1][1][0]), "+v"(acc[1][1][1][1]), "+v"(acc[1][1][2][0]), "+v"(acc[1][1][2][1]), "+v"(acc[1][1][3][0]), "+v"(acc[1][1][3][1]) :: "memory");
        if (wr == 0) PG8_BAR;
        E(acc, cur, wr, wc, fr, fq);
        if (!has_next) break;
#pragma unroll
        for (int a = 0; a < 2; ++a)
#pragma unroll
            for (int b = 0; b < 2; ++b)
#pragma unroll
                for (int m = 0; m < 4; ++m)
#pragma unroll
                    for (int n = 0; n < 2; ++n) acc[a][b][m][n] = (f32x4){0.f, 0.f, 0.f, 0.f};
        cur = nxt; cA = nA; cB = nB; c00 = n00; c01 = n01; c10 = n10; c11 = n11; ++ui;
        if (wr == 1) PG8_BAR;
    }
    PG8_WAIT_V(0);
    PG8_BAR;
#undef PG8_SA
#undef PG8_SB
#undef PG8_STAGE_A
#undef PG8_STAGE_B
#undef PG8_LDA
#undef PG8_LDB
#undef PG8_MMA
#undef PG8_WAIT_V
#undef PG8_WAIT_L
#undef PG8_BAR
#undef PG8_SCHED
}

struct GridOrder {
    int nM, nN, nG, G, c;
    __device__ __forceinline__ void init(int nM_, int nN_, int nG_) { nM = nM_; nN = nN_; nG = nG_; G = gridDim.x; c = blockIdx.x; }
    __device__ __forceinline__ bool next_mn(int i, Unit& u) const {
        const long L = (long)i * G + c; const int per = nM * nN; if (L >= (long)per * nG) return false;
        u.g = (int)(L / per); int wgid = (int)(L % per);
        if (nG == 1) { const int q = per / NXCD, r = per % NXCD, xcd = wgid % NXCD, off = wgid / NXCD; wgid = (xcd < r ? xcd * (q + 1) : r * (q + 1) + (xcd - r) * q) + off; }
        const int nig = WGM * nN, gid = wgid / nig, fm = gid * WGM, gsz = (nM - fm) < WGM ? (nM - fm) : WGM;
        u.pm = fm + ((wgid % nig) % gsz); u.pn = (wgid % nig) / gsz; return true;
    }
};
}
using pg8::Unit;

struct Frame { const Params* p; unsigned char* ws; LAS unsigned char* lds; int tid, lane, wid; };
#define WSP(T, off) ((T*)(ws + (off)))

__device__ __forceinline__ void phase_mods(const Params& P, unsigned char* ws, LAS unsigned char* lds) {
    const int tid = threadIdx.x;
    LAS float* sil = (LAS float*)lds;
    LAS float* part = sil + 9 * 1024;
    float* mods = WSP(float, WS_MODS);
    __syncthreads();
    for (int i = tid; i < 9 * 1024; i += NTHREADS) { const int r = i >> 10, k = i & 1023; const float v = r < 8 ? P.in[1][r * 1024 + k] : P.in[3][k]; sil[i] = v / (1.f + __expf(-v)); }
    __syncthreads();
    for (int u = blockIdx.x; u < 192; u += gridDim.x) {
        const int layer = u / 96, cb = u % 96;
        const float* W = P.in[layer ? 19 : 4]; const float* bm = P.in[layer ? 20 : 5];
        const int cl = tid & 63, kq = tid >> 6, col = cb * 64 + cl;
        float a0 = 0, a1 = 0, a2 = 0, a3 = 0, a4 = 0, a5 = 0, a6 = 0, a7 = 0, a8 = 0;
#pragma unroll 16
        for (int kk = 0; kk < 128; ++kk) { const int k = kq * 128 + kk;
            const float w = W[(size_t)k * 6144 + col];
            a0 += sil[0 * 1024 + k] * w; a1 += sil[1 * 1024 + k] * w; a2 += sil[2 * 1024 + k] * w; a3 += sil[3 * 1024 + k] * w; a4 += sil[4 * 1024 + k] * w;
            a5 += sil[5 * 1024 + k] * w; a6 += sil[6 * 1024 + k] * w; a7 += sil[7 * 1024 + k] * w; a8 += sil[8 * 1024 + k] * w; }
        __syncthreads();
        LAS float* pp = part + kq * 9 * 64 + cl;
        pp[0 * 64] = a0; pp[1 * 64] = a1; pp[2 * 64] = a2; pp[3 * 64] = a3; pp[4 * 64] = a4; pp[5 * 64] = a5; pp[6 * 64] = a6; pp[7 * 64] = a7; pp[8 * 64] = a8;
        __syncthreads();
        for (int i = tid; i < 9 * 64; i += NTHREADS) { const int r = i >> 6, c = i & 63;
            mods[((size_t)layer * 9 + r) * 6144 + cb * 64 + c] = (((part[0 * 576 + i] + part[1 * 576 + i]) + (part[2 * 576 + i] + part[3 * 576 + i])) + ((part[4 * 576 + i] + part[5 * 576 + i]) + (part[6 * 576 + i] + part[7 * 576 + i]))) + bm[cb * 64 + c]; }
    }
    __syncthreads();
}

__device__ __forceinline__ int cmap_col(int kind, int n, int nsrc) {
    if (kind == 1) {
        if (n < 2048) return n;
        if (n < 2816) return n + 32;
        if (n < 2848) return n - 2816 + 2048;
        return -1;
    }
    return n < nsrc ? n : -1;
}
__device__ __forceinline__ void convert_tile(const float* src, int nsrc, int K, bf16_t* dst, int kind, int tn, int tk, LAS float* tile  , int tid) {
    const int n0 = tn * 64, k0 = tk * 64;
    __syncthreads();
    {
        const int tx = tid & 15, ty = tid >> 4;
        const int n = n0 + tx * 4; const int sc = cmap_col(kind, n, nsrc);
#pragma unroll
        for (int i = 0; i < 2; ++i) { const int k = ty + 32 * i; f32x4 v = (f32x4){0.f, 0.f, 0.f, 0.f};
            if (sc >= 0) v = *(const f32x4*)(src + (size_t)(k0 + k) * nsrc + sc);
            tile[k * 65 + tx * 4 + 0] = v[0]; tile[k * 65 + tx * 4 + 1] = v[1]; tile[k * 65 + tx * 4 + 2] = v[2]; tile[k * 65 + tx * 4 + 3] = v[3]; }
    }
    __syncthreads();
    {
        const int kk = tid & 7, nn = tid >> 3;
        u32x4 w;
        w.x = pk2(tile[(kk * 8 + 0) * 65 + nn], tile[(kk * 8 + 1) * 65 + nn]); w.y = pk2(tile[(kk * 8 + 2) * 65 + nn], tile[(kk * 8 + 3) * 65 + nn]);
        w.z = pk2(tile[(kk * 8 + 4) * 65 + nn], tile[(kk * 8 + 5) * 65 + nn]); w.w = pk2(tile[(kk * 8 + 6) * 65 + nn], tile[(kk * 8 + 7) * 65 + nn]);
        *(u32x4*)(dst + (size_t)(n0 + nn) * K + k0 + kk * 8) = w;
    }
}
__device__ __forceinline__ void convert_tile8(const float* src, int nsrc, int K, unsigned char* dst, int tn, int tk, LAS float* tile  , int tid, int kind = 0) {
    const int n0 = tn * 64, k0 = tk * 64;
    __syncthreads();
    {   const int tx = tid & 15, ty = tid >> 4; const int sc = cmap_col(kind, n0 + tx * 4, nsrc);
#pragma unroll
        for (int i = 0; i < 2; ++i) { const int k = ty + 32 * i; f32x4 v = (f32x4){0.f, 0.f, 0.f, 0.f}; if (sc >= 0) v = *(const f32x4*)(src + (size_t)(k0 + k) * nsrc + sc);
            tile[k * 65 + tx * 4 + 0] = v[0]; tile[k * 65 + tx * 4 + 1] = v[1]; tile[k * 65 + tx * 4 + 2] = v[2]; tile[k * 65 + tx * 4 + 3] = v[3]; }
    }
    __syncthreads();
    {   const int kk = tid & 7, nn = tid >> 3; u32x2 w;
        w.x = pk4_fp8(tile[(kk * 8 + 0) * 65 + nn] * W8_SCALE, tile[(kk * 8 + 1) * 65 + nn] * W8_SCALE, tile[(kk * 8 + 2) * 65 + nn] * W8_SCALE, tile[(kk * 8 + 3) * 65 + nn] * W8_SCALE);
        w.y = pk4_fp8(tile[(kk * 8 + 4) * 65 + nn] * W8_SCALE, tile[(kk * 8 + 5) * 65 + nn] * W8_SCALE, tile[(kk * 8 + 6) * 65 + nn] * W8_SCALE, tile[(kk * 8 + 7) * 65 + nn] * W8_SCALE);
        *(u32x2*)(dst + (size_t)(n0 + nn) * K + k0 + kk * 8) = w;
    }
}
__device__ __forceinline__ void phase_convert_moe8(const Params& P, unsigned char* ws, LAS unsigned char* lds, int layer) {
    LAS float* tile = (LAS float*)lds; const int tid = threadIdx.x;
    const float* wgu = P.in[layer ? 39 : 15]; const float* wd = P.in[layer ? 41 : 17];
    constexpr int IG = 32 * 32 * 4, ID = 32 * 16 * 4;
    const int tx = tid & 15, ty = tid >> 4;
    f32x4 v[8];
#define CV_DECODE(IT, SRC, NSRC, DST, TN, KB) do { if ((IT) < IG) { const int e_ = (IT) >> 7, r_ = (IT) & 127; SRC = wgu + (size_t)e_ * 1024 * 2048; NSRC = 2048; DST = ws + WS_WGU + (size_t)e_ * 2048 * 1024; TN = r_ >> 2; KB = r_ & 3; } \
        else { const int i2_ = (IT) - IG, e_ = i2_ >> 6, r_ = i2_ & 63; SRC = wd + (size_t)e_ * 1024 * 1024; NSRC = 1024; DST = ws + WS_WD + (size_t)e_ * 1024 * 1024; TN = r_ >> 2; KB = r_ & 3; } } while (0)
#define CV_LOAD(IT) do { const float* s_; int ns_, tn_, kb_; unsigned char* d_; CV_DECODE(IT, s_, ns_, d_, tn_, kb_); (void)d_; \
        _Pragma("unroll") for (int i = 0; i < 8; ++i) v[i] = *(const f32x4*)(s_ + (size_t)(kb_ * 256 + ty + 32 * i) * ns_ + tn_ * 64 + tx * 4); } while (0)
    int it = blockIdx.x;
    if (it < IG + ID) CV_LOAD(it);
    for (; it < IG + ID; it += gridDim.x) {
        const float* src; int nsrc, tn, kb; unsigned char* dst; CV_DECODE(it, src, nsrc, dst, tn, kb); (void)src; (void)nsrc;
        __syncthreads();
#pragma unroll
        for (int i = 0; i < 8; ++i) { const int k = ty + 32 * i, sk = 4 * i;
#pragma unroll
            for (int q = 0; q < 4; ++q) tile[k * 65 + ((tx * 4 + q + sk) & 63)] = v[i][q]; }
        __syncthreads();
        if (it + (int)gridDim.x < IG + ID) CV_LOAD(it + (int)gridDim.x);
        {   const int kq = tid & 7, nn = tid >> 3, col = (nn + 4 * kq) & 63; unsigned w[8];
#pragma unroll
            for (int j = 0; j < 8; ++j) { const int kk = kq * 32 + j * 4;
                w[j] = pk4_fp8(tile[(kk + 0) * 65 + col] * W8_SCALE, tile[(kk + 1) * 65 + col] * W8_SCALE, tile[(kk + 2) * 65 + col] * W8_SCALE, tile[(kk + 3) * 65 + col] * W8_SCALE); }
            unsigned char* o = dst + (size_t)(tn * 64 + nn) * 1024 + kb * 256 + kq * 32;
            *(u32x4*)o = (u32x4){w[0], w[1], w[2], w[3]}; *(u32x4*)(o + 16) = (u32x4){w[4], w[5], w[6], w[7]};
        }
    }
#undef CV_LOAD
#undef CV_DECODE
    __syncthreads();
}
struct CsJob { const float* src; int nsrc, K, kind, tn, tk, fp8; unsigned char* dst; };
__device__ __forceinline__ CsJob cs_job(const Params& P, unsigned char* ws, int t) {
    const int T0 = 48 * 16, T1 = T0 + 256, T2 = T1 + 24 * 16, T3 = T2 + 256; CsJob j;
    if (t < T0)      { j.src = P.in[8];  j.nsrc = 2848; j.K = 1024; j.kind = 1; j.tn = t / 16; j.tk = t % 16; j.fp8 = 0; j.dst = ws + WS_WIN0T; }
    else if (t < T1) { j.src = P.in[9];  j.nsrc = 1024; j.K = 1024; j.kind = 0; j.tn = (t - T0) / 16; j.tk = (t - T0) % 16; j.fp8 = 1; j.dst = ws + WS_WOUT0T; }
    else if (t < T2) { j.src = P.in[23]; j.nsrc = 1408; j.K = 1024; j.kind = 2; j.tn = (t - T1) / 16; j.tk = (t - T1) % 16; j.fp8 = 1; j.dst = ws + WS_WIN1T; }
    else if (t < T3) { j.src = P.in[24]; j.nsrc = 1024; j.K = 1024; j.kind = 0; j.tn = (t - T2) / 16; j.tk = (t - T2) % 16; j.fp8 = 0; j.dst = ws + WS_WOUT1T; }
    else             { j.src = P.in[33]; j.nsrc = 256;  j.K = 256;  j.kind = 0; j.tn = (t - T3) / 4;  j.tk = (t - T3) % 4;  j.fp8 = 0; j.dst = ws + WS_WGLUT; }
    return j;
}
__device__ __forceinline__ void cs_load(const CsJob& j, int tid, f32x4& v0, f32x4& v1) {
    const int tx = tid & 15, ty = tid >> 4; const int sc = cmap_col(j.kind, j.tn * 64 + tx * 4, j.nsrc);
    v0 = (f32x4){0.f, 0.f, 0.f, 0.f}; v1 = v0;
    if (sc >= 0) { v0 = *(const f32x4*)(j.src + (size_t)(j.tk * 64 + ty) * j.nsrc + sc); v1 = *(const f32x4*)(j.src + (size_t)(j.tk * 64 + ty + 32) * j.nsrc + sc); }
}
__device__ __forceinline__ void phase_convert_small(const Params& P, unsigned char* ws, LAS unsigned char* lds) {
    LAS float* tile = (LAS float*)lds; const int tid = threadIdx.x;
    const int T4 = 48 * 16 + 256 + 24 * 16 + 256 + 16;
    int t = blockIdx.x; if (t >= T4) { __syncthreads(); return; }
    CsJob job = cs_job(P, ws, t); f32x4 v0, v1; cs_load(job, tid, v0, v1);
    for (; t < T4; t += gridDim.x) {
        const int tnx = t + gridDim.x; CsJob jn = job; f32x4 n0 = v0, n1 = v1;
        if (tnx < T4) { jn = cs_job(P, ws, tnx); cs_load(jn, tid, n0, n1); }
        __syncthreads();
        {   const int tx = tid & 15, ty = tid >> 4;
            tile[ty * 65 + tx * 4 + 0] = v0[0]; tile[ty * 65 + tx * 4 + 1] = v0[1]; tile[ty * 65 + tx * 4 + 2] = v0[2]; tile[ty * 65 + tx * 4 + 3] = v0[3];
            tile[(ty + 32) * 65 + tx * 4 + 0] = v1[0]; tile[(ty + 32) * 65 + tx * 4 + 1] = v1[1]; tile[(ty + 32) * 65 + tx * 4 + 2] = v1[2]; tile[(ty + 32) * 65 + tx * 4 + 3] = v1[3]; }
        __syncthreads();
        {   const int kk = tid & 7, nn = tid >> 3; const int n0_ = job.tn * 64, k0_ = job.tk * 64;
            if (job.fp8) { u32x2 w;
                w.x = pk4_fp8(tile[(kk * 8 + 0) * 65 + nn] * W8_SCALE, tile[(kk * 8 + 1) * 65 + nn] * W8_SCALE, tile[(kk * 8 + 2) * 65 + nn] * W8_SCALE, tile[(kk * 8 + 3) * 65 + nn] * W8_SCALE);
                w.y = pk4_fp8(tile[(kk * 8 + 4) * 65 + nn] * W8_SCALE, tile[(kk * 8 + 5) * 65 + nn] * W8_SCALE, tile[(kk * 8 + 6) * 65 + nn] * W8_SCALE, tile[(kk * 8 + 7) * 65 + nn] * W8_SCALE);
                *(u32x2*)(job.dst + (size_t)(n0_ + nn) * job.K + k0_ + kk * 8) = w; }
            else { u32x4 w;
                w.x = pk2(tile[(kk * 8 + 0) * 65 + nn], tile[(kk * 8 + 1) * 65 + nn]); w.y = pk2(tile[(kk * 8 + 2) * 65 + nn], tile[(kk * 8 + 3) * 65 + nn]);
                w.z = pk2(tile[(kk * 8 + 4) * 65 + nn], tile[(kk * 8 + 5) * 65 + nn]); w.w = pk2(tile[(kk * 8 + 6) * 65 + nn], tile[(kk * 8 + 7) * 65 + nn]);
                *(u32x4*)((bf16_t*)job.dst + (size_t)(n0_ + nn) * job.K + k0_ + kk * 8) = w; } }
        job = jn; v0 = n0; v1 = n1;
    }
    __syncthreads();
}
__device__ __forceinline__ void phase_convert_moe(const Params& P, unsigned char* ws, LAS unsigned char* lds, int layer) {
    LAS float* tile = (LAS float*)lds; const int tid = threadIdx.x;
    const float* wgu = P.in[layer ? 39 : 15]; const float* wd = P.in[layer ? 41 : 17];
    const int TG = 32 * 32 * 16, TD = 32 * 16 * 16;
    for (int t = blockIdx.x; t < TG + TD; t += gridDim.x) {
        if (t < TG) { const int e = t / 512, r = t % 512; convert_tile(wgu + (size_t)e * 1024 * 2048, 2048, 1024, WSP(bf16_t, WS_WGU) + (size_t)e * 2048 * 1024, 0, r / 16, r % 16, tile, tid); }
        else { const int t2 = t - TG, e = t2 / 256, r = t2 % 256; convert_tile(wd + (size_t)e * 1024 * 1024, 1024, 1024, WSP(bf16_t, WS_WD) + (size_t)e * 1024 * 1024, 0, r / 16, r % 16, tile, tid); }
    }
    __syncthreads();
}


__device__ __forceinline__ void cmul(float ar, float ai, float br, float bi, float& cr, float& ci) { cr = ar * br - ai * bi; ci = ar * bi + ai * br; }
__device__ __forceinline__ void s5_lam(const Params& P, int dir, int g, int p, float& lr, float& li, float& dt) {
    lr = P.in[25][(dir * 16 + g) * 64 + p]; li = P.in[26][(dir * 16 + g) * 64 + p]; dt = expf(P.in[27][dir * 16 + g]);
}
__device__ __forceinline__ void s5_apow(float lr, float li, float dt, float tau, float& re, float& im) {
    const float mag = __expf(lr * dt * tau); float s, c; __sincosf(li * dt * tau, &s, &c); re = mag * c; im = mag * s;
}
__device__ __forceinline__ void s5_bscale(float lr, float li, float dt, float& re, float& im) {
    float ar, ai; s5_apow(lr, li, dt, 1.f, ar, ai); ar -= 1.f; const float d = lr * lr + li * li; re = (ar * lr + ai * li) / d; im = (ai * lr - ar * li) / d;
}
__device__ __forceinline__ void phase_s5_kernels(const Params& P, unsigned char* ws, LAS unsigned char* lds) {
    const int tid = threadIdx.x;
    LAS float* zr = (LAS float*)lds;
    LAS float* zi = zr + 128;
    float* Kt = WSP(float, WS_S5K);
    for (int u = blockIdx.x; u < 16 * 2 * 32; u += gridDim.x) {
        const int g = u / 64, dir = (u / 32) & 1, tp = u % 32;
        __syncthreads();
        if (tid < 128) { const int sub = tid >> 6, p = tid & 63; float lr, li, dt; s5_lam(P, dir, g, p, lr, li, dt);
            float ar, ai, br, bi, r, i; s5_apow(lr, li, dt, (float)(tp * 2 + sub), ar, ai); s5_bscale(lr, li, dt, br, bi); cmul(ar, ai, br, bi, r, i); zr[tid] = r; zi[tid] = i; }
        __syncthreads();
        const int sub = tid >> 8, cj = tid & 255, c = cj >> 4, j = cj & 15;
        float acc = 0.f;
#pragma unroll 16
        for (int p = 0; p < 64; ++p) {
            const float cr = P.in[30][(g * 16 + c) * 64 + p], ci = P.in[31][(g * 16 + c) * 64 + p];
            const float br = P.in[28][(g * 64 + p) * 16 + j], bi = P.in[29][(g * 64 + p) * 16 + j];
            float tr, ti, ur, ui; cmul(zr[sub * 64 + p], zi[sub * 64 + p], br, bi, tr, ti); cmul(cr, ci, tr, ti, ur, ui); acc += ur;
        }
        Kt[(((size_t)g * 2 + dir) * 64 + tp * 2 + sub) * 256 + cj] = acc;
    }
    if (blockIdx.x == gridDim.x - 1) {
        float* A64 = WSP(float, WS_S5A64);
        for (int i = tid; i < 2 * 16 * 64; i += NTHREADS) { const int dir = i / 1024, g = (i / 64) & 15, p = i & 63; float lr, li, dt, r, im; s5_lam(P, dir, g, p, lr, li, dt); s5_apow(lr, li, dt, 64.f, r, im); A64[i * 2] = r; A64[i * 2 + 1] = im; }
    }
    __syncthreads();
}
__device__ __forceinline__ void phase_s5_tables(const Params& P, unsigned char* ws) {
    const float* __restrict__ Kt = WSP(float, WS_S5K);
    bf16_t* __restrict__ TE = WSP(bf16_t, WS_S5TE); bf16_t* __restrict__ Ft = WSP(bf16_t, WS_S5F);
    const float* __restrict__ Cr = P.in[30]; const float* __restrict__ Ci = P.in[31]; const float* __restrict__ Br = P.in[28]; const float* __restrict__ Bi = P.in[29];
    const size_t gsz = (size_t)gridDim.x * NTHREADS, gid = (size_t)blockIdx.x * NTHREADS + threadIdx.x;
#pragma unroll 4
    for (size_t i = gid; i < (size_t)16 * 1024 * 128; i += gsz) {
        const int g = (int)(i / (1024 * 128)), r = (int)((i / 128) % 1024), k8 = (int)(i % 128);
        const int t = r >> 4, c = r & 15, s = k8 >> 1, j0 = (k8 & 1) * 8;
        const int df = s <= t ? t - s : 0, db = s >= t ? s - t : 0;
        const float* pf = Kt + (((size_t)g * 2 + 0) * 64 + df) * 256 + c * 16 + j0; const float* pb = Kt + (((size_t)g * 2 + 1) * 64 + db) * 256 + c * 16 + j0;
        const f32x4 f0 = *(const f32x4*)pf, f1 = *(const f32x4*)(pf + 4), b0 = *(const f32x4*)pb, b1 = *(const f32x4*)(pb + 4);
        const float mf = s <= t ? 1.f : 0.f, mb = s >= t ? 1.f : 0.f;
        const f32x4 x0 = f0 * mf + b0 * mb, x1 = f1 * mf + b1 * mb;
        u32x4 w; w.x = pk2(x0[0], x0[1]); w.y = pk2(x0[2], x0[3]); w.z = pk2(x1[0], x1[1]); w.w = pk2(x1[2], x1[3]);
        *(u32x4*)(TE + ((size_t)g * 1024 + r) * 1280 + k8 * 8) = w;
    }
#pragma unroll 4
    for (size_t i = gid; i < (size_t)16 * 1024 * 128; i += gsz) {
        const int g = (int)(i / (1024 * 128)), r = (int)((i / 128) % 1024), dp = (int)(i % 128), dir = dp >> 6, p = dp & 63;
        const int t = r >> 4, c = r & 15;
        float lr, li, dt, ar, ai, zr, zi; s5_lam(P, dir, g, p, lr, li, dt);
        s5_apow(lr, li, dt, dir == 0 ? (float)(t + 1) : (float)(64 - t), ar, ai);
        cmul(Cr[(g * 16 + c) * 64 + p], Ci[(g * 16 + c) * 64 + p], ar, ai, zr, zi);
        bf16_t* row = TE + ((size_t)g * 1024 + r) * 1280 + 1024 + dir * 128;
        row[p] = (bf16_t)f2bf(zr); row[64 + p] = (bf16_t)f2bf(-zi);
    }
#pragma unroll 4
    for (size_t i = gid; i < (size_t)16 * 128 * 1024; i += gsz) {
        const int g = (int)(i / (128 * 1024)), dp = (int)((i / 1024) % 128), k = (int)(i % 1024), dir = dp >> 6, p = dp & 63, s = k >> 4, j = k & 15;
        float lr, li, dt, ar, ai, br, bi, tr, ti, zr, zi; s5_lam(P, dir, g, p, lr, li, dt);
        s5_apow(lr, li, dt, dir == 0 ? (float)(63 - s) : (float)s, ar, ai); s5_bscale(lr, li, dt, br, bi); cmul(ar, ai, br, bi, tr, ti);
        cmul(tr, ti, Br[(g * 64 + p) * 16 + j], Bi[(g * 64 + p) * 16 + j], zr, zi);
        Ft[((size_t)g * 256 + dir * 128 + p) * 1024 + k] = (bf16_t)f2bf(zr);
        Ft[((size_t)g * 256 + dir * 128 + 64 + p) * 1024 + k] = (bf16_t)f2bf(zi);
    }
}

__device__ __forceinline__ void phase_router_tables(const Params& P, unsigned char* ws, LAS unsigned char* lds) {
    LAS float* part = (LAS float*)lds;
    const float* mods = WSP(float, WS_MODS); bf16_t* GWH = WSP(bf16_t, WS_GW); bf16_t* GWL = GWH + (size_t)2 * 9 * 32 * 1024; float* CB = WSP(float, WS_CB);
    const size_t gsz = (size_t)gridDim.x * NTHREADS, gid = (size_t)blockIdx.x * NTHREADS + threadIdx.x;
    for (size_t i = gid; i < (size_t)2 * 9 * 1024 * 32; i += gsz) {
        const int layer = (int)(i / (9 * 32768)), r = (int)((i / 32768) % 9), k = (int)((i / 32) % 1024), e = (int)(i % 32);
        const float* m = mods + ((size_t)layer * 9 + r) * 6144;
        const float v = P.in[layer ? 22 : 7][k] * (1.f + m[4096 + k]) * P.in[layer ? 37 : 13][k * 32 + e];
        const unsigned h = f2bf(v), l = f2bf(v - __builtin_bit_cast(float, h << 16)); const size_t o = (((size_t)layer * 9 + r) * 32 + e) * 1024 + k;
        GWH[o] = (bf16_t)h; GWL[o] = (bf16_t)l;
    }
    for (int u = blockIdx.x; u < 18; u += gridDim.x) {
        const int layer = u / 9, r = u % 9, e = threadIdx.x & 31, ks = threadIdx.x >> 5;
        const float* m = mods + ((size_t)layer * 9 + r) * 6144; const float* W = P.in[layer ? 37 : 13];
        float a = 0.f;
#pragma unroll 16
        for (int k = ks * 64; k < ks * 64 + 64; ++k) a += m[3072 + k] * W[k * 32 + e];
        __syncthreads(); part[threadIdx.x] = a; __syncthreads();
        if (threadIdx.x < 32) { float t = P.in[layer ? 38 : 14][e];
            for (int q = 0; q < 16; ++q) t += part[q * 32 + e];
            CB[(layer * 9 + r) * 32 + e] = t; }
    }
}

__device__ __forceinline__ void phase_norm1(const Params& P, unsigned char* ws, int layer, const float* xlat, const float* xctx) {
    const int lane = threadIdx.x & 63, gw = blockIdx.x * 8 + (threadIdx.x >> 6), nw = gridDim.x * 8;
    const float* mods = WSP(float, WS_MODS) + (size_t)layer * 9 * 6144; const float* g = P.in[layer ? 21 : 6];
    bf16_t* XN = WSP(bf16_t, WS_XN);
    f32x4 nx[3][4]; f32x4 gg[4];
#define N1_ROWPTR(ROW) ((ROW) < NCTX ? xctx + (size_t)(ROW) * 1024 : xlat + (size_t)((ROW) - NCTX) * 1024)
#pragma unroll
    for (int i = 0; i < 4; ++i) gg[i] = *(const f32x4*)(g + i * 256 + lane * 4);
#pragma unroll
    for (int u = 0; u < 3; ++u) if (gw + u * nw < NTOK) { const float* x = N1_ROWPTR(gw + u * nw);
#pragma unroll
        for (int i = 0; i < 4; ++i) nx[u][i] = *(const f32x4*)(x + i * 256 + lane * 4); }
    for (int row0 = gw; row0 < NTOK; row0 += 3 * nw) {
#pragma unroll
        for (int u = 0; u < 3; ++u) { const int row = row0 + u * nw; if (row < NTOK) {
            const int r = row < NCTX ? 8 : (row - NCTX) >> 13;
            f32x4 v[4]; float ss = 0.f;
#pragma unroll
            for (int i = 0; i < 4; ++i) { v[i] = nx[u][i]; ss += v[i][0] * v[i][0] + v[i][1] * v[i][1] + v[i][2] * v[i][2] + v[i][3] * v[i][3]; }
            if (row + 3 * nw < NTOK) { const float* x = N1_ROWPTR(row + 3 * nw);
#pragma unroll
                for (int i = 0; i < 4; ++i) nx[u][i] = *(const f32x4*)(x + i * 256 + lane * 4); }
            const float* m = mods + (size_t)r * 6144; f32x4 sh[4], sc[4];
#pragma unroll
            for (int i = 0; i < 4; ++i) { const int k = i * 256 + lane * 4; sh[i] = *(const f32x4*)(m + k); sc[i] = *(const f32x4*)(m + 1024 + k); }
            ss = wave_sum(ss); const float rstd = rsqrtf(ss * (1.f / 1024.f) + 1e-6f);
#pragma unroll
            for (int i = 0; i < 4; ++i) { const int k = i * 256 + lane * 4;
                const f32x4 o = v[i] * rstd * gg[i] * (1.f + sc[i]) + sh[i];
                u32x2 w; w.x = pk2(o[0], o[1]); w.y = pk2(o[2], o[3]); *(u32x2*)(XN + (size_t)row * 1024 + k) = w; } } }
    }
#undef N1_ROWPTR
}

struct SchedPlain : pg8::GridOrder {
    const char* A; const char* Bt; unsigned lda_bytes; int ldb_bytes; size_t a_gstride, b_gstride;
    __device__ __forceinline__ bool next(int i, Unit& u) const { return next_mn(i, u); }
    __device__ __forceinline__ const char* a_base(const Unit& u) const { return A + (size_t)u.g * a_gstride + (size_t)u.pm * 256 * lda_bytes; }
    __device__ __forceinline__ unsigned a_off(const Unit&, int r) const { return (unsigned)r * lda_bytes; }
    __device__ __forceinline__ const char* b_base(const Unit& u) const { return Bt + (size_t)u.g * b_gstride + (size_t)u.pn * 256 * ldb_bytes; }
};
typedef const f32x4 (&AccRef)[2][2][4][2];
__device__ __forceinline__ u32x4 pack8(const f32x4& v0, const f32x4& v1) { u32x4 w; w.x = pg8::cvt_pk_bf16(v0[0], v0[1]); w.y = pg8::cvt_pk_bf16(v0[2], v0[3]); w.z = pg8::cvt_pk_bf16(v1[0], v1[1]); w.w = pg8::cvt_pk_bf16(v1[2], v1[3]); return w; }

struct EpiInProj0 { static constexpr bool PERM = true;
    unsigned char* R; const float* gate_bias;
    __device__ __forceinline__ void operator()(AccRef acc, const Unit& u, int wr, int wc, int fr, int fq) const {
        const int row0 = u.pm * 256 + wr * 64 + fr, c8 = wc * 32 + 8 * fq;
#pragma unroll
        for (int ai = 0; ai < 2; ++ai)
#pragma unroll
            for (int m = 0; m < 4; ++m) { const size_t row = (size_t)(row0 + ai * 128 + m * 16);
#pragma unroll
                for (int bj = 0; bj < 2; ++bj) { f32x4 v0 = acc[ai][bj][m][0], v1 = acc[ai][bj][m][1];
                    if (u.pn < 10) { const int sec = u.pn >> 1, col = (u.pn & 1) * 256 + bj * 128 + c8;
                        if (sec == 1) { v0 = v0 * 0.125f; v1 = v1 * 0.125f; }
                        *(u32x4*)(R + R_QA + (size_t)sec * PROJ512 + (row * 512 + col) * 2) = pack8(v0, v1); }
                    else if (u.pn == 10) { *(u32x4*)(R + (bj == 0 ? R_KBR : R_VBR) + (row * 128 + c8) * 2) = pack8(v0, v1); }
                    else if (bj == 0 && wc == 0) { float* gp = (float*)(R + R_G) + row * 32 + 8 * fq;
                        const f32x4 b0 = *(const f32x4*)(gate_bias + 8 * fq), b1 = *(const f32x4*)(gate_bias + 8 * fq + 4);
                        *(f32x4*)gp = v0 + b0; *(f32x4*)(gp + 4) = v1 + b1; } } }
    }
};
__device__ __forceinline__ void row_to_chunk(int row, int& n, int& s) {
    if (row < NCTX) { const int b = row >> 8, l = row & 255; n = 1024 + b * 4 + (l >> 6); s = l & 63; }
    else { const int r2 = row - NCTX, b = r2 >> 13, st = r2 & 8191; n = b * 128 + (st >> 6); s = st & 63; }
}
struct EpiInProj1 { static constexpr bool PERM = true;
    unsigned char* R;
    __device__ __forceinline__ void operator()(AccRef acc, const Unit& u, int wr, int wc, int fr, int fq) const {
        const int row0 = u.pm * 256 + wr * 64 + fr, c8 = wc * 32 + 8 * fq;
#pragma unroll
        for (int ai = 0; ai < 2; ++ai)
#pragma unroll
            for (int m = 0; m < 4; ++m) { const int rowi = row0 + ai * 128 + m * 16; const size_t row = (size_t)rowi;
#pragma unroll
                for (int bj = 0; bj < 2; ++bj) { const u32x4 w = pack8(acc[ai][bj][m][0] * W8_INV, acc[ai][bj][m][1] * W8_INV);
                    if (u.pn == 0) { const int c0 = bj * 128 + c8, g = c0 >> 4, j0 = c0 & 15; int n, s; row_to_chunk(rowi, n, s);
                        *(u32x4*)(R + R_UX + (((size_t)g * 1280 + n) * 1280 + s * 16 + j0) * 2) = w; }
                    else if (u.pn < 4) { *(u32x4*)(R + R_Q1 + (row * 768 + (u.pn - 1) * 256 + bj * 128 + c8) * 2) = w; }
                    else if (u.pn == 4) { *(u32x4*)(R + R_KV1 + (row * 384 + bj * 128 + c8) * 2) = w; }
                    else if (bj == 0) { *(u32x4*)(R + R_KV1 + (row * 384 + 256 + c8) * 2) = w; } } }
    }
};
struct EpiResid { static constexpr bool PERM = false;
    const float* xin; float* xout; const float* hin; float* hout; const float* gate  ; int row_base; float scale;
    __device__ __forceinline__ void operator()(AccRef acc, const Unit& u, int wr, int wc, int fr, int fq) const {
        const int row0 = row_base + u.pm * 256 + wr * 64 + fr, col0 = u.pn * 256 + wc * 32 + 4 * fq;
#pragma unroll
        for (int ai = 0; ai < 2; ++ai)
#pragma unroll
            for (int m = 0; m < 4; ++m) { const int row = row0 + ai * 128 + m * 16;
                const float* src; float* dst; const float* g;
                if (row < NCTX) { src = hin + (size_t)row * 1024; dst = hout + (size_t)row * 1024; g = gate + 8 * 6144; }
                else { const int r2 = row - NCTX; src = xin + (size_t)r2 * 1024; dst = xout + (size_t)r2 * 1024; g = gate + (r2 >> 13) * 6144; }
#pragma unroll
                for (int bj = 0; bj < 2; ++bj)
#pragma unroll
                    for (int n = 0; n < 2; ++n) { const int c = col0 + bj * 128 + n * 16;
                        *(f32x4*)(dst + c) = *(const f32x4*)(src + c) + *(const f32x4*)(g + c) * (acc[ai][bj][m][n] * scale); } }
    }
};
struct EpiS5F { static constexpr bool PERM = false;
    float* S;
    __device__ __forceinline__ void operator()(AccRef acc, const Unit& u, int wr, int wc, int fr, int fq) const {
        const int row0 = u.pm * 256 + wr * 64 + fr, col0 = wc * 32 + 4 * fq;
#pragma unroll
        for (int ai = 0; ai < 2; ++ai)
#pragma unroll
            for (int m = 0; m < 4; ++m) { float* rp = S + ((size_t)u.g * 1280 + row0 + ai * 128 + m * 16) * 256 + col0;
#pragma unroll
                for (int bj = 0; bj < 2; ++bj)
#pragma unroll
                    for (int n = 0; n < 2; ++n) *(f32x4*)(rp + bj * 128 + n * 16) = acc[ai][bj][m][n]; }
    }
};
__device__ __forceinline__ float gelu_tanh(float x) { const float u = 0.7978845608028654f * (x + 0.044715f * x * x * x); const float e = __builtin_amdgcn_exp2f(2.885390081777927f * u); const float th = 1.f - 2.f * __builtin_amdgcn_rcpf(e + 1.f); return 0.5f * x * (1.f + th); }
struct EpiS5Y { static constexpr bool PERM = true;
    const bf16_t* UX; bf16_t* Yg; const float* dskip;
    __device__ __forceinline__ void operator()(AccRef acc, const Unit& u, int wr, int wc, int fr, int fq) const {
        const int row0 = u.pm * 256 + wr * 64 + fr;
#pragma unroll
        for (int ai = 0; ai < 2; ++ai)
#pragma unroll
            for (int m = 0; m < 4; ++m) { const int n = row0 + ai * 128 + m * 16;
#pragma unroll
                for (int bj = 0; bj < 2; ++bj) { const int c0 = u.pn * 256 + bj * 128 + wc * 32 + 8 * fq, t = c0 >> 4, cc = c0 & 15;
                    const u32x4 uw = *(const u32x4*)(UX + ((size_t)u.g * 1280 + n) * 1280 + t * 16 + cc);
                    const float* ds = dskip + u.g * 16 + cc;
                    f32x4 v0 = acc[ai][bj][m][0], v1 = acc[ai][bj][m][1];
                    v0[0] = gelu_tanh(v0[0] + ds[0] * bflo(uw.x)); v0[1] = gelu_tanh(v0[1] + ds[1] * bfhi(uw.x)); v0[2] = gelu_tanh(v0[2] + ds[2] * bflo(uw.y)); v0[3] = gelu_tanh(v0[3] + ds[3] * bfhi(uw.y));
                    v1[0] = gelu_tanh(v1[0] + ds[4] * bflo(uw.z)); v1[1] = gelu_tanh(v1[1] + ds[5] * bfhi(uw.z)); v1[2] = gelu_tanh(v1[2] + ds[6] * bflo(uw.w)); v1[3] = gelu_tanh(v1[3] + ds[7] * bfhi(uw.w));
                    *(u32x4*)(Yg + ((size_t)n * 64 + t) * 256 + u.g * 16 + cc) = pack8(v0, v1); } }
    }
};
struct EpiGLU { static constexpr bool PERM = true;
    const bf16_t* Yg; bf16_t* MIX; const float* bglu;
    __device__ __forceinline__ void operator()(AccRef acc, const Unit& u, int wr, int wc, int fr, int fq) const {
        const int row0 = u.pm * 256 + wr * 64 + fr;
#pragma unroll
        for (int ai = 0; ai < 2; ++ai)
#pragma unroll
            for (int m = 0; m < 4; ++m) { const size_t tok = (size_t)(row0 + ai * 128 + m * 16);
#pragma unroll
                for (int bj = 0; bj < 2; ++bj) { const int c0 = bj * 128 + wc * 32 + 8 * fq;
                    const u32x4 yw = *(const u32x4*)(Yg + tok * 256 + c0); const float* bg = bglu + c0;
                    f32x4 v0 = acc[ai][bj][m][0], v1 = acc[ai][bj][m][1];
                    v0[0] = bflo(yw.x) * sigmoidf_(v0[0] + bg[0]); v0[1] = bfhi(yw.x) * sigmoidf_(v0[1] + bg[1]); v0[2] = bflo(yw.y) * sigmoidf_(v0[2] + bg[2]); v0[3] = bfhi(yw.y) * sigmoidf_(v0[3] + bg[3]);
                    v1[0] = bflo(yw.z) * sigmoidf_(v1[0] + bg[4]); v1[1] = bfhi(yw.z) * sigmoidf_(v1[1] + bg[5]); v1[2] = bflo(yw.w) * sigmoidf_(v1[2] + bg[6]); v1[3] = bfhi(yw.w) * sigmoidf_(v1[3] + bg[7]);
                    if (DBG_SKIP & 8) { v0 = v0 * 0.f; v1 = v1 * 0.f; }
                    *(u32x4*)(MIX + ((size_t)NCTX + tok) * 1024 + c0) = pack8(v0, v1); } }
    }
};

struct MoeTab { LAS int* pad_start  ; LAS int* rb_start  ; LAS unsigned char* rb_exp  ; };
__device__ __forceinline__ MoeTab moe_tab(LAS unsigned char* misc) { MoeTab t; t.pad_start = (LAS int*)(misc + 64); t.rb_start = (LAS int*)(misc + 64 + 256); t.rb_exp = misc + 64 + 512; return t; }
__device__ __forceinline__ void moe_build_tab(const unsigned* cnt, const MoeTab& T) {
    __syncthreads();
    if (threadIdx.x == 0) { int ps = 0, rb = 0; for (int e = 0; e < NEXP; ++e) { T.pad_start[e] = ps; T.rb_start[e] = rb; const int nb = ((int)cnt[e] + 255) >> 8; ps += nb * 256; rb += nb; } T.pad_start[NEXP] = ps; T.rb_start[NEXP] = rb; }
    __syncthreads();
    const int nrb = T.rb_start[NEXP];
    for (int i = threadIdx.x; i < nrb; i += NTHREADS) { int e = 0; while (T.rb_start[e + 1] <= i) ++e; T.rb_exp[i] = (unsigned char)e; }
    __syncthreads();
}
struct SchedMoe1 {
    const char* XN; const int* rowtok; const char* W; MoeTab T; int rb_lo, rb_hi, G, c; int ldb_bytes;
    __device__ __forceinline__ bool next(int i, Unit& u) const { const int x = c & 7, slot = c >> 3, W = G >> 3, nrb = rb_hi - rb_lo, r0 = (int)((long)nrb * x / 8), r1 = (int)((long)nrb * (x + 1) / 8);
        const long j = (long)i * W + slot; const int rbl = (int)(j >> 3); if (r0 + rbl >= r1) return false; u.pm = rb_lo + r0 + rbl; u.pn = (int)(j & 7); u.g = T.rb_exp[u.pm]; return true; }
    __device__ __forceinline__ const char* a_base(const Unit&) const { return XN; }
    __device__ __forceinline__ unsigned a_off(const Unit& u, int r) const { return (unsigned)rowtok[u.pm * 256 + r] * 1024u; }
    __device__ __forceinline__ const char* b_base(const Unit& u) const { return W + ((size_t)u.g * 2048 + (size_t)u.pn * 256) * 1024; }
};
struct EpiSwiGLU { static constexpr bool PERM = true;
    unsigned char* ACT; const float* bgu; int rb_lo;
    __device__ __forceinline__ void operator()(AccRef acc, const Unit& u, int wr, int wc, int fr, int fq) const {
        const int row0 = (u.pm - rb_lo) * 256 + wr * 64 + fr;
#pragma unroll
        for (int bj = 0; bj < 2; ++bj) { const int c0 = u.pn * 256 + bj * 128 + wc * 32 + 8 * fq;
            const f32x4 b0 = *(const f32x4*)(bgu + (size_t)u.g * 2048 + c0), b1 = *(const f32x4*)(bgu + (size_t)u.g * 2048 + c0 + 4);
#pragma unroll
            for (int ai = 0; ai < 2; ++ai)
#pragma unroll
                for (int m = 0; m < 4; ++m) { const f32x4 v0 = fma4(acc[ai][bj][m][0], W8_INV, b0), v1 = fma4(acc[ai][bj][m][1], W8_INV, b1);
                    float o[4];
#pragma unroll
                    for (int q = 0; q < 4; ++q) { const float hg = q < 2 ? v0[2 * q] : v1[2 * q - 4], hl = q < 2 ? v0[2 * q + 1] : v1[2 * q - 3];
                        const float glu = fminf(hg, 7.f), lin1 = __builtin_amdgcn_fmed3f(hl, -7.f, 7.f) + 1.f;
                        o[q] = glu * __builtin_amdgcn_rcpf(1.f + __builtin_amdgcn_exp2f(glu * (-1.702f * 1.4426950408889634f))) * lin1; }
                    *(unsigned*)(ACT + (size_t)(row0 + ai * 128 + m * 16) * 1024 + (c0 >> 1)) = pk4_fp8_nc(o[0], o[1], o[2], o[3]); } }
    }
};
struct SchedMoe2 {
    const char* ACT; const char* W; MoeTab T; int rb_lo, rb_hi, G, c; int ldb_bytes;
    __device__ __forceinline__ bool next(int i, Unit& u) const { const int x = c & 7, slot = c >> 3, W = G >> 3, nrb = rb_hi - rb_lo, r0 = (int)((long)nrb * x / 8), r1 = (int)((long)nrb * (x + 1) / 8);
        const long j = (long)i * W + slot; const int rbl = (int)(j >> 2); if (r0 + rbl >= r1) return false; u.pm = rb_lo + r0 + rbl; u.pn = (int)(j & 3); u.g = T.rb_exp[u.pm]; return true; }
    __device__ __forceinline__ const char* a_base(const Unit& u) const { return ACT + (size_t)(u.pm - rb_lo) * 256 * 1024; }
    __device__ __forceinline__ unsigned a_off(const Unit&, int r) const { return (unsigned)r * 1024u; }
    __device__ __forceinline__ const char* b_base(const Unit& u) const { return W + ((size_t)u.g * 1024 + (size_t)u.pn * 256) * 1024; }
};
struct EpiMoeOut { static constexpr bool PERM = true;
    unsigned char* OUT; const float* bd; int rb_lo;
    __device__ __forceinline__ void operator()(AccRef acc, const Unit& u, int wr, int wc, int fr, int fq) const {
        const int row0 = (u.pm - rb_lo) * 256 + wr * 64 + fr;
#pragma unroll
        for (int bj = 0; bj < 2; ++bj) { const int c0 = u.pn * 256 + bj * 128 + wc * 32 + 8 * fq;
            const f32x4 b0 = *(const f32x4*)(bd + (size_t)u.g * 1024 + c0), b1 = *(const f32x4*)(bd + (size_t)u.g * 1024 + c0 + 4);
#pragma unroll
            for (int ai = 0; ai < 2; ++ai)
#pragma unroll
                for (int m = 0; m < 4; ++m) { const f32x4 v0 = fma4(acc[ai][bj][m][0], W8_INV, b0), v1 = fma4(acc[ai][bj][m][1], W8_INV, b1);
                    *(u32x2*)(OUT + (size_t)(row0 + ai * 128 + m * 16) * 1024 + c0) = (u32x2){pk4_fp8(v0[0], v0[1], v0[2], v0[3]), pk4_fp8(v1[0], v1[1], v1[2], v1[3])}; } }
    }
};

__device__ __forceinline__ int crow(int r, int hi) { return (r & 3) + 8 * (r >> 2) + 4 * hi; }
__device__ __forceinline__ f32x16 mma32(LAS const bf16_t* A, int lda, LAS const bf16_t* Bt, int ldb, int K, f32x16 acc, int lane) {
    const int r = lane & 31, hh = lane >> 5;
    for (int ks = 0; ks < K; ks += 16) {
        const bf16x8 a = *(LAS const bf16x8*)(A + r * lda + ks + hh * 8);
        const bf16x8 b = *(LAS const bf16x8*)(Bt + r * ldb + ks + hh * 8);
        acc = __builtin_amdgcn_mfma_f32_32x32x16_bf16(a, b, acc, 0, 0, 0);
    }
    return acc;
}
__device__ __forceinline__ void lds_addf(LAS float* p, float v) { (void)__hip_atomic_fetch_add(p, v, __ATOMIC_RELAXED, __HIP_MEMORY_SCOPE_WORKGROUP); }
__device__ __forceinline__ int lds_addi(LAS int* p, int v) { return __hip_atomic_fetch_add(p, v, __ATOMIC_RELAXED, __HIP_MEMORY_SCOPE_WORKGROUP); }
constexpr f32x16 F16ZERO = {0.f, 0.f, 0.f, 0.f, 0.f, 0.f, 0.f, 0.f, 0.f, 0.f, 0.f, 0.f, 0.f, 0.f, 0.f, 0.f};

__device__ __forceinline__ int mlstm_row0(int b, int n) { return n < 4 ? b * 256 + n * 64 : NCTX + b * 8192 + (n - 4) * 64; }
__device__ __forceinline__ size_t mlstm_unit(int b, int h, int dir, int n) { return ((size_t)((b * 8 + h) * 2 + dir)) * NCH + n; }
constexpr int LP = 72;

template <bool TR>
__device__ __forceinline__ void load_tile64(const bf16_t* g, size_t ld, LAS bf16_t* dst, int tid) {
    const int row = tid >> 3, c8 = (tid & 7) * 8;
    const u32x4 w = *(const u32x4*)(g + (size_t)row * ld + c8);
    if (!TR) *(LAS u32x4*)(dst + row * LP + c8) = w;
    else { dst[(c8 + 0) * LP + row] = (bf16_t)(w.x & 0xffff); dst[(c8 + 1) * LP + row] = (bf16_t)(w.x >> 16); dst[(c8 + 2) * LP + row] = (bf16_t)(w.y & 0xffff); dst[(c8 + 3) * LP + row] = (bf16_t)(w.y >> 16);
           dst[(c8 + 4) * LP + row] = (bf16_t)(w.z & 0xffff); dst[(c8 + 5) * LP + row] = (bf16_t)(w.z >> 16); dst[(c8 + 6) * LP + row] = (bf16_t)(w.w & 0xffff); dst[(c8 + 7) * LP + row] = (bf16_t)(w.w >> 16); }
}

__device__ __forceinline__ void phase_mlstm_local(unsigned char* ws, LAS unsigned char* lds) {
    const int tid = threadIdx.x, lane = tid & 63, wid = tid >> 6;
    unsigned char* R = ws + WS_R;
    LAS bf16_t* Ks = (LAS bf16_t*)lds; LAS bf16_t* Vt = Ks + 64 * LP; LAS bf16_t* KwT = Vt + 64 * LP;
    LAS float* vec = (LAS float*)(lds + 4 * 64 * LP * 2);
    LAS float* lf_f = vec, *li_f = vec + 64, *lf_b = vec + 128, *li_b = vec + 192, *w_f = vec + 256, *w_b = vec + 320;
    const bf16_t* KA = (const bf16_t*)(R + R_KA); const bf16_t* VA = (const bf16_t*)(R + R_VA); const float* G = (const float*)(R + R_G);
    bf16_t* CS = (bf16_t*)(R + R_CS); float* NS = (float*)(R + R_NS); float* ML = (float*)(R + R_ML); float* BL = (float*)(R + R_BL);
    for (int u = blockIdx.x; u < NB * 8 * NCH; u += gridDim.x) {
        const int n = u % NCH, h = (u / NCH) & 7, b = u / (NCH * 8); const int row0 = mlstm_row0(b, n);
        __syncthreads();
        load_tile64<false>(KA + (size_t)row0 * 512 + h * 64, 512, Ks, tid);
        load_tile64<true>(VA + (size_t)row0 * 512 + h * 64, 512, Vt, tid);
        if (tid < 64) { const float* gp = G + (size_t)(row0 + tid) * 32 + h; li_f[tid] = gp[0]; lf_f[tid] = logsigmoidf_(gp[8]); li_b[tid] = gp[16]; lf_b[tid] = logsigmoidf_(gp[24]); }
        __syncthreads();
        if (tid < 64) {
            float bf = 0.f, tot_f = 0.f, bb = 0.f, tot_b = 0.f;
            for (int r = 0; r < 64; ++r) { const float a = lf_f[r], c = lf_b[r]; tot_f += a; tot_b += c; if (r <= tid) bf += a; if (r >= tid) bb += c; }
            const float wl_f = tot_f - bf + li_f[tid], wl_b = tot_b - bb + li_b[tid];
            const float mf = wave_max(wl_f), mb = wave_max(wl_b);
            w_f[tid] = __expf(wl_f - mf); w_b[tid] = __expf(wl_b - mb);
            if (tid == 0) { ML[mlstm_unit(b, h, 0, n)] = mf; ML[mlstm_unit(b, h, 1, n)] = mb; BL[mlstm_unit(b, h, 0, n)] = tot_f; BL[mlstm_unit(b, h, 1, n)] = tot_b; }
        }
        __syncthreads();
        {
            const int s = tid >> 3, c8 = (tid & 7) * 8; const float wf = w_f[s], wb = w_b[s];
#pragma unroll
            for (int q = 0; q < 8; ++q) { const float kv = bf2f(Ks[s * LP + c8 + q]); KwT[(c8 + q) * LP + s] = (bf16_t)f2bf(kv * wf); KwT[64 * LP + (c8 + q) * LP + s] = (bf16_t)f2bf(kv * wb); }
        }
        __syncthreads();
        {
            const int dir = wid >> 2, dvb = (wid >> 1) & 1, dkb = wid & 1;
            const f32x16 acc = mma32(Vt + dvb * 32 * LP, LP, KwT + dir * 64 * LP + dkb * 32 * LP, LP, 64, F16ZERO, lane);
            bf16_t* cs = CS + mlstm_unit(b, h, dir, n) * 4096;
#pragma unroll
            for (int r = 0; r < 16; ++r) cs[(dvb * 32 + crow(r, lane >> 5)) * 64 + dkb * 32 + (lane & 31)] = (bf16_t)f2bf(acc[r]);
        }
        if (tid < 128) { const int dir = tid >> 6, dk = tid & 63; float a = 0.f; for (int s = 0; s < 64; ++s) a += bf2f(KwT[dir * 64 * LP + dk * LP + s]); NS[mlstm_unit(b, h, dir, n) * 64 + dk] = a; }
    }
    __syncthreads();
}

__device__ __forceinline__ void phase_mlstm_scan(unsigned char* ws) {
    const int tid = threadIdx.x;
    unsigned char* R = ws + WS_R;
    bf16_t* CS = (bf16_t*)(R + R_CS); float* NS = (float*)(R + R_NS); const float* ML = (const float*)(R + R_ML); const float* BL = (const float*)(R + R_BL); float* MP = (float*)(R + R_MP);
    for (int q = blockIdx.x; q < NB * 8 * 2; q += gridDim.x) {
        const int dir = q & 1; const size_t base = (size_t)q * NCH;
        float C[8]; float nst = 0.f, m = -1e30f;
#pragma unroll
        for (int i = 0; i < 8; ++i) C[i] = 0.f;
        int n = dir ? 3 : 0;
        u32x4 cl = *(const u32x4*)(CS + (base + n) * 4096 + tid * 8); float nl = tid < 64 ? NS[(base + n) * 64 + tid] : 0.f; float ml = ML[base + n], bl = BL[base + n];
        for (int i = 0; i < NCH; ++i) {
            const int nn = (i + 1 < NCH) ? (dir ? ((i + 1) < 4 ? 3 - (i + 1) : 135 - (i + 1)) : i + 1) : n;
            const u32x4 cl2 = *(const u32x4*)(CS + (base + nn) * 4096 + tid * 8); const float nl2 = tid < 64 ? NS[(base + nn) * 64 + tid] : 0.f; const float ml2 = ML[base + nn], bl2 = BL[base + nn];
            float clf[8] = {bflo(cl.x), bfhi(cl.x), bflo(cl.y), bfhi(cl.y), bflo(cl.z), bfhi(cl.z), bflo(cl.w), bfhi(cl.w)};
            u32x4 st; st.x = pk2(C[0], C[1]); st.y = pk2(C[2], C[3]); st.z = pk2(C[4], C[5]); st.w = pk2(C[6], C[7]);
            *(u32x4*)(CS + (base + n) * 4096 + tid * 8) = st;
            if (tid < 64) NS[(base + n) * 64 + tid] = nst;
            if (tid == 0) MP[base + n] = m;
            const float mnew = fmaxf(bl + m, ml), dec = __expf(bl + m - mnew), fre = __expf(ml - mnew);
#pragma unroll
            for (int k = 0; k < 8; ++k) C[k] = dec * C[k] + fre * clf[k];
            nst = dec * nst + fre * nl; m = mnew;
            n = nn; cl = cl2; nl = nl2; ml = ml2; bl = bl2;
        }
    }
}

__device__ __forceinline__ void phase_mlstm_out(const Params& P, unsigned char* ws, LAS unsigned char* lds) {
    const int tid = threadIdx.x, lane = tid & 63, wid = tid >> 6;
    unsigned char* R = ws + WS_R;
    LAS bf16_t* Qs = (LAS bf16_t*)lds; LAS bf16_t* Ks = Qs + 64 * LP; LAS bf16_t* Vt = Ks + 64 * LP; LAS bf16_t* Cst = Vt + 64 * LP  ; LAS bf16_t* sW = Cst + 2 * 64 * LP  ;
    LAS float* H = (LAS float*)(lds + 7 * 64 * LP * 2);
    LAS float* vec = H + 2 * 64 * 65;
    LAS float* lf_f = vec, *li_f = vec + 64, *lf_b = vec + 128, *li_b = vec + 192;
    LAS float* rowc = vec + 256  , *colc = vec + 384  , *inter = vec + 512  , *emm = vec + 640  , *qn = vec + 768  , *rs = vec + 896  , *nsv = vec + 1024  ;
    const bf16_t* QA = (const bf16_t*)(R + R_QA); const bf16_t* KA = (const bf16_t*)(R + R_KA); const bf16_t* VA = (const bf16_t*)(R + R_VA); const bf16_t* OA = (const bf16_t*)(R + R_OA);
    const float* G = (const float*)(R + R_G); const bf16_t* CS = (const bf16_t*)(R + R_CS); const float* NS = (const float*)(R + R_NS); const float* MP = (const float*)(R + R_MP);
    bf16_t* MIX = WSP(bf16_t, WS_XN); const float* mnorm = P.in[11];
    for (int u = blockIdx.x; u < NB * 8 * NCH; u += gridDim.x) {
        const int n = u % NCH, h = (u / NCH) & 7, b = u / (NCH * 8); const int row0 = mlstm_row0(b, n);
        __syncthreads();
        load_tile64<false>(QA + (size_t)row0 * 512 + h * 64, 512, Qs, tid);
        load_tile64<false>(KA + (size_t)row0 * 512 + h * 64, 512, Ks, tid);
        load_tile64<true>(VA + (size_t)row0 * 512 + h * 64, 512, Vt, tid);
        load_tile64<false>(CS + mlstm_unit(b, h, 0, n) * 4096, 64, Cst, tid);
        load_tile64<false>(CS + mlstm_unit(b, h, 1, n) * 4096, 64, Cst + 64 * LP, tid);
        if (tid < 64) { const float* gp = G + (size_t)(row0 + tid) * 32 + h; li_f[tid] = gp[0]; lf_f[tid] = logsigmoidf_(gp[8]); li_b[tid] = gp[16]; lf_b[tid] = logsigmoidf_(gp[24]); }
        if (tid >= 64 && tid < 192) { const int d = (tid - 64) >> 6, k = (tid - 64) & 63; nsv[d * 64 + k] = NS[mlstm_unit(b, h, d, n) * 64 + k]; rs[d * 64 + k] = 0.f; }
        __syncthreads();
        if (tid < 128) {
            const int dir = tid >> 6, t = tid & 63; const float mprev = MP[mlstm_unit(b, h, dir, n)];
            float bt = 0.f, pm = -3.0e38f, bs = 0.f;
            if (dir == 0) { for (int s = 0; s <= t; ++s) { bs += lf_f[s]; pm = fmaxf(pm, li_f[s] - bs); } bt = bs; colc[t] = li_f[t] - bt; }
            else { for (int s = 63; s >= t; --s) { bs += lf_b[s]; pm = fmaxf(pm, li_b[s] - bs); } bt = bs; colc[64 + t] = li_b[t] - bt; }
            const float il = bt + mprev, mt = fmaxf(il, bt + pm);
            rowc[dir * 64 + t] = bt - mt; inter[dir * 64 + t] = __expf(il - mt); emm[dir * 64 + t] = __expf(-mt);
            float a = 0.f; for (int k = 0; k < 64; ++k) a += bf2f(Qs[t * LP + k]) * nsv[dir * 64 + k]; qn[dir * 64 + t] = a;
        }
        __syncthreads();
        {
            const int dir = wid >> 2, ti = (wid >> 1) & 1, sj = wid & 1, hi = lane >> 5, sl = lane & 31, s = sj * 32 + sl;
            const f32x16 acc = mma32(Qs + ti * 32 * LP, LP, Ks + sj * 32 * LP, LP, 64, F16ZERO, lane);
            const float cc = colc[dir * 64 + s];
#pragma unroll
            for (int r = 0; r < 16; ++r) { const int t = ti * 32 + crow(r, hi);
                const bool ok = dir == 0 ? (s <= t) : (s >= t);
                float v = ok ? acc[r] * __expf(rowc[dir * 64 + t] + cc) : 0.f;
                sW[dir * 64 * LP + t * LP + s] = (bf16_t)f2bf(v);
                v += __shfl_xor(v, 16); v += __shfl_xor(v, 8); v += __shfl_xor(v, 4); v += __shfl_xor(v, 2); v += __shfl_xor(v, 1);
                if (sl == 0) lds_addf(&rs[dir * 64 + t], v); }
        }
        __syncthreads();
        {
            const int dir = wid >> 2, ti = (wid >> 1) & 1, dj = wid & 1, hi = lane >> 5, dv = dj * 32 + (lane & 31);
            const f32x16 aqc = mma32(Qs + ti * 32 * LP, LP, Cst + dir * 64 * LP + dj * 32 * LP, LP, 64, F16ZERO, lane);
            const f32x16 asv = mma32(sW + dir * 64 * LP + ti * 32 * LP, LP, Vt + dj * 32 * LP, LP, 64, F16ZERO, lane);
#pragma unroll
            for (int r = 0; r < 16; ++r) { const int t = ti * 32 + crow(r, hi); const float it = (DBG_SKIP & 128) ? 0.f : inter[dir * 64 + t];
                const float den = fmaxf(fabsf(it * qn[dir * 64 + t] + rs[dir * 64 + t]), emm[dir * 64 + t]);
                H[(dir * 64 + t) * 65 + dv] = (it * aqc[r] + asv[r]) / den; }
        }
        __syncthreads();
        {
            const int t = tid >> 3, d8 = (tid & 7) * 8; float hv[8], ss = 0.f;
#pragma unroll
            for (int q = 0; q < 8; ++q) { hv[q] = ((DBG_SKIP & 256) ? 0.f : H[t * 65 + d8 + q]) + ((DBG_SKIP & 64) ? 0.f : H[(64 + t) * 65 + d8 + q]); ss += hv[q] * hv[q]; }
            ss += __shfl_xor(ss, 1); ss += __shfl_xor(ss, 2); ss += __shfl_xor(ss, 4);
            const float rstd = rsqrtf(ss * (1.f / 64.f) + 1e-6f);
            const u32x4 ow = *(const u32x4*)(OA + (size_t)(row0 + t) * 512 + h * 64 + d8);
            const float og[8] = {bflo(ow.x), bfhi(ow.x), bflo(ow.y), bfhi(ow.y), bflo(ow.z), bfhi(ow.z), bflo(ow.w), bfhi(ow.w)};
            float o[8];
#pragma unroll
            for (int q = 0; q < 8; ++q) o[q] = hv[q] * rstd * mnorm[h * 64 + d8 + q] * sigmoidf_(og[q]);
            u32x4 w; w.x = pk2(o[0], o[1]); w.y = pk2(o[2], o[3]); w.z = pk2(o[4], o[5]); w.w = pk2(o[6], o[7]);
            if (DBG_SKIP & 1) w = (u32x4){0u, 0u, 0u, 0u};
            *(u32x2*)((unsigned char*)MIX + (size_t)(row0 + t) * 1024 + h * 64 + d8) = bf8_to_fp8(w);
        }
    }
    __syncthreads();
}


__device__ __forceinline__ float wave_psum(float v, int lane) {
#pragma unroll
    for (int d = 1; d < 64; d <<= 1) { const float t = __shfl_up(v, d); if (lane >= d) v += t; }
    return v;
}
__device__ __forceinline__ float wave_pmax(float v, int lane) {
#pragma unroll
    for (int d = 1; d < 64; d <<= 1) { const float t = __shfl_up(v, d); if (lane >= d) v = fmaxf(v, t); }
    return v;
}
__device__ __forceinline__ float wave_smax(float v, int lane) {
#pragma unroll
    for (int d = 1; d < 64; d <<= 1) { const float t = __shfl_down(v, d); if (lane + d < 64) v = fmaxf(v, t); }
    return v;
}
__device__ __forceinline__ void st_tile_T(LAS bf16_t* dst, const u32x4 w, int row, int c8) {
    dst[(c8 + 0) * LP + row] = (bf16_t)(w.x & 0xffff); dst[(c8 + 1) * LP + row] = (bf16_t)(w.x >> 16); dst[(c8 + 2) * LP + row] = (bf16_t)(w.y & 0xffff); dst[(c8 + 3) * LP + row] = (bf16_t)(w.y >> 16);
    dst[(c8 + 4) * LP + row] = (bf16_t)(w.z & 0xffff); dst[(c8 + 5) * LP + row] = (bf16_t)(w.z >> 16); dst[(c8 + 6) * LP + row] = (bf16_t)(w.w & 0xffff); dst[(c8 + 7) * LP + row] = (bf16_t)(w.w >> 16);
}
__device__ __forceinline__ void phase_mlstm_local2(unsigned char* ws, LAS unsigned char* lds) {
    const int tid = threadIdx.x, lane = tid & 63, wid = tid >> 6, row = tid >> 3, c8 = (tid & 7) * 8;
    unsigned char* R = ws + WS_R;
    LAS bf16_t* Ks = (LAS bf16_t*)lds; LAS bf16_t* Vt = Ks + 64 * LP; LAS bf16_t* KwT = Vt + 64 * LP;
    LAS float* vec = (LAS float*)(lds + 4 * 64 * LP * 2); LAS float* w_f = vec, *w_b = vec + 64;
    const bf16_t* KA = (const bf16_t*)(R + R_KA); const bf16_t* VA = (const bf16_t*)(R + R_VA); const float* G = (const float*)(R + R_G);
    bf16_t* CS = (bf16_t*)(R + R_CS); float* NS = (float*)(R + R_NS); float* ML = (float*)(R + R_ML); float* BL = (float*)(R + R_BL);
    float* BT = (float*)(R + R_BT); float* PM = (float*)(R + R_PM); float* GC = (float*)(R + R_GC);
    const int NU = NB * 8 * NCH;
    int u = blockIdx.x;
    u32x4 kw = (u32x4){0u, 0u, 0u, 0u}, vw = kw; float g0 = 0.f, g1 = 0.f, g2 = 0.f, g3 = 0.f;
    if (u < NU) { const int n = u % NCH, h = (u / NCH) & 7, b = u / (NCH * 8), row0 = mlstm_row0(b, n);
        kw = *(const u32x4*)(KA + (size_t)(row0 + row) * 512 + h * 64 + c8); vw = *(const u32x4*)(VA + (size_t)(row0 + row) * 512 + h * 64 + c8);
        if (wid == 0) { const float* gp = G + (size_t)(row0 + lane) * 32 + h; g0 = gp[0]; g1 = gp[8]; g2 = gp[16]; g3 = gp[24]; } }
    for (; u < NU; u += gridDim.x) {
        const int n = u % NCH, h = (u / NCH) & 7, b = u / (NCH * 8);
        __syncthreads();
        *(LAS u32x4*)(Ks + row * LP + c8) = kw; st_tile_T(Vt, vw, row, c8);
        if (wid == 0) {
            const float li_f = g0, lf_f = logsigmoidf_(g1), li_b = g2, lf_b = logsigmoidf_(g3);
            const float bf = wave_psum(lf_f, lane), pb = wave_psum(lf_b, lane);
            const float tot_f = __shfl(bf, 63), tot_b = __shfl(pb, 63), bb = tot_b - pb + lf_b;
            const float wl_f = tot_f - bf + li_f, wl_b = tot_b - bb + li_b, mf = wave_max(wl_f), mb = wave_max(wl_b);
            w_f[lane] = __expf(wl_f - mf); w_b[lane] = __expf(wl_b - mb);
            const float gf = li_f - bf, gb = li_b - bb, pmf = wave_pmax(gf, lane), pmb = wave_smax(gb, lane);
            const size_t uf = mlstm_unit(b, h, 0, n), ub = mlstm_unit(b, h, 1, n);
            BT[uf * 64 + lane] = bf; BT[ub * 64 + lane] = bb; PM[uf * 64 + lane] = pmf; PM[ub * 64 + lane] = pmb; GC[uf * 64 + lane] = gf; GC[ub * 64 + lane] = gb;
            if (lane == 0) { ML[uf] = mf; ML[ub] = mb; BL[uf] = tot_f; BL[ub] = tot_b; }
        }
        __syncthreads();
        const int un = u + gridDim.x;
        if (un < NU) { const int n2 = un % NCH, h2 = (un / NCH) & 7, b2 = un / (NCH * 8), r2 = mlstm_row0(b2, n2);
            kw = *(const u32x4*)(KA + (size_t)(r2 + row) * 512 + h2 * 64 + c8); vw = *(const u32x4*)(VA + (size_t)(r2 + row) * 512 + h2 * 64 + c8);
            if (wid == 0) { const float* gp = G + (size_t)(r2 + lane) * 32 + h2; g0 = gp[0]; g1 = gp[8]; g2 = gp[16]; g3 = gp[24]; } }
        {   const float wf = w_f[row], wb = w_b[row];
#pragma unroll
            for (int q = 0; q < 8; ++q) { const float kv = bf2f(Ks[row * LP + c8 + q]); KwT[(c8 + q) * LP + row] = (bf16_t)f2bf(kv * wf); KwT[64 * LP + (c8 + q) * LP + row] = (bf16_t)f2bf(kv * wb); } }
        __syncthreads();
        {   const int dir = wid >> 2, dvb = (wid >> 1) & 1, dkb = wid & 1;
            const f32x16 acc = mma32(Vt + dvb * 32 * LP, LP, KwT + dir * 64 * LP + dkb * 32 * LP, LP, 64, F16ZERO, lane);
            bf16_t* cs = CS + mlstm_unit(b, h, dir, n) * 4096;
#pragma unroll
            for (int r = 0; r < 16; ++r) cs[(dvb * 32 + crow(r, lane >> 5)) * 64 + dkb * 32 + (lane & 31)] = (bf16_t)f2bf(acc[r]); }
        if (tid < 128) { const int dir = tid >> 6, dk = tid & 63; float a = 0.f;
#pragma unroll 8
            for (int s8 = 0; s8 < 64; s8 += 8) { const u32x4 w = *(LAS const u32x4*)(KwT + dir * 64 * LP + dk * LP + s8); a += ((bflo(w.x) + bfhi(w.x)) + (bflo(w.y) + bfhi(w.y))) + ((bflo(w.z) + bfhi(w.z)) + (bflo(w.w) + bfhi(w.w))); }
            NS[mlstm_unit(b, h, dir, n) * 64 + dk] = a; }
    }
    __syncthreads();
}

__device__ __forceinline__ void phase_mlstm_out2(const Params& P, unsigned char* ws, LAS unsigned char* lds) {
    const int tid = threadIdx.x, lane = tid & 63, wid = tid >> 6, row = tid >> 3, c8 = (tid & 7) * 8;
    unsigned char* R = ws + WS_R;
    LAS bf16_t* Qs = (LAS bf16_t*)lds; LAS bf16_t* Ks = Qs + 64 * LP; LAS bf16_t* Vt = Ks + 64 * LP; LAS bf16_t* Cst = Vt + 64 * LP  ; LAS bf16_t* sW = Cst + 2 * 64 * LP  ;
    LAS bf16_t* NsT = sW + 2 * 64 * LP  ; LAS bf16_t* Ones = NsT + 2 * 32 * LP  ;
    LAS float* H = (LAS float*)(lds + (7 * 64 + 3 * 32) * LP * 2);
    LAS float* vec = H + 2 * 64 * 65; LAS float* BTv = vec, *PMv = vec + 128, *GCv = vec + 256, *MPv = vec + 384;
    const bf16_t* QA = (const bf16_t*)(R + R_QA); const bf16_t* KA = (const bf16_t*)(R + R_KA); const bf16_t* VA = (const bf16_t*)(R + R_VA); const bf16_t* OA = (const bf16_t*)(R + R_OA);
    const bf16_t* CS = (const bf16_t*)(R + R_CS); const float* NS = (const float*)(R + R_NS); const float* MP = (const float*)(R + R_MP);
    const float* BT = (const float*)(R + R_BT); const float* PM = (const float*)(R + R_PM); const float* GC = (const float*)(R + R_GC);
    bf16_t* MIX = WSP(bf16_t, WS_XN); const float* mnorm = P.in[11];
    __syncthreads();
    for (int i = tid; i < 3 * 32 * LP; i += NTHREADS) NsT[i] = (bf16_t)((i >= 2 * 32 * LP && i < 2 * 32 * LP + 64) ? 0x3f80 : 0);
    const int NU = NB * 8 * NCH;
    int u = blockIdx.x;
    u32x4 qw = (u32x4){0u, 0u, 0u, 0u}, kw = qw, vw = qw, cfw = qw, cbw = qw, ow = qw; float pbt = 0.f, ppm = 0.f, pgc = 0.f, pns = 0.f, pmp = 0.f;
#define M3_PREFETCH(UU) do { const int n_ = (UU) % NCH, h_ = ((UU) / NCH) & 7, b_ = (UU) / (NCH * 8), r_ = mlstm_row0(b_, n_); const size_t go_ = (size_t)(r_ + row) * 512 + h_ * 64 + c8; \
        qw = *(const u32x4*)(QA + go_); kw = *(const u32x4*)(KA + go_); vw = *(const u32x4*)(VA + go_); ow = *(const u32x4*)(OA + go_); \
        cfw = *(const u32x4*)(CS + mlstm_unit(b_, h_, 0, n_) * 4096 + row * 64 + c8); cbw = *(const u32x4*)(CS + mlstm_unit(b_, h_, 1, n_) * 4096 + row * 64 + c8); \
        if (tid < 128) { const size_t uu_ = mlstm_unit(b_, h_, tid >> 6, n_); pbt = BT[uu_ * 64 + (tid & 63)]; ppm = PM[uu_ * 64 + (tid & 63)]; pgc = GC[uu_ * 64 + (tid & 63)]; pns = NS[uu_ * 64 + (tid & 63)]; pmp = MP[uu_]; } } while (0)
    if (u < NU) M3_PREFETCH(u);
    for (; u < NU; u += gridDim.x) {
        const int n = u % NCH, h = (u / NCH) & 7, b = u / (NCH * 8); const int row0 = mlstm_row0(b, n);
        __syncthreads();
        *(LAS u32x4*)(Qs + row * LP + c8) = qw; *(LAS u32x4*)(Ks + row * LP + c8) = kw; st_tile_T(Vt, vw, row, c8);
        *(LAS u32x4*)(Cst + row * LP + c8) = cfw; *(LAS u32x4*)(Cst + 64 * LP + row * LP + c8) = cbw;
        const u32x4 ocur = ow;
        if (tid < 128) { BTv[tid] = pbt; PMv[tid] = ppm; GCv[tid] = pgc; NsT[(tid >> 6) * 32 * LP + (tid & 63)] = (bf16_t)f2bf(pns); if ((tid & 63) == 0) MPv[tid >> 6] = pmp; }
        __syncthreads();
        if (u + (int)gridDim.x < NU) M3_PREFETCH(u + (int)gridDim.x);
        {
            const int dir = wid >> 2, ti = (wid >> 1) & 1, sj = wid & 1, hi = lane >> 5, s = sj * 32 + (lane & 31);
            const f32x16 acc = mma32(Qs + ti * 32 * LP, LP, Ks + sj * 32 * LP, LP, 64, F16ZERO, lane);
            const float cc = GCv[dir * 64 + s], mprev = MPv[dir];
#pragma unroll
            for (int r = 0; r < 16; ++r) { const int t = ti * 32 + crow(r, hi); const float bt = BTv[dir * 64 + t], mt = fmaxf(bt + mprev, bt + PMv[dir * 64 + t]);
                const bool ok = dir == 0 ? (s <= t) : (s >= t);
                const float v = ok ? acc[r] * __expf((bt - mt) + cc) : 0.f;
                sW[dir * 64 * LP + t * LP + s] = (bf16_t)f2bf(v); }
        }
        __syncthreads();
        {
            const int dir = wid >> 2, ti = (wid >> 1) & 1, dj = wid & 1, hi = lane >> 5, dv = dj * 32 + (lane & 31);
            const f32x16 aqc = mma32(Qs + ti * 32 * LP, LP, Cst + dir * 64 * LP + dj * 32 * LP, LP, 64, F16ZERO, lane);
            const f32x16 asv = mma32(sW + dir * 64 * LP + ti * 32 * LP, LP, Vt + dj * 32 * LP, LP, 64, F16ZERO, lane);
            const f32x16 aqn = mma32(Qs + ti * 32 * LP, LP, NsT + dir * 32 * LP, LP, 64, F16ZERO, lane);
            const f32x16 ars = mma32(sW + dir * 64 * LP + ti * 32 * LP, LP, Ones, LP, 64, F16ZERO, lane);
            const float mprev = MPv[dir];
#pragma unroll
            for (int r = 0; r < 16; ++r) { const int t = ti * 32 + crow(r, hi); const float bt = BTv[dir * 64 + t], il = bt + mprev, mt = fmaxf(il, bt + PMv[dir * 64 + t]), it = __expf(il - mt);
                const float qn = __shfl(aqn[r], hi * 32), rs = __shfl(ars[r], hi * 32);
                const float den = fmaxf(fabsf(it * qn + rs), __expf(-mt)), rden = __builtin_amdgcn_rcpf(den);
                H[(dir * 64 + t) * 65 + dv] = (it * aqc[r] + asv[r]) * rden; }
        }
        __syncthreads();
        {   const int t = row, d8 = c8; float hv[8], ss = 0.f;
#pragma unroll
            for (int q = 0; q < 8; ++q) { hv[q] = H[t * 65 + d8 + q] + H[(64 + t) * 65 + d8 + q]; ss += hv[q] * hv[q]; }
            ss += __shfl_xor(ss, 1); ss += __shfl_xor(ss, 2); ss += __shfl_xor(ss, 4);
            const float rstd = rsqrtf(ss * (1.f / 64.f) + 1e-6f);
            const float og[8] = {bflo(ocur.x), bfhi(ocur.x), bflo(ocur.y), bfhi(ocur.y), bflo(ocur.z), bfhi(ocur.z), bflo(ocur.w), bfhi(ocur.w)};
            float o[8];
#pragma unroll
            for (int q = 0; q < 8; ++q) o[q] = hv[q] * rstd * mnorm[h * 64 + d8 + q] * sigmoidf_(og[q]);
            u32x4 w; w.x = pk2(o[0], o[1]); w.y = pk2(o[2], o[3]); w.z = pk2(o[4], o[5]); w.w = pk2(o[6], o[7]);
            *(u32x2*)((unsigned char*)MIX + (size_t)(row0 + t) * 1024 + h * 64 + d8) = bf8_to_fp8(w);
        }
    }
#undef M3_PREFETCH
    __syncthreads();
}

__device__ __forceinline__ void qk_prep_tile(const bf16_t* src, size_t spitch, bf16_t* dst, size_t dpitch, const float* gain, bool rope, int pos0, int tid) {
    const int r = tid >> 3, q = tid & 7, i0 = (q & 3) * 4, d1 = (q >> 2) * 32 + i0, d2 = d1 + 16;
    const u32x2 w1 = *(const u32x2*)(src + (size_t)r * spitch + d1), w2 = *(const u32x2*)(src + (size_t)r * spitch + d2);
    float a[4] = {bflo(w1.x), bfhi(w1.x), bflo(w1.y), bfhi(w1.y)}, c[4] = {bflo(w2.x), bfhi(w2.x), bflo(w2.y), bfhi(w2.y)};
    if (gain) {
        float ss = 0.f;
#pragma unroll
        for (int i = 0; i < 4; ++i) ss += a[i] * a[i] + c[i] * c[i];
        ss += __shfl_xor(ss, 1); ss += __shfl_xor(ss, 2); ss += __shfl_xor(ss, 4);
        const float rstd = rsqrtf(ss * (1.f / 64.f) + 1e-6f);
#pragma unroll
        for (int i = 0; i < 4; ++i) { a[i] = (float)bf2f((bf16_t)f2bf(a[i] * rstd * gain[d1 + i])); c[i] = (float)bf2f((bf16_t)f2bf(c[i] * rstd * gain[d2 + i])); }
    }
    if (rope) {
        const int pos = pos0 + r; const float pc = (float)((q >> 2) ? (pos & 63) : (pos >> 6));
#pragma unroll
        for (int i = 0; i < 4; ++i) { const float inv = exp2f(-(float)(i0 + i) * (13.287712379549449f / 16.f)); float sn, cs; __sincosf(pc * inv, &sn, &cs);
            const float t1 = a[i], t2 = c[i]; a[i] = t1 * cs - t2 * sn; c[i] = t2 * cs + t1 * sn; }
    }
    u32x2 o1, o2; o1.x = pk2(a[0], a[1]); o1.y = pk2(a[2], a[3]); o2.x = pk2(c[0], c[1]); o2.y = pk2(c[2], c[3]);
    *(u32x2*)(dst + (size_t)r * dpitch + d1) = o1; *(u32x2*)(dst + (size_t)r * dpitch + d2) = o2;
}
__device__ __forceinline__ void phase_qkv_prep(LAS unsigned char* lds, const bf16_t* ksrc, size_t kpitch, const bf16_t* vsrc, size_t vpitch, bf16_t* qbuf, size_t qpitch, int HKV, int HQ,
                                               bf16_t* Kc, bf16_t* VT, const float* qgain, const float* kgain, bool ctx_q) {
    const int tid = threadIdx.x;
    LAS bf16_t* tl = (LAS bf16_t*)lds;
    const int nkv = NB * HKV * NCH;
    for (int u = blockIdx.x; u < nkv; u += gridDim.x) {
        const int j = u % NCH, kvh = (u / NCH) % HKV, b = u / (NCH * HKV);
        const int row0 = j < 4 ? b * 256 + j * 64 : NCTX + b * 8192 + (j - 4) * 64;
        const size_t key0 = (size_t)j * 64;
        qk_prep_tile(ksrc + (size_t)row0 * kpitch + kvh * 64, kpitch, Kc + (((size_t)b * HKV + kvh) * NKEY + key0) * 64, 64, kgain, j >= 4, (j - 4) * 64, tid);
        __syncthreads();
        { const int r = tid >> 3, c8 = (tid & 7) * 8; *(LAS u32x4*)(tl + r * LP + c8) = *(const u32x4*)(vsrc + (size_t)(row0 + r) * vpitch + kvh * 64 + c8); }
        __syncthreads();
        { const int dv = tid >> 3, k8 = (tid & 7) * 8; u32x4 w;
          w.x = (unsigned)tl[(k8 + 0) * LP + dv] | ((unsigned)tl[(k8 + 1) * LP + dv] << 16); w.y = (unsigned)tl[(k8 + 2) * LP + dv] | ((unsigned)tl[(k8 + 3) * LP + dv] << 16);
          w.z = (unsigned)tl[(k8 + 4) * LP + dv] | ((unsigned)tl[(k8 + 5) * LP + dv] << 16); w.w = (unsigned)tl[(k8 + 6) * LP + dv] | ((unsigned)tl[(k8 + 7) * LP + dv] << 16);
          *(u32x4*)(VT + (((size_t)b * HKV + kvh) * 64 + dv) * NKEY + key0 + k8) = w; }
    }
    const int ntile = (ctx_q ? NTOK : NLAT) / 64;
    for (int u = blockIdx.x; u < ntile * HQ; u += gridDim.x) {
        const int hq = u % HQ, tI = u / HQ; const int row0 = ctx_q ? tI * 64 : NCTX + tI * 64; const bool lat = row0 >= NCTX;
        if (!lat && !qgain) continue;
        bf16_t* qp = qbuf + (size_t)row0 * qpitch + hq * 64;
        qk_prep_tile(qp, qpitch, qp, qpitch, qgain, lat, lat ? ((row0 - NCTX) & 8191) : 0, tid);
    }
    __syncthreads();
}

struct AttnArgs {
    const bf16_t* Q; size_t qpitch; const bf16_t* Kc; const bf16_t* VT; bf16_t* O; size_t opitch; int ocol0; int HKV; const float* sink; int swa;
};
__device__ __forceinline__ void attn_unit_v1(const AttnArgs& A, LAS unsigned char* lds, int b, int kvh, int qrow0, int qpos0  ) {
    const int tid = threadIdx.x, lane = tid & 63, wid = tid >> 6, r32 = lane & 31, hh = lane >> 5;
    LAS bf16_t* Kb = (LAS bf16_t*)lds; LAS bf16_t* Vb = Kb + 2 * 64 * LP; LAS bf16_t* Ost = Vb + 2 * 64 * LP + wid * 32 * LP;
    const int head = kvh * 4 + (wid >> 1);
    const int qrow = qrow0 + 32 * (wid & 1) + r32;
    const bf16_t* Kg = A.Kc + ((size_t)b * A.HKV + kvh) * NKEY * 64; const bf16_t* Vg = A.VT + ((size_t)b * A.HKV + kvh) * 64 * NKEY;
    int lt0 = 4, lt1 = 4;
    if (qpos0 >= 0) { if (A.swa) { const int qb = qpos0 >> 6; lt0 = 4 + (qb - 2 < 0 ? 0 : qb - 2); lt1 = 4 + (qb + 3 > 128 ? 128 : qb + 3); } else { lt0 = 4; lt1 = NCH; } }
    const int ntile = 4 + (lt1 - lt0);
    bf16x8 qf[4];
#pragma unroll
    for (int ks = 0; ks < 4; ++ks) qf[ks] = *(const bf16x8*)(A.Q + (size_t)qrow * A.qpitch + head * 64 + ks * 16 + hh * 8);
    f32x16 o0 = F16ZERO, o1 = F16ZERO; float m = -1e30f, l = 0.f;
    const int lr = tid >> 3, lc = (tid & 7) * 8;
    __syncthreads();
    { const int j = 0; *(LAS u32x4*)(Kb + lr * LP + lc) = *(const u32x4*)(Kg + ((size_t)j * 64 + lr) * 64 + lc); *(LAS u32x4*)(Vb + lr * LP + lc) = *(const u32x4*)(Vg + (size_t)lr * NKEY + j * 64 + lc); }
    u32x4 kn = *(const u32x4*)(Kg + ((size_t)1 * 64 + lr) * 64 + lc), vn = *(const u32x4*)(Vg + (size_t)lr * NKEY + 1 * 64 + lc);
    u32x4 kn2 = *(const u32x4*)(Kg + ((size_t)2 * 64 + lr) * 64 + lc), vn2 = *(const u32x4*)(Vg + (size_t)lr * NKEY + 2 * 64 + lc);
    u32x4 kn3 = *(const u32x4*)(Kg + ((size_t)3 * 64 + lr) * 64 + lc), vn3 = *(const u32x4*)(Vg + (size_t)lr * NKEY + 3 * 64 + lc);
    __syncthreads();
    for (int it = 0; it < ntile; ++it) {
        const int cur = it & 1, j = it < 4 ? it : lt0 + (it - 4);
        u32x4 kn4 = kn3, vn4 = vn3; const bool more = it + 1 < ntile;
        if (it + 4 < ntile) { const int jn = lt0 + it; kn4 = *(const u32x4*)(Kg + ((size_t)jn * 64 + lr) * 64 + lc); vn4 = *(const u32x4*)(Vg + (size_t)lr * NKEY + jn * 64 + lc); }
        LAS const bf16_t* Kt = Kb + cur * 64 * LP; LAS const bf16_t* Vt = Vb + cur * 64 * LP;
        f32x16 s0 = F16ZERO, s1 = F16ZERO;
#pragma unroll
        for (int ks = 0; ks < 4; ++ks) {
            const bf16x8 k0 = *(LAS const bf16x8*)(Kt + r32 * LP + ks * 16 + hh * 8), k1 = *(LAS const bf16x8*)(Kt + (32 + r32) * LP + ks * 16 + hh * 8);
            s0 = __builtin_amdgcn_mfma_f32_32x32x16_bf16(k0, qf[ks], s0, 0, 0, 0); s1 = __builtin_amdgcn_mfma_f32_32x32x16_bf16(k1, qf[ks], s1, 0, 0, 0);
        }
        constexpr float SC = 0.125f * 1.4426950408889634f;
        const int dt_ = (j - 4) - (qpos0 >> 6); const bool edge = A.swa && j >= 4 && (dt_ == 2 || dt_ == -2);
        float tmax = -1e30f;
        if (edge) {
#pragma unroll
            for (int r = 0; r < 16; ++r) { float a = s0[r] * SC, c = s1[r] * SC;
                const int kp = (j - 4) * 64 + crow(r, hh), qp = qpos0 + 32 * (wid & 1) + r32; const int d0 = qp - kp, d1 = qp - (kp + 32);
                if (d0 > 128 || d0 < -128) a = -1e30f; if (d1 > 128 || d1 < -128) c = -1e30f;
                s0[r] = a; s1[r] = c; tmax = fmaxf(tmax, fmaxf(a, c)); }
        } else {
#pragma unroll
            for (int r = 0; r < 16; ++r) { const float a = s0[r] * SC, c = s1[r] * SC; s0[r] = a; s1[r] = c; tmax = fmaxf(tmax, fmaxf(a, c)); }
        }
        tmax = fmaxf(tmax, __shfl_xor(tmax, 32));
        if (!__all(tmax <= m)) {
            const float mnew = fmaxf(m, tmax), alpha = __builtin_amdgcn_exp2f(m - mnew);
            l *= alpha; m = mnew;
#pragma unroll
            for (int r = 0; r < 16; ++r) { o0[r] *= alpha; o1[r] *= alpha; }
        }
        float ps = 0.f;
#pragma unroll
        for (int r = 0; r < 16; ++r) { s0[r] = __builtin_amdgcn_exp2f(s0[r] - m); s1[r] = __builtin_amdgcn_exp2f(s1[r] - m); ps += s0[r] + s1[r]; }
        ps += __shfl_xor(ps, 32);
        l += ps;
#pragma unroll
        for (int sub = 0; sub < 2; ++sub)
#pragma unroll
            for (int s2 = 0; s2 < 2; ++s2) {
                const f32x16& sp = sub ? s1 : s0;
                u32x4 pw; pw.x = pg8::cvt_pk_bf16(sp[8 * s2 + 0], sp[8 * s2 + 1]); pw.y = pg8::cvt_pk_bf16(sp[8 * s2 + 2], sp[8 * s2 + 3]); pw.z = pg8::cvt_pk_bf16(sp[8 * s2 + 4], sp[8 * s2 + 5]); pw.w = pg8::cvt_pk_bf16(sp[8 * s2 + 6], sp[8 * s2 + 7]);
                const bf16x8 pf = __builtin_bit_cast(bf16x8, pw);
                const int kof = sub * 32 + s2 * 16 + 4 * hh;
                u32x4 v0w, v1w;
                { const u32x2 a = *(LAS const u32x2*)(Vt + r32 * LP + kof), c = *(LAS const u32x2*)(Vt + r32 * LP + kof + 8); v0w.x = a.x; v0w.y = a.y; v0w.z = c.x; v0w.w = c.y; }
                { const u32x2 a = *(LAS const u32x2*)(Vt + (32 + r32) * LP + kof), c = *(LAS const u32x2*)(Vt + (32 + r32) * LP + kof + 8); v1w.x = a.x; v1w.y = a.y; v1w.z = c.x; v1w.w = c.y; }
                o0 = __builtin_amdgcn_mfma_f32_32x32x16_bf16(__builtin_bit_cast(bf16x8, v0w), pf, o0, 0, 0, 0);
                o1 = __builtin_amdgcn_mfma_f32_32x32x16_bf16(__builtin_bit_cast(bf16x8, v1w), pf, o1, 0, 0, 0);
            }
        if (more) { *(LAS u32x4*)(Kb + (cur ^ 1) * 64 * LP + lr * LP + lc) = kn; *(LAS u32x4*)(Vb + (cur ^ 1) * 64 * LP + lr * LP + lc) = vn; }
        kn = kn2; vn = vn2; kn2 = kn3; vn2 = vn3; kn3 = kn4; vn3 = vn4;
        __syncthreads();
    }
    if (A.sink) l += __builtin_amdgcn_exp2f(A.sink[head] * 1.4426950408889634f - m);
    const float inv = 1.f / l;
#pragma unroll
    for (int r = 0; r < 16; ++r) { Ost[r32 * LP + crow(r, hh)] = (bf16_t)f2bf(o0[r] * inv); Ost[r32 * LP + 32 + crow(r, hh)] = (bf16_t)f2bf(o1[r] * inv); }
    asm volatile("s_waitcnt lgkmcnt(0)" ::: "memory");
#pragma unroll
    for (int p = 0; p < 4; ++p) { const int q = p * 8 + (lane >> 3), d8 = (lane & 7) * 8;
        u32x4 ov = *(LAS const u32x4*)(Ost + q * LP + d8); if ((DBG_SKIP & 2) && A.swa) ov = (u32x4){0u, 0u, 0u, 0u}; if ((DBG_SKIP & 16) && !A.swa) ov = (u32x4){0u, 0u, 0u, 0u};
        *(u32x2*)((unsigned char*)A.O + (size_t)(qrow0 + 32 * (wid & 1) + q) * A.opitch + A.ocol0 + (wid >> 1) * 64 + kvh * 256 + d8) = bf8_to_fp8(ov); }
}
__device__ __forceinline__ float xor32_max(float v) { float a = v, b = v; asm volatile("v_nop\n\tv_nop\n\tv_permlane32_swap_b32 %0, %1\n\tv_nop\n\tv_nop" : "+v"(a), "+v"(b)); return fmaxf(a, b); }
__device__ __forceinline__ float xor32_sum(float v) { float a = v, b = v; asm volatile("v_nop\n\tv_nop\n\tv_permlane32_swap_b32 %0, %1\n\tv_nop\n\tv_nop" : "+v"(a), "+v"(b)); return a + b; }
template <int NG>
__device__ __forceinline__ void attn_unit(const AttnArgs& A, LAS unsigned char* lds, int b, int kvh, int qrow0, int qpos0  ) {
    const int tid = threadIdx.x, lane = tid & 63, wid = tid >> 6, r32 = lane & 31, hh = lane >> 5;
    constexpr int RW = 32 * NG;
    constexpr float CS2 = 0.125f * 1.4426950408889634f;
    LAS bf16_t* Kb = (LAS bf16_t*)lds; LAS bf16_t* Vb = Kb + 2 * 64 * LP; LAS bf16_t* Ost = Vb + 2 * 64 * LP + wid * RW * LP;
    const int head = kvh * 4 + (wid >> 1);
    const int wrow0 = qrow0 + RW * (wid & 1);
    const bf16_t* Kg = A.Kc + ((size_t)b * A.HKV + kvh) * NKEY * 64; const bf16_t* Vg = A.VT + ((size_t)b * A.HKV + kvh) * 64 * NKEY;
    int lt0 = 4, lt1 = 4;
    if (qpos0 >= 0) { if (A.swa) { const int k0 = qpos0 - 128, k1 = qpos0 + 64 * NG + 128; lt0 = 4 + (k0 < 0 ? 0 : k0 >> 6); lt1 = 4 + (k1 > SEQ ? SEQ >> 6 : k1 >> 6); } else { lt0 = 4; lt1 = NCH; } }
    const int ntile = 4 + (lt1 - lt0);
    bf16x8 qf[NG][4];
#pragma unroll
    for (int g = 0; g < NG; ++g)
#pragma unroll
        for (int ks = 0; ks < 4; ++ks) qf[g][ks] = *(const bf16x8*)(A.Q + (size_t)(wrow0 + 32 * g + r32) * A.qpitch + head * 64 + ks * 16 + hh * 8);
    f32x16 o[NG][2]; float m[NG], l[NG];
#pragma unroll
    for (int g = 0; g < NG; ++g) { o[g][0] = F16ZERO; o[g][1] = F16ZERO; m[g] = -1e30f; l[g] = 0.f; }
    const int lr = tid >> 3, lc = (tid & 7) * 8;
    __syncthreads();
    { *(LAS u32x4*)(Kb + lr * LP + lc) = *(const u32x4*)(Kg + (size_t)lr * 64 + lc); *(LAS u32x4*)(Vb + lr * LP + lc) = *(const u32x4*)(Vg + (size_t)lr * NKEY + lc); }
    __syncthreads();
    for (int it = 0; it < ntile; ++it) {
        const int cur = it & 1, j = it < 4 ? it : lt0 + (it - 4);
        u32x4 kn, vn; const bool more = it + 1 < ntile;
        if (more) { const int jn = (it + 1) < 4 ? it + 1 : lt0 + (it + 1 - 4); kn = *(const u32x4*)(Kg + ((size_t)jn * 64 + lr) * 64 + lc); vn = *(const u32x4*)(Vg + (size_t)lr * NKEY + jn * 64 + lc); }
        LAS const bf16_t* Kt = Kb + cur * 64 * LP; LAS const bf16_t* Vt = Vb + cur * 64 * LP;
        f32x16 s[NG][2];
#pragma unroll
        for (int g = 0; g < NG; ++g) { s[g][0] = F16ZERO; s[g][1] = F16ZERO; }
#pragma unroll
        for (int ks = 0; ks < 4; ++ks) {
            const bf16x8 k0 = *(LAS const bf16x8*)(Kt + r32 * LP + ks * 16 + hh * 8), k1 = *(LAS const bf16x8*)(Kt + (32 + r32) * LP + ks * 16 + hh * 8);
#pragma unroll
            for (int g = 0; g < NG; ++g) { s[g][0] = __builtin_amdgcn_mfma_f32_32x32x16_bf16(k0, qf[g][ks], s[g][0], 0, 0, 0); s[g][1] = __builtin_amdgcn_mfma_f32_32x32x16_bf16(k1, qf[g][ks], s[g][1], 0, 0, 0); }
        }
        const bool masked = A.swa && j >= 4;
#pragma unroll
        for (int g = 0; g < NG; ++g) {
            float tmax = -1e30f;
            const int qp = qpos0 + RW * (wid & 1) + 32 * g + r32, kb0 = (j - 4) * 64;
#pragma unroll
            for (int r = 0; r < 16; ++r) { float a = s[g][0][r], c = s[g][1][r];
                if (masked) { const int d0 = qp - (kb0 + crow(r, hh)), d1 = d0 - 32; if (d0 > 128 || d0 < -128) a = -1e30f; if (d1 > 128 || d1 < -128) c = -1e30f; }
                s[g][0][r] = a; s[g][1][r] = c; tmax = fmaxf(tmax, fmaxf(a, c)); }
            tmax = xor32_max(tmax);
            const bool keep = __all((tmax - m[g]) * CS2 <= 8.f);
            if (!keep) { const float mnew = fmaxf(m[g], tmax), alpha = __builtin_amdgcn_exp2f((m[g] - mnew) * CS2);
                l[g] *= alpha; m[g] = mnew;
#pragma unroll
                for (int r = 0; r < 16; ++r) { o[g][0][r] *= alpha; o[g][1][r] *= alpha; } }
            const float mc = m[g] * CS2;
            float ps = 0.f;
#pragma unroll
            for (int r = 0; r < 16; ++r) { const float p0 = __builtin_amdgcn_exp2f(s[g][0][r] * CS2 - mc), p1 = __builtin_amdgcn_exp2f(s[g][1][r] * CS2 - mc); s[g][0][r] = p0; s[g][1][r] = p1; ps += p0 + p1; }
            l[g] += ps;
        }
#pragma unroll
        for (int sub = 0; sub < 2; ++sub)
#pragma unroll
            for (int s2 = 0; s2 < 2; ++s2) {
                const int kof = sub * 32 + s2 * 16 + 4 * hh;
                u32x4 v0w, v1w;
                { const u32x2 a = *(LAS const u32x2*)(Vt + r32 * LP + kof), c = *(LAS const u32x2*)(Vt + r32 * LP + kof + 8); v0w.x = a.x; v0w.y = a.y; v0w.z = c.x; v0w.w = c.y; }
                { const u32x2 a = *(LAS const u32x2*)(Vt + (32 + r32) * LP + kof), c = *(LAS const u32x2*)(Vt + (32 + r32) * LP + kof + 8); v1w.x = a.x; v1w.y = a.y; v1w.z = c.x; v1w.w = c.y; }
#pragma unroll
                for (int g = 0; g < NG; ++g) {
                    const f32x16& sp = s[g][sub];
                    u32x4 pw; pw.x = pg8::cvt_pk_bf16(sp[8 * s2 + 0], sp[8 * s2 + 1]); pw.y = pg8::cvt_pk_bf16(sp[8 * s2 + 2], sp[8 * s2 + 3]); pw.z = pg8::cvt_pk_bf16(sp[8 * s2 + 4], sp[8 * s2 + 5]); pw.w = pg8::cvt_pk_bf16(sp[8 * s2 + 6], sp[8 * s2 + 7]);
                    const bf16x8 pf = __builtin_bit_cast(bf16x8, pw);
                    o[g][0] = __builtin_amdgcn_mfma_f32_32x32x16_bf16(__builtin_bit_cast(bf16x8, v0w), pf, o[g][0], 0, 0, 0);
                    o[g][1] = __builtin_amdgcn_mfma_f32_32x32x16_bf16(__builtin_bit_cast(bf16x8, v1w), pf, o[g][1], 0, 0, 0);
                }
            }
        if (more) { *(LAS u32x4*)(Kb + (cur ^ 1) * 64 * LP + lr * LP + lc) = kn; *(LAS u32x4*)(Vb + (cur ^ 1) * 64 * LP + lr * LP + lc) = vn; }
        __syncthreads();
    }
#pragma unroll
    for (int g = 0; g < NG; ++g) {
        float lt = xor32_sum(l[g]);
        if (A.sink) lt += __builtin_amdgcn_exp2f(A.sink[head] * 1.4426950408889634f - m[g] * CS2);
        const float inv = 1.f / lt;
#pragma unroll
        for (int r = 0; r < 16; ++r) { Ost[(32 * g + r32) * LP + crow(r, hh)] = (bf16_t)f2bf(o[g][0][r] * inv); Ost[(32 * g + r32) * LP + 32 + crow(r, hh)] = (bf16_t)f2bf(o[g][1][r] * inv); }
    }
    asm volatile("s_waitcnt lgkmcnt(0)" ::: "memory");
#pragma unroll
    for (int p = 0; p < 4 * NG; ++p) { const int q = p * 8 + (lane >> 3), d8 = (lane & 7) * 8;
        u32x4 ov = *(LAS const u32x4*)(Ost + q * LP + d8); if ((DBG_SKIP & 2) && A.swa) ov = (u32x4){0u, 0u, 0u, 0u}; if ((DBG_SKIP & 16) && !A.swa) ov = (u32x4){0u, 0u, 0u, 0u};
        *(u32x2*)((unsigned char*)A.O + (size_t)(wrow0 + q) * A.opitch + A.ocol0 + (wid >> 1) * 64 + kvh * 256 + d8) = bf8_to_fp8(ov); }
}
#define ATT_BAR() do { asm volatile("s_waitcnt lgkmcnt(0)" ::: "memory"); __builtin_amdgcn_s_barrier(); asm volatile("" ::: "memory"); } while (0)
__device__ __forceinline__ void attn_unit_ph(const AttnArgs& A, LAS unsigned char* lds, int b, int kvh, int qrow0) {
    constexpr int NG = 2, RW = 64;
    constexpr float CS2 = 0.125f * 1.4426950408889634f;
    const int tid = threadIdx.x, lane = tid & 63, wid = tid >> 6, r32 = lane & 31, hh = lane >> 5, half = wid & 1;
    const int hl = wid >> 1, rh = wid & 1;
    LAS bf16_t* Kb = (LAS bf16_t*)lds; LAS bf16_t* Vb = Kb + 2 * 64 * LP; LAS bf16_t* Ost = Vb + 2 * 64 * LP + wid * RW * LP;
    const int head = kvh * 4 + hl;
    const int wrow0 = qrow0 + RW * rh;
    const bf16_t* Kg = A.Kc + ((size_t)b * A.HKV + kvh) * NKEY * 64; const bf16_t* Vg = A.VT + ((size_t)b * A.HKV + kvh) * 64 * NKEY;
    int ntile = NCH; asm volatile("" : "+s"(ntile));
    bf16x8 qf[NG][4];
#pragma unroll
    for (int g = 0; g < NG; ++g)
#pragma unroll
        for (int ks = 0; ks < 4; ++ks) qf[g][ks] = *(const bf16x8*)(A.Q + (size_t)(wrow0 + 32 * g + r32) * A.qpitch + head * 64 + ks * 16 + hh * 8);
    f32x16 o[NG][2]; float m[NG], l[NG];
#pragma unroll
    for (int g = 0; g < NG; ++g) { o[g][0] = F16ZERO; o[g][1] = F16ZERO; m[g] = -1e30f; l[g] = 0.f; }
    const int lr = tid >> 3, lc = (tid & 7) * 8;
    u32x4 kn, vn;
#define ATT_LOAD(J) do { kn = *(const u32x4*)(Kg + ((size_t)(J) * 64 + lr) * 64 + lc); vn = *(const u32x4*)(Vg + (size_t)lr * NKEY + (J) * 64 + lc); } while (0)
#define ATT_WRITE(J) do { *(LAS u32x4*)(Kb + ((J) & 1) * 64 * LP + lr * LP + lc) = kn; *(LAS u32x4*)(Vb + ((J) & 1) * 64 * LP + lr * LP + lc) = vn; } while (0)
    __syncthreads();
    ATT_LOAD(0); ATT_WRITE(0); ATT_LOAD(1); ATT_WRITE(1); ATT_LOAD(2);
    ATT_BAR();
    if (half == 1) ATT_BAR();
#pragma unroll 1
    for (int t = 0; t < ntile; ++t) {
        LAS const bf16_t* Kt = Kb + (t & 1) * 64 * LP; LAS const bf16_t* Vt = Vb + (t & 1) * 64 * LP;
        if (half == 1 && t >= 1 && t + 1 < ntile) { ATT_WRITE(t + 1); if (t + 2 < ntile) ATT_LOAD(t + 2); }
        f32x16 s[NG][2];
#pragma unroll
        for (int g = 0; g < NG; ++g) { s[g][0] = F16ZERO; s[g][1] = F16ZERO; }
#pragma unroll
        for (int ks = 0; ks < 4; ++ks) {
            const bf16x8 k0 = *(LAS const bf16x8*)(Kt + r32 * LP + ks * 16 + hh * 8), k1 = *(LAS const bf16x8*)(Kt + (32 + r32) * LP + ks * 16 + hh * 8);
#pragma unroll
            for (int g = 0; g < NG; ++g) { s[g][0] = __builtin_amdgcn_mfma_f32_32x32x16_bf16(k0, qf[g][ks], s[g][0], 0, 0, 0); s[g][1] = __builtin_amdgcn_mfma_f32_32x32x16_bf16(k1, qf[g][ks], s[g][1], 0, 0, 0); }
        }
        ATT_BAR();
        if (half == 0 && t >= 1 && t + 1 < ntile) { ATT_WRITE(t + 1); if (t + 2 < ntile) ATT_LOAD(t + 2); }
#pragma unroll
        for (int g = 0; g < NG; ++g) {
            float tmax = -1e30f;
#pragma unroll
            for (int r = 0; r < 16; ++r) tmax = fmaxf(tmax, fmaxf(s[g][0][r], s[g][1][r]));
            tmax = fmaxf(tmax, __shfl_xor(tmax, 32));
            const float mnew = fmaxf(m[g], tmax), alpha = __builtin_amdgcn_exp2f((m[g] - mnew) * CS2), mc = mnew * CS2;
            float ps = 0.f;
#pragma unroll
            for (int r = 0; r < 16; ++r) { const float p0 = __builtin_amdgcn_exp2f(s[g][0][r] * CS2 - mc), p1 = __builtin_amdgcn_exp2f(s[g][1][r] * CS2 - mc); s[g][0][r] = p0; s[g][1][r] = p1; ps += p0 + p1; }
            ps += __shfl_xor(ps, 32);
            l[g] = l[g] * alpha + ps; m[g] = mnew;
#pragma unroll
            for (int r = 0; r < 16; ++r) { o[g][0][r] *= alpha; o[g][1][r] *= alpha; }
        }
#pragma unroll
        for (int sub = 0; sub < 2; ++sub)
#pragma unroll
            for (int s2 = 0; s2 < 2; ++s2) {
                const int kof = sub * 32 + s2 * 16 + 4 * hh;
                u32x4 v0w, v1w;
                { const u32x2 a = *(LAS const u32x2*)(Vt + r32 * LP + kof), c = *(LAS const u32x2*)(Vt + r32 * LP + kof + 8); v0w.x = a.x; v0w.y = a.y; v0w.z = c.x; v0w.w = c.y; }
                { const u32x2 a = *(LAS const u32x2*)(Vt + (32 + r32) * LP + kof), c = *(LAS const u32x2*)(Vt + (32 + r32) * LP + kof + 8); v1w.x = a.x; v1w.y = a.y; v1w.z = c.x; v1w.w = c.y; }
#pragma unroll
                for (int g = 0; g < NG; ++g) {
                    const f32x16& sp = s[g][sub];
                    u32x4 pw; pw.x = pg8::cvt_pk_bf16(sp[8 * s2 + 0], sp[8 * s2 + 1]); pw.y = pg8::cvt_pk_bf16(sp[8 * s2 + 2], sp[8 * s2 + 3]); pw.z = pg8::cvt_pk_bf16(sp[8 * s2 + 4], sp[8 * s2 + 5]); pw.w = pg8::cvt_pk_bf16(sp[8 * s2 + 6], sp[8 * s2 + 7]);
                    const bf16x8 pf = __builtin_bit_cast(bf16x8, pw);
                    o[g][0] = __builtin_amdgcn_mfma_f32_32x32x16_bf16(__builtin_bit_cast(bf16x8, v0w), pf, o[g][0], 0, 0, 0);
                    o[g][1] = __builtin_amdgcn_mfma_f32_32x32x16_bf16(__builtin_bit_cast(bf16x8, v1w), pf, o[g][1], 0, 0, 0);
                }
            }
        ATT_BAR();
    }
    if (half == 0) ATT_BAR();
#undef ATT_LOAD
#undef ATT_WRITE
#pragma unroll
    for (int g = 0; g < NG; ++g) {
        const float inv = 1.f / l[g];
#pragma unroll
        for (int r = 0; r < 16; ++r) { Ost[(32 * g + r32) * LP + crow(r, hh)] = (bf16_t)f2bf(o[g][0][r] * inv); Ost[(32 * g + r32) * LP + 32 + crow(r, hh)] = (bf16_t)f2bf(o[g][1][r] * inv); }
    }
    asm volatile("s_waitcnt lgkmcnt(0)" ::: "memory");
#pragma unroll
    for (int p = 0; p < 4 * NG; ++p) { const int q = p * 8 + (lane >> 3), d8 = (lane & 7) * 8;
        *(u32x2*)((unsigned char*)A.O + (size_t)(wrow0 + q) * A.opitch + A.ocol0 + hl * 64 + kvh * 256 + d8) = bf8_to_fp8(*(LAS const u32x4*)(Ost + q * LP + d8)); }
}
__device__ __forceinline__ void phase_attention_dense(const AttnArgs& A, LAS unsigned char* lds, LAS unsigned char* misc, unsigned* qword) {
    constexpr int QR = 128, NQB = SEQ / QR;
    const int nlat = NB * A.HKV * NQB;
    LAS int* slot = (LAS int*)(misc + 32);
    for (;;) {
        __syncthreads();
        if (threadIdx.x == 0) *slot = (int)atomicAdd(qword, 1u);
        __syncthreads();
        const int u = *slot;
        if (u >= nlat) break;
        const int qb = u % NQB, kvh = (u / NQB) % A.HKV, b = u / (NQB * A.HKV);
        attn_unit_ph(A, lds, b, kvh, NCTX + b * 8192 + qb * QR);
    }
    __syncthreads();
}
template <int NG>
__device__ __forceinline__ void phase_attention(const AttnArgs& A, LAS unsigned char* lds, LAS unsigned char* misc, unsigned* qword, bool ctx_q) {
    constexpr int QR = 64 * NG, NQB = SEQ / QR, NCB = CTXL / QR;
    const int nlat = NB * A.HKV * NQB, nctx = ctx_q ? NB * A.HKV * NCB : 0;
    LAS int* slot = (LAS int*)(misc + 32);
    for (;;) {
        __syncthreads();
        if (threadIdx.x == 0) *slot = (int)atomicAdd(qword, 1u);
        __syncthreads();
        const int u = *slot;
        if (u >= nlat + nctx) break;
        if (u < nlat) { const int qb = u % NQB, kvh = (u / NQB) % A.HKV, b = u / (NQB * A.HKV); attn_unit<NG>(A, lds, b, kvh, NCTX + b * 8192 + qb * QR, qb * QR); }
        else { const int v = u - nlat, qb = v % NCB, kvh = (v / NCB) % A.HKV, b = v / (NCB * A.HKV); attn_unit<NG>(A, lds, b, kvh, b * 256 + qb * QR, -1); }
    }
    __syncthreads();
}

__device__ __forceinline__ void phase_attention_v1(const AttnArgs& A, LAS unsigned char* lds, LAS unsigned char* misc, unsigned* qword, bool ctx_q) {
    const int nlat = NB * A.HKV * 128, nctx = ctx_q ? NB * A.HKV * 4 : 0;
    LAS int* slot = (LAS int*)(misc + 32);
    for (;;) {
        __syncthreads();
        if (threadIdx.x == 0) *slot = (int)atomicAdd(qword, 1u);
        __syncthreads();
        const int u = *slot;
        if (u >= nlat + nctx) break;
        if (u < nlat) { const int qb = u & 127, kvh = (u >> 7) % A.HKV, b = u / (128 * A.HKV); attn_unit_v1(A, lds, b, kvh, NCTX + b * 8192 + qb * 64, qb * 64); }
        else { const int v = u - nlat, qb = v & 3, kvh = (v >> 2) % A.HKV, b = v / (4 * A.HKV); attn_unit_v1(A, lds, b, kvh, b * 256 + qb * 64, -1); }
    }
    __syncthreads();
}


__device__ __forceinline__ void qk_prep_tile8(const bf16_t* src, size_t spitch, unsigned char* dst, size_t dpitch, const float* gain, bool rope, int pos0, int tid, float oscale) {
    const int r = tid >> 3, q = tid & 7, i0 = (q & 3) * 4, d1 = (q >> 2) * 32 + i0, d2 = d1 + 16;
    const u32x2 w1 = *(const u32x2*)(src + (size_t)r * spitch + d1), w2 = *(const u32x2*)(src + (size_t)r * spitch + d2);
    float a[4] = {bflo(w1.x), bfhi(w1.x), bflo(w1.y), bfhi(w1.y)}, c[4] = {bflo(w2.x), bfhi(w2.x), bflo(w2.y), bfhi(w2.y)};
    float ss = 0.f;
#pragma unroll
    for (int i = 0; i < 4; ++i) ss += a[i] * a[i] + c[i] * c[i];
    ss += __shfl_xor(ss, 1); ss += __shfl_xor(ss, 2); ss += __shfl_xor(ss, 4);
    const float rstd = rsqrtf(ss * (1.f / 64.f) + 1e-6f);
#pragma unroll
    for (int i = 0; i < 4; ++i) { a[i] = a[i] * rstd * gain[d1 + i]; c[i] = c[i] * rstd * gain[d2 + i]; }
    if (rope) {
        const int pos = pos0 + r; const float pc = (float)((q >> 2) ? (pos & 63) : (pos >> 6));
#pragma unroll
        for (int i = 0; i < 4; ++i) { const float inv = exp2f(-(float)(i0 + i) * (13.287712379549449f / 16.f)); float sn, cs; __sincosf(pc * inv, &sn, &cs);
            const float t1 = a[i], t2 = c[i]; a[i] = t1 * cs - t2 * sn; c[i] = t2 * cs + t1 * sn; }
    }
    *(unsigned*)(dst + (size_t)r * dpitch + d1) = pk4_fp8(a[0] * oscale, a[1] * oscale, a[2] * oscale, a[3] * oscale); *(unsigned*)(dst + (size_t)r * dpitch + d2) = pk4_fp8(c[0] * oscale, c[1] * oscale, c[2] * oscale, c[3] * oscale);
}
__device__ __forceinline__ void phase_qkv_prep8(unsigned char* ws, LAS unsigned char* lds, const float* qgain, const float* kgain) {
    const int tid = threadIdx.x; unsigned char* R = ws + WS_R;
    const bf16_t* kv = (const bf16_t*)(R + R_KV1); const bf16_t* q1 = (const bf16_t*)(R + R_Q1);
    unsigned char* K8 = R + R_K8; unsigned char* VT8 = R + R_VT8; unsigned char* Q8 = R + R_Q8;
    LAS bf16_t* tl = (LAS bf16_t*)lds;
    for (int u = blockIdx.x; u < NB * 3 * NCH; u += gridDim.x) {
        const int j = u % NCH, kvh = (u / NCH) % 3, b = u / (NCH * 3);
        const int row0 = j < 4 ? b * 256 + j * 64 : NCTX + b * 8192 + (j - 4) * 64;
        const size_t key0 = (size_t)j * 64;
        qk_prep_tile8(kv + (size_t)row0 * 384 + kvh * 64, 384, K8 + (((size_t)b * 3 + kvh) * NKEY + key0) * 64, 64, kgain, j >= 4, (j - 4) * 64, tid, 0.25f);
        __syncthreads();
        { const int r = tid >> 3, c8 = (tid & 7) * 8; *(LAS u32x4*)(tl + r * LP + c8) = *(const u32x4*)(kv + (size_t)(row0 + r) * 384 + 192 + kvh * 64 + c8); }
        __syncthreads();
        { const int dv = tid >> 3, p8 = (tid & 7) * 8, hh = p8 >> 5, sub = (p8 >> 4) & 1, ka = 32 * sub + 4 * hh + ((p8 & 8) ? 16 : 0);
          u32x2 w;
          w.x = pk4_fp8(bf2f(tl[(ka + 0) * LP + dv]), bf2f(tl[(ka + 1) * LP + dv]), bf2f(tl[(ka + 2) * LP + dv]), bf2f(tl[(ka + 3) * LP + dv]));
          w.y = pk4_fp8(bf2f(tl[(ka + 8) * LP + dv]), bf2f(tl[(ka + 9) * LP + dv]), bf2f(tl[(ka + 10) * LP + dv]), bf2f(tl[(ka + 11) * LP + dv]));
          *(u32x2*)(VT8 + (((size_t)b * 3 + kvh) * 64 + dv) * NKEY + key0 + p8) = w; }
    }
    for (int u = blockIdx.x; u < (NLAT / 64) * 12; u += gridDim.x) {
        const int hq = u % 12, tI = u / 12; const int lrow0 = tI * 64;
        qk_prep_tile8(q1 + (size_t)(NCTX + lrow0) * 768 + hq * 64, 768, Q8 + (size_t)lrow0 * 768 + hq * 64, 768, qgain, true, lrow0 & 8191, tid, 4.f * 0.125f * 1.4426950408889634f);
    }
    __syncthreads();
}
__device__ __forceinline__ void mfma8_acc(f32x16& acc, const i32x8& a, const i32x8& b, int sc) {
    asm volatile("s_nop 1\n\tv_mfma_scale_f32_32x32x64_f8f6f4 %0, %1, %2, %0, %3, %3 op_sel_hi:[0,0,0]" : "+v"(acc) : "v"(a), "v"(b), "v"(sc));
}
__device__ __forceinline__ void mfma8_z(f32x16& out, const i32x8& a, const i32x8& b, int sc) {
    asm volatile("s_nop 1\n\tv_mfma_scale_f32_32x32x64_f8f6f4 %0, %1, %2, 0, %3, %3 op_sel_hi:[0,0,0]" : "=&v"(out) : "v"(a), "v"(b), "v"(sc));
}
__device__ __forceinline__ void mfma8_c(f32x16& out, const i32x8& a, const i32x8& b, const f32x16& c, int sc) {
    asm volatile("s_nop 1\n\tv_mfma_scale_f32_32x32x64_f8f6f4 %0, %1, %2, %3, %4, %4 op_sel_hi:[0,0,0]" : "=&v"(out) : "v"(a), "v"(b), "v"(c), "v"(sc));
}
__device__ __forceinline__ float max3_(float a, float b, float c) { float r; asm("v_max3_f32 %0, %1, %2, %3" : "=v"(r) : "v"(a), "v"(b), "v"(c)); return r; }
__device__ __forceinline__ i32x8 lds_frag8(LAS const unsigned char* p) { const u32x4 a = *(LAS const u32x4*)p, b = *(LAS const u32x4*)(p + 16); return __builtin_bit_cast(i32x8, __builtin_shufflevector(a, b, 0, 1, 2, 3, 4, 5, 6, 7)); }
constexpr int LP8 = 80;
__device__ __forceinline__ void attn_unit8(unsigned char* R, bf16_t* O, LAS unsigned char* lds, int b, int kvh, int lrow0  , const bool SREF, const float mref) {
    constexpr float CS2 = 0.125f * 1.4426950408889634f;
    const int tid = threadIdx.x, lane = tid & 63, wid = tid >> 6, r32 = lane & 31, hh = lane >> 5; const int sc = 0x7F7F7F7F;
    LAS unsigned char* Kb = lds; LAS unsigned char* Vb = lds + 2 * 64 * LP8; LAS bf16_t* Ost = (LAS bf16_t*)(lds + 4 * 64 * LP8) + wid * 64 * LP;
    const int head = kvh * 4 + (wid >> 1), wrow0 = lrow0 + 64 * (wid & 1);
    const unsigned char* Kg = R + R_K8 + ((size_t)b * 3 + kvh) * NKEY * 64; const unsigned char* Vg = R + R_VT8 + ((size_t)b * 3 + kvh) * 64 * NKEY; const unsigned char* Qg = R + R_Q8;
    i32x8 qf[2];
#pragma unroll
    for (int g = 0; g < 2; ++g) { const unsigned char* qp = Qg + (size_t)(wrow0 + 32 * g + r32) * 768 + head * 64 + 32 * hh; const u32x4 a = *(const u32x4*)qp, c = *(const u32x4*)(qp + 16);
        qf[g] = __builtin_bit_cast(i32x8, __builtin_shufflevector(a, c, 0, 1, 2, 3, 4, 5, 6, 7)); }
    f32x16 o[2][2]; const f32x16 cref = F16ZERO - mref; f32x2 l2[2]; float mrun[2] = {0.f, 0.f};
#pragma unroll
    for (int g = 0; g < 2; ++g) { o[g][0] = F16ZERO; o[g][1] = F16ZERO; l2[g] = (f32x2){0.f, 0.f}; }
    const int st = tid & 255, srow = st >> 2, spc = (st & 3) * 16; const bool isv = tid >= 256;
    const unsigned char* gsrc = isv ? Vg + (size_t)srow * NKEY + spc : Kg + (size_t)srow * 64 + spc; const size_t gstep = isv ? 64 : 64 * 64;
    LAS unsigned char* ldst = (isv ? Vb : Kb) + srow * LP8 + spc;
    int ntile = NCH; asm volatile("" : "+s"(ntile));
    __syncthreads();
    *(LAS u32x4*)ldst = *(const u32x4*)gsrc;
    u32x4 pre0 = *(const u32x4*)(gsrc + gstep);
    __syncthreads();
#pragma unroll 1
    for (int it = 0; it < ntile; ++it) {
        const int cur = it & 1; const bool more = it + 1 < ntile;
        u32x4 pre1 = pre0; if (it + 2 < ntile) pre1 = *(const u32x4*)(gsrc + (size_t)(it + 2) * gstep);
        LAS const unsigned char* Kt = Kb + cur * 64 * LP8; LAS const unsigned char* Vt = Vb + cur * 64 * LP8;
        const i32x8 k0 = lds_frag8(Kt + r32 * LP8 + 32 * hh), k1 = lds_frag8(Kt + (32 + r32) * LP8 + 32 * hh);
        f32x16 s[2][2];
        mfma8_c(s[0][0], k0, qf[0], cref, sc); mfma8_c(s[0][1], k1, qf[0], cref, sc); mfma8_c(s[1][0], k0, qf[1], cref, sc); mfma8_c(s[1][1], k1, qf[1], cref, sc);
        asm volatile("s_nop 15\n\ts_nop 7" : "+v"(s[0][0]), "+v"(s[0][1]), "+v"(s[1][0]), "+v"(s[1][1]));
        const i32x8 v0 = lds_frag8(Vt + r32 * LP8 + 32 * hh), v1 = lds_frag8(Vt + (32 + r32) * LP8 + 32 * hh);
#pragma unroll
        for (int g = 0; g < 2; ++g) {
            if (!SREF) {
                float tmax = -3.0e38f;
#pragma unroll
                for (int r = 0; r < 16; ++r) tmax = max3_(tmax, s[g][0][r], s[g][1][r]);
                tmax = xor32_max(tmax);
                if (it == 0 || !__all(tmax <= mrun[g] + 8.f)) { const float mnew = it == 0 ? tmax : fmaxf(tmax, mrun[g]), alpha = it == 0 ? 1.f : __builtin_amdgcn_exp2f(mrun[g] - mnew);
                    l2[g] = l2[g] * alpha; o[g][0] = o[g][0] * alpha; o[g][1] = o[g][1] * alpha; mrun[g] = mnew; }
                s[g][0] = s[g][0] - mrun[g]; s[g][1] = s[g][1] - mrun[g];
            }
            unsigned pw[8];
#pragma unroll
            for (int q4 = 0; q4 < 4; ++q4) {
                float p0[4], p1[4];
#pragma unroll
                for (int e = 0; e < 4; ++e) { p0[e] = __builtin_amdgcn_exp2f(s[g][0][4 * q4 + e]); p1[e] = __builtin_amdgcn_exp2f(s[g][1][4 * q4 + e]); }
                l2[g] = l2[g] + (f32x2){p0[0], p0[1]}; l2[g] = l2[g] + (f32x2){p0[2], p0[3]}; l2[g] = l2[g] + (f32x2){p1[0], p1[1]}; l2[g] = l2[g] + (f32x2){p1[2], p1[3]};
                int w0 = 0, w1 = 0;
                w0 = __builtin_amdgcn_cvt_pk_fp8_f32(p0[0], p0[1], w0, false); w0 = __builtin_amdgcn_cvt_pk_fp8_f32(p0[2], p0[3], w0, true);
                w1 = __builtin_amdgcn_cvt_pk_fp8_f32(p1[0], p1[1], w1, false); w1 = __builtin_amdgcn_cvt_pk_fp8_f32(p1[2], p1[3], w1, true);
                pw[q4] = (unsigned)w0; pw[4 + q4] = (unsigned)w1; }
            const i32x8 pf = (i32x8){(int)pw[0], (int)pw[1], (int)pw[2], (int)pw[3], (int)pw[4], (int)pw[5], (int)pw[6], (int)pw[7]};
            mfma8_acc(o[g][0], v0, pf, sc); mfma8_acc(o[g][1], v1, pf, sc);
        }
        if (more) *(LAS u32x4*)(ldst + (cur ^ 1) * 64 * LP8) = pre0;
        pre0 = pre1;
        __syncthreads();
    }
    asm volatile("s_nop 15\n\ts_nop 7" : "+v"(o[0][0]), "+v"(o[0][1]), "+v"(o[1][0]), "+v"(o[1][1]));
#pragma unroll
    for (int g = 0; g < 2; ++g) {
        const float inv = 1.f / xor32_sum(l2[g][0] + l2[g][1]);
#pragma unroll
        for (int r = 0; r < 16; ++r) { Ost[(32 * g + r32) * LP + crow(r, hh)] = (bf16_t)f2bf(o[g][0][r] * inv); Ost[(32 * g + r32) * LP + 32 + crow(r, hh)] = (bf16_t)f2bf(o[g][1][r] * inv); }
    }
    asm volatile("s_waitcnt lgkmcnt(0)" ::: "memory");
#pragma unroll
    for (int p = 0; p < 8; ++p) { const int q = p * 8 + (lane >> 3), d8 = (lane & 7) * 8;
        *(u32x4*)(O + (size_t)(NCTX + wrow0 + q) * 1024 + 256 + (wid >> 1) * 64 + kvh * 256 + d8) = *(LAS const u32x4*)(Ost + q * LP + d8); }
}
__device__ __forceinline__ void attn8_reference(unsigned char* ws, const float* gq, const float* gk) {
    if (blockIdx.x == 0 && threadIdx.x < 64) { float mq = fabsf(gq[threadIdx.x]), mk = fabsf(gk[threadIdx.x]);
#pragma unroll
        for (int o = 32; o; o >>= 1) { mq = fmaxf(mq, __shfl_xor(mq, o)); mk = fmaxf(mk, __shfl_xor(mk, o)); }
        if (threadIdx.x == 0) WSP(float, WS_CTL)[CW_CNT + 80] = 1.0625f * 1.0625f * 8.f * 1.4426950408889634f * mq * mk - 8.8f; }
}
__device__ __forceinline__ void phase_attention8(unsigned char* ws, LAS unsigned char* lds, LAS unsigned char* misc, unsigned* qword, const float* gq, const float* gk) {
    constexpr int NQB = SEQ / 128; const int nlat = NB * 3 * NQB;
    LAS int* slot = (LAS int*)(misc + 32);
    (void)gq; (void)gk;
    const float mref = __builtin_bit_cast(float, __builtin_amdgcn_readfirstlane((int)WSP(unsigned, WS_CTL)[CW_CNT + 80]));
    const bool sref = mref <= 8.f;
    for (;;) {
        __syncthreads();
        if (threadIdx.x == 0) *slot = (int)atomicAdd(qword, 1u);
        __syncthreads();
        const int u = *slot;
        if (u >= nlat) break;
        const int qb = u % NQB, kvh = (u / NQB) % 3, b = u / (NQB * 3);
        attn_unit8(ws + WS_R, WSP(bf16_t, WS_XN), lds, b, kvh, b * 8192 + qb * 128, sref, sref ? mref : 0.f);
    }
    __syncthreads();
}

__device__ __forceinline__ void phase_norm2_route(const Params& P, unsigned char* ws, LAS unsigned char* lds, int layer, int row_lo) {
    const int tid = threadIdx.x, lane = tid & 63, wid = tid >> 6, r32 = lane & 31, hh = lane >> 5;
    LAS float* xs = (LAS float*)(lds + wid * 12800);
    LAS float* lg = xs + 32 * 65;
    LAS float* rsd = lg + 32 * 33;
    LAS int* cnt_l = (LAS int*)(lds + 8 * 12800);
    LAS int* base_l = cnt_l + 32;
    const float* mods = WSP(float, WS_MODS) + (size_t)layer * 9 * 6144; const float* gff = P.in[layer ? 22 : 7];
    const bf16_t* GWH = WSP(bf16_t, WS_GW) + (size_t)layer * 9 * 32768; const bf16_t* GWL = GWH + (size_t)2 * 9 * 32 * 1024; const float* CB = WSP(float, WS_CB) + layer * 9 * 32;
    bf16_t* XN = WSP(bf16_t, WS_XN); int* tope = WSP(int, WS_TOPE); float* topg = WSP(float, WS_TOPG); int* rank = WSP(int, WS_RANK); int* rowtok = WSP(int, WS_ROWTOK);
    unsigned* gcnt = WSP(unsigned, WS_CTL) + CW_CNT + layer * 32;
    const float* xlat = P.out; const float* xctx = WSP(float, WS_HCTX);
    for (size_t i = (size_t)blockIdx.x * NTHREADS + tid; i < (size_t)MAXRB * 256; i += (size_t)gridDim.x * NTHREADS) rowtok[i] = row_lo;
    const int ngroups = (NTOK - row_lo) / 256;
    for (int grp = blockIdx.x; grp < ngroups; grp += gridDim.x) {
        const int R0 = row_lo + grp * 256 + wid * 32;
        const int rb = R0 < NCTX ? 8 : (R0 - NCTX) >> 13;
        const float* xb = R0 < NCTX ? xctx + (size_t)R0 * 1024 : xlat + (size_t)(R0 - NCTX) * 1024;
        __syncthreads();
        if (tid < 32) cnt_l[tid] = 0;
        f32x16 acc = F16ZERO; float ss = 0.f;
        const bf16_t* gwh = GWH + (size_t)rb * 32768 + (size_t)r32 * 1024 + 8 * hh; const bf16_t* gwl = GWL + (size_t)rb * 32768 + (size_t)r32 * 1024 + 8 * hh;
        const float* xr = xb + (size_t)r32 * 1024 + 8 * hh;
#pragma unroll 4
        for (int k0 = 0; k0 < 1024; k0 += 16) {
            const f32x4 a0 = *(const f32x4*)(xr + k0), a1 = *(const f32x4*)(xr + k0 + 4);
            const bf16x8 bh = *(const bf16x8*)(gwh + k0), bl = *(const bf16x8*)(gwl + k0);
            ss += a0[0] * a0[0] + a0[1] * a0[1] + a0[2] * a0[2] + a0[3] * a0[3] + a1[0] * a1[0] + a1[1] * a1[1] + a1[2] * a1[2] + a1[3] * a1[3];
            u32x4 hw, lw;
            hw.x = pk2(a0[0], a0[1]); hw.y = pk2(a0[2], a0[3]); hw.z = pk2(a1[0], a1[1]); hw.w = pk2(a1[2], a1[3]);
            lw.x = pk2(a0[0] - bflo(hw.x), a0[1] - bfhi(hw.x)); lw.y = pk2(a0[2] - bflo(hw.y), a0[3] - bfhi(hw.y)); lw.z = pk2(a1[0] - bflo(hw.z), a1[1] - bfhi(hw.z)); lw.w = pk2(a1[2] - bflo(hw.w), a1[3] - bfhi(hw.w));
            const bf16x8 ah = __builtin_bit_cast(bf16x8, hw), al = __builtin_bit_cast(bf16x8, lw);
            acc = __builtin_amdgcn_mfma_f32_32x32x16_bf16(ah, bh, acc, 0, 0, 0); acc = __builtin_amdgcn_mfma_f32_32x32x16_bf16(al, bh, acc, 0, 0, 0); acc = __builtin_amdgcn_mfma_f32_32x32x16_bf16(ah, bl, acc, 0, 0, 0);
        }
        ss += __shfl_xor(ss, 32);
        const float rstd = rsqrtf(ss * (1.f / 1024.f) + 1e-6f);
        if (hh == 0) rsd[r32] = rstd;
        const float cb = CB[rb * 32 + r32];
#pragma unroll
        for (int r = 0; r < 16; ++r) { const int row = crow(r, hh); lg[row * 33 + r32] = rsd[row] * acc[r] + cb; }
        int se[4] = {0, 0, 0, 0}, sr[4] = {0, 0, 0, 0}; float sg[4] = {0.f, 0.f, 0.f, 0.f};
        if (lane < 32) {
            float tv[4];
#pragma unroll
            for (int k = 0; k < 4; ++k) { float best = -3.0e38f; int bi = 0;
                for (int e = 0; e < 32; ++e) { const float v = lg[lane * 33 + e]; if (v > best) { best = v; bi = e; } }
                tv[k] = best; se[k] = bi; lg[lane * 33 + bi] = -3.0e38f; }
            const float e1 = __expf(tv[1] - tv[0]), e2 = __expf(tv[2] - tv[0]), e3 = __expf(tv[3] - tv[0]), inv = 1.f / (1.f + e1 + e2 + e3);
            sg[0] = inv; sg[1] = e1 * inv; sg[2] = e2 * inv; sg[3] = e3 * inv;
        }
        __syncthreads();
        if (lane < 32) {
#pragma unroll
            for (int k = 0; k < 4; ++k) sr[k] = lds_addi(&cnt_l[se[k]], 1);
        }
        __syncthreads();
        if (tid < 32) base_l[tid] = (int)atomicAdd(&gcnt[tid], (unsigned)cnt_l[tid]);
        __syncthreads();
        if (lane < 32) { const size_t row = (size_t)(R0 + lane);
#pragma unroll
            for (int k = 0; k < 4; ++k) { tope[row * 4 + k] = se[k]; topg[row * 4 + k] = sg[k]; rank[row * 4 + k] = base_l[se[k]] + sr[k]; } }
        const float* m = mods + (size_t)rb * 6144;
        f32x4 nx[4][4];
#pragma unroll
        for (int u = 0; u < 4; ++u)
#pragma unroll
            for (int q = 0; q < 4; ++q) nx[u][q] = *(const f32x4*)(xb + (size_t)u * 1024 + q * 256 + lane * 4);
        for (int i0 = 0; i0 < 32; i0 += 4) {
#pragma unroll
            for (int u = 0; u < 4; ++u) { const int i = i0 + u; const float rs_i = rsd[i]; f32x4 v[4];
#pragma unroll
                for (int q = 0; q < 4; ++q) v[q] = nx[u][q];
                if (i + 4 < 32) { const float* x = xb + (size_t)(i + 4) * 1024;
#pragma unroll
                    for (int q = 0; q < 4; ++q) nx[u][q] = *(const f32x4*)(x + q * 256 + lane * 4); }
#pragma unroll
                for (int q = 0; q < 4; ++q) { const int k = q * 256 + lane * 4;
                    const f32x4 o = v[q] * rs_i * *(const f32x4*)(gff + k) * (1.f + *(const f32x4*)(m + 4096 + k)) + *(const f32x4*)(m + 3072 + k);
                    *(unsigned*)((unsigned char*)XN + (size_t)(R0 + i) * 1024 + k) = pk4_fp8(o[0], o[1], o[2], o[3]); } } }
    }
    __syncthreads();
}
__device__ __forceinline__ void phase_moe_scatter(unsigned char* ws, const MoeTab& T, int row_lo) {
    const int* tope = WSP(int, WS_TOPE); const int* rank = WSP(int, WS_RANK); int* rowtok = WSP(int, WS_ROWTOK);
    for (size_t i = (size_t)blockIdx.x * NTHREADS + threadIdx.x + (size_t)row_lo * 4; i < (size_t)NTOK * 4; i += (size_t)gridDim.x * NTHREADS)
        rowtok[T.pad_start[tope[i]] + rank[i]] = (int)(i >> 2);
}
__device__ __forceinline__ void phase_moe_combine_norm(const Params& P, unsigned char* ws, const MoeTab& T, int layer, int row_lo) {
    const int lane = threadIdx.x & 63, gw = blockIdx.x * 8 + (threadIdx.x >> 6), nw = gridDim.x * 8;
    const int* tope = WSP(int, WS_TOPE); const int* rank = WSP(int, WS_RANK); const float* topg = WSP(float, WS_TOPG);
    const unsigned char* OUT = ws + WS_OUT; const float* mods = WSP(float, WS_MODS) + (size_t)layer * 9 * 6144; const float* mods1 = WSP(float, WS_MODS) + (size_t)9 * 6144;
    float* xlat = P.out; float* xctx = WSP(float, WS_HCTX); bf16_t* XN = WSP(bf16_t, WS_XN);
    const float* gn = layer ? P.in[43] : P.in[21];
    for (int row = row_lo + gw; row < NTOK; row += nw) {
        f32x4 a[4];
#pragma unroll
        for (int q = 0; q < 4; ++q) a[q] = (f32x4){0.f, 0.f, 0.f, 0.f};
#pragma unroll
        for (int k = 0; k < 4; ++k) { const int e = tope[(size_t)row * 4 + k], dest = T.pad_start[e] + rank[(size_t)row * 4 + k];
            const float g = topg[(size_t)row * 4 + k]; const unsigned char* o = OUT + (size_t)dest * 1024;
#pragma unroll
            for (int q = 0; q < 4; ++q) { const int w = *(const int*)(o + q * 256 + lane * 4); const f32x2 lo = __builtin_amdgcn_cvt_pk_f32_fp8(w, false), hi = __builtin_amdgcn_cvt_pk_f32_fp8(w, true);
                a[q][0] += g * lo.x; a[q][1] += g * lo.y; a[q][2] += g * hi.x; a[q][3] += g * hi.y; } }
        float* x; int r; if (row < NCTX) { x = xctx + (size_t)row * 1024; r = 8; } else { x = xlat + (size_t)(row - NCTX) * 1024; r = (row - NCTX) >> 13; }
        const float* gt = mods + (size_t)r * 6144 + 5120;
        float ss = 0.f;
#pragma unroll
        for (int q = 0; q < 4; ++q) { const int k = q * 256 + lane * 4; a[q] = *(const f32x4*)(x + k) + *(const f32x4*)(gt + k) * a[q]; ss += a[q][0] * a[q][0] + a[q][1] * a[q][1] + a[q][2] * a[q][2] + a[q][3] * a[q][3]; }
        ss = wave_sum(ss); const float rstd = rsqrtf(ss * (1.f / 1024.f) + 1e-6f);
        if (layer == 0) {
            const float* m = mods1 + (size_t)r * 6144;
#pragma unroll
            for (int q = 0; q < 4; ++q) { const int k = q * 256 + lane * 4; *(f32x4*)(x + k) = a[q];
                const f32x4 o = a[q] * rstd * *(const f32x4*)(gn + k) * (1.f + *(const f32x4*)(m + 1024 + k)) + *(const f32x4*)(m + k);
                *(unsigned*)((unsigned char*)XN + (size_t)row * 1024 + k) = pk4_fp8(o[0], o[1], o[2], o[3]); }
        } else {
#pragma unroll
            for (int q = 0; q < 4; ++q) { const int k = q * 256 + lane * 4; *(f32x4*)(x + k) = a[q] * rstd * *(const f32x4*)(gn + k); }
        }
    }
}

__device__ __forceinline__ void phase_s5_scan(unsigned char* ws) {
    const int gid = blockIdx.x * NTHREADS + threadIdx.x;
    if (gid >= NB * 16 * 2 * 64) return;
    const int p = gid & 63, dir = (gid >> 6) & 1, g = (gid >> 7) & 15, b = gid >> 11;
    const float* A64 = WSP(float, WS_S5A64); const float ar = A64[((dir * 16 + g) * 64 + p) * 2], ai = A64[((dir * 16 + g) * 64 + p) * 2 + 1];
    const float* Sl = (const float*)(ws + WS_R + R_SLOC) + (size_t)g * 1280 * 256 + dir * 128 + p;
    bf16_t* UX = (bf16_t*)(ws + WS_R + R_UX) + (size_t)g * 1280 * 1280 + 1024 + dir * 128 + p;
    float xr = 0.f, xi = 0.f;
    for (int i0 = 0; i0 < NCH; i0 += 12) {
        int nidx[12]; float sr[12], si[12];
#pragma unroll
        for (int q = 0; q < 12; ++q) { const int i = i0 + q; int c, n;
            if (i < 4) { c = dir ? 3 - i : i; n = 1024 + b * 4 + c; } else { c = dir ? 131 - i : i - 4; n = b * 128 + c; }
            nidx[q] = (i < 4) ? -1 - n : n; sr[q] = Sl[(size_t)n * 256]; si[q] = Sl[(size_t)n * 256 + 64]; }
#pragma unroll
        for (int q = 0; q < 12; ++q) {
            if (nidx[q] >= 0) { UX[(size_t)nidx[q] * 1280] = (bf16_t)f2bf(xr); UX[(size_t)nidx[q] * 1280 + 64] = (bf16_t)f2bf(xi); }
            const float nr = ar * xr - ai * xi + sr[q], ni = ar * xi + ai * xr + si[q]; xr = nr; xi = ni; }
    }
}

__device__ __forceinline__ void phase_final_norm(const Params& P) {
    const int lane = threadIdx.x & 63, gw = blockIdx.x * 8 + (threadIdx.x >> 6), nw = gridDim.x * 8; const float* g = P.in[43];
    for (int row = gw; row < NLAT; row += nw) { float* x = P.out + (size_t)row * 1024; f32x4 v[4]; float ss = 0.f;
#pragma unroll
        for (int i = 0; i < 4; ++i) { v[i] = *(const f32x4*)(x + i * 256 + lane * 4); ss += v[i][0] * v[i][0] + v[i][1] * v[i][1] + v[i][2] * v[i][2] + v[i][3] * v[i][3]; }
        ss = wave_sum(ss); const float rstd = rsqrtf(ss * (1.f / 1024.f) + 1e-6f);
#pragma unroll
        for (int i = 0; i < 4; ++i) *(f32x4*)(x + i * 256 + lane * 4) = v[i] * rstd * *(const f32x4*)(g + i * 256 + lane * 4); }
}

constexpr int NPHASE = 23;
__global__ void __launch_bounds__(NTHREADS, 2) hybrid_fwd(Params P) {
    extern __shared__ __attribute__((aligned(16))) unsigned char shm_raw[];
    LAS unsigned char* lds = (LAS unsigned char*)shm_raw;
    LAS unsigned char* misc = lds + LDS_STAGE;
    unsigned char* ws = P.ws; unsigned char* R = ws + WS_R;
    const int lo = P.ph_lo, hi = P.ph_hi;
    if (threadIdx.x == 0) *(LAS u32x4*)misc = (u32x4){0u, 0u, 0u, 0u};
    __syncthreads();
    XcdBarrier bar; bar.bar = WSP(unsigned, WS_CTL); bar.x = 0; bar.st = (volatile LAS unsigned*)misc;
    if (hi - lo > 1) bar = xcd_barrier_post(WSP(unsigned, WS_CTL), (volatile LAS unsigned*)misc);
    const MoeTab T = moe_tab(misc);
    const float* mods = WSP(float, WS_MODS);
#ifndef PHMASK
#define PHMASK 0x7fffffffull
#endif
#define IN(k) ((((PHMASK) >> (k)) & 1ull) != 0ull && lo <= (k) && (k) < hi)
#define SEAM(k) do { if (IN(k) && IN((k) + 1)) xcd_barrier(bar); } while (0)

    if (IN(0)) { attn8_reference(ws, P.in[35], P.in[36]); phase_mods(P, ws, lds); phase_convert_small(P, ws, lds); phase_convert_moe8(P, ws, lds, 0); if (REP(0)) phase_convert_moe8(P, ws, lds, 0); phase_s5_kernels(P, ws, lds); }
    SEAM(0);
    if (IN(1)) { phase_router_tables(P, ws, lds); phase_s5_tables(P, ws); if (REP(1)) phase_s5_tables(P, ws); phase_norm1(P, ws, 0, P.in[0], P.in[2]); if (REP(15)) phase_norm1(P, ws, 0, P.in[0], P.in[2]); }
    SEAM(1);
    if (IN(2)) { SchedPlain S; S.init(NTOK / 256, 12, 1); S.A = (const char*)(ws + WS_XN); S.Bt = (const char*)(ws + WS_WIN0T); S.lda_bytes = 2048; S.ldb_bytes = 2048; S.a_gstride = 0; S.b_gstride = 0;
        EpiInProj0 E; E.R = R; E.gate_bias = P.in[10]; pg8::gemm_phase(lds, S, E, 1024); if (REP(2)) pg8::gemm_phase(lds, S, E, 1024); }
    SEAM(2);
    if (IN(3)) { phase_qkv_prep(lds, (const bf16_t*)(R + R_KBR), 128, (const bf16_t*)(R + R_VBR), 128, (bf16_t*)(R + R_QB), 512, 2, 8, (bf16_t*)(R + R_KC0), (bf16_t*)(R + R_VT0), nullptr, nullptr, true);
        phase_mlstm_local2(ws, lds); if (REP(3)) phase_mlstm_local2(ws, lds); }
    SEAM(3);
    if (IN(4)) { phase_mlstm_scan(ws);
        AttnArgs A; A.Q = (const bf16_t*)(R + R_QB); A.qpitch = 512; A.Kc = (const bf16_t*)(R + R_KC0); A.VT = (const bf16_t*)(R + R_VT0); A.O = WSP(bf16_t, WS_XN); A.opitch = 1024; A.ocol0 = 512; A.HKV = 2; A.sink = P.in[12]; A.swa = 1;
        phase_attention_v1(A, lds, misc, WSP(unsigned, WS_CTL) + CW_Q0, true); if (REP(4)) phase_attention_v1(A, lds, misc, WSP(unsigned, WS_CTL) + CW_Q0 + 128, true); }
    SEAM(4);
    if (IN(5)) { phase_mlstm_out2(P, ws, lds); if (REP(5)) phase_mlstm_out2(P, ws, lds); }
    SEAM(5);
    if (IN(6)) { SchedPlain S; S.init(NTOK / 256, 4, 1); S.A = (const char*)(ws + WS_XN); S.Bt = (const char*)(ws + WS_WOUT0T); S.lda_bytes = 1024; S.ldb_bytes = 1024; S.a_gstride = 0; S.b_gstride = 0;
        EpiResid E; E.xin = P.in[0]; E.xout = P.out; E.hin = P.in[2]; E.hout = WSP(float, WS_HCTX); E.gate = mods + 2048; E.row_base = 0; E.scale = W8_INV; pg8::gemm_phase8(lds, S, E, 512); if (REP(6)) pg8::gemm_phase8(lds, S, E, 512); }
    SEAM(6);
#define MOE_LAYER(PH0, LAYER, ROWLO)                                                                                                                              \
    if (IN(PH0)) phase_norm2_route(P, ws, lds, LAYER, ROWLO);                                                                                                     \
    SEAM(PH0);                                                                                                                                                    \
    if (IN(PH0 + 1)) { moe_build_tab(WSP(unsigned, WS_CTL) + CW_CNT + LAYER * 32, T); phase_moe_scatter(ws, T, ROWLO); }                                          \
    SEAM(PH0 + 1);                                                                                                                                                \
    {   if (IN(PH0 + 2) || IN(PH0 + 3) || IN(PH0 + 4)) moe_build_tab(WSP(unsigned, WS_CTL) + CW_CNT + LAYER * 32, T);                                            \
        const int nrb = T.rb_start[NEXP];                                                                                                                         \
        if (IN(PH0 + 2)) { SchedMoe1 S; S.XN = (const char*)(ws + WS_XN); S.rowtok = WSP(int, WS_ROWTOK); S.W = (const char*)(ws + WS_WGU); S.T = T; S.rb_lo = 0; S.rb_hi = nrb; S.G = gridDim.x; S.c = blockIdx.x; S.ldb_bytes = 1024; \
            EpiSwiGLU E; E.ACT = ws + WS_ACT8; E.bgu = P.in[LAYER ? 40 : 16]; E.rb_lo = 0; pg8::gemm_phase8(lds, S, E, 512); if (REP(9)) pg8::gemm_phase8(lds, S, E, 512); }  \
        SEAM(PH0 + 2);                                                                                                                                            \
        if (IN(PH0 + 3)) { SchedMoe2 S; S.ACT = (const char*)(ws + WS_ACT8); S.W = (const char*)(ws + WS_WD); S.T = T; S.rb_lo = 0; S.rb_hi = nrb; S.G = gridDim.x; S.c = blockIdx.x; S.ldb_bytes = 1024; \
            EpiMoeOut E; E.OUT = ws + WS_OUT; E.bd = P.in[LAYER ? 42 : 18]; E.rb_lo = 0; pg8::gemm_phase8(lds, S, E, 512); if (REP(10)) pg8::gemm_phase8(lds, S, E, 512); }  \
        SEAM(PH0 + 3);                                                                                                                                            \
        if (IN(PH0 + 4)) { phase_moe_combine_norm(P, ws, T, LAYER, ROWLO); if (LAYER == 0) phase_convert_moe8(P, ws, lds, 1); }                                    \
    }
    MOE_LAYER(7, 0, 0)
    SEAM(11);
    if (IN(12)) { SchedPlain S; S.init(NTOK / 256, 6, 1); S.A = (const char*)(ws + WS_XN); S.Bt = (const char*)(ws + WS_WIN1T); S.lda_bytes = 1024; S.ldb_bytes = 1024; S.a_gstride = 0; S.b_gstride = 0;
        EpiInProj1 E; E.R = R; pg8::gemm_phase8(lds, S, E, 512); if (REP(16)) pg8::gemm_phase8(lds, S, E, 512); }
    SEAM(12);
    if (IN(13)) { phase_qkv_prep8(ws, lds, P.in[35], P.in[36]);
        SchedPlain S; S.init(5, 1, 16); S.A = (const char*)(R + R_UX); S.Bt = (const char*)(ws + WS_S5F); S.lda_bytes = 2560; S.ldb_bytes = 2048; S.a_gstride = (size_t)1280 * 2560; S.b_gstride = (size_t)256 * 2048;
        EpiS5F E; E.S = (float*)(R + R_SLOC); pg8::gemm_phase(lds, S, E, 1024); }
    SEAM(13);
    if (IN(14)) { phase_s5_scan(ws);
        phase_attention8(ws, lds, misc, WSP(unsigned, WS_CTL) + CW_Q0 + 64, P.in[35], P.in[36]); if (REP(18)) phase_attention8(ws, lds, misc, WSP(unsigned, WS_CTL) + CW_Q0 + 192, P.in[35], P.in[36]); }
    SEAM(14);
    if (IN(15)) { SchedPlain S; S.init(4, 4, 16); S.A = (const char*)(R + R_UX); S.Bt = (const char*)(ws + WS_S5TE); S.lda_bytes = 2560; S.ldb_bytes = 2560; S.a_gstride = (size_t)1280 * 2560; S.b_gstride = (size_t)1024 * 2560;
        EpiS5Y E; E.UX = (const bf16_t*)(R + R_UX); E.Yg = (bf16_t*)(R + R_YG); E.dskip = P.in[32]; pg8::gemm_phase(lds, S, E, 1280); if (REP(19)) pg8::gemm_phase(lds, S, E, 1280); }
    SEAM(15);
    if (IN(16)) { SchedPlain S; S.init(NLAT / 256, 1, 1); S.A = (const char*)(R + R_YG); S.Bt = (const char*)(ws + WS_WGLUT); S.lda_bytes = 512; S.ldb_bytes = 512; S.a_gstride = 0; S.b_gstride = 0;
        EpiGLU E; E.Yg = (const bf16_t*)(R + R_YG); E.MIX = WSP(bf16_t, WS_XN); E.bglu = P.in[34]; pg8::gemm_phase(lds, S, E, 256); if (REP(20)) pg8::gemm_phase(lds, S, E, 256); }
    SEAM(16);
    if (IN(17)) { SchedPlain S; S.init(NLAT / 256, 4, 1); S.A = (const char*)(ws + WS_XN) + (size_t)NCTX * 2048; S.Bt = (const char*)(ws + WS_WOUT1T); S.lda_bytes = 2048; S.ldb_bytes = 2048; S.a_gstride = 0; S.b_gstride = 0;
        EpiResid E; E.xin = P.out; E.xout = P.out; E.hin = WSP(float, WS_HCTX); E.hout = WSP(float, WS_HCTX); E.gate = mods + 9 * 6144 + 2048; E.row_base = NCTX; E.scale = 1.f; pg8::gemm_phase(lds, S, E, 1024); }
    SEAM(17);
    MOE_LAYER(18, 1, NCTX)
#undef IN
#undef SEAM
}

extern "C" void kernel_launch(void* const* d_in, const int* in_sizes, int n_in, void* d_out, int out_size, void* d_ws, size_t ws_size, hipStream_t stream) {
    (void)in_sizes; (void)out_size;
    if (n_in < 44 || ws_size < WS_END) { fprintf(stderr, "kernel_launch: n_in %d ws_size %zu need %zu\n", n_in, ws_size, (size_t)WS_END); return; }
    static int grid = 0;
    if (!grid) {
        int dev = 0, cus = 0, per_cu = 0;
        hipGetDevice(&dev);
        hipDeviceGetAttribute(&cus, hipDeviceAttributeMultiprocessorCount, dev);
        hipFuncSetAttribute((const void*)hybrid_fwd, hipFuncAttributeMaxDynamicSharedMemorySize, LDS_BYTES);
        hipOccupancyMaxActiveBlocksPerMultiprocessor(&per_cu, (const void*)hybrid_fwd, NTHREADS, LDS_BYTES);
        if (per_cu < 1) { fprintf(stderr, "kernel_launch: occupancy query says %d blocks per CU\n", per_cu); per_cu = 1; }
        grid = cus;
    }
    hipMemsetAsync(d_ws, 0, WS_ZERO_BYTES, stream);
    Params p{};
    for (int i = 0; i < 44; ++i) p.in[i] = (const float*)d_in[i];
    p.out = (float*)d_out; p.ws = (unsigned char*)d_ws;
#if MK_MULTI
    for (int ph = 0; ph < NPHASE; ++ph) { p.ph_lo = ph; p.ph_hi = ph + 1; hipLaunchKernelGGL(hybrid_fwd, dim3(grid), dim3(NTHREADS), LDS_BYTES, stream, p); }
#else
    p.ph_lo = 0; p.ph_hi = NPHASE;
    hipLaunchKernelGGL(hybrid_fwd, dim3(grid), dim3(NTHREADS), LDS_BYTES, stream, p);
#endif
}
```

```cpp
#include <hip/hip_runtime.h>
#include <cstdio>
#include <cstdint>

#ifndef DBG_SKIP
#define DBG_SKIP 0
#endif
#ifndef DBG_REP
#define DBG_REP 0ull
#endif
#define REP(k) ((((DBG_REP) >> (k)) & 1ull) != 0ull)
#ifndef MK_MULTI
#define MK_MULTI 0
#endif

#define LAS __attribute__((address_space(3)))
typedef unsigned short bf16_t;
typedef short bf16x8 __attribute__((ext_vector_type(8)));
typedef short bf16x4 __attribute__((ext_vector_type(4)));
typedef float f32x4 __attribute__((ext_vector_type(4)));
typedef float f32x2 __attribute__((ext_vector_type(2)));
typedef float f32x16 __attribute__((ext_vector_type(16)));
typedef unsigned u32x4 __attribute__((ext_vector_type(4)));
typedef unsigned u32x2 __attribute__((ext_vector_type(2)));
typedef int i32x8 __attribute__((ext_vector_type(8)));

constexpr int NB = 8, SEQ = 8192, DM = 1024, CTXL = 256;
constexpr int NCTX = NB * CTXL;
constexpr int NLAT = NB * SEQ;
constexpr int NTOK = NCTX + NLAT;
constexpr int NCH = 132;
constexpr int NKEY = CTXL + SEQ;
constexpr int NEXP = 32;
constexpr int MAXRB = 1088;
constexpr int NTHREADS = 512;
constexpr int LDS_STAGE = 131072;
constexpr int LDS_MISC = 16384;
constexpr int LDS_BYTES = LDS_STAGE + LDS_MISC;

__device__ __forceinline__ unsigned f2bf(float f) { unsigned u = __builtin_bit_cast(unsigned, f); return (u + 0x7fffu + ((u >> 16) & 1u)) >> 16; }
__device__ __forceinline__ unsigned pk2(float lo, float hi) { unsigned r; asm("v_cvt_pk_bf16_f32 %0, %1, %2" : "=v"(r) : "v"(lo), "v"(hi)); return r; }
__device__ __forceinline__ float bf2f(unsigned short b) { return __builtin_bit_cast(float, ((unsigned)b) << 16); }
__device__ __forceinline__ float bflo(unsigned w) { return __builtin_bit_cast(float, w << 16); }
__device__ __forceinline__ float bfhi(unsigned w) { return __builtin_bit_cast(float, w & 0xffff0000u); }
__device__ __forceinline__ float wave_sum(float v) {
#pragma unroll
    for (int o = 32; o >= 1; o >>= 1) v += __shfl_xor(v, o);
    return v;
}
__device__ __forceinline__ float wave_max(float v) {
#pragma unroll
    for (int o = 32; o >= 1; o >>= 1) v = fmaxf(v, __shfl_xor(v, o));
    return v;
}

__device__ __forceinline__ float clamp448(float x) { return __builtin_amdgcn_fmed3f(x, -448.f, 448.f); }
__device__ __forceinline__ unsigned pk4_fp8(float a, float b, float c, float d) {
    int w = 0; w = __builtin_amdgcn_cvt_pk_fp8_f32(clamp448(a), clamp448(b), w, false); w = __builtin_amdgcn_cvt_pk_fp8_f32(clamp448(c), clamp448(d), w, true); return (unsigned)w;
}
__device__ __forceinline__ unsigned pk4_fp8_nc(float a, float b, float c, float d) {
    int w = 0; w = __builtin_amdgcn_cvt_pk_fp8_f32(a, b, w, false); w = __builtin_amdgcn_cvt_pk_fp8_f32(c, d, w, true); return (unsigned)w;
}
__device__ __forceinline__ f32x4 fma4(const f32x4 a, const float s, const f32x4 b) { f32x4 r; r.x = __builtin_fmaf(a.x, s, b.x); r.y = __builtin_fmaf(a.y, s, b.y); r.z = __builtin_fmaf(a.z, s, b.z); r.w = __builtin_fmaf(a.w, s, b.w); return r; }
__device__ __forceinline__ u32x2 bf8_to_fp8(const u32x4 w) { u32x2 o; o.x = pk4_fp8(bflo(w.x), bfhi(w.x), bflo(w.y), bfhi(w.y)); o.y = pk4_fp8(bflo(w.z), bfhi(w.z), bflo(w.w), bfhi(w.w)); return o; }
constexpr float W8_SCALE = 32.f, W8_INV = 1.f / 32.f;
__device__ __forceinline__ float sigmoidf_(float x) { return __builtin_amdgcn_rcpf(1.f + __builtin_amdgcn_exp2f(-1.4426950408889634f * x)); }
__device__ __forceinline__ float logsigmoidf_(float x) { return fminf(x, 0.f) - log1pf(__expf(-fabsf(x))); }

#define XB_TMO      128
#define XB_XCNT(j)  (256  + 64 * (j))
#define XB_XSUB(j)  (1280 + 64 * (j))
#define XB_XGEN(j)  (2304 + 64 * (j))
#define XB_TOP      3328
#define XB_TOPGEN   3392
#define XCD_BAR_WORDS 3456
#define XB_SPIN_CAP (1u << 22)

__device__ __forceinline__ unsigned xb_ld(unsigned* p)              { return __hip_atomic_load(p, __ATOMIC_RELAXED, __HIP_MEMORY_SCOPE_AGENT); }
__device__ __forceinline__ unsigned xb_add(unsigned* p, unsigned v) { return __hip_atomic_fetch_add(p, v, __ATOMIC_RELAXED, __HIP_MEMORY_SCOPE_AGENT); }
__device__ __forceinline__ unsigned xb_xcc_id() { return (unsigned)__builtin_amdgcn_s_getreg((3 << 11) | 20) & 0xFu; }
#define XB_SPIN(cond, bar) do { unsigned _sp = 0; while (cond) { __builtin_amdgcn_s_sleep(1); \
    if ((++_sp & 255u) == 0u) { if (xb_ld(&(bar)[XB_TMO])) break; if (_sp > XB_SPIN_CAP) { atomicAdd(&(bar)[XB_TMO], 1u); break; } } } } while (0)

struct XcdBarrier { unsigned* bar; unsigned x; volatile LAS unsigned* st; };

__device__ __forceinline__ XcdBarrier xcd_barrier_post(unsigned* bar, volatile LAS unsigned* st) {
    XcdBarrier b; b.bar = bar; b.x = xb_xcc_id(); b.st = st;
    if (threadIdx.x == 0) (void)xb_add(&bar[XB_XCNT(b.x)], 1u);
    return b;
}
__device__ __forceinline__ void xcd_barrier_complete(unsigned* bar, unsigned x, unsigned& nloc, unsigned& nx) {
    const unsigned G = gridDim.x * gridDim.y * gridDim.z;
    unsigned sum, cnt, mine, sp = 0u;
    for (;;) {
        sum = 0u; cnt = 0u; mine = 0u;
#pragma unroll
        for (unsigned j = 0; j < 16; ++j) { const unsigned c = xb_ld(&bar[XB_XCNT(j)]); sum += c; cnt += (c > 0u) ? 1u : 0u; mine = (j == x) ? c : mine; }
        if (sum == G) break;
        __builtin_amdgcn_s_sleep(1);
        if ((++sp & 255u) == 0u) { if (xb_ld(&bar[XB_TMO])) break; if (sp > XB_SPIN_CAP) { atomicAdd(&bar[XB_TMO], 1u); break; } }
    }
    nloc = mine > 0u ? mine : 1u; nx = cnt > 0u ? cnt : 1u;
}
__device__ __forceinline__ void xcd_barrier(const XcdBarrier& b) {
    asm volatile("s_waitcnt vmcnt(0)" ::: "memory");
    __syncthreads();
    if (threadIdx.x == 0) {
        unsigned* bar = b.bar;
        __builtin_amdgcn_s_waitcnt(0);
        unsigned nloc = b.st[0], nx = b.st[1];
        if (nloc == 0u) { xcd_barrier_complete(bar, b.x, nloc, nx); b.st[0] = nloc; b.st[1] = nx; }
        const unsigned old = xb_add(&bar[XB_XSUB(b.x)], 1u);
        const unsigned gen = old / nloc;
        if (old + 1u == (gen + 1u) * nloc) {
            __builtin_amdgcn_fence(__ATOMIC_RELEASE, "agent");
            asm volatile("s_waitcnt vmcnt(0)" ::: "memory");
            const unsigned og = xb_add(&bar[XB_TOP], 1u);
            const unsigned tg = og / nx;
            if (og + 1u == (tg + 1u) * nx) xb_add(&bar[XB_TOPGEN], 1u);
            else XB_SPIN(xb_ld(&bar[XB_TOPGEN]) == tg, bar);
            __builtin_amdgcn_fence(__ATOMIC_ACQUIRE, "agent");
            xb_add(&bar[XB_XGEN(b.x)], 1u);
            asm volatile("s_waitcnt vmcnt(0)" ::: "memory");
        } else {
            XB_SPIN(xb_ld(&bar[XB_XGEN(b.x)]) == gen, bar);
            __builtin_amdgcn_fence(__ATOMIC_ACQUIRE, "agent");
            asm volatile("s_waitcnt vmcnt(0)" ::: "memory");
        }
    }
    __syncthreads();
}

constexpr size_t al256(size_t x) { return (x + 255) & ~(size_t)255; }
constexpr size_t WS_CTL    = 0;
constexpr size_t CTL_BYTES = 65536;
constexpr size_t WS_MODS   = WS_CTL + CTL_BYTES;
constexpr size_t MODS_BYTES = al256((size_t)2 * 9 * 6144 * 4);
constexpr size_t WS_ZERO_BYTES = WS_MODS + MODS_BYTES;
constexpr size_t WS_GW     = WS_ZERO_BYTES;
constexpr size_t WS_CB     = WS_GW + (size_t)2 * 9 * 1024 * 32 * 4;
constexpr size_t WS_S5K    = al256(WS_CB + 2 * 9 * 32 * 4);
constexpr size_t WS_S5A64  = WS_S5K + (size_t)16 * 2 * 64 * 256 * 4;
constexpr size_t WS_WIN0T  = al256(WS_S5A64 + 2 * 16 * 64 * 2 * 4);
constexpr size_t WS_WOUT0T = WS_WIN0T + (size_t)3072 * 1024 * 2;
constexpr size_t WS_WIN1T  = WS_WOUT0T + (size_t)1024 * 1024 * 2;
constexpr size_t WS_WOUT1T = WS_WIN1T + (size_t)1536 * 1024 * 2;
constexpr size_t WS_WGLUT  = WS_WOUT1T + (size_t)1024 * 1024 * 2;
constexpr size_t WS_S5TE   = WS_WGLUT + (size_t)256 * 256 * 2;
constexpr size_t WS_S5F    = WS_S5TE + (size_t)16 * 1024 * 1280 * 2;
constexpr size_t WS_WGU    = WS_S5F + (size_t)16 * 256 * 1024 * 2;
constexpr size_t WS_WD     = WS_WGU + (size_t)32 * 2048 * 1024;
constexpr size_t WS_HCTX   = WS_WD + (size_t)32 * 1024 * 1024;
constexpr size_t WS_TOPE   = WS_HCTX + (size_t)NCTX * 1024 * 4;
constexpr size_t WS_TOPG   = WS_TOPE + (size_t)NTOK * 4 * 4;
constexpr size_t WS_RANK   = WS_TOPG + (size_t)NTOK * 4 * 4;
constexpr size_t WS_ROWTOK = WS_RANK + (size_t)NTOK * 4 * 4;
constexpr size_t WS_XN     = al256(WS_ROWTOK + (size_t)MAXRB * 256 * 4);
constexpr size_t WS_R      = WS_XN + (size_t)NTOK * 1024 * 2;
constexpr size_t WS_ACT8   = WS_XN + (size_t)NTOK * 1024;
constexpr size_t WS_OUT    = WS_ACT8 + (size_t)MAXRB * 256 * 1024;
constexpr size_t WS_MOE_END = WS_OUT + (size_t)MAXRB * 256 * 1024 * 2;
constexpr size_t PROJ512   = (size_t)NTOK * 512 * 2;
constexpr size_t R_QA = 0, R_KA = R_QA + PROJ512, R_VA = R_KA + PROJ512, R_OA = R_VA + PROJ512, R_QB = R_OA + PROJ512;
constexpr size_t R_KBR = R_QB + PROJ512;
constexpr size_t R_VBR = R_KBR + (size_t)NTOK * 128 * 2;
constexpr size_t R_G   = R_VBR + (size_t)NTOK * 128 * 2;
constexpr size_t R_KC0 = R_G + (size_t)NTOK * 32 * 4;
constexpr size_t R_VT0 = R_KC0 + (size_t)NB * 2 * NKEY * 64 * 2;
constexpr size_t R_CS  = R_VT0 + (size_t)NB * 2 * NKEY * 64 * 2;
constexpr size_t NSEQ_M = (size_t)NB * 8 * 2 * NCH;
constexpr size_t R_NS  = R_CS + NSEQ_M * 8192;
constexpr size_t R_ML  = R_NS + NSEQ_M * 256;
constexpr size_t R_BL  = R_ML + NSEQ_M * 4;
constexpr size_t R_MP  = R_BL + NSEQ_M * 4;
constexpr size_t R_BT  = R_MP + NSEQ_M * 4;
constexpr size_t R_PM  = R_BT + NSEQ_M * 256;
constexpr size_t R_GC  = R_PM + NSEQ_M * 256;
constexpr size_t R_L0_END = R_GC + NSEQ_M * 256;
constexpr size_t R_UX  = 0;
constexpr size_t R_Q1  = R_UX + (size_t)16 * 1280 * 1280 * 2;
constexpr size_t R_KV1 = R_Q1 + (size_t)NTOK * 768 * 2;
constexpr size_t R_KC1 = R_KV1 + (size_t)NTOK * 384 * 2;
constexpr size_t R_VT1 = R_KC1 + (size_t)NB * 3 * NKEY * 64 * 2;
constexpr size_t R_SLOC = R_VT1 + (size_t)NB * 3 * NKEY * 64 * 2;
constexpr size_t R_YG  = R_SLOC + (size_t)16 * 1280 * 256 * 4;
constexpr size_t R_Q8  = R_YG + (size_t)NLAT * 256 * 2;
constexpr size_t R_K8  = R_Q8 + (size_t)NLAT * 768;
constexpr size_t R_VT8 = R_K8 + (size_t)NB * 3 * NKEY * 64;
constexpr size_t R_L1_END = R_VT8 + (size_t)NB * 3 * NKEY * 64;
constexpr size_t R_BYTES = (R_L0_END > R_L1_END ? R_L0_END : R_L1_END);
constexpr size_t WS_END = (WS_R + R_BYTES > WS_MOE_END ? WS_R + R_BYTES : WS_MOE_END);

constexpr int CW_Q0 = 4096;
constexpr int CW_CNT = 8192;
constexpr int CW_TRIP = 8192 + 128;

struct Params {
    const float* in[44];
    float* out;
    unsigned char* ws;
    int ph_lo, ph_hi;
};

namespace pg8 {
constexpr int BM = 256, BK = 64, HALF = 128, HTB = HALF * BK * 2, NXCD = 8, WGM = 8;
__host__ __device__ __forceinline__ int lds_byte(int r, int c) { const int st = (r >> 4) * 2 + (c >> 5), rr = r & 15, cc = c & 31, ob = rr * 64 + cc * 2; return st * 1024 + (ob ^ (((ob >> 9) & 1) << 5)); }
__host__ __device__ __forceinline__ void stage_rc(int b, int& R, int& C) { const int st = b / 1024, sb = b % 1024, swz = sb ^ (((sb >> 9) & 1) << 5); R = (st >> 1) * 16 + swz / 64; C = (st & 1) * 32 + (swz % 64) / 2; }
__host__ __device__ __forceinline__ int perm32(int rho) { const int n = rho >> 4, i = rho & 15; return 8 * (i >> 2) + 4 * n + (i & 3); }

struct Unit { int pm, pn, g; };

__device__ __forceinline__ unsigned cvt_pk_bf16(float lo, float hi) { unsigned r; asm volatile("v_cvt_pk_bf16_f32 %0, %1, %2" : "=v"(r) : "v"(lo), "v"(hi)); return r; }

template <class Epi, class Sched>
__device__ __forceinline__ void gemm_phase(LAS unsigned char* lds, const Sched& S, const Epi& E, int K) {
    asm volatile("" : "+s"(K));
    const int tid = threadIdx.x, wid = __builtin_amdgcn_readfirstlane(tid >> 6), lane = tid & 63, wr = wid >> 2, wc = wid & 3, fr = lane & 15, fq = lane >> 4;
    const int nt = K / BK;
    int Rr[2], Cc[2]; unsigned voffB[2];
#pragma unroll
    for (int i = 0; i < 2; ++i) { int R, C; stage_rc(tid * 16 + i * 8192, R, C); const int Rb = Epi::PERM ? ((R & ~31) + perm32(R & 31)) : R;
        Rr[i] = R; Cc[i] = C; voffB[i] = (unsigned)Rb * (unsigned)S.ldb_bytes + (unsigned)C * 2u; }
    const size_t kstep = (size_t)(BK * 2);
    const size_t hstepB = (size_t)HALF * S.ldb_bytes;
    const unsigned ldsw = (unsigned)wid * 1024u;
    const int aoff = lds_byte(wr * 64 + fr, fq * 8), boff = lds_byte(wc * 32 + fr, fq * 8);
#define PG8_SA(b, h) (((b) * 2 + (h)) * HTB)
#define PG8_SB(b, h) ((4 + (b) * 2 + (h)) * HTB)
#define PG8_STAGE_B(bufoff, gbase) do { _Pragma("unroll") for (int _i = 0; _i < 2; ++_i) \
        __builtin_amdgcn_global_load_lds((const unsigned*)((const char*)(gbase) + voffB[_i]), (LAS unsigned*)(lds + (bufoff) + ldsw + _i * 8192), 16, 0, 0); } while (0)
#define PG8_STAGE_A(bufoff, gbase, o0, o1) do { \
        __builtin_amdgcn_global_load_lds((const unsigned*)((const char*)(gbase) + (o0)), (LAS unsigned*)(lds + (bufoff) + ldsw), 16, 0, 0); \
        __builtin_amdgcn_global_load_lds((const unsigned*)((const char*)(gbase) + (o1)), (LAS unsigned*)(lds + (bufoff) + ldsw + 8192), 16, 0, 0); } while (0)
#define PG8_LDA(dst, b, h) do { _Pragma("unroll") for (int m = 0; m < 4; ++m) _Pragma("unroll") for (int k = 0; k < 2; ++k) dst[m][k] = *(const LAS bf16x8*)(lds + PG8_SA(b, h) + aoff + m * 2048 + k * 1024); } while (0)
#define PG8_LDB(dst, b, h) do { _Pragma("unroll") for (int n = 0; n < 2; ++n) _Pragma("unroll") for (int k = 0; k < 2; ++k) dst[n][k] = *(const LAS bf16x8*)(lds + PG8_SB(b, h) + boff + n * 2048 + k * 1024); } while (0)
#define PG8_MMA(ai, bj, At, Bt) do { __builtin_amdgcn_s_setprio(1); _Pragma("unroll") for (int m = 0; m < 4; ++m) _Pragma("unroll") for (int n = 0; n < 2; ++n) _Pragma("unroll") for (int k = 0; k < 2; ++k) \
        acc[ai][bj][m][n] = __builtin_amdgcn_mfma_f32_16x16x32_bf16(Bt[n][k], At[m][k], acc[ai][bj][m][n], 0, 0, 0); __builtin_amdgcn_s_setprio(0); } while (0)
#define PG8_WAIT_V(n) asm volatile("s_waitcnt vmcnt(" #n ")" ::: "memory")
#define PG8_WAIT_L(n) asm volatile("s_waitcnt lgkmcnt(" #n ")" ::: "memory")
#define PG8_BAR __builtin_amdgcn_s_barrier()
#define PG8_SCHED __builtin_amdgcn_sched_barrier(0)
    Unit cur, nxt; int ui = 0;
    if (!S.next(0, cur)) return;
    f32x4 acc[2][2][4][2];
#pragma unroll
    for (int a = 0; a < 2; ++a)
#pragma unroll
        for (int b = 0; b < 2; ++b)
#pragma unroll
            for (int m = 0; m < 4; ++m)
#pragma unroll
                for (int n = 0; n < 2; ++n) acc[a][b][m][n] = (f32x4){0.f, 0.f, 0.f, 0.f};
    bf16x8 At[4][2], B0[2][2], B1[2][2];
    const char* cA = S.a_base(cur); const char* cB = S.b_base(cur);
    unsigned c00 = S.a_off(cur, Rr[0]) + Cc[0] * 2u, c01 = S.a_off(cur, Rr[1]) + Cc[1] * 2u, c10 = S.a_off(cur, HALF + Rr[0]) + Cc[0] * 2u, c11 = S.a_off(cur, HALF + Rr[1]) + Cc[1] * 2u;
    PG8_STAGE_B(PG8_SB(0, 0), cB); PG8_STAGE_B(PG8_SB(0, 1), cB + hstepB); PG8_STAGE_A(PG8_SA(0, 0), cA, c00, c01); PG8_STAGE_A(PG8_SA(0, 1), cA, c10, c11);
    if (wr == 1) PG8_BAR;
    PG8_WAIT_V(2); PG8_BAR;
    PG8_STAGE_B(PG8_SB(1, 0), cB + kstep); PG8_STAGE_A(PG8_SA(1, 0), cA + kstep, c00, c01); PG8_STAGE_B(PG8_SB(1, 1), cB + hstepB + kstep);
    PG8_WAIT_V(6); PG8_BAR;
    for (;;) {
        const bool has_next = S.next(ui + 1, nxt);
        const char* nA = has_next ? S.a_base(nxt) : cA; const char* nB = has_next ? S.b_base(nxt) : cB;
        unsigned n00 = c00, n01 = c01, n10 = c10, n11 = c11;
        if (has_next) { n00 = S.a_off(nxt, Rr[0]) + Cc[0] * 2u; n01 = S.a_off(nxt, Rr[1]) + Cc[1] * 2u; n10 = S.a_off(nxt, HALF + Rr[0]) + Cc[0] * 2u; n11 = S.a_off(nxt, HALF + Rr[1]) + Cc[1] * 2u; }
        for (int t = 0; t < nt; t += 2) {
            const bool last = (t == nt - 2);
            const char* a1 = cA + (size_t)(t + 1) * kstep;
            const char* a2 = last ? nA : cA + (size_t)(t + 2) * kstep; const char* b2 = last ? nB : cB + (size_t)(t + 2) * kstep;
            const char* a3 = a2 + kstep; const char* b3 = b2 + kstep;
            const unsigned x00 = last ? n00 : c00, x01 = last ? n01 : c01, x10 = last ? n10 : c10, x11 = last ? n11 : c11;
            PG8_LDB(B0, 0, 0); PG8_LDB(B1, 0, 1); PG8_SCHED; PG8_LDA(At, 0, 0); PG8_STAGE_A(PG8_SA(1, 1), a1, c10, c11);
            PG8_WAIT_V(8); PG8_WAIT_L(0); PG8_BAR; PG8_MMA(0, 0, At, B0); PG8_MMA(0, 1, At, B1); PG8_BAR; PG8_SCHED;
            PG8_LDA(At, 0, 1); PG8_STAGE_B(PG8_SB(0, 0), b2); PG8_STAGE_B(PG8_SB(0, 1), b2 + hstepB); PG8_STAGE_A(PG8_SA(0, 0), a2, x00, x01);
            PG8_WAIT_V(8); PG8_WAIT_L(0); PG8_BAR; PG8_MMA(1, 0, At, B0); PG8_MMA(1, 1, At, B1); PG8_BAR; PG8_SCHED;
            PG8_LDB(B0, 1, 0); PG8_LDB(B1, 1, 1); PG8_SCHED; PG8_LDA(At, 1, 0); PG8_STAGE_A(PG8_SA(0, 1), a2, x10, x11);
            PG8_WAIT_V(8); PG8_WAIT_L(0); PG8_BAR; PG8_MMA(0, 0, At, B0); PG8_MMA(0, 1, At, B1); PG8_BAR; PG8_SCHED;
            PG8_LDA(At, 1, 1); PG8_STAGE_B(PG8_SB(1, 0), b3); PG8_STAGE_B(PG8_SB(1, 1), b3 + hstepB); PG8_STAGE_A(PG8_SA(1, 0), a3, x00, x01);
            PG8_WAIT_V(8); PG8_WAIT_L(0); PG8_BAR; PG8_MMA(1, 0, At, B0); PG8_MMA(1, 1, At, B1); PG8_BAR; PG8_SCHED;
        }
        if (wr == 0) PG8_BAR;
        E(acc, cur, wr, wc, fr, fq);
        if (!has_next) break;
#pragma unroll
        for (int a = 0; a < 2; ++a)
#pragma unroll
            for (int b = 0; b < 2; ++b)
#pragma unroll
                for (int m = 0; m < 4; ++m)
#pragma unroll
                    for (int n = 0; n < 2; ++n) acc[a][b][m][n] = (f32x4){0.f, 0.f, 0.f, 0.f};
        cur = nxt; cA = nA; cB = nB; c00 = n00; c01 = n01; c10 = n10; c11 = n11; ++ui;
        if (wr == 1) PG8_BAR;
    }
    PG8_WAIT_V(0);
    PG8_BAR;
#undef PG8_SA
#undef PG8_SB
#undef PG8_STAGE_A
#undef PG8_STAGE_B
#undef PG8_LDA
#undef PG8_LDB
#undef PG8_MMA
#undef PG8_WAIT_V
#undef PG8_WAIT_L
#undef PG8_BAR
#undef PG8_SCHED
}

template <class Epi, class Sched>
__device__ __forceinline__ void gemm_phase8(LAS unsigned char* lds, const Sched& S, const Epi& E, int K) {
    asm volatile("" : "+s"(K));
    const int tid = threadIdx.x, wid = __builtin_amdgcn_readfirstlane(tid >> 6), lane = tid & 63, wr = wid >> 2, wc = wid & 3, fr = lane & 15, fq = lane >> 4;
    const int nt = K / BK;
    int Rr[2], Cc[2]; unsigned voffB[2];
#pragma unroll
    for (int i = 0; i < 2; ++i) { int R, C; stage_rc(tid * 16 + i * 8192, R, C); const int Rb = Epi::PERM ? ((R & ~31) + perm32(R & 31)) : R;
        Rr[i] = R; Cc[i] = C; voffB[i] = (unsigned)Rb * (unsigned)S.ldb_bytes + (unsigned)C * 2u; }
    const size_t kstep = (size_t)(BK * 2);
    const size_t hstepB = (size_t)HALF * S.ldb_bytes;
    const unsigned ldsw = (unsigned)wid * 1024u;
    const int sl0 = 2 * fq + (fq >> 1), sl1 = 2 * fq + (1 ^ (fq >> 1));
    const int aoff0 = lds_byte(wr * 64 + fr, sl0 * 8), aoff1 = lds_byte(wr * 64 + fr, sl1 * 8), boff0 = lds_byte(wc * 32 + fr, sl0 * 8), boff1 = lds_byte(wc * 32 + fr, sl1 * 8);
#define PG8_SA(b, h) (((b) * 2 + (h)) * HTB)
#define PG8_SB(b, h) ((4 + (b) * 2 + (h)) * HTB)
#define PG8_STAGE_B(bufoff, gbase) do { _Pragma("unroll") for (int _i = 0; _i < 2; ++_i) \
        __builtin_amdgcn_global_load_lds((const unsigned*)((const char*)(gbase) + voffB[_i]), (LAS unsigned*)(lds + (bufoff) + ldsw + _i * 8192), 16, 0, 0); } while (0)
#define PG8_STAGE_A(bufoff, gbase, o0, o1) do { \
        __builtin_amdgcn_global_load_lds((const unsigned*)((const char*)(gbase) + (o0)), (LAS unsigned*)(lds + (bufoff) + ldsw), 16, 0, 0); \
        __builtin_amdgcn_global_load_lds((const unsigned*)((const char*)(gbase) + (o1)), (LAS unsigned*)(lds + (bufoff) + ldsw + 8192), 16, 0, 0); } while (0)
#define PG8_LDA(dst, b, h) do { _Pragma("unroll") for (int m = 0; m < 4; ++m) { const u32x4 p0_ = *(const LAS u32x4*)(lds + PG8_SA(b, h) + aoff0 + m * 2048), p1_ = *(const LAS u32x4*)(lds + PG8_SA(b, h) + aoff1 + m * 2048); \
        dst[m] = __builtin_bit_cast(i32x8, __builtin_shufflevector(p0_, p1_, 0, 1, 2, 3, 4, 5, 6, 7)); } } while (0)
#define PG8_LDB(dst, b, h) do { _Pragma("unroll") for (int n = 0; n < 2; ++n) { const u32x4 p0_ = *(const LAS u32x4*)(lds + PG8_SB(b, h) + boff0 + n * 2048), p1_ = *(const LAS u32x4*)(lds + PG8_SB(b, h) + boff1 + n * 2048); \
        dst[n] = __builtin_bit_cast(i32x8, __builtin_shufflevector(p0_, p1_, 0, 1, 2, 3, 4, 5, 6, 7)); } } while (0)
#define PG8_MMA(ai, bj, At, Bt) do { __builtin_amdgcn_s_setprio(1); _Pragma("unroll") for (int m = 0; m < 4; ++m) _Pragma("unroll") for (int n = 0; n < 2; ++n) \
        asm volatile("v_mfma_scale_f32_16x16x128_f8f6f4 %0, %1, %2, %0, %3, %3 op_sel_hi:[0,0,0]" : "+v"(acc[ai][bj][m][n]) : "v"(Bt[n]), "v"(At[m]), "v"(sc8)); __builtin_amdgcn_s_setprio(0); } while (0)
#define PG8_WAIT_V(n) asm volatile("s_waitcnt vmcnt(" #n ")" ::: "memory")
#define PG8_WAIT_L(n) asm volatile("s_waitcnt lgkmcnt(" #n ")" ::: "memory")
#define PG8_BAR __builtin_amdgcn_s_barrier()
#define PG8_SCHED __builtin_amdgcn_sched_barrier(0)
    Unit cur, nxt; int ui = 0;
    if (!S.next(0, cur)) return;
    f32x4 acc[2][2][4][2];
#pragma unroll
    for (int a = 0; a < 2; ++a)
#pragma unroll
        for (int b = 0; b < 2; ++b)
#pragma unroll
            for (int m = 0; m < 4; ++m)
#pragma unroll
                for (int n = 0; n < 2; ++n) acc[a][b][m][n] = (f32x4){0.f, 0.f, 0.f, 0.f};
    i32x8 At[4], B0[2], B1[2]; const int sc8 = 0x7F7F7F7F;

    const char* cA = S.a_base(cur); const char* cB = S.b_base(cur);
    unsigned c00 = S.a_off(cur, Rr[0]) + Cc[0] * 2u, c01 = S.a_off(cur, Rr[1]) + Cc[1] * 2u, c10 = S.a_off(cur, HALF + Rr[0]) + Cc[0] * 2u, c11 = S.a_off(cur, HALF + Rr[1]) + Cc[1] * 2u;
    PG8_STAGE_B(PG8_SB(0, 0), cB); PG8_STAGE_B(PG8_SB(0, 1), cB + hstepB); PG8_STAGE_A(PG8_SA(0, 0), cA, c00, c01); PG8_STAGE_A(PG8_SA(0, 1), cA, c10, c11);
    if (wr == 1) PG8_BAR;
    PG8_WAIT_V(2); PG8_BAR;
    PG8_STAGE_B(PG8_SB(1, 0), cB + kstep); PG8_STAGE_A(PG8_SA(1, 0), cA + kstep, c00, c01); PG8_STAGE_B(PG8_SB(1, 1), cB + hstepB + kstep);
    PG8_WAIT_V(6); PG8_BAR;
    for (;;) {
        const bool has_next = S.next(ui + 1, nxt);
        const char* nA = has_next ? S.a_base(nxt) : cA; const char* nB = has_next ? S.b_base(nxt) : cB;
        unsigned n00 = c00, n01 = c01, n10 = c10, n11 = c11;
        if (has_next) { n00 = S.a_off(nxt, Rr[0]) + Cc[0] * 2u; n01 = S.a_off(nxt, Rr[1]) + Cc[1] * 2u; n10 = S.a_off(nxt, HALF + Rr[0]) + Cc[0] * 2u; n11 = S.a_off(nxt, HALF + Rr[1]) + Cc[1] * 2u; }
        for (int t = 0; t < nt; t += 2) {
            const bool last = (t == nt - 2);
            const char* a1 = cA + (size_t)(t + 1) * kstep;
            const char* a2 = last ? nA : cA + (size_t)(t + 2) * kstep; const char* b2 = last ? nB : cB + (size_t)(t + 2) * kstep;
            const char* a3 = a2 + kstep; const char* b3 = b2 + kstep;
            const unsigned x00 = last ? n00 : c00, x01 = last ? n01 : c01, x10 = last ? n10 : c10, x11 = last ? n11 : c11;
            PG8_LDB(B0, 0, 0); PG8_LDB(B1, 0, 1); PG8_SCHED; PG8_LDA(At, 0, 0); PG8_STAGE_A(PG8_SA(1, 1), a1, c10, c11);
            PG8_WAIT_V(8); PG8_WAIT_L(0); PG8_BAR; PG8_MMA(0, 0, At, B0); PG8_MMA(0, 1, At, B1); PG8_BAR; PG8_SCHED;
            PG8_LDA(At, 0, 1); PG8_STAGE_B(PG8_SB(0, 0), b2); PG8_STAGE_B(PG8_SB(0, 1), b2 + hstepB); PG8_STAGE_A(PG8_SA(0, 0), a2, x00, x01);
            PG8_WAIT_V(8); PG8_WAIT_L(0); PG8_BAR; PG8_MMA(1, 0, At, B0); PG8_MMA(1, 1, At, B1); PG8_BAR; PG8_SCHED;
            PG8_LDB(B0, 1, 0); PG8_LDB(B1, 1, 1); PG8_SCHED; PG8_LDA(At, 1, 0); PG8_STAGE_A(PG8_SA(0, 1), a2, x10, x11);
            PG8_WAIT_V(8); PG8_WAIT_L(0); PG8_BAR; PG8_MMA(0, 0, At, B0); PG8_MMA(0, 1, At, B1); PG8_BAR; PG8_SCHED;
            PG8_LDA(At, 1, 1); PG8_STAGE_B(PG8_SB(1, 0), b3); PG8_STAGE_B(PG8_SB(1, 1), b3 + hstepB); PG8_STAGE_A(PG8_SA(1, 0), a3, x00, x01);
            PG8_WAIT_V(8); PG8_WAIT_L(0); PG8_BAR; PG8_MMA(1, 0, At, B0); PG8_MMA(1, 1, At, B1); PG8_BAR; PG8_SCHED;
        }
        asm volatile("s_nop 15\n\ts_nop 15" : "+v"(acc[1][1][0][0]), "+v"(acc[1][1][0][1]), "+v"(acc[1][1][1][0]), "+v"(acc[1][1][1][1]), "+v"(acc[1][1][2][0]), "+v"(acc[1][1][2][1]), "+v"(acc[1][1][3][0]), "+v"(acc[1][1][3][1]) :: "memory");
        if (wr == 0) PG8_BAR;
        E(acc, cur, wr, wc, fr, fq);
        if (!has_next) break;
#pragma unroll
        for (int a = 0; a < 2; ++a)
#pragma unroll
            for (int b = 0; b < 2; ++b)
#pragma unroll
                for (int m = 0; m < 4; ++m)
#pragma unroll
                    for (int n = 0; n < 2; ++n) acc[a][b][m][n] = (f32x4){0.f, 0.f, 0.f, 0.f};
        cur = nxt; cA = nA; cB = nB; c00 = n00; c01 = n01; c10 = n10; c11 = n11; ++ui;
        if (wr == 1) PG8_BAR;
    }
    PG8_WAIT_V(0);
    PG8_BAR;
#undef PG8_SA
#undef PG8_SB
#undef PG8_STAGE_A
#undef PG8_STAGE_B
#undef PG8_LDA
#undef PG8_LDB
#undef PG8_MMA
#undef PG8_WAIT_V
#undef PG8_WAIT_L
#undef PG8_BAR
#undef PG8_SCHED
}

struct GridOrder {
    int nM, nN, nG, G, c;
    __device__ __forceinline__ void init(int nM_, int nN_, int nG_) { nM = nM_; nN = nN_; nG = nG_; G = gridDim.x; c = blockIdx.x; }
    __device__ __forceinline__ bool next_mn(int i, Unit& u) const {
        const long L = (long)i * G + c; const int per = nM * nN; if (L >= (long)per * nG) return false;
        u.g = (int)(L / per); int wgid = (int)(L % per);
        if (nG == 1) { const int q = per / NXCD, r = per % NXCD, xcd = wgid % NXCD, off = wgid / NXCD; wgid = (xcd < r ? xcd * (q + 1) : r * (q + 1) + (xcd - r) * q) + off; }
        const int nig = WGM * nN, gid = wgid / nig, fm = gid * WGM, gsz = (nM - fm) < WGM ? (nM - fm) : WGM;
        u.pm = fm + ((wgid % nig) % gsz); u.pn = (wgid % nig) / gsz; return true;
    }
};
}
using pg8::Unit;

struct Frame { const Params* p; unsigned char* ws; LAS unsigned char* lds; int tid, lane, wid; };
#define WSP(T, off) ((T*)(ws + (off)))

__device__ __forceinline__ void phase_mods(const Params& P, unsigned char* ws, LAS unsigned char* lds) {
    const int tid = threadIdx.x;
    LAS float* sil = (LAS float*)lds;
    LAS float* part = sil + 9 * 1024;
    float* mods = WSP(float, WS_MODS);
    __syncthreads();
    for (int i = tid; i < 9 * 1024; i += NTHREADS) { const int r = i >> 10, k = i & 1023; const float v = r < 8 ? P.in[1][r * 1024 + k] : P.in[3][k]; sil[i] = v / (1.f + __expf(-v)); }
    __syncthreads();
    for (int u = blockIdx.x; u < 192; u += gridDim.x) {
        const int layer = u / 96, cb = u % 96;
        const float* W = P.in[layer ? 19 : 4]; const float* bm = P.in[layer ? 20 : 5];
        const int cl = tid & 63, kq = tid >> 6, col = cb * 64 + cl;
        float a0 = 0, a1 = 0, a2 = 0, a3 = 0, a4 = 0, a5 = 0, a6 = 0, a7 = 0, a8 = 0;
#pragma unroll 16
        for (int kk = 0; kk < 128; ++kk) { const int k = kq * 128 + kk;
            const float w = W[(size_t)k * 6144 + col];
            a0 += sil[0 * 1024 + k] * w; a1 += sil[1 * 1024 + k] * w; a2 += sil[2 * 1024 + k] * w; a3 += sil[3 * 1024 + k] * w; a4 += sil[4 * 1024 + k] * w;
            a5 += sil[5 * 1024 + k] * w; a6 += sil[6 * 1024 + k] * w; a7 += sil[7 * 1024 + k] * w; a8 += sil[8 * 1024 + k] * w; }
        __syncthreads();
        LAS float* pp = part + kq * 9 * 64 + cl;
        pp[0 * 64] = a0; pp[1 * 64] = a1; pp[2 * 64] = a2; pp[3 * 64] = a3; pp[4 * 64] = a4; pp[5 * 64] = a5; pp[6 * 64] = a6; pp[7 * 64] = a7; pp[8 * 64] = a8;
        __syncthreads();
        for (int i = tid; i < 9 * 64; i += NTHREADS) { const int r = i >> 6, c = i & 63;
            mods[((size_t)layer * 9 + r) * 6144 + cb * 64 + c] = (((part[0 * 576 + i] + part[1 * 576 + i]) + (part[2 * 576 + i] + part[3 * 576 + i])) + ((part[4 * 576 + i] + part[5 * 576 + i]) + (part[6 * 576 + i] + part[7 * 576 + i]))) + bm[cb * 64 + c]; }
    }
    __syncthreads();
}

__device__ __forceinline__ int cmap_col(int kind, int n, int nsrc) {
    if (kind == 1) {
        if (n < 2048) return n;
        if (n < 2816) return n + 32;
        if (n < 2848) return n - 2816 + 2048;
        return -1;
    }
    return n < nsrc ? n : -1;
}
__device__ __forceinline__ void convert_tile(const float* src, int nsrc, int K, bf16_t* dst, int kind, int tn, int tk, LAS float* tile  , int tid) {
    const int n0 = tn * 64, k0 = tk * 64;
    __syncthreads();
    {
        const int tx = tid & 15, ty = tid >> 4;
        const int n = n0 + tx * 4; const int sc = cmap_col(kind, n, nsrc);
#pragma unroll
        for (int i = 0; i < 2; ++i) { const int k = ty + 32 * i; f32x4 v = (f32x4){0.f, 0.f, 0.f, 0.f};
            if (sc >= 0) v = *(const f32x4*)(src + (size_t)(k0 + k) * nsrc + sc);
            tile[k * 65 + tx * 4 + 0] = v[0]; tile[k * 65 + tx * 4 + 1] = v[1]; tile[k * 65 + tx * 4 + 2] = v[2]; tile[k * 65 + tx * 4 + 3] = v[3]; }
    }
    __syncthreads();
    {
        const int kk = tid & 7, nn = tid >> 3;
        u32x4 w;
        w.x = pk2(tile[(kk * 8 + 0) * 65 + nn], tile[(kk * 8 + 1) * 65 + nn]); w.y = pk2(tile[(kk * 8 + 2) * 65 + nn], tile[(kk * 8 + 3) * 65 + nn]);
        w.z = pk2(tile[(kk * 8 + 4) * 65 + nn], tile[(kk * 8 + 5) * 65 + nn]); w.w = pk2(tile[(kk * 8 + 6) * 65 + nn], tile[(kk * 8 + 7) * 65 + nn]);
        *(u32x4*)(dst + (size_t)(n0 + nn) * K + k0 + kk * 8) = w;
    }
}
__device__ __forceinline__ void convert_tile8(const float* src, int nsrc, int K, unsigned char* dst, int tn, int tk, LAS float* tile  , int tid, int kind = 0) {
    const int n0 = tn * 64, k0 = tk * 64;
    __syncthreads();
    {   const int tx = tid & 15, ty = tid >> 4; const int sc = cmap_col(kind, n0 + tx * 4, nsrc);
#pragma unroll
        for (int i = 0; i < 2; ++i) { const int k = ty + 32 * i; f32x4 v = (f32x4){0.f, 0.f, 0.f, 0.f}; if (sc >= 0) v = *(const f32x4*)(src + (size_t)(k0 + k) * nsrc + sc);
            tile[k * 65 + tx * 4 + 0] = v[0]; tile[k * 65 + tx * 4 + 1] = v[1]; tile[k * 65 + tx * 4 + 2] = v[2]; tile[k * 65 + tx * 4 + 3] = v[3]; }
    }
    __syncthreads();
    {   const int kk = tid & 7, nn = tid >> 3; u32x2 w;
        w.x = pk4_fp8(tile[(kk * 8 + 0) * 65 + nn] * W8_SCALE, tile[(kk * 8 + 1) * 65 + nn] * W8_SCALE, tile[(kk * 8 + 2) * 65 + nn] * W8_SCALE, tile[(kk * 8 + 3) * 65 + nn] * W8_SCALE);
        w.y = pk4_fp8(tile[(kk * 8 + 4) * 65 + nn] * W8_SCALE, tile[(kk * 8 + 5) * 65 + nn] * W8_SCALE, tile[(kk * 8 + 6) * 65 + nn] * W8_SCALE, tile[(kk * 8 + 7) * 65 + nn] * W8_SCALE);
        *(u32x2*)(dst + (size_t)(n0 + nn) * K + k0 + kk * 8) = w;
    }
}
__device__ __forceinline__ void phase_convert_moe8(const Params& P, unsigned char* ws, LAS unsigned char* lds, int layer, bool skew = false) {
    LAS float* tile = (LAS float*)lds; const int tid = threadIdx.x;
    const float* wgu = P.in[layer ? 39 : 15]; const float* wd = P.in[layer ? 41 : 17];
    constexpr int IG = 32 * 32 * 4, ID = 32 * 16 * 4;
    const int tx = tid & 15, ty = tid >> 4;
    f32x4 v[8];
#define CV_DECODE(IT, SRC, NSRC, DST, TN, KB) do { if ((IT) < IG) { const int e_ = (IT) >> 7, r_ = (IT) & 127; SRC = wgu + (size_t)e_ * 1024 * 2048; NSRC = 2048; DST = ws + WS_WGU + (size_t)e_ * 2048 * 1024; TN = r_ >> 2; KB = r_ & 3; } \
        else { const int i2_ = (IT) - IG, e_ = i2_ >> 6, r_ = i2_ & 63; SRC = wd + (size_t)e_ * 1024 * 1024; NSRC = 1024; DST = ws + WS_WD + (size_t)e_ * 1024 * 1024; TN = r_ >> 2; KB = r_ & 3; } } while (0)
#define CV_LOAD(IT) do { const float* s_; int ns_, tn_, kb_; unsigned char* d_; CV_DECODE(IT, s_, ns_, d_, tn_, kb_); (void)d_; \
        _Pragma("unroll") for (int i = 0; i < 8; ++i) v[i] = *(const f32x4*)(s_ + (size_t)(kb_ * 256 + ty + 32 * i) * ns_ + tn_ * 64 + tx * 4); } while (0)
    const bool sk = skew && gridDim.x == 256, two = sk && blockIdx.x >= 192;
    const int stepA = sk ? (two ? 64 : 320) : (int)gridDim.x, stepB = sk ? (two ? 256 : 320) : (int)gridDim.x;
    int it = blockIdx.x, tog = 0;
    if (it < IG + ID) CV_LOAD(it);
    for (; it < IG + ID; it += (tog ? stepB : stepA), tog ^= 1) {
        const float* src; int nsrc, tn, kb; unsigned char* dst; CV_DECODE(it, src, nsrc, dst, tn, kb); (void)src; (void)nsrc;
        __syncthreads();
#pragma unroll
        for (int i = 0; i < 8; ++i) { const int k = ty + 32 * i, sk = 4 * i;
#pragma unroll
            for (int q = 0; q < 4; ++q) tile[k * 65 + ((tx * 4 + q + sk) & 63)] = v[i][q]; }
        __syncthreads();
        { const int itn = it + (tog ? stepB : stepA); if (itn < IG + ID) CV_LOAD(itn); }
        {   const int kq = tid & 7, nn = tid >> 3, col = (nn + 4 * kq) & 63; unsigned w[8];
#pragma unroll
            for (int j = 0; j < 8; ++j) { const int kk = kq * 32 + j * 4;
                w[j] = pk4_fp8(tile[(kk + 0) * 65 + col] * W8_SCALE, tile[(kk + 1) * 65 + col] * W8_SCALE, tile[(kk + 2) * 65 + col] * W8_SCALE, tile[(kk + 3) * 65 + col] * W8_SCALE); }
            unsigned char* o = dst + (size_t)(tn * 64 + nn) * 1024 + kb * 256 + kq * 32;
            *(u32x4*)o = (u32x4){w[0], w[1], w[2], w[3]}; *(u32x4*)(o + 16) = (u32x4){w[4], w[5], w[6], w[7]};
        }
    }
#undef CV_LOAD
#undef CV_DECODE
    __syncthreads();
}
struct CsJob { const float* src; int nsrc, K, kind, tn, tk, fp8; unsigned char* dst; };
__device__ __forceinline__ CsJob cs_job(const Params& P, unsigned char* ws, int t) {
    const int T0 = 48 * 16, T1 = T0 + 256, T2 = T1 + 24 * 16, T3 = T2 + 256; CsJob j;
    if (t < T0)      { j.src = P.in[8];  j.nsrc = 2848; j.K = 1024; j.kind = 1; j.tn = t / 16; j.tk = t % 16; j.fp8 = 0; j.dst = ws + WS_WIN0T; }
    else if (t < T1) { j.src = P.in[9];  j.nsrc = 1024; j.K = 1024; j.kind = 0; j.tn = (t - T0) / 16; j.tk = (t - T0) % 16; j.fp8 = 1; j.dst = ws + WS_WOUT0T; }
    else if (t < T2) { j.src = P.in[23]; j.nsrc = 1408; j.K = 1024; j.kind = 2; j.tn = (t - T1) / 16; j.tk = (t - T1) % 16; j.fp8 = 1; j.dst = ws + WS_WIN1T; }
    else if (t < T3) { j.src = P.in[24]; j.nsrc = 1024; j.K = 1024; j.kind = 0; j.tn = (t - T2) / 16; j.tk = (t - T2) % 16; j.fp8 = 0; j.dst = ws + WS_WOUT1T; }
    else             { j.src = P.in[33]; j.nsrc = 256;  j.K = 256;  j.kind = 0; j.tn = (t - T3) / 4;  j.tk = (t - T3) % 4;  j.fp8 = 0; j.dst = ws + WS_WGLUT; }
    return j;
}
__device__ __forceinline__ void cs_load(const CsJob& j, int tid, f32x4& v0, f32x4& v1) {
    const int tx = tid & 15, ty = tid >> 4; const int sc = cmap_col(j.kind, j.tn * 64 + tx * 4, j.nsrc);
    v0 = (f32x4){0.f, 0.f, 0.f, 0.f}; v1 = v0;
    if (sc >= 0) { v0 = *(const f32x4*)(j.src + (size_t)(j.tk * 64 + ty) * j.nsrc + sc); v1 = *(const f32x4*)(j.src + (size_t)(j.tk * 64 + ty + 32) * j.nsrc + sc); }
}
__device__ __forceinline__ void phase_convert_small(const Params& P, unsigned char* ws, LAS unsigned char* lds) {
    LAS float* tile = (LAS float*)lds; const int tid = threadIdx.x;
    const int T4 = 48 * 16 + 256 + 24 * 16 + 256 + 16;
    int t = blockIdx.x; if (t >= T4) { __syncthreads(); return; }
    CsJob job = cs_job(P, ws, t); f32x4 v0, v1; cs_load(job, tid, v0, v1);
    for (; t < T4; t += gridDim.x) {
        const int tnx = t + gridDim.x; CsJob jn = job; f32x4 n0 = v0, n1 = v1;
        if (tnx < T4) { jn = cs_job(P, ws, tnx); cs_load(jn, tid, n0, n1); }
        __syncthreads();
        {   const int tx = tid & 15, ty = tid >> 4;
            tile[ty * 65 + tx * 4 + 0] = v0[0]; tile[ty * 65 + tx * 4 + 1] = v0[1]; tile[ty * 65 + tx * 4 + 2] = v0[2]; tile[ty * 65 + tx * 4 + 3] = v0[3];
            tile[(ty + 32) * 65 + tx * 4 + 0] = v1[0]; tile[(ty + 32) * 65 + tx * 4 + 1] = v1[1]; tile[(ty + 32) * 65 + tx * 4 + 2] = v1[2]; tile[(ty + 32) * 65 + tx * 4 + 3] = v1[3]; }
        __syncthreads();
        {   const int kk = tid & 7, nn = tid >> 3; const int n0_ = job.tn * 64, k0_ = job.tk * 64;
            if (job.fp8) { u32x2 w;
                w.x = pk4_fp8(tile[(kk * 8 + 0) * 65 + nn] * W8_SCALE, tile[(kk * 8 + 1) * 65 + nn] * W8_SCALE, tile[(kk * 8 + 2) * 65 + nn] * W8_SCALE, tile[(kk * 8 + 3) * 65 + nn] * W8_SCALE);
                w.y = pk4_fp8(tile[(kk * 8 + 4) * 65 + nn] * W8_SCALE, tile[(kk * 8 + 5) * 65 + nn] * W8_SCALE, tile[(kk * 8 + 6) * 65 + nn] * W8_SCALE, tile[(kk * 8 + 7) * 65 + nn] * W8_SCALE);
                *(u32x2*)(job.dst + (size_t)(n0_ + nn) * job.K + k0_ + kk * 8) = w; }
            else { u32x4 w;
                w.x = pk2(tile[(kk * 8 + 0) * 65 + nn], tile[(kk * 8 + 1) * 65 + nn]); w.y = pk2(tile[(kk * 8 + 2) * 65 + nn], tile[(kk * 8 + 3) * 65 + nn]);
                w.z = pk2(tile[(kk * 8 + 4) * 65 + nn], tile[(kk * 8 + 5) * 65 + nn]); w.w = pk2(tile[(kk * 8 + 6) * 65 + nn], tile[(kk * 8 + 7) * 65 + nn]);
                *(u32x4*)((bf16_t*)job.dst + (size_t)(n0_ + nn) * job.K + k0_ + kk * 8) = w; } }
        job = jn; v0 = n0; v1 = n1;
    }
    __syncthreads();
}
__device__ __forceinline__ void phase_convert_moe(const Params& P, unsigned char* ws, LAS unsigned char* lds, int layer) {
    LAS float* tile = (LAS float*)lds; const int tid = threadIdx.x;
    const float* wgu = P.in[layer ? 39 : 15]; const float* wd = P.in[layer ? 41 : 17];
    const int TG = 32 * 32 * 16, TD = 32 * 16 * 16;
    for (int t = blockIdx.x; t < TG + TD; t += gridDim.x) {
        if (t < TG) { const int e = t / 512, r = t % 512; convert_tile(wgu + (size_t)e * 1024 * 2048, 2048, 1024, WSP(bf16_t, WS_WGU) + (size_t)e * 2048 * 1024, 0, r / 16, r % 16, tile, tid); }
        else { const int t2 = t - TG, e = t2 / 256, r = t2 % 256; convert_tile(wd + (size_t)e * 1024 * 1024, 1024, 1024, WSP(bf16_t, WS_WD) + (size_t)e * 1024 * 1024, 0, r / 16, r % 16, tile, tid); }
    }
    __syncthreads();
}


__device__ __forceinline__ void cmul(float ar, float ai, float br, float bi, float& cr, float& ci) { cr = ar * br - ai * bi; ci = ar * bi + ai * br; }
__device__ __forceinline__ void s5_lam(const Params& P, int dir, int g, int p, float& lr, float& li, float& dt) {
    lr = P.in[25][(dir * 16 + g) * 64 + p]; li = P.in[26][(dir * 16 + g) * 64 + p]; dt = expf(P.in[27][dir * 16 + g]);
}
__device__ __forceinline__ void s5_apow(float lr, float li, float dt, float tau, float& re, float& im) {
    const float mag = expf(lr * dt * tau); float s, c; sincosf(li * dt * tau, &s, &c); re = mag * c; im = mag * s;
}
__device__ __forceinline__ void s5_bscale(float lr, float li, float dt, float& re, float& im) {
    float ar, ai; s5_apow(lr, li, dt, 1.f, ar, ai); ar -= 1.f; const float d = lr * lr + li * li; re = (ar * lr + ai * li) / d; im = (ai * lr - ar * li) / d;
}
__device__ __forceinline__ void phase_s5_kernels(const Params& P, unsigned char* ws, LAS unsigned char* lds) {
    const int tid = threadIdx.x;
    LAS float* zr = (LAS float*)lds;
    LAS float* zi = zr + 128;
    float* Kt = WSP(float, WS_S5K);
    for (int u = blockIdx.x; u < 16 * 2 * 32; u += gridDim.x) {
        const int g = u / 64, dir = (u / 32) & 1, tp = u % 32;
        __syncthreads();
        if (tid < 128) { const int sub = tid >> 6, p = tid & 63; float lr, li, dt; s5_lam(P, dir, g, p, lr, li, dt);
            float ar, ai, br, bi, r, i; s5_apow(lr, li, dt, (float)(tp * 2 + sub), ar, ai); s5_bscale(lr, li, dt, br, bi); cmul(ar, ai, br, bi, r, i); zr[tid] = r; zi[tid] = i; }
        __syncthreads();
        const int sub = tid >> 8, cj = tid & 255, c = cj >> 4, j = cj & 15;
        float acc = 0.f;
#pragma unroll 16
        for (int p = 0; p < 64; ++p) {
            const float cr = P.in[30][(g * 16 + c) * 64 + p], ci = P.in[31][(g * 16 + c) * 64 + p];
            const float br = P.in[28][(g * 64 + p) * 16 + j], bi = P.in[29][(g * 64 + p) * 16 + j];
            float tr, ti, ur, ui; cmul(zr[sub * 64 + p], zi[sub * 64 + p], br, bi, tr, ti); cmul(cr, ci, tr, ti, ur, ui); acc += ur;
        }
        Kt[(((size_t)g * 2 + dir) * 64 + tp * 2 + sub) * 256 + cj] = acc;
    }
    if (blockIdx.x == gridDim.x - 1) {
        float* A64 = WSP(float, WS_S5A64);
        for (int i = tid; i < 2 * 16 * 64; i += NTHREADS) { const int dir = i / 1024, g = (i / 64) & 15, p = i & 63; float lr, li, dt, r, im; s5_lam(P, dir, g, p, lr, li, dt); s5_apow(lr, li, dt, 64.f, r, im); A64[i * 2] = r; A64[i * 2 + 1] = im; }
    }
    __syncthreads();
}
__device__ __forceinline__ void phase_s5_tables(const Params& P, unsigned char* ws) {
    const float* __restrict__ Kt = WSP(float, WS_S5K);
    bf16_t* __restrict__ TE = WSP(bf16_t, WS_S5TE); bf16_t* __restrict__ Ft = WSP(bf16_t, WS_S5F);
    const float* __restrict__ Cr = P.in[30]; const float* __restrict__ Ci = P.in[31]; const float* __restrict__ Br = P.in[28]; const float* __restrict__ Bi = P.in[29];
    const size_t gsz = (size_t)gridDim.x * NTHREADS, gid = (size_t)blockIdx.x * NTHREADS + threadIdx.x;
#pragma unroll 4
    for (size_t i = gid; i < (size_t)16 * 1024 * 128; i += gsz) {
        const int g = (int)(i / (1024 * 128)), r = (int)((i / 128) % 1024), k8 = (int)(i % 128);
        const int t = r >> 4, c = r & 15, s = k8 >> 1, j0 = (k8 & 1) * 8;
        const int df = s <= t ? t - s : 0, db = s >= t ? s - t : 0;
        const float* pf = Kt + (((size_t)g * 2 + 0) * 64 + df) * 256 + c * 16 + j0; const float* pb = Kt + (((size_t)g * 2 + 1) * 64 + db) * 256 + c * 16 + j0;
        const f32x4 f0 = *(const f32x4*)pf, f1 = *(const f32x4*)(pf + 4), b0 = *(const f32x4*)pb, b1 = *(const f32x4*)(pb + 4);
        const float mf = s <= t ? 1.f : 0.f, mb = s >= t ? 1.f : 0.f;
        const f32x4 x0 = f0 * mf + b0 * mb, x1 = f1 * mf + b1 * mb;
        u32x4 w; w.x = pk2(x0[0], x0[1]); w.y = pk2(x0[2], x0[3]); w.z = pk2(x1[0], x1[1]); w.w = pk2(x1[2], x1[3]);
        *(u32x4*)(TE + ((size_t)g * 1024 + r) * 1280 + k8 * 8) = w;
    }
#pragma unroll 4
    for (size_t i = gid; i < (size_t)16 * 1024 * 128; i += gsz) {
        const int g = (int)(i / (1024 * 128)), r = (int)((i / 128) % 1024), dp = (int)(i % 128), dir = dp >> 6, p = dp & 63;
        const int t = r >> 4, c = r & 15;
        float lr, li, dt, ar, ai, zr, zi; s5_lam(P, dir, g, p, lr, li, dt);
        s5_apow(lr, li, dt, dir == 0 ? (float)(t + 1) : (float)(64 - t), ar, ai);
        cmul(Cr[(g * 16 + c) * 64 + p], Ci[(g * 16 + c) * 64 + p], ar, ai, zr, zi);
        bf16_t* row = TE + ((size_t)g * 1024 + r) * 1280 + 1024 + dir * 128;
        row[p] = (bf16_t)f2bf(zr); row[64 + p] = (bf16_t)f2bf(-zi);
    }
#pragma unroll 4
    for (size_t i = gid; i < (size_t)16 * 128 * 1024; i += gsz) {
        const int g = (int)(i / (128 * 1024)), dp = (int)((i / 1024) % 128), k = (int)(i % 1024), dir = dp >> 6, p = dp & 63, s = k >> 4, j = k & 15;
        float lr, li, dt, ar, ai, br, bi, tr, ti, zr, zi; s5_lam(P, dir, g, p, lr, li, dt);
        s5_apow(lr, li, dt, dir == 0 ? (float)(63 - s) : (float)s, ar, ai); s5_bscale(lr, li, dt, br, bi); cmul(ar, ai, br, bi, tr, ti);
        cmul(tr, ti, Br[(g * 64 + p) * 16 + j], Bi[(g * 64 + p) * 16 + j], zr, zi);
        Ft[((size_t)g * 256 + dir * 128 + p) * 1024 + k] = (bf16_t)f2bf(zr);
        Ft[((size_t)g * 256 + dir * 128 + 64 + p) * 1024 + k] = (bf16_t)f2bf(zi);
    }
}

__device__ __forceinline__ void phase_router_tables(const Params& P, unsigned char* ws, LAS unsigned char* lds) {
    LAS float* part = (LAS float*)lds;
    const float* mods = WSP(float, WS_MODS); bf16_t* GWH = WSP(bf16_t, WS_GW); bf16_t* GWL = GWH + (size_t)2 * 9 * 32 * 1024; float* CB = WSP(float, WS_CB);
    const size_t gsz = (size_t)gridDim.x * NTHREADS, gid = (size_t)blockIdx.x * NTHREADS + threadIdx.x;
    for (size_t i = gid; i < (size_t)2 * 9 * 1024 * 32; i += gsz) {
        const int layer = (int)(i / (9 * 32768)), r = (int)((i / 32768) % 9), k = (int)((i / 32) % 1024), e = (int)(i % 32);
        const float* m = mods + ((size_t)layer * 9 + r) * 6144;
        const float v = P.in[layer ? 22 : 7][k] * (1.f + m[4096 + k]) * P.in[layer ? 37 : 13][k * 32 + e];
        const unsigned h = f2bf(v), l = f2bf(v - __builtin_bit_cast(float, h << 16)); const size_t o = (((size_t)layer * 9 + r) * 32 + e) * 1024 + k;
        GWH[o] = (bf16_t)h; GWL[o] = (bf16_t)l;
    }
    for (int u = blockIdx.x; u < 18; u += gridDim.x) {
        const int layer = u / 9, r = u % 9, e = threadIdx.x & 31, ks = threadIdx.x >> 5;
        const float* m = mods + ((size_t)layer * 9 + r) * 6144; const float* W = P.in[layer ? 37 : 13];
        float a = 0.f;
#pragma unroll 16
        for (int k = ks * 64; k < ks * 64 + 64; ++k) a += m[3072 + k] * W[k * 32 + e];
        __syncthreads(); part[threadIdx.x] = a; __syncthreads();
        if (threadIdx.x < 32) { float t = P.in[layer ? 38 : 14][e];
            for (int q = 0; q < 16; ++q) t += part[q * 32 + e];
            CB[(layer * 9 + r) * 32 + e] = t; }
    }
}

__device__ __forceinline__ void phase_norm1(const Params& P, unsigned char* ws, int layer, const float* xlat, const float* xctx) {
    const int lane = threadIdx.x & 63, gw = blockIdx.x * 8 + (threadIdx.x >> 6), nw = gridDim.x * 8;
    const float* mods = WSP(float, WS_MODS) + (size_t)layer * 9 * 6144; const float* g = P.in[layer ? 21 : 6];
    bf16_t* XN = WSP(bf16_t, WS_XN);
    f32x4 nx[3][4]; f32x4 gg[4];
#define N1_ROWPTR(ROW) ((ROW) < NCTX ? xctx + (size_t)(ROW) * 1024 : xlat + (size_t)((ROW) - NCTX) * 1024)
#pragma unroll
    for (int i = 0; i < 4; ++i) gg[i] = *(const f32x4*)(g + i * 256 + lane * 4);
#pragma unroll
    for (int u = 0; u < 3; ++u) if (gw + u * nw < NTOK) { const float* x = N1_ROWPTR(gw + u * nw);
#pragma unroll
        for (int i = 0; i < 4; ++i) nx[u][i] = *(const f32x4*)(x + i * 256 + lane * 4); }
    for (int row0 = gw; row0 < NTOK; row0 += 3 * nw) {
#pragma unroll
        for (int u = 0; u < 3; ++u) { const int row = row0 + u * nw; if (row < NTOK) {
            const int r = row < NCTX ? 8 : (row - NCTX) >> 13;
            f32x4 v[4]; float ss = 0.f;
#pragma unroll
            for (int i = 0; i < 4; ++i) { v[i] = nx[u][i]; ss += v[i][0] * v[i][0] + v[i][1] * v[i][1] + v[i][2] * v[i][2] + v[i][3] * v[i][3]; }
            if (row + 3 * nw < NTOK) { const float* x = N1_ROWPTR(row + 3 * nw);
#pragma unroll
                for (int i = 0; i < 4; ++i) nx[u][i] = *(const f32x4*)(x + i * 256 + lane * 4); }
            const float* m = mods + (size_t)r * 6144; f32x4 sh[4], sc[4];
#pragma unroll
            for (int i = 0; i < 4; ++i) { const int k = i * 256 + lane * 4; sh[i] = *(const f32x4*)(m + k); sc[i] = *(const f32x4*)(m + 1024 + k); }
            ss = wave_sum(ss); const float rstd = rsqrtf(ss * (1.f / 1024.f) + 1e-6f);
#pragma unroll
            for (int i = 0; i < 4; ++i) { const int k = i * 256 + lane * 4;
                const f32x4 o = v[i] * rstd * gg[i] * (1.f + sc[i]) + sh[i];
                u32x2 w; w.x = pk2(o[0], o[1]); w.y = pk2(o[2], o[3]); *(u32x2*)(XN + (size_t)row * 1024 + k) = w; } } }
    }
#undef N1_ROWPTR
}

struct SchedPlain : pg8::GridOrder {
    const char* A; const char* Bt; unsigned lda_bytes; int ldb_bytes; size_t a_gstride, b_gstride;
    __device__ __forceinline__ bool next(int i, Unit& u) const { return next_mn(i, u); }
    __device__ __forceinline__ const char* a_base(const Unit& u) const { return A + (size_t)u.g * a_gstride + (size_t)u.pm * 256 * lda_bytes; }
    __device__ __forceinline__ unsigned a_off(const Unit&, int r) const { return (unsigned)r * lda_bytes; }
    __device__ __forceinline__ const char* b_base(const Unit& u) const { return Bt + (size_t)u.g * b_gstride + (size_t)u.pn * 256 * ldb_bytes; }
};
typedef const f32x4 (&AccRef)[2][2][4][2];
__device__ __forceinline__ u32x4 pack8(const f32x4& v0, const f32x4& v1) { u32x4 w; w.x = pg8::cvt_pk_bf16(v0[0], v0[1]); w.y = pg8::cvt_pk_bf16(v0[2], v0[3]); w.z = pg8::cvt_pk_bf16(v1[0], v1[1]); w.w = pg8::cvt_pk_bf16(v1[2], v1[3]); return w; }

struct EpiInProj0 { static constexpr bool PERM = true;
    unsigned char* R; const float* gate_bias;
    __device__ __forceinline__ void operator()(AccRef acc, const Unit& u, int wr, int wc, int fr, int fq) const {
        const int row0 = u.pm * 256 + wr * 64 + fr, c8 = wc * 32 + 8 * fq;
#pragma unroll
        for (int ai = 0; ai < 2; ++ai)
#pragma unroll
            for (int m = 0; m < 4; ++m) { const size_t row = (size_t)(row0 + ai * 128 + m * 16);
#pragma unroll
                for (int bj = 0; bj < 2; ++bj) { f32x4 v0 = acc[ai][bj][m][0], v1 = acc[ai][bj][m][1];
                    if (u.pn < 10) { const int sec = u.pn >> 1, col = (u.pn & 1) * 256 + bj * 128 + c8;
                        if (sec == 1) { v0 = v0 * 0.125f; v1 = v1 * 0.125f; }
                        *(u32x4*)(R + R_QA + (size_t)sec * PROJ512 + (row * 512 + col) * 2) = pack8(v0, v1); }
                    else if (u.pn == 10) { *(u32x4*)(R + (bj == 0 ? R_KBR : R_VBR) + (row * 128 + c8) * 2) = pack8(v0, v1); }
                    else if (bj == 0 && wc == 0) { float* gp = (float*)(R + R_G) + row * 32 + 8 * fq;
                        const f32x4 b0 = *(const f32x4*)(gate_bias + 8 * fq), b1 = *(const f32x4*)(gate_bias + 8 * fq + 4);
                        *(f32x4*)gp = v0 + b0; *(f32x4*)(gp + 4) = v1 + b1; } } }
    }
};
__device__ __forceinline__ void row_to_chunk(int row, int& n, int& s) {
    if (row < NCTX) { const int b = row >> 8, l = row & 255; n = 1024 + b * 4 + (l >> 6); s = l & 63; }
    else { const int r2 = row - NCTX, b = r2 >> 13, st = r2 & 8191; n = b * 128 + (st >> 6); s = st & 63; }
}
struct EpiInProj1 { static constexpr bool PERM = true;
    unsigned char* R;
    __device__ __forceinline__ void operator()(AccRef acc, const Unit& u, int wr, int wc, int fr, int fq) const {
        const int row0 = u.pm * 256 + wr * 64 + fr, c8 = wc * 32 + 8 * fq;
#pragma unroll
        for (int ai = 0; ai < 2; ++ai)
#pragma unroll
            for (int m = 0; m < 4; ++m) { const int rowi = row0 + ai * 128 + m * 16; const size_t row = (size_t)rowi;
#pragma unroll
                for (int bj = 0; bj < 2; ++bj) { const u32x4 w = pack8(acc[ai][bj][m][0] * W8_INV, acc[ai][bj][m][1] * W8_INV);
                    if (u.pn == 0) { const int c0 = bj * 128 + c8, g = c0 >> 4, j0 = c0 & 15; int n, s; row_to_chunk(rowi, n, s);
                        *(u32x4*)(R + R_UX + (((size_t)g * 1280 + n) * 1280 + s * 16 + j0) * 2) = w; }
                    else if (u.pn < 4) { *(u32x4*)(R + R_Q1 + (row * 768 + (u.pn - 1) * 256 + bj * 128 + c8) * 2) = w; }
                    else if (u.pn == 4) { *(u32x4*)(R + R_KV1 + (row * 384 + bj * 128 + c8) * 2) = w; }
                    else if (bj == 0) { *(u32x4*)(R + R_KV1 + (row * 384 + 256 + c8) * 2) = w; } } }
    }
};
struct EpiResid { static constexpr bool PERM = false;
    const float* xin; float* xout; const float* hin; float* hout; const float* gate  ; int row_base; float scale;
    __device__ __forceinline__ void operator()(AccRef acc, const Unit& u, int wr, int wc, int fr, int fq) const {
        const int row0 = row_base + u.pm * 256 + wr * 64 + fr, col0 = u.pn * 256 + wc * 32 + 4 * fq;
#pragma unroll
        for (int ai = 0; ai < 2; ++ai)
#pragma unroll
            for (int m = 0; m < 4; ++m) { const int row = row0 + ai * 128 + m * 16;
                const float* src; float* dst; const float* g;
                if (row < NCTX) { src = hin + (size_t)row * 1024; dst = hout + (size_t)row * 1024; g = gate + 8 * 6144; }
                else { const int r2 = row - NCTX; src = xin + (size_t)r2 * 1024; dst = xout + (size_t)r2 * 1024; g = gate + (r2 >> 13) * 6144; }
#pragma unroll
                for (int bj = 0; bj < 2; ++bj)
#pragma unroll
                    for (int n = 0; n < 2; ++n) { const int c = col0 + bj * 128 + n * 16;
                        *(f32x4*)(dst + c) = *(const f32x4*)(src + c) + *(const f32x4*)(g + c) * (acc[ai][bj][m][n] * scale); } }
    }
};
struct EpiS5F { static constexpr bool PERM = false;
    float* S;
    __device__ __forceinline__ void operator()(AccRef acc, const Unit& u, int wr, int wc, int fr, int fq) const {
        const int row0 = u.pm * 256 + wr * 64 + fr, col0 = wc * 32 + 4 * fq;
#pragma unroll
        for (int ai = 0; ai < 2; ++ai)
#pragma unroll
            for (int m = 0; m < 4; ++m) { float* rp = S + ((size_t)u.g * 1280 + row0 + ai * 128 + m * 16) * 256 + col0;
#pragma unroll
                for (int bj = 0; bj < 2; ++bj)
#pragma unroll
                    for (int n = 0; n < 2; ++n) *(f32x4*)(rp + bj * 128 + n * 16) = acc[ai][bj][m][n]; }
    }
};
__device__ __forceinline__ float gelu_tanh(float x) { const float u = 0.7978845608028654f * (x + 0.044715f * x * x * x); const float e = __builtin_amdgcn_exp2f(2.885390081777927f * u); const float th = 1.f - 2.f * __builtin_amdgcn_rcpf(e + 1.f); return 0.5f * x * (1.f + th); }
struct EpiS5Y { static constexpr bool PERM = true;
    const bf16_t* UX; bf16_t* Yg; const float* dskip;
    __device__ __forceinline__ void operator()(AccRef acc, const Unit& u, int wr, int wc, int fr, int fq) const {
        const int row0 = u.pm * 256 + wr * 64 + fr;
#pragma unroll
        for (int ai = 0; ai < 2; ++ai)
#pragma unroll
            for (int m = 0; m < 4; ++m) { const int n = row0 + ai * 128 + m * 16;
#pragma unroll
                for (int bj = 0; bj < 2; ++bj) { const int c0 = u.pn * 256 + bj * 128 + wc * 32 + 8 * fq, t = c0 >> 4, cc = c0 & 15;
                    const u32x4 uw = *(const u32x4*)(UX + ((size_t)u.g * 1280 + n) * 1280 + t * 16 + cc);
                    const float* ds = dskip + u.g * 16 + cc;
                    f32x4 v0 = acc[ai][bj][m][0], v1 = acc[ai][bj][m][1];
                    v0[0] = gelu_tanh(v0[0] + ds[0] * bflo(uw.x)); v0[1] = gelu_tanh(v0[1] + ds[1] * bfhi(uw.x)); v0[2] = gelu_tanh(v0[2] + ds[2] * bflo(uw.y)); v0[3] = gelu_tanh(v0[3] + ds[3] * bfhi(uw.y));
                    v1[0] = gelu_tanh(v1[0] + ds[4] * bflo(uw.z)); v1[1] = gelu_tanh(v1[1] + ds[5] * bfhi(uw.z)); v1[2] = gelu_tanh(v1[2] + ds[6] * bflo(uw.w)); v1[3] = gelu_tanh(v1[3] + ds[7] * bfhi(uw.w));
                    *(u32x4*)(Yg + ((size_t)n * 64 + t) * 256 + u.g * 16 + cc) = pack8(v0, v1); } }
    }
};
struct EpiGLU { static constexpr bool PERM = true;
    const bf16_t* Yg; bf16_t* MIX; const float* bglu;
    __device__ __forceinline__ void operator()(AccRef acc, const Unit& u, int wr, int wc, int fr, int fq) const {
        const int row0 = u.pm * 256 + wr * 64 + fr;
#pragma unroll
        for (int ai = 0; ai < 2; ++ai)
#pragma unroll
            for (int m = 0; m < 4; ++m) { const size_t tok = (size_t)(row0 + ai * 128 + m * 16);
#pragma unroll
                for (int bj = 0; bj < 2; ++bj) { const int c0 = bj * 128 + wc * 32 + 8 * fq;
                    const u32x4 yw = *(const u32x4*)(Yg + tok * 256 + c0); const float* bg = bglu + c0;
                    f32x4 v0 = acc[ai][bj][m][0], v1 = acc[ai][bj][m][1];
                    v0[0] = bflo(yw.x) * sigmoidf_(v0[0] + bg[0]); v0[1] = bfhi(yw.x) * sigmoidf_(v0[1] + bg[1]); v0[2] = bflo(yw.y) * sigmoidf_(v0[2] + bg[2]); v0[3] = bfhi(yw.y) * sigmoidf_(v0[3] + bg[3]);
                    v1[0] = bflo(yw.z) * sigmoidf_(v1[0] + bg[4]); v1[1] = bfhi(yw.z) * sigmoidf_(v1[1] + bg[5]); v1[2] = bflo(yw.w) * sigmoidf_(v1[2] + bg[6]); v1[3] = bfhi(yw.w) * sigmoidf_(v1[3] + bg[7]);
                    if (DBG_SKIP & 8) { v0 = v0 * 0.f; v1 = v1 * 0.f; }
                    *(u32x4*)(MIX + ((size_t)NCTX + tok) * 1024 + c0) = pack8(v0, v1); } }
    }
};

struct MoeTab { LAS int* pad_start  ; LAS int* rb_start  ; LAS unsigned char* rb_exp  ; };
__device__ __forceinline__ MoeTab moe_tab(LAS unsigned char* misc) { MoeTab t; t.pad_start = (LAS int*)(misc + 64); t.rb_start = (LAS int*)(misc + 64 + 256); t.rb_exp = misc + 64 + 512; return t; }
__device__ __forceinline__ void moe_build_tab(const unsigned* cnt, const MoeTab& T) {
    __syncthreads();
    if (threadIdx.x == 0) { int ps = 0, rb = 0; for (int e = 0; e < NEXP; ++e) { T.pad_start[e] = ps; T.rb_start[e] = rb; const int nb = ((int)cnt[e] + 255) >> 8; ps += nb * 256; rb += nb; } T.pad_start[NEXP] = ps; T.rb_start[NEXP] = rb; }
    __syncthreads();
    const int nrb = T.rb_start[NEXP];
    for (int i = threadIdx.x; i < nrb; i += NTHREADS) { int e = 0; while (T.rb_start[e + 1] <= i) ++e; T.rb_exp[i] = (unsigned char)e; }
    __syncthreads();
}
struct SchedMoe1 {
    const char* XN; const int* rowtok; const char* W; MoeTab T; int rb_lo, rb_hi, G, c; int ldb_bytes;
    __device__ __forceinline__ bool next(int i, Unit& u) const { const int x = c & 7, slot = c >> 3, W = G >> 3, nrb = rb_hi - rb_lo, r0 = (int)((long)nrb * x / 8), r1 = (int)((long)nrb * (x + 1) / 8);
        const long j = (long)i * W + slot; const int rbl = (int)(j >> 3); if (r0 + rbl >= r1) return false; u.pm = rb_lo + r0 + rbl; u.pn = (int)(j & 7); u.g = T.rb_exp[u.pm]; return true; }
    __device__ __forceinline__ const char* a_base(const Unit&) const { return XN; }
    __device__ __forceinline__ unsigned a_off(const Unit& u, int r) const { return (unsigned)rowtok[u.pm * 256 + r] * 1024u; }
    __device__ __forceinline__ const char* b_base(const Unit& u) const { return W + ((size_t)u.g * 2048 + (size_t)u.pn * 256) * 1024; }
};
struct EpiSwiGLU { static constexpr bool PERM = true;
    unsigned char* ACT; const float* bgu; int rb_lo;
    __device__ __forceinline__ void operator()(AccRef acc, const Unit& u, int wr, int wc, int fr, int fq) const {
        const int row0 = (u.pm - rb_lo) * 256 + wr * 64 + fr;
#pragma unroll
        for (int bj = 0; bj < 2; ++bj) { const int c0 = u.pn * 256 + bj * 128 + wc * 32 + 8 * fq;
            const f32x4 b0 = *(const f32x4*)(bgu + (size_t)u.g * 2048 + c0), b1 = *(const f32x4*)(bgu + (size_t)u.g * 2048 + c0 + 4);
#pragma unroll
            for (int ai = 0; ai < 2; ++ai)
#pragma unroll
                for (int m = 0; m < 4; ++m) { const f32x4 v0 = fma4(acc[ai][bj][m][0], W8_INV, b0), v1 = fma4(acc[ai][bj][m][1], W8_INV, b1);
                    float o[4];
#pragma unroll
                    for (int q = 0; q < 4; ++q) { const float hg = q < 2 ? v0[2 * q] : v1[2 * q - 4], hl = q < 2 ? v0[2 * q + 1] : v1[2 * q - 3];
                        const float glu = fminf(hg, 7.f), lin1 = __builtin_amdgcn_fmed3f(hl, -7.f, 7.f) + 1.f;
                        o[q] = glu * __builtin_amdgcn_rcpf(1.f + __builtin_amdgcn_exp2f(glu * (-1.702f * 1.4426950408889634f))) * lin1; }
                    *(unsigned*)(ACT + (size_t)(row0 + ai * 128 + m * 16) * 1024 + (c0 >> 1)) = pk4_fp8_nc(o[0], o[1], o[2], o[3]); } }
    }
};
struct SchedMoe2 {
    const char* ACT; const char* W; MoeTab T; int rb_lo, rb_hi, G, c; int ldb_bytes;
    __device__ __forceinline__ bool next(int i, Unit& u) const { const int x = c & 7, slot = c >> 3, W = G >> 3, nrb = rb_hi - rb_lo, r0 = (int)((long)nrb * x / 8), r1 = (int)((long)nrb * (x + 1) / 8);
        const long j = (long)i * W + slot; const int rbl = (int)(j >> 2); if (r0 + rbl >= r1) return false; u.pm = rb_lo + r0 + rbl; u.pn = (int)(j & 3); u.g = T.rb_exp[u.pm]; return true; }
    __device__ __forceinline__ const char* a_base(const Unit& u) const { return ACT + (size_t)(u.pm - rb_lo) * 256 * 1024; }
    __device__ __forceinline__ unsigned a_off(const Unit&, int r) const { return (unsigned)r * 1024u; }
    __device__ __forceinline__ const char* b_base(const Unit& u) const { return W + ((size_t)u.g * 1024 + (size_t)u.pn * 256) * 1024; }
};
struct EpiMoeOut { static constexpr bool PERM = true;
    unsigned char* OUT; const float* bd; int rb_lo;
    __device__ __forceinline__ void operator()(AccRef acc, const Unit& u, int wr, int wc, int fr, int fq) const {
        const int row0 = (u.pm - rb_lo) * 256 + wr * 64 + fr;
#pragma unroll
        for (int bj = 0; bj < 2; ++bj) { const int c0 = u.pn * 256 + bj * 128 + wc * 32 + 8 * fq;
            const f32x4 b0 = *(const f32x4*)(bd + (size_t)u.g * 1024 + c0), b1 = *(const f32x4*)(bd + (size_t)u.g * 1024 + c0 + 4);
#pragma unroll
            for (int ai = 0; ai < 2; ++ai)
#pragma unroll
                for (int m = 0; m < 4; ++m) { const f32x4 v0 = fma4(acc[ai][bj][m][0], W8_INV, b0), v1 = fma4(acc[ai][bj][m][1], W8_INV, b1);
                    *(u32x2*)(OUT + (size_t)(row0 + ai * 128 + m * 16) * 1024 + c0) = (u32x2){pk4_fp8(v0[0], v0[1], v0[2], v0[3]), pk4_fp8(v1[0], v1[1], v1[2], v1[3])}; } }
    }
};

__device__ __forceinline__ int crow(int r, int hi) { return (r & 3) + 8 * (r >> 2) + 4 * hi; }
__device__ __forceinline__ f32x16 mma32(LAS const bf16_t* A, int lda, LAS const bf16_t* Bt, int ldb, int K, f32x16 acc, int lane) {
    const int r = lane & 31, hh = lane >> 5;
    for (int ks = 0; ks < K; ks += 16) {
        const bf16x8 a = *(LAS const bf16x8*)(A + r * lda + ks + hh * 8);
        const bf16x8 b = *(LAS const bf16x8*)(Bt + r * ldb + ks + hh * 8);
        acc = __builtin_amdgcn_mfma_f32_32x32x16_bf16(a, b, acc, 0, 0, 0);
    }
    return acc;
}
__device__ __forceinline__ void lds_addf(LAS float* p, float v) { (void)__hip_atomic_fetch_add(p, v, __ATOMIC_RELAXED, __HIP_MEMORY_SCOPE_WORKGROUP); }
__device__ __forceinline__ int lds_addi(LAS int* p, int v) { return __hip_atomic_fetch_add(p, v, __ATOMIC_RELAXED, __HIP_MEMORY_SCOPE_WORKGROUP); }
constexpr f32x16 F16ZERO = {0.f, 0.f, 0.f, 0.f, 0.f, 0.f, 0.f, 0.f, 0.f, 0.f, 0.f, 0.f, 0.f, 0.f, 0.f, 0.f};

__device__ __forceinline__ int mlstm_row0(int b, int n) { return n < 4 ? b * 256 + n * 64 : NCTX + b * 8192 + (n - 4) * 64; }
__device__ __forceinline__ size_t mlstm_unit(int b, int h, int dir, int n) { return ((size_t)((b * 8 + h) * 2 + dir)) * NCH + n; }
constexpr int LP = 72;

template <bool TR>
__device__ __forceinline__ void load_tile64(const bf16_t* g, size_t ld, LAS bf16_t* dst, int tid) {
    const int row = tid >> 3, c8 = (tid & 7) * 8;
    const u32x4 w = *(const u32x4*)(g + (size_t)row * ld + c8);
    if (!TR) *(LAS u32x4*)(dst + row * LP + c8) = w;
    else { dst[(c8 + 0) * LP + row] = (bf16_t)(w.x & 0xffff); dst[(c8 + 1) * LP + row] = (bf16_t)(w.x >> 16); dst[(c8 + 2) * LP + row] = (bf16_t)(w.y & 0xffff); dst[(c8 + 3) * LP + row] = (bf16_t)(w.y >> 16);
           dst[(c8 + 4) * LP + row] = (bf16_t)(w.z & 0xffff); dst[(c8 + 5) * LP + row] = (bf16_t)(w.z >> 16); dst[(c8 + 6) * LP + row] = (bf16_t)(w.w & 0xffff); dst[(c8 + 7) * LP + row] = (bf16_t)(w.w >> 16); }
}

__device__ __forceinline__ void phase_mlstm_local(unsigned char* ws, LAS unsigned char* lds) {
    const int tid = threadIdx.x, lane = tid & 63, wid = tid >> 6;
    unsigned char* R = ws + WS_R;
    LAS bf16_t* Ks = (LAS bf16_t*)lds; LAS bf16_t* Vt = Ks + 64 * LP; LAS bf16_t* KwT = Vt + 64 * LP;
    LAS float* vec = (LAS float*)(lds + 4 * 64 * LP * 2);
    LAS float* lf_f = vec, *li_f = vec + 64, *lf_b = vec + 128, *li_b = vec + 192, *w_f = vec + 256, *w_b = vec + 320;
    const bf16_t* KA = (const bf16_t*)(R + R_KA); const bf16_t* VA = (const bf16_t*)(R + R_VA); const float* G = (const float*)(R + R_G);
    bf16_t* CS = (bf16_t*)(R + R_CS); float* NS = (float*)(R + R_NS); float* ML = (float*)(R + R_ML); float* BL = (float*)(R + R_BL);
    for (int u = blockIdx.x; u < NB * 8 * NCH; u += gridDim.x) {
        const int n = u % NCH, h = (u / NCH) & 7, b = u / (NCH * 8); const int row0 = mlstm_row0(b, n);
        __syncthreads();
        load_tile64<false>(KA + (size_t)row0 * 512 + h * 64, 512, Ks, tid);
        load_tile64<true>(VA + (size_t)row0 * 512 + h * 64, 512, Vt, tid);
        if (tid < 64) { const float* gp = G + (size_t)(row0 + tid) * 32 + h; li_f[tid] = gp[0]; lf_f[tid] = logsigmoidf_(gp[8]); li_b[tid] = gp[16]; lf_b[tid] = logsigmoidf_(gp[24]); }
        __syncthreads();
        if (tid < 64) {
            float bf = 0.f, tot_f = 0.f, bb = 0.f, tot_b = 0.f;
            for (int r = 0; r < 64; ++r) { const float a = lf_f[r], c = lf_b[r]; tot_f += a; tot_b += c; if (r <= tid) bf += a; if (r >= tid) bb += c; }
            const float wl_f = tot_f - bf + li_f[tid], wl_b = tot_b - bb + li_b[tid];
            const float mf = wave_max(wl_f), mb = wave_max(wl_b);
            w_f[tid] = __expf(wl_f - mf); w_b[tid] = __expf(wl_b - mb);
            if (tid == 0) { ML[mlstm_unit(b, h, 0, n)] = mf; ML[mlstm_unit(b, h, 1, n)] = mb; BL[mlstm_unit(b, h, 0, n)] = tot_f; BL[mlstm_unit(b, h, 1, n)] = tot_b; }
        }
        __syncthreads();
        {
            const int s = tid >> 3, c8 = (tid & 7) * 8; const float wf = w_f[s], wb = w_b[s];
#pragma unroll
            for (int q = 0; q < 8; ++q) { const float kv = bf2f(Ks[s * LP + c8 + q]); KwT[(c8 + q) * LP + s] = (bf16_t)f2bf(kv * wf); KwT[64 * LP + (c8 + q) * LP + s] = (bf16_t)f2bf(kv * wb); }
        }
        __syncthreads();
        {
            const int dir = wid >> 2, dvb = (wid >> 1) & 1, dkb = wid & 1;
            const f32x16 acc = mma32(Vt + dvb * 32 * LP, LP, KwT + dir * 64 * LP + dkb * 32 * LP, LP, 64, F16ZERO, lane);
            bf16_t* cs = CS + mlstm_unit(b, h, dir, n) * 4096;
#pragma unroll
            for (int r = 0; r < 16; ++r) cs[(dvb * 32 + crow(r, lane >> 5)) * 64 + dkb * 32 + (lane & 31)] = (bf16_t)f2bf(acc[r]);
        }
        if (tid < 128) { const int dir = tid >> 6, dk = tid & 63; float a = 0.f; for (int s = 0; s < 64; ++s) a += bf2f(KwT[dir * 64 * LP + dk * LP + s]); NS[mlstm_unit(b, h, dir, n) * 64 + dk] = a; }
    }
    __syncthreads();
}

__device__ __forceinline__ void phase_mlstm_scan(unsigned char* ws) {
    const int tid = threadIdx.x;
    unsigned char* R = ws + WS_R;
    bf16_t* CS = (bf16_t*)(R + R_CS); float* NS = (float*)(R + R_NS); const float* ML = (const float*)(R + R_ML); const float* BL = (const float*)(R + R_BL); float* MP = (float*)(R + R_MP);
    for (int q = blockIdx.x; q < NB * 8 * 2; q += gridDim.x) {
        const int dir = q & 1; const size_t base = (size_t)q * NCH;
        float C[8]; float nst = 0.f, m = -1e30f;
#pragma unroll
        for (int i = 0; i < 8; ++i) C[i] = 0.f;
        int n = dir ? 3 : 0;
        u32x4 cl = *(const u32x4*)(CS + (base + n) * 4096 + tid * 8); float nl = tid < 64 ? NS[(base + n) * 64 + tid] : 0.f; float ml = ML[base + n], bl = BL[base + n];
        for (int i = 0; i < NCH; ++i) {
            const int nn = (i + 1 < NCH) ? (dir ? ((i + 1) < 4 ? 3 - (i + 1) : 135 - (i + 1)) : i + 1) : n;
            const u32x4 cl2 = *(const u32x4*)(CS + (base + nn) * 4096 + tid * 8); const float nl2 = tid < 64 ? NS[(base + nn) * 64 + tid] : 0.f; const float ml2 = ML[base + nn], bl2 = BL[base + nn];
            float clf[8] = {bflo(cl.x), bfhi(cl.x), bflo(cl.y), bfhi(cl.y), bflo(cl.z), bfhi(cl.z), bflo(cl.w), bfhi(cl.w)};
            u32x4 st; st.x = pk2(C[0], C[1]); st.y = pk2(C[2], C[3]); st.z = pk2(C[4], C[5]); st.w = pk2(C[6], C[7]);
            *(u32x4*)(CS + (base + n) * 4096 + tid * 8) = st;
            if (tid < 64) NS[(base + n) * 64 + tid] = nst;
            if (tid == 0) MP[base + n] = m;
            const float mnew = fmaxf(bl + m, ml), dec = __expf(bl + m - mnew), fre = __expf(ml - mnew);
#pragma unroll
            for (int k = 0; k < 8; ++k) C[k] = dec * C[k] + fre * clf[k];
            nst = dec * nst + fre * nl; m = mnew;
            n = nn; cl = cl2; nl = nl2; ml = ml2; bl = bl2;
        }
    }
}

__device__ __forceinline__ void phase_mlstm_out(const Params& P, unsigned char* ws, LAS unsigned char* lds) {
    const int tid = threadIdx.x, lane = tid & 63, wid = tid >> 6;
    unsigned char* R = ws + WS_R;
    LAS bf16_t* Qs = (LAS bf16_t*)lds; LAS bf16_t* Ks = Qs + 64 * LP; LAS bf16_t* Vt = Ks + 64 * LP; LAS bf16_t* Cst = Vt + 64 * LP  ; LAS bf16_t* sW = Cst + 2 * 64 * LP  ;
    LAS float* H = (LAS float*)(lds + 7 * 64 * LP * 2);
    LAS float* vec = H + 2 * 64 * 65;
    LAS float* lf_f = vec, *li_f = vec + 64, *lf_b = vec + 128, *li_b = vec + 192;
    LAS float* rowc = vec + 256  , *colc = vec + 384  , *inter = vec + 512  , *emm = vec + 640  , *qn = vec + 768  , *rs = vec + 896  , *nsv = vec + 1024  ;
    const bf16_t* QA = (const bf16_t*)(R + R_QA); const bf16_t* KA = (const bf16_t*)(R + R_KA); const bf16_t* VA = (const bf16_t*)(R + R_VA); const bf16_t* OA = (const bf16_t*)(R + R_OA);
    const float* G = (const float*)(R + R_G); const bf16_t* CS = (const bf16_t*)(R + R_CS); const float* NS = (const float*)(R + R_NS); const float* MP = (const float*)(R + R_MP);
    bf16_t* MIX = WSP(bf16_t, WS_XN); const float* mnorm = P.in[11];
    for (int u = blockIdx.x; u < NB * 8 * NCH; u += gridDim.x) {
        const int n = u % NCH, h = (u / NCH) & 7, b = u / (NCH * 8); const int row0 = mlstm_row0(b, n);
        __syncthreads();
        load_tile64<false>(QA + (size_t)row0 * 512 + h * 64, 512, Qs, tid);
        load_tile64<false>(KA + (size_t)row0 * 512 + h * 64, 512, Ks, tid);
        load_tile64<true>(VA + (size_t)row0 * 512 + h * 64, 512, Vt, tid);
        load_tile64<false>(CS + mlstm_unit(b, h, 0, n) * 4096, 64, Cst, tid);
        load_tile64<false>(CS + mlstm_unit(b, h, 1, n) * 4096, 64, Cst + 64 * LP, tid);
        if (tid < 64) { const float* gp = G + (size_t)(row0 + tid) * 32 + h; li_f[tid] = gp[0]; lf_f[tid] = logsigmoidf_(gp[8]); li_b[tid] = gp[16]; lf_b[tid] = logsigmoidf_(gp[24]); }
        if (tid >= 64 && tid < 192) { const int d = (tid - 64) >> 6, k = (tid - 64) & 63; nsv[d * 64 + k] = NS[mlstm_unit(b, h, d, n) * 64 + k]; rs[d * 64 + k] = 0.f; }
        __syncthreads();
        if (tid < 128) {
            const int dir = tid >> 6, t = tid & 63; const float mprev = MP[mlstm_unit(b, h, dir, n)];
            float bt = 0.f, pm = -3.0e38f, bs = 0.f;
            if (dir == 0) { for (int s = 0; s <= t; ++s) { bs += lf_f[s]; pm = fmaxf(pm, li_f[s] - bs); } bt = bs; colc[t] = li_f[t] - bt; }
            else { for (int s = 63; s >= t; --s) { bs += lf_b[s]; pm = fmaxf(pm, li_b[s] - bs); } bt = bs; colc[64 + t] = li_b[t] - bt; }
            const float il = bt + mprev, mt = fmaxf(il, bt + pm);
            rowc[dir * 64 + t] = bt - mt; inter[dir * 64 + t] = __expf(il - mt); emm[dir * 64 + t] = __expf(-mt);
            float a = 0.f; for (int k = 0; k < 64; ++k) a += bf2f(Qs[t * LP + k]) * nsv[dir * 64 + k]; qn[dir * 64 + t] = a;
        }
        __syncthreads();
        {
            const int dir = wid >> 2, ti = (wid >> 1) & 1, sj = wid & 1, hi = lane >> 5, sl = lane & 31, s = sj * 32 + sl;
            const f32x16 acc = mma32(Qs + ti * 32 * LP, LP, Ks + sj * 32 * LP, LP, 64, F16ZERO, lane);
            const float cc = colc[dir * 64 + s];
#pragma unroll
            for (int r = 0; r < 16; ++r) { const int t = ti * 32 + crow(r, hi);
                const bool ok = dir == 0 ? (s <= t) : (s >= t);
                float v = ok ? acc[r] * __expf(rowc[dir * 64 + t] + cc) : 0.f;
                sW[dir * 64 * LP + t * LP + s] = (bf16_t)f2bf(v);
                v += __shfl_xor(v, 16); v += __shfl_xor(v, 8); v += __shfl_xor(v, 4); v += __shfl_xor(v, 2); v += __shfl_xor(v, 1);
                if (sl == 0) lds_addf(&rs[dir * 64 + t], v); }
        }
        __syncthreads();
        {
            const int dir = wid >> 2, ti = (wid >> 1) & 1, dj = wid & 1, hi = lane >> 5, dv = dj * 32 + (lane & 31);
            const f32x16 aqc = mma32(Qs + ti * 32 * LP, LP, Cst + dir * 64 * LP + dj * 32 * LP, LP, 64, F16ZERO, lane);
            const f32x16 asv = mma32(sW + dir * 64 * LP + ti * 32 * LP, LP, Vt + dj * 32 * LP, LP, 64, F16ZERO, lane);
#pragma unroll
            for (int r = 0; r < 16; ++r) { const int t = ti * 32 + crow(r, hi); const float it = (DBG_SKIP & 128) ? 0.f : inter[dir * 64 + t];
                const float den = fmaxf(fabsf(it * qn[dir * 64 + t] + rs[dir * 64 + t]), emm[dir * 64 + t]);
                H[(dir * 64 + t) * 65 + dv] = (it * aqc[r] + asv[r]) / den; }
        }
        __syncthreads();
        {
            const int t = tid >> 3, d8 = (tid & 7) * 8; float hv[8], ss = 0.f;
#pragma unroll
            for (int q = 0; q < 8; ++q) { hv[q] = ((DBG_SKIP & 256) ? 0.f : H[t * 65 + d8 + q]) + ((DBG_SKIP & 64) ? 0.f : H[(64 + t) * 65 + d8 + q]); ss += hv[q] * hv[q]; }
            ss += __shfl_xor(ss, 1); ss += __shfl_xor(ss, 2); ss += __shfl_xor(ss, 4);
            const float rstd = rsqrtf(ss * (1.f / 64.f) + 1e-6f);
            const u32x4 ow = *(const u32x4*)(OA + (size_t)(row0 + t) * 512 + h * 64 + d8);
            const float og[8] = {bflo(ow.x), bfhi(ow.x), bflo(ow.y), bfhi(ow.y), bflo(ow.z), bfhi(ow.z), bflo(ow.w), bfhi(ow.w)};
            float o[8];
#pragma unroll
            for (int q = 0; q < 8; ++q) o[q] = hv[q] * rstd * mnorm[h * 64 + d8 + q] * sigmoidf_(og[q]);
            u32x4 w; w.x = pk2(o[0], o[1]); w.y = pk2(o[2], o[3]); w.z = pk2(o[4], o[5]); w.w = pk2(o[6], o[7]);
            if (DBG_SKIP & 1) w = (u32x4){0u, 0u, 0u, 0u};
            *(u32x2*)((unsigned char*)MIX + (size_t)(row0 + t) * 1024 + h * 64 + d8) = bf8_to_fp8(w);
        }
    }
    __syncthreads();
}


__device__ __forceinline__ float wave_psum(float v, int lane) {
#pragma unroll
    for (int d = 1; d < 64; d <<= 1) { const float t = __shfl_up(v, d); if (lane >= d) v += t; }
    return v;
}
__device__ __forceinline__ float wave_pmax(float v, int lane) {
#pragma unroll
    for (int d = 1; d < 64; d <<= 1) { const float t = __shfl_up(v, d); if (lane >= d) v = fmaxf(v, t); }
    return v;
}
__device__ __forceinline__ float wave_smax(float v, int lane) {
#pragma unroll
    for (int d = 1; d < 64; d <<= 1) { const float t = __shfl_down(v, d); if (lane + d < 64) v = fmaxf(v, t); }
    return v;
}
__device__ __forceinline__ void st_tile_T(LAS bf16_t* dst, const u32x4 w, int row, int c8) {
    dst[(c8 + 0) * LP + row] = (bf16_t)(w.x & 0xffff); dst[(c8 + 1) * LP + row] = (bf16_t)(w.x >> 16); dst[(c8 + 2) * LP + row] = (bf16_t)(w.y & 0xffff); dst[(c8 + 3) * LP + row] = (bf16_t)(w.y >> 16);
    dst[(c8 + 4) * LP + row] = (bf16_t)(w.z & 0xffff); dst[(c8 + 5) * LP + row] = (bf16_t)(w.z >> 16); dst[(c8 + 6) * LP + row] = (bf16_t)(w.w & 0xffff); dst[(c8 + 7) * LP + row] = (bf16_t)(w.w >> 16);
}
__device__ __forceinline__ void phase_mlstm_local2(unsigned char* ws, LAS unsigned char* lds) {
    const int tid = threadIdx.x, lane = tid & 63, wid = tid >> 6, row = tid >> 3, c8 = (tid & 7) * 8;
    unsigned char* R = ws + WS_R;
    LAS bf16_t* Ks = (LAS bf16_t*)lds; LAS bf16_t* Vt = Ks + 64 * LP; LAS bf16_t* KwT = Vt + 64 * LP;
    LAS float* vec = (LAS float*)(lds + 4 * 64 * LP * 2); LAS float* w_f = vec, *w_b = vec + 64;
    const bf16_t* KA = (const bf16_t*)(R + R_KA); const bf16_t* VA = (const bf16_t*)(R + R_VA); const float* G = (const float*)(R + R_G);
    bf16_t* CS = (bf16_t*)(R + R_CS); float* NS = (float*)(R + R_NS); float* ML = (float*)(R + R_ML); float* BL = (float*)(R + R_BL);
    float* BT = (float*)(R + R_BT); float* PM = (float*)(R + R_PM); float* GC = (float*)(R + R_GC);
    const int NU = NB * 8 * NCH;
    int u = blockIdx.x;
    u32x4 kw = (u32x4){0u, 0u, 0u, 0u}, vw = kw; float g0 = 0.f, g1 = 0.f, g2 = 0.f, g3 = 0.f;
    if (u < NU) { const int n = u % NCH, h = (u / NCH) & 7, b = u / (NCH * 8), row0 = mlstm_row0(b, n);
        kw = *(const u32x4*)(KA + (size_t)(row0 + row) * 512 + h * 64 + c8); vw = *(const u32x4*)(VA + (size_t)(row0 + row) * 512 + h * 64 + c8);
        if (wid == 0) { const float* gp = G + (size_t)(row0 + lane) * 32 + h; g0 = gp[0]; g1 = gp[8]; g2 = gp[16]; g3 = gp[24]; } }
    for (; u < NU; u += gridDim.x) {
        const int n = u % NCH, h = (u / NCH) & 7, b = u / (NCH * 8);
        __syncthreads();
        *(LAS u32x4*)(Ks + row * LP + c8) = kw; st_tile_T(Vt, vw, row, c8);
        if (wid == 0) {
            const float li_f = g0, lf_f = logsigmoidf_(g1), li_b = g2, lf_b = logsigmoidf_(g3);
            const float bf = wave_psum(lf_f, lane), pb = wave_psum(lf_b, lane);
            const float tot_f = __shfl(bf, 63), tot_b = __shfl(pb, 63), bb = tot_b - pb + lf_b;
            const float wl_f = tot_f - bf + li_f, wl_b = tot_b - bb + li_b, mf = wave_max(wl_f), mb = wave_max(wl_b);
            w_f[lane] = __expf(wl_f - mf); w_b[lane] = __expf(wl_b - mb);
            const float gf = li_f - bf, gb = li_b - bb, pmf = wave_pmax(gf, lane), pmb = wave_smax(gb, lane);
            const size_t uf = mlstm_unit(b, h, 0, n), ub = mlstm_unit(b, h, 1, n);
            BT[uf * 64 + lane] = bf; BT[ub * 64 + lane] = bb; PM[uf * 64 + lane] = pmf; PM[ub * 64 + lane] = pmb; GC[uf * 64 + lane] = gf; GC[ub * 64 + lane] = gb;
            if (lane == 0) { ML[uf] = mf; ML[ub] = mb; BL[uf] = tot_f; BL[ub] = tot_b; }
        }
        __syncthreads();
        const int un = u + gridDim.x;
        if (un < NU) { const int n2 = un % NCH, h2 = (un / NCH) & 7, b2 = un / (NCH * 8), r2 = mlstm_row0(b2, n2);
            kw = *(const u32x4*)(KA + (size_t)(r2 + row) * 512 + h2 * 64 + c8); vw = *(const u32x4*)(VA + (size_t)(r2 + row) * 512 + h2 * 64 + c8);
            if (wid == 0) { const float* gp = G + (size_t)(r2 + lane) * 32 + h2; g0 = gp[0]; g1 = gp[8]; g2 = gp[16]; g3 = gp[24]; } }
        {   const float wf = w_f[row], wb = w_b[row];
#pragma unroll
            for (int q = 0; q < 8; ++q) { const float kv = bf2f(Ks[row * LP + c8 + q]); KwT[(c8 + q) * LP + row] = (bf16_t)f2bf(kv * wf); KwT[64 * LP + (c8 + q) * LP + row] = (bf16_t)f2bf(kv * wb); } }
        __syncthreads();
        {   const int dir = wid >> 2, dvb = (wid >> 1) & 1, dkb = wid & 1;
            const f32x16 acc = mma32(Vt + dvb * 32 * LP, LP, KwT + dir * 64 * LP + dkb * 32 * LP, LP, 64, F16ZERO, lane);
            bf16_t* cs = CS + mlstm_unit(b, h, dir, n) * 4096;
#pragma unroll
            for (int r = 0; r < 16; ++r) cs[(dvb * 32 + crow(r, lane >> 5)) * 64 + dkb * 32 + (lane & 31)] = (bf16_t)f2bf(acc[r]); }
        if (tid < 128) { const int dir = tid >> 6, dk = tid & 63; float a = 0.f;
#pragma unroll 8
            for (int s8 = 0; s8 < 64; s8 += 8) { const u32x4 w = *(LAS const u32x4*)(KwT + dir * 64 * LP + dk * LP + s8); a += ((bflo(w.x) + bfhi(w.x)) + (bflo(w.y) + bfhi(w.y))) + ((bflo(w.z) + bfhi(w.z)) + (bflo(w.w) + bfhi(w.w))); }
            NS[mlstm_unit(b, h, dir, n) * 64 + dk] = a; }
    }
    __syncthreads();
}

__device__ __forceinline__ void phase_mlstm_out2(const Params& P, unsigned char* ws, LAS unsigned char* lds) {
    const int tid = threadIdx.x, lane = tid & 63, wid = tid >> 6, row = tid >> 3, c8 = (tid & 7) * 8;
    unsigned char* R = ws + WS_R;
    LAS bf16_t* Qs = (LAS bf16_t*)lds; LAS bf16_t* Ks = Qs + 64 * LP; LAS bf16_t* Vt = Ks + 64 * LP; LAS bf16_t* Cst = Vt + 64 * LP  ; LAS bf16_t* sW = Cst + 2 * 64 * LP  ;
    LAS bf16_t* NsT = sW + 2 * 64 * LP  ; LAS bf16_t* Ones = NsT + 2 * 32 * LP  ;
    LAS float* H = (LAS float*)(lds + (7 * 64 + 3 * 32) * LP * 2);
    LAS float* vec = H + 2 * 64 * 65; LAS float* BTv = vec, *PMv = vec + 128, *GCv = vec + 256, *MPv = vec + 384;
    const bf16_t* QA = (const bf16_t*)(R + R_QA); const bf16_t* KA = (const bf16_t*)(R + R_KA); const bf16_t* VA = (const bf16_t*)(R + R_VA); const bf16_t* OA = (const bf16_t*)(R + R_OA);
    const bf16_t* CS = (const bf16_t*)(R + R_CS); const float* NS = (const float*)(R + R_NS); const float* MP = (const float*)(R + R_MP);
    const float* BT = (const float*)(R + R_BT); const float* PM = (const float*)(R + R_PM); const float* GC = (const float*)(R + R_GC);
    bf16_t* MIX = WSP(bf16_t, WS_XN); const float* mnorm = P.in[11];
    __syncthreads();
    for (int i = tid; i < 3 * 32 * LP; i += NTHREADS) NsT[i] = (bf16_t)((i >= 2 * 32 * LP && i < 2 * 32 * LP + 64) ? 0x3f80 : 0);
    const int NU = NB * 8 * NCH;
    int u = blockIdx.x;
    u32x4 qw = (u32x4){0u, 0u, 0u, 0u}, kw = qw, vw = qw, cfw = qw, cbw = qw, ow = qw; float pbt = 0.f, ppm = 0.f, pgc = 0.f, pns = 0.f, pmp = 0.f;
#define M3_PREFETCH(UU) do { const int n_ = (UU) % NCH, h_ = ((UU) / NCH) & 7, b_ = (UU) / (NCH * 8), r_ = mlstm_row0(b_, n_); const size_t go_ = (size_t)(r_ + row) * 512 + h_ * 64 + c8; \
        qw = *(const u32x4*)(QA + go_); kw = *(const u32x4*)(KA + go_); vw = *(const u32x4*)(VA + go_); ow = *(const u32x4*)(OA + go_); \
        cfw = *(const u32x4*)(CS + mlstm_unit(b_, h_, 0, n_) * 4096 + row * 64 + c8); cbw = *(const u32x4*)(CS + mlstm_unit(b_, h_, 1, n_) * 4096 + row * 64 + c8); \
        if (tid < 128) { const size_t uu_ = mlstm_unit(b_, h_, tid >> 6, n_); pbt = BT[uu_ * 64 + (tid & 63)]; ppm = PM[uu_ * 64 + (tid & 63)]; pgc = GC[uu_ * 64 + (tid & 63)]; pns = NS[uu_ * 64 + (tid & 63)]; pmp = MP[uu_]; } } while (0)
    if (u < NU) M3_PREFETCH(u);
    for (; u < NU; u += gridDim.x) {
        const int n = u % NCH, h = (u / NCH) & 7, b = u / (NCH * 8); const int row0 = mlstm_row0(b, n);
        __syncthreads();
        *(LAS u32x4*)(Qs + row * LP + c8) = qw; *(LAS u32x4*)(Ks + row * LP + c8) = kw; st_tile_T(Vt, vw, row, c8);
        *(LAS u32x4*)(Cst + row * LP + c8) = cfw; *(LAS u32x4*)(Cst + 64 * LP + row * LP + c8) = cbw;
        const u32x4 ocur = ow;
        if (tid < 128) { BTv[tid] = pbt; PMv[tid] = ppm; GCv[tid] = pgc; NsT[(tid >> 6) * 32 * LP + (tid & 63)] = (bf16_t)f2bf(pns); if ((tid & 63) == 0) MPv[tid >> 6] = pmp; }
        __syncthreads();
        if (u + (int)gridDim.x < NU) M3_PREFETCH(u + (int)gridDim.x);
        {
            const int dir = wid >> 2, ti = (wid >> 1) & 1, sj = wid & 1, hi = lane >> 5, s = sj * 32 + (lane & 31);
            const f32x16 acc = mma32(Qs + ti * 32 * LP, LP, Ks + sj * 32 * LP, LP, 64, F16ZERO, lane);
            const float cc = GCv[dir * 64 + s], mprev = MPv[dir];
#pragma unroll
            for (int r = 0; r < 16; ++r) { const int t = ti * 32 + crow(r, hi); const float bt = BTv[dir * 64 + t], mt = fmaxf(bt + mprev, bt + PMv[dir * 64 + t]);
                const bool ok = dir == 0 ? (s <= t) : (s >= t);
                const float v = ok ? acc[r] * __expf((bt - mt) + cc) : 0.f;
                sW[dir * 64 * LP + t * LP + s] = (bf16_t)f2bf(v); }
        }
        __syncthreads();
        {
            const int dir = wid >> 2, ti = (wid >> 1) & 1, dj = wid & 1, hi = lane >> 5, dv = dj * 32 + (lane & 31);
            const f32x16 aqc = mma32(Qs + ti * 32 * LP, LP, Cst + dir * 64 * LP + dj * 32 * LP, LP, 64, F16ZERO, lane);
            const f32x16 asv = mma32(sW + dir * 64 * LP + ti * 32 * LP, LP, Vt + dj * 32 * LP, LP, 64, F16ZERO, lane);
            const f32x16 aqn = mma32(Qs + ti * 32 * LP, LP, NsT + dir * 32 * LP, LP, 64, F16ZERO, lane);
            const f32x16 ars = mma32(sW + dir * 64 * LP + ti * 32 * LP, LP, Ones, LP, 64, F16ZERO, lane);
            const float mprev = MPv[dir];
#pragma unroll
            for (int r = 0; r < 16; ++r) { const int t = ti * 32 + crow(r, hi); const float bt = BTv[dir * 64 + t], il = bt + mprev, mt = fmaxf(il, bt + PMv[dir * 64 + t]), it = __expf(il - mt);
                const float qn = __shfl(aqn[r], hi * 32), rs = __shfl(ars[r], hi * 32);
                const float den = fmaxf(fabsf(it * qn + rs), __expf(-mt)), rden = __builtin_amdgcn_rcpf(den);
                H[(dir * 64 + t) * 65 + dv] = (it * aqc[r] + asv[r]) * rden; }
        }
        __syncthreads();
        {   const int t = row, d8 = c8; float hv[8], ss = 0.f;
#pragma unroll
            for (int q = 0; q < 8; ++q) { hv[q] = H[t * 65 + d8 + q] + H[(64 + t) * 65 + d8 + q]; ss += hv[q] * hv[q]; }
            ss += __shfl_xor(ss, 1); ss += __shfl_xor(ss, 2); ss += __shfl_xor(ss, 4);
            const float rstd = rsqrtf(ss * (1.f / 64.f) + 1e-6f);
            const float og[8] = {bflo(ocur.x), bfhi(ocur.x), bflo(ocur.y), bfhi(ocur.y), bflo(ocur.z), bfhi(ocur.z), bflo(ocur.w), bfhi(ocur.w)};
            float o[8];
#pragma unroll
            for (int q = 0; q < 8; ++q) o[q] = hv[q] * rstd * mnorm[h * 64 + d8 + q] * sigmoidf_(og[q]);
            u32x4 w; w.x = pk2(o[0], o[1]); w.y = pk2(o[2], o[3]); w.z = pk2(o[4], o[5]); w.w = pk2(o[6], o[7]);
            *(u32x2*)((unsigned char*)MIX + (size_t)(row0 + t) * 1024 + h * 64 + d8) = bf8_to_fp8(w);
        }
    }
#undef M3_PREFETCH
    __syncthreads();
}

__device__ __forceinline__ void qk_prep_tile(const bf16_t* src, size_t spitch, bf16_t* dst, size_t dpitch, const float* gain, bool rope, int pos0, int tid) {
    const int r = tid >> 3, q = tid & 7, i0 = (q & 3) * 4, d1 = (q >> 2) * 32 + i0, d2 = d1 + 16;
    const u32x2 w1 = *(const u32x2*)(src + (size_t)r * spitch + d1), w2 = *(const u32x2*)(src + (size_t)r * spitch + d2);
    float a[4] = {bflo(w1.x), bfhi(w1.x), bflo(w1.y), bfhi(w1.y)}, c[4] = {bflo(w2.x), bfhi(w2.x), bflo(w2.y), bfhi(w2.y)};
    if (gain) {
        float ss = 0.f;
#pragma unroll
        for (int i = 0; i < 4; ++i) ss += a[i] * a[i] + c[i] * c[i];
        ss += __shfl_xor(ss, 1); ss += __shfl_xor(ss, 2); ss += __shfl_xor(ss, 4);
        const float rstd = rsqrtf(ss * (1.f / 64.f) + 1e-6f);
#pragma unroll
        for (int i = 0; i < 4; ++i) { a[i] = (float)bf2f((bf16_t)f2bf(a[i] * rstd * gain[d1 + i])); c[i] = (float)bf2f((bf16_t)f2bf(c[i] * rstd * gain[d2 + i])); }
    }
    if (rope) {
        const int pos = pos0 + r; const float pc = (float)((q >> 2) ? (pos & 63) : (pos >> 6));
#pragma unroll
        for (int i = 0; i < 4; ++i) { const float inv = exp2f(-(float)(i0 + i) * (13.287712379549449f / 16.f)); float sn, cs; __sincosf(pc * inv, &sn, &cs);
            const float t1 = a[i], t2 = c[i]; a[i] = t1 * cs - t2 * sn; c[i] = t2 * cs + t1 * sn; }
    }
    u32x2 o1, o2; o1.x = pk2(a[0], a[1]); o1.y = pk2(a[2], a[3]); o2.x = pk2(c[0], c[1]); o2.y = pk2(c[2], c[3]);
    *(u32x2*)(dst + (size_t)r * dpitch + d1) = o1; *(u32x2*)(dst + (size_t)r * dpitch + d2) = o2;
}
__device__ __forceinline__ void phase_qkv_prep(LAS unsigned char* lds, const bf16_t* ksrc, size_t kpitch, const bf16_t* vsrc, size_t vpitch, bf16_t* qbuf, size_t qpitch, int HKV, int HQ,
                                               bf16_t* Kc, bf16_t* VT, const float* qgain, const float* kgain, bool ctx_q) {
    const int tid = threadIdx.x;
    LAS bf16_t* tl = (LAS bf16_t*)lds;
    const int nkv = NB * HKV * NCH;
    for (int u = blockIdx.x; u < nkv; u += gridDim.x) {
        const int j = u % NCH, kvh = (u / NCH) % HKV, b = u / (NCH * HKV);
        const int row0 = j < 4 ? b * 256 + j * 64 : NCTX + b * 8192 + (j - 4) * 64;
        const size_t key0 = (size_t)j * 64;
        qk_prep_tile(ksrc + (size_t)row0 * kpitch + kvh * 64, kpitch, Kc + (((size_t)b * HKV + kvh) * NKEY + key0) * 64, 64, kgain, j >= 4, (j - 4) * 64, tid);
        __syncthreads();
        { const int r = tid >> 3, c8 = (tid & 7) * 8; *(LAS u32x4*)(tl + r * LP + c8) = *(const u32x4*)(vsrc + (size_t)(row0 + r) * vpitch + kvh * 64 + c8); }
        __syncthreads();
        { const int dv = tid >> 3, k8 = (tid & 7) * 8; u32x4 w;
          w.x = (unsigned)tl[(k8 + 0) * LP + dv] | ((unsigned)tl[(k8 + 1) * LP + dv] << 16); w.y = (unsigned)tl[(k8 + 2) * LP + dv] | ((unsigned)tl[(k8 + 3) * LP + dv] << 16);
          w.z = (unsigned)tl[(k8 + 4) * LP + dv] | ((unsigned)tl[(k8 + 5) * LP + dv] << 16); w.w = (unsigned)tl[(k8 + 6) * LP + dv] | ((unsigned)tl[(k8 + 7) * LP + dv] << 16);
          *(u32x4*)(VT + (((size_t)b * HKV + kvh) * 64 + dv) * NKEY + key0 + k8) = w; }
    }
    const int ntile = (ctx_q ? NTOK : NLAT) / 64;
    for (int u = blockIdx.x; u < ntile * HQ; u += gridDim.x) {
        const int hq = u % HQ, tI = u / HQ; const int row0 = ctx_q ? tI * 64 : NCTX + tI * 64; const bool lat = row0 >= NCTX;
        if (!lat && !qgain) continue;
        bf16_t* qp = qbuf + (size_t)row0 * qpitch + hq * 64;
        qk_prep_tile(qp, qpitch, qp, qpitch, qgain, lat, lat ? ((row0 - NCTX) & 8191) : 0, tid);
    }
    __syncthreads();
}

struct AttnArgs {
    const bf16_t* Q; size_t qpitch; const bf16_t* Kc; const bf16_t* VT; bf16_t* O; size_t opitch; int ocol0; int HKV; const float* sink; int swa;
};
__device__ __forceinline__ void attn_unit_v1(const AttnArgs& A, LAS unsigned char* lds, int b, int kvh, int qrow0, int qpos0  ) {
    const int tid = threadIdx.x, lane = tid & 63, wid = tid >> 6, r32 = lane & 31, hh = lane >> 5;
    LAS bf16_t* Kb = (LAS bf16_t*)lds; LAS bf16_t* Vb = Kb + 2 * 64 * LP; LAS bf16_t* Ost = Vb + 2 * 64 * LP + wid * 32 * LP;
    const int head = kvh * 4 + (wid >> 1);
    const int qrow = qrow0 + 32 * (wid & 1) + r32;
    const bf16_t* Kg = A.Kc + ((size_t)b * A.HKV + kvh) * NKEY * 64; const bf16_t* Vg = A.VT + ((size_t)b * A.HKV + kvh) * 64 * NKEY;
    int lt0 = 4, lt1 = 4;
    if (qpos0 >= 0) { if (A.swa) { const int qb = qpos0 >> 6; lt0 = 4 + (qb - 2 < 0 ? 0 : qb - 2); lt1 = 4 + (qb + 3 > 128 ? 128 : qb + 3); } else { lt0 = 4; lt1 = NCH; } }
    const int ntile = 4 + (lt1 - lt0);
    bf16x8 qf[4];
#pragma unroll
    for (int ks = 0; ks < 4; ++ks) qf[ks] = *(const bf16x8*)(A.Q + (size_t)qrow * A.qpitch + head * 64 + ks * 16 + hh * 8);
    f32x16 o0 = F16ZERO, o1 = F16ZERO; float m = -1e30f, l = 0.f;
    const int lr = tid >> 3, lc = (tid & 7) * 8;
    __syncthreads();
    { const int j = 0; *(LAS u32x4*)(Kb + lr * LP + lc) = *(const u32x4*)(Kg + ((size_t)j * 64 + lr) * 64 + lc); *(LAS u32x4*)(Vb + lr * LP + lc) = *(const u32x4*)(Vg + (size_t)lr * NKEY + j * 64 + lc); }
    u32x4 kn = *(const u32x4*)(Kg + ((size_t)1 * 64 + lr) * 64 + lc), vn = *(const u32x4*)(Vg + (size_t)lr * NKEY + 1 * 64 + lc);
    u32x4 kn2 = *(const u32x4*)(Kg + ((size_t)2 * 64 + lr) * 64 + lc), vn2 = *(const u32x4*)(Vg + (size_t)lr * NKEY + 2 * 64 + lc);
    u32x4 kn3 = *(const u32x4*)(Kg + ((size_t)3 * 64 + lr) * 64 + lc), vn3 = *(const u32x4*)(Vg + (size_t)lr * NKEY + 3 * 64 + lc);
    __syncthreads();
    for (int it = 0; it < ntile; ++it) {
        const int cur = it & 1, j = it < 4 ? it : lt0 + (it - 4);
        u32x4 kn4 = kn3, vn4 = vn3; const bool more = it + 1 < ntile;
        if (it + 4 < ntile) { const int jn = lt0 + it; kn4 = *(const u32x4*)(Kg + ((size_t)jn * 64 + lr) * 64 + lc); vn4 = *(const u32x4*)(Vg + (size_t)lr * NKEY + jn * 64 + lc); }
        LAS const bf16_t* Kt = Kb + cur * 64 * LP; LAS const bf16_t* Vt = Vb + cur * 64 * LP;
        f32x16 s0 = F16ZERO, s1 = F16ZERO;
#pragma unroll
        for (int ks = 0; ks < 4; ++ks) {
            const bf16x8 k0 = *(LAS const bf16x8*)(Kt + r32 * LP + ks * 16 + hh * 8), k1 = *(LAS const bf16x8*)(Kt + (32 + r32) * LP + ks * 16 + hh * 8);
            s0 = __builtin_amdgcn_mfma_f32_32x32x16_bf16(k0, qf[ks], s0, 0, 0, 0); s1 = __builtin_amdgcn_mfma_f32_32x32x16_bf16(k1, qf[ks], s1, 0, 0, 0);
        }
        constexpr float SC = 0.125f * 1.4426950408889634f;
        const int dt_ = (j - 4) - (qpos0 >> 6); const bool edge = A.swa && j >= 4 && (dt_ == 2 || dt_ == -2);
        float tmax = -1e30f;
        if (edge) {
#pragma unroll
            for (int r = 0; r < 16; ++r) { float a = s0[r] * SC, c = s1[r] * SC;
                const int kp = (j - 4) * 64 + crow(r, hh), qp = qpos0 + 32 * (wid & 1) + r32; const int d0 = qp - kp, d1 = qp - (kp + 32);
                if (d0 > 128 || d0 < -128) a = -1e30f; if (d1 > 128 || d1 < -128) c = -1e30f;
                s0[r] = a; s1[r] = c; tmax = fmaxf(tmax, fmaxf(a, c)); }
        } else {
#pragma unroll
            for (int r = 0; r < 16; ++r) { const float a = s0[r] * SC, c = s1[r] * SC; s0[r] = a; s1[r] = c; tmax = fmaxf(tmax, fmaxf(a, c)); }
        }
        tmax = fmaxf(tmax, __shfl_xor(tmax, 32));
        if (!__all(tmax <= m)) {
            const float mnew = fmaxf(m, tmax), alpha = __builtin_amdgcn_exp2f(m - mnew);
            l *= alpha; m = mnew;
#pragma unroll
            for (int r = 0; r < 16; ++r) { o0[r] *= alpha; o1[r] *= alpha; }
        }
        float ps = 0.f;
#pragma unroll
        for (int r = 0; r < 16; ++r) { s0[r] = __builtin_amdgcn_exp2f(s0[r] - m); s1[r] = __builtin_amdgcn_exp2f(s1[r] - m); ps += s0[r] + s1[r]; }
        ps += __shfl_xor(ps, 32);
        l += ps;
#pragma unroll
        for (int sub = 0; sub < 2; ++sub)
#pragma unroll
            for (int s2 = 0; s2 < 2; ++s2) {
                const f32x16& sp = sub ? s1 : s0;
                u32x4 pw; pw.x = pg8::cvt_pk_bf16(sp[8 * s2 + 0], sp[8 * s2 + 1]); pw.y = pg8::cvt_pk_bf16(sp[8 * s2 + 2], sp[8 * s2 + 3]); pw.z = pg8::cvt_pk_bf16(sp[8 * s2 + 4], sp[8 * s2 + 5]); pw.w = pg8::cvt_pk_bf16(sp[8 * s2 + 6], sp[8 * s2 + 7]);
                const bf16x8 pf = __builtin_bit_cast(bf16x8, pw);
                const int kof = sub * 32 + s2 * 16 + 4 * hh;
                u32x4 v0w, v1w;
                { const u32x2 a = *(LAS const u32x2*)(Vt + r32 * LP + kof), c = *(LAS const u32x2*)(Vt + r32 * LP + kof + 8); v0w.x = a.x; v0w.y = a.y; v0w.z = c.x; v0w.w = c.y; }
                { const u32x2 a = *(LAS const u32x2*)(Vt + (32 + r32) * LP + kof), c = *(LAS const u32x2*)(Vt + (32 + r32) * LP + kof + 8); v1w.x = a.x; v1w.y = a.y; v1w.z = c.x; v1w.w = c.y; }
                o0 = __builtin_amdgcn_mfma_f32_32x32x16_bf16(__builtin_bit_cast(bf16x8, v0w), pf, o0, 0, 0, 0);
                o1 = __builtin_amdgcn_mfma_f32_32x32x16_bf16(__builtin_bit_cast(bf16x8, v1w), pf, o1, 0, 0, 0);
            }
        if (more) { *(LAS u32x4*)(Kb + (cur ^ 1) * 64 * LP + lr * LP + lc) = kn; *(LAS u32x4*)(Vb + (cur ^ 1) * 64 * LP + lr * LP + lc) = vn; }
        kn = kn2; vn = vn2; kn2 = kn3; vn2 = vn3; kn3 = kn4; vn3 = vn4;
        __syncthreads();
    }
    if (A.sink) l += __builtin_amdgcn_exp2f(A.sink[head] * 1.4426950408889634f - m);
    const float inv = 1.f / l;
#pragma unroll
    for (int r = 0; r < 16; ++r) { Ost[r32 * LP + crow(r, hh)] = (bf16_t)f2bf(o0[r] * inv); Ost[r32 * LP + 32 + crow(r, hh)] = (bf16_t)f2bf(o1[r] * inv); }
    asm volatile("s_waitcnt lgkmcnt(0)" ::: "memory");
#pragma unroll
    for (int p = 0; p < 4; ++p) { const int q = p * 8 + (lane >> 3), d8 = (lane & 7) * 8;
        u32x4 ov = *(LAS const u32x4*)(Ost + q * LP + d8); if ((DBG_SKIP & 2) && A.swa) ov = (u32x4){0u, 0u, 0u, 0u}; if ((DBG_SKIP & 16) && !A.swa) ov = (u32x4){0u, 0u, 0u, 0u};
        *(u32x2*)((unsigned char*)A.O + (size_t)(qrow0 + 32 * (wid & 1) + q) * A.opitch + A.ocol0 + (wid >> 1) * 64 + kvh * 256 + d8) = bf8_to_fp8(ov); }
}
__device__ __forceinline__ float xor32_max(float v) { float a = v, b = v; asm volatile("v_nop\n\tv_nop\n\tv_permlane32_swap_b32 %0, %1\n\tv_nop\n\tv_nop" : "+v"(a), "+v"(b)); return fmaxf(a, b); }
__device__ __forceinline__ float xor32_sum(float v) { float a = v, b = v; asm volatile("v_nop\n\tv_nop\n\tv_permlane32_swap_b32 %0, %1\n\tv_nop\n\tv_nop" : "+v"(a), "+v"(b)); return a + b; }
template <int NG>
__device__ __forceinline__ void attn_unit(const AttnArgs& A, LAS unsigned char* lds, int b, int kvh, int qrow0, int qpos0  ) {
    const int tid = threadIdx.x, lane = tid & 63, wid = tid >> 6, r32 = lane & 31, hh = lane >> 5;
    constexpr int RW = 32 * NG;
    constexpr float CS2 = 0.125f * 1.4426950408889634f;
    LAS bf16_t* Kb = (LAS bf16_t*)lds; LAS bf16_t* Vb = Kb + 2 * 64 * LP; LAS bf16_t* Ost = Vb + 2 * 64 * LP + wid * RW * LP;
    const int head = kvh * 4 + (wid >> 1);
    const int wrow0 = qrow0 + RW * (wid & 1);
    const bf16_t* Kg = A.Kc + ((size_t)b * A.HKV + kvh) * NKEY * 64; const bf16_t* Vg = A.VT + ((size_t)b * A.HKV + kvh) * 64 * NKEY;
    int lt0 = 4, lt1 = 4;
    if (qpos0 >= 0) { if (A.swa) { const int k0 = qpos0 - 128, k1 = qpos0 + 64 * NG + 128; lt0 = 4 + (k0 < 0 ? 0 : k0 >> 6); lt1 = 4 + (k1 > SEQ ? SEQ >> 6 : k1 >> 6); } else { lt0 = 4; lt1 = NCH; } }
    const int ntile = 4 + (lt1 - lt0);
    bf16x8 qf[NG][4];
#pragma unroll
    for (int g = 0; g < NG; ++g)
#pragma unroll
        for (int ks = 0; ks < 4; ++ks) qf[g][ks] = *(const bf16x8*)(A.Q + (size_t)(wrow0 + 32 * g + r32) * A.qpitch + head * 64 + ks * 16 + hh * 8);
    f32x16 o[NG][2]; float m[NG], l[NG];
#pragma unroll
    for (int g = 0; g < NG; ++g) { o[g][0] = F16ZERO; o[g][1] = F16ZERO; m[g] = -1e30f; l[g] = 0.f; }
    const int lr = tid >> 3, lc = (tid & 7) * 8;
    __syncthreads();
    { *(LAS u32x4*)(Kb + lr * LP + lc) = *(const u32x4*)(Kg + (size_t)lr * 64 + lc); *(LAS u32x4*)(Vb + lr * LP + lc) = *(const u32x4*)(Vg + (size_t)lr * NKEY + lc); }
    __syncthreads();
    for (int it = 0; it < ntile; ++it) {
        const int cur = it & 1, j = it < 4 ? it : lt0 + (it - 4);
        u32x4 kn, vn; const bool more = it + 1 < ntile;
        if (more) { const int jn = (it + 1) < 4 ? it + 1 : lt0 + (it + 1 - 4); kn = *(const u32x4*)(Kg + ((size_t)jn * 64 + lr) * 64 + lc); vn = *(const u32x4*)(Vg + (size_t)lr * NKEY + jn * 64 + lc); }
        LAS const bf16_t* Kt = Kb + cur * 64 * LP; LAS const bf16_t* Vt = Vb + cur * 64 * LP;
        f32x16 s[NG][2];
#pragma unroll
        for (int g = 0; g < NG; ++g) { s[g][0] = F16ZERO; s[g][1] = F16ZERO; }
#pragma unroll
        for (int ks = 0; ks < 4; ++ks) {
            const bf16x8 k0 = *(LAS const bf16x8*)(Kt + r32 * LP + ks * 16 + hh * 8), k1 = *(LAS const bf16x8*)(Kt + (32 + r32) * LP + ks * 16 + hh * 8);
#pragma unroll
            for (int g = 0; g < NG; ++g) { s[g][0] = __builtin_amdgcn_mfma_f32_32x32x16_bf16(k0, qf[g][ks], s[g][0], 0, 0, 0); s[g][1] = __builtin_amdgcn_mfma_f32_32x32x16_bf16(k1, qf[g][ks], s[g][1], 0, 0, 0); }
        }
        const bool masked = A.swa && j >= 4;
#pragma unroll
        for (int g = 0; g < NG; ++g) {
            float tmax = -1e30f;
            const int qp = qpos0 + RW * (wid & 1) + 32 * g + r32, kb0 = (j - 4) * 64;
#pragma unroll
            for (int r = 0; r < 16; ++r) { float a = s[g][0][r], c = s[g][1][r];
                if (masked) { const int d0 = qp - (kb0 + crow(r, hh)), d1 = d0 - 32; if (d0 > 128 || d0 < -128) a = -1e30f; if (d1 > 128 || d1 < -128) c = -1e30f; }
                s[g][0][r] = a; s[g][1][r] = c; tmax = fmaxf(tmax, fmaxf(a, c)); }
            tmax = xor32_max(tmax);
            const bool keep = __all((tmax - m[g]) * CS2 <= 8.f);
            if (!keep) { const float mnew = fmaxf(m[g], tmax), alpha = __builtin_amdgcn_exp2f((m[g] - mnew) * CS2);
                l[g] *= alpha; m[g] = mnew;
#pragma unroll
                for (int r = 0; r < 16; ++r) { o[g][0][r] *= alpha; o[g][1][r] *= alpha; } }
            const float mc = m[g] * CS2;
            float ps = 0.f;
#pragma unroll
            for (int r = 0; r < 16; ++r) { const float p0 = __builtin_amdgcn_exp2f(s[g][0][r] * CS2 - mc), p1 = __builtin_amdgcn_exp2f(s[g][1][r] * CS2 - mc); s[g][0][r] = p0; s[g][1][r] = p1; ps += p0 + p1; }
            l[g] += ps;
        }
#pragma unroll
        for (int sub = 0; sub < 2; ++sub)
#pragma unroll
            for (int s2 = 0; s2 < 2; ++s2) {
                const int kof = sub * 32 + s2 * 16 + 4 * hh;
                u32x4 v0w, v1w;
                { const u32x2 a = *(LAS const u32x2*)(Vt + r32 * LP + kof), c = *(LAS const u32x2*)(Vt + r32 * LP + kof + 8); v0w.x = a.x; v0w.y = a.y; v0w.z = c.x; v0w.w = c.y; }
                { const u32x2 a = *(LAS const u32x2*)(Vt + (32 + r32) * LP + kof), c = *(LAS const u32x2*)(Vt + (32 + r32) * LP + kof + 8); v1w.x = a.x; v1w.y = a.y; v1w.z = c.x; v1w.w = c.y; }
#pragma unroll
                for (int g = 0; g < NG; ++g) {
                    const f32x16& sp = s[g][sub];
                    u32x4 pw; pw.x = pg8::cvt_pk_bf16(sp[8 * s2 + 0], sp[8 * s2 + 1]); pw.y = pg8::cvt_pk_bf16(sp[8 * s2 + 2], sp[8 * s2 + 3]); pw.z = pg8::cvt_pk_bf16(sp[8 * s2 + 4], sp[8 * s2 + 5]); pw.w = pg8::cvt_pk_bf16(sp[8 * s2 + 6], sp[8 * s2 + 7]);
                    const bf16x8 pf = __builtin_bit_cast(bf16x8, pw);
                    o[g][0] = __builtin_amdgcn_mfma_f32_32x32x16_bf16(__builtin_bit_cast(bf16x8, v0w), pf, o[g][0], 0, 0, 0);
                    o[g][1] = __builtin_amdgcn_mfma_f32_32x32x16_bf16(__builtin_bit_cast(bf16x8, v1w), pf, o[g][1], 0, 0, 0);
                }
            }
        if (more) { *(LAS u32x4*)(Kb + (cur ^ 1) * 64 * LP + lr * LP + lc) = kn; *(LAS u32x4*)(Vb + (cur ^ 1) * 64 * LP + lr * LP + lc) = vn; }
        __syncthreads();
    }
#pragma unroll
    for (int g = 0; g < NG; ++g) {
        float lt = xor32_sum(l[g]);
        if (A.sink) lt += __builtin_amdgcn_exp2f(A.sink[head] * 1.4426950408889634f - m[g] * CS2);
        const float inv = 1.f / lt;
#pragma unroll
        for (int r = 0; r < 16; ++r) { Ost[(32 * g + r32) * LP + crow(r, hh)] = (bf16_t)f2bf(o[g][0][r] * inv); Ost[(32 * g + r32) * LP + 32 + crow(r, hh)] = (bf16_t)f2bf(o[g][1][r] * inv); }
    }
    asm volatile("s_waitcnt lgkmcnt(0)" ::: "memory");
#pragma unroll
    for (int p = 0; p < 4 * NG; ++p) { const int q = p * 8 + (lane >> 3), d8 = (lane & 7) * 8;
        u32x4 ov = *(LAS const u32x4*)(Ost + q * LP + d8); if ((DBG_SKIP & 2) && A.swa) ov = (u32x4){0u, 0u, 0u, 0u}; if ((DBG_SKIP & 16) && !A.swa) ov = (u32x4){0u, 0u, 0u, 0u};
        *(u32x2*)((unsigned char*)A.O + (size_t)(wrow0 + q) * A.opitch + A.ocol0 + (wid >> 1) * 64 + kvh * 256 + d8) = bf8_to_fp8(ov); }
}
#define ATT_BAR() do { asm volatile("s_waitcnt lgkmcnt(0)" ::: "memory"); __builtin_amdgcn_s_barrier(); asm volatile("" ::: "memory"); } while (0)
__device__ __forceinline__ void attn_unit_ph(const AttnArgs& A, LAS unsigned char* lds, int b, int kvh, int qrow0) {
    constexpr int NG = 2, RW = 64;
    constexpr float CS2 = 0.125f * 1.4426950408889634f;
    const int tid = threadIdx.x, lane = tid & 63, wid = tid >> 6, r32 = lane & 31, hh = lane >> 5, half = wid & 1;
    const int hl = wid >> 1, rh = wid & 1;
    LAS bf16_t* Kb = (LAS bf16_t*)lds; LAS bf16_t* Vb = Kb + 2 * 64 * LP; LAS bf16_t* Ost = Vb + 2 * 64 * LP + wid * RW * LP;
    const int head = kvh * 4 + hl;
    const int wrow0 = qrow0 + RW * rh;
    const bf16_t* Kg = A.Kc + ((size_t)b * A.HKV + kvh) * NKEY * 64; const bf16_t* Vg = A.VT + ((size_t)b * A.HKV + kvh) * 64 * NKEY;
    int ntile = NCH; asm volatile("" : "+s"(ntile));
    bf16x8 qf[NG][4];
#pragma unroll
    for (int g = 0; g < NG; ++g)
#pragma unroll
        for (int ks = 0; ks < 4; ++ks) qf[g][ks] = *(const bf16x8*)(A.Q + (size_t)(wrow0 + 32 * g + r32) * A.qpitch + head * 64 + ks * 16 + hh * 8);
    f32x16 o[NG][2]; float m[NG], l[NG];
#pragma unroll
    for (int g = 0; g < NG; ++g) { o[g][0] = F16ZERO; o[g][1] = F16ZERO; m[g] = -1e30f; l[g] = 0.f; }
    const int lr = tid >> 3, lc = (tid & 7) * 8;
    u32x4 kn, vn;
#define ATT_LOAD(J) do { kn = *(const u32x4*)(Kg + ((size_t)(J) * 64 + lr) * 64 + lc); vn = *(const u32x4*)(Vg + (size_t)lr * NKEY + (J) * 64 + lc); } while (0)
#define ATT_WRITE(J) do { *(LAS u32x4*)(Kb + ((J) & 1) * 64 * LP + lr * LP + lc) = kn; *(LAS u32x4*)(Vb + ((J) & 1) * 64 * LP + lr * LP + lc) = vn; } while (0)
    __syncthreads();
    ATT_LOAD(0); ATT_WRITE(0); ATT_LOAD(1); ATT_WRITE(1); ATT_LOAD(2);
    ATT_BAR();
    if (half == 1) ATT_BAR();
#pragma unroll 1
    for (int t = 0; t < ntile; ++t) {
        LAS const bf16_t* Kt = Kb + (t & 1) * 64 * LP; LAS const bf16_t* Vt = Vb + (t & 1) * 64 * LP;
        if (half == 1 && t >= 1 && t + 1 < ntile) { ATT_WRITE(t + 1); if (t + 2 < ntile) ATT_LOAD(t + 2); }
        f32x16 s[NG][2];
#pragma unroll
        for (int g = 0; g < NG; ++g) { s[g][0] = F16ZERO; s[g][1] = F16ZERO; }
#pragma unroll
        for (int ks = 0; ks < 4; ++ks) {
            const bf16x8 k0 = *(LAS const bf16x8*)(Kt + r32 * LP + ks * 16 + hh * 8), k1 = *(LAS const bf16x8*)(Kt + (32 + r32) * LP + ks * 16 + hh * 8);
#pragma unroll
            for (int g = 0; g < NG; ++g) { s[g][0] = __builtin_amdgcn_mfma_f32_32x32x16_bf16(k0, qf[g][ks], s[g][0], 0, 0, 0); s[g][1] = __builtin_amdgcn_mfma_f32_32x32x16_bf16(k1, qf[g][ks], s[g][1], 0, 0, 0); }
        }
        ATT_BAR();
        if (half == 0 && t >= 1 && t + 1 < ntile) { ATT_WRITE(t + 1); if (t + 2 < ntile) ATT_LOAD(t + 2); }
#pragma unroll
        for (int g = 0; g < NG; ++g) {
            float tmax = -1e30f;
#pragma unroll
            for (int r = 0; r < 16; ++r) tmax = fmaxf(tmax, fmaxf(s[g][0][r], s[g][1][r]));
            tmax = fmaxf(tmax, __shfl_xor(tmax, 32));
            const float mnew = fmaxf(m[g], tmax), alpha = __builtin_amdgcn_exp2f((m[g] - mnew) * CS2), mc = mnew * CS2;
            float ps = 0.f;
#pragma unroll
            for (int r = 0; r < 16; ++r) { const float p0 = __builtin_amdgcn_exp2f(s[g][0][r] * CS2 - mc), p1 = __builtin_amdgcn_exp2f(s[g][1][r] * CS2 - mc); s[g][0][r] = p0; s[g][1][r] = p1; ps += p0 + p1; }
            ps += __shfl_xor(ps, 32);
            l[g] = l[g] * alpha + ps; m[g] = mnew;
#pragma unroll
            for (int r = 0; r < 16; ++r) { o[g][0][r] *= alpha; o[g][1][r] *= alpha; }
        }
#pragma unroll
        for (int sub = 0; sub < 2; ++sub)
#pragma unroll
            for (int s2 = 0; s2 < 2; ++s2) {
                const int kof = sub * 32 + s2 * 16 + 4 * hh;
                u32x4 v0w, v1w;
                { const u32x2 a = *(LAS const u32x2*)(Vt + r32 * LP + kof), c = *(LAS const u32x2*)(Vt + r32 * LP + kof + 8); v0w.x = a.x; v0w.y = a.y; v0w.z = c.x; v0w.w = c.y; }
                { const u32x2 a = *(LAS const u32x2*)(Vt + (32 + r32) * LP + kof), c = *(LAS const u32x2*)(Vt + (32 + r32) * LP + kof + 8); v1w.x = a.x; v1w.y = a.y; v1w.z = c.x; v1w.w = c.y; }
#pragma unroll
                for (int g = 0; g < NG; ++g) {
                    const f32x16& sp = s[g][sub];
                    u32x4 pw; pw.x = pg8::cvt_pk_bf16(sp[8 * s2 + 0], sp[8 * s2 + 1]); pw.y = pg8::cvt_pk_bf16(sp[8 * s2 + 2], sp[8 * s2 + 3]); pw.z = pg8::cvt_pk_bf16(sp[8 * s2 + 4], sp[8 * s2 + 5]); pw.w = pg8::cvt_pk_bf16(sp[8 * s2 + 6], sp[8 * s2 + 7]);
                    const bf16x8 pf = __builtin_bit_cast(bf16x8, pw);
                    o[g][0] = __builtin_amdgcn_mfma_f32_32x32x16_bf16(__builtin_bit_cast(bf16x8, v0w), pf, o[g][0], 0, 0, 0);
                    o[g][1] = __builtin_amdgcn_mfma_f32_32x32x16_bf16(__builtin_bit_cast(bf16x8, v1w), pf, o[g][1], 0, 0, 0);
                }
            }
        ATT_BAR();
    }
    if (half == 0) ATT_BAR();
#undef ATT_LOAD
#undef ATT_WRITE
#pragma unroll
    for (int g = 0; g < NG; ++g) {
        const float inv = 1.f / l[g];
#pragma unroll
        for (int r = 0; r < 16; ++r) { Ost[(32 * g + r32) * LP + crow(r, hh)] = (bf16_t)f2bf(o[g][0][r] * inv); Ost[(32 * g + r32) * LP + 32 + crow(r, hh)] = (bf16_t)f2bf(o[g][1][r] * inv); }
    }
    asm volatile("s_waitcnt lgkmcnt(0)" ::: "memory");
#pragma unroll
    for (int p = 0; p < 4 * NG; ++p) { const int q = p * 8 + (lane >> 3), d8 = (lane & 7) * 8;
        *(u32x2*)((unsigned char*)A.O + (size_t)(wrow0 + q) * A.opitch + A.ocol0 + hl * 64 + kvh * 256 + d8) = bf8_to_fp8(*(LAS const u32x4*)(Ost + q * LP + d8)); }
}
__device__ __forceinline__ void phase_attention_dense(const AttnArgs& A, LAS unsigned char* lds, LAS unsigned char* misc, unsigned* qword) {
    constexpr int QR = 128, NQB = SEQ / QR;
    const int nlat = NB * A.HKV * NQB;
    LAS int* slot = (LAS int*)(misc + 32);
    for (;;) {
        __syncthreads();
        if (threadIdx.x == 0) *slot = (int)atomicAdd(qword, 1u);
        __syncthreads();
        const int u = *slot;
        if (u >= nlat) break;
        const int qb = u % NQB, kvh = (u / NQB) % A.HKV, b = u / (NQB * A.HKV);
        attn_unit_ph(A, lds, b, kvh, NCTX + b * 8192 + qb * QR);
    }
    __syncthreads();
}
template <int NG>
__device__ __forceinline__ void phase_attention(const AttnArgs& A, LAS unsigned char* lds, LAS unsigned char* misc, unsigned* qword, bool ctx_q) {
    constexpr int QR = 64 * NG, NQB = SEQ / QR, NCB = CTXL / QR;
    const int nlat = NB * A.HKV * NQB, nctx = ctx_q ? NB * A.HKV * NCB : 0;
    LAS int* slot = (LAS int*)(misc + 32);
    for (;;) {
        __syncthreads();
        if (threadIdx.x == 0) *slot = (int)atomicAdd(qword, 1u);
        __syncthreads();
        const int u = *slot;
        if (u >= nlat + nctx) break;
        if (u < nlat) { const int qb = u % NQB, kvh = (u / NQB) % A.HKV, b = u / (NQB * A.HKV); attn_unit<NG>(A, lds, b, kvh, NCTX + b * 8192 + qb * QR, qb * QR); }
        else { const int v = u - nlat, qb = v % NCB, kvh = (v / NCB) % A.HKV, b = v / (NCB * A.HKV); attn_unit<NG>(A, lds, b, kvh, b * 256 + qb * QR, -1); }
    }
    __syncthreads();
}

__device__ __forceinline__ void phase_attention_v1(const AttnArgs& A, LAS unsigned char* lds, LAS unsigned char* misc, unsigned* qword, bool ctx_q) {
    const int nlat = NB * A.HKV * 128, nctx = ctx_q ? NB * A.HKV * 4 : 0;
    LAS int* slot = (LAS int*)(misc + 32);
    for (;;) {
        __syncthreads();
        if (threadIdx.x == 0) *slot = (int)atomicAdd(qword, 1u);
        __syncthreads();
        const int u = *slot;
        if (u >= nlat + nctx) break;
        if (u < nlat) { const int qb = u & 127, kvh = (u >> 7) % A.HKV, b = u / (128 * A.HKV); attn_unit_v1(A, lds, b, kvh, NCTX + b * 8192 + qb * 64, qb * 64); }
        else { const int v = u - nlat, qb = v & 3, kvh = (v >> 2) % A.HKV, b = v / (4 * A.HKV); attn_unit_v1(A, lds, b, kvh, b * 256 + qb * 64, -1); }
    }
    __syncthreads();
}


__device__ __forceinline__ void qk_load_tile8(const bf16_t* src, size_t spitch, int tid, u32x2& w1, u32x2& w2) {
    const int r = tid >> 3, q = tid & 7, i0 = (q & 3) * 4, d1 = (q >> 2) * 32 + i0, d2 = d1 + 16;
    w1 = *(const u32x2*)(src + (size_t)r * spitch + d1); w2 = *(const u32x2*)(src + (size_t)r * spitch + d2);
}
__device__ __forceinline__ void qk_finish_tile8(const u32x2 w1, const u32x2 w2, unsigned char* dst, size_t dpitch, const float* gain, bool rope, int pos0, int tid, float oscale) {
    const int r = tid >> 3, q = tid & 7, i0 = (q & 3) * 4, d1 = (q >> 2) * 32 + i0, d2 = d1 + 16;
    float a[4] = {bflo(w1.x), bfhi(w1.x), bflo(w1.y), bfhi(w1.y)}, c[4] = {bflo(w2.x), bfhi(w2.x), bflo(w2.y), bfhi(w2.y)};
    float ss = 0.f;
#pragma unroll
    for (int i = 0; i < 4; ++i) ss += a[i] * a[i] + c[i] * c[i];
    ss += __shfl_xor(ss, 1); ss += __shfl_xor(ss, 2); ss += __shfl_xor(ss, 4);
    const float rstd = rsqrtf(ss * (1.f / 64.f) + 1e-6f);
#pragma unroll
    for (int i = 0; i < 4; ++i) { a[i] = a[i] * rstd * gain[d1 + i]; c[i] = c[i] * rstd * gain[d2 + i]; }
    if (rope) {
        const int pos = pos0 + r; const float pc = (float)((q >> 2) ? (pos & 63) : (pos >> 6));
#pragma unroll
        for (int i = 0; i < 4; ++i) { const float inv = exp2f(-(float)(i0 + i) * (13.287712379549449f / 16.f)); float sn, cs; __sincosf(pc * inv, &sn, &cs);
            const float t1 = a[i], t2 = c[i]; a[i] = t1 * cs - t2 * sn; c[i] = t2 * cs + t1 * sn; }
    }
    *(unsigned*)(dst + (size_t)r * dpitch + d1) = pk4_fp8(a[0] * oscale, a[1] * oscale, a[2] * oscale, a[3] * oscale); *(unsigned*)(dst + (size_t)r * dpitch + d2) = pk4_fp8(c[0] * oscale, c[1] * oscale, c[2] * oscale, c[3] * oscale);
}
__device__ __forceinline__ void qk_prep_tile8(const bf16_t* src, size_t spitch, unsigned char* dst, size_t dpitch, const float* gain, bool rope, int pos0, int tid, float oscale) {
    u32x2 w1, w2; qk_load_tile8(src, spitch, tid, w1, w2); qk_finish_tile8(w1, w2, dst, dpitch, gain, rope, pos0, tid, oscale);
}
__device__ __forceinline__ void phase_qkv_prep8(unsigned char* ws, LAS unsigned char* lds, const float* qgain, const float* kgain) {
    const int tid = threadIdx.x; unsigned char* R = ws + WS_R;
    const bf16_t* kv = (const bf16_t*)(R + R_KV1); const bf16_t* q1 = (const bf16_t*)(R + R_Q1);
    unsigned char* K8 = R + R_K8; unsigned char* VT8 = R + R_VT8; unsigned char* Q8 = R + R_Q8;
    LAS bf16_t* tl = (LAS bf16_t*)lds;
    for (int u = blockIdx.x; u < NB * 3 * NCH; u += gridDim.x) {
        const int j = u % NCH, kvh = (u / NCH) % 3, b = u / (NCH * 3);
        const int row0 = j < 4 ? b * 256 + j * 64 : NCTX + b * 8192 + (j - 4) * 64;
        const size_t key0 = (size_t)j * 64;
        qk_prep_tile8(kv + (size_t)row0 * 384 + kvh * 64, 384, K8 + (((size_t)b * 3 + kvh) * NKEY + key0) * 64, 64, kgain, j >= 4, (j - 4) * 64, tid, 0.25f);
        __syncthreads();
        { const int r = tid >> 3, c8 = (tid & 7) * 8; *(LAS u32x4*)(tl + r * LP + c8) = *(const u32x4*)(kv + (size_t)(row0 + r) * 384 + 192 + kvh * 64 + c8); }
        __syncthreads();
        { const int dv = tid >> 3, p8 = (tid & 7) * 8, hh = p8 >> 5, sub = (p8 >> 4) & 1, ka = 32 * sub + 4 * hh + ((p8 & 8) ? 16 : 0);
          u32x2 w;
          w.x = pk4_fp8(bf2f(tl[(ka + 0) * LP + dv]), bf2f(tl[(ka + 1) * LP + dv]), bf2f(tl[(ka + 2) * LP + dv]), bf2f(tl[(ka + 3) * LP + dv]));
          w.y = pk4_fp8(bf2f(tl[(ka + 8) * LP + dv]), bf2f(tl[(ka + 9) * LP + dv]), bf2f(tl[(ka + 10) * LP + dv]), bf2f(tl[(ka + 11) * LP + dv]));
          *(u32x2*)(VT8 + (((size_t)b * 3 + kvh) * 64 + dv) * NKEY + key0 + p8) = w; }
    }
    const int skipq = gridDim.x == 256 ? 80 : 0, gq_ = (int)gridDim.x - skipq;
    for (int u0 = (int)blockIdx.x - skipq; u0 >= 0 && u0 < (NLAT / 64) * 12; u0 += 4 * gq_) {
        u32x2 w1[4], w2[4];
#pragma unroll
        for (int k = 0; k < 4; ++k) { const int u = u0 + k * gq_; if (u < (NLAT / 64) * 12) { const int hq = u % 12, tI = u / 12; qk_load_tile8(q1 + (size_t)(NCTX + tI * 64) * 768 + hq * 64, 768, tid, w1[k], w2[k]); } }
#pragma unroll
        for (int k = 0; k < 4; ++k) { const int u = u0 + k * gq_; if (u < (NLAT / 64) * 12) { const int hq = u % 12, tI = u / 12; const int lrow0 = tI * 64;
            qk_finish_tile8(w1[k], w2[k], Q8 + (size_t)lrow0 * 768 + hq * 64, 768, qgain, true, lrow0 & 8191, tid, 4.f * 0.125f * 1.4426950408889634f); } }
    }
    __syncthreads();
}
__device__ __forceinline__ void mfma8_acc(f32x16& acc, const i32x8& a, const i32x8& b, int sc) {
    asm volatile("s_nop 1\n\tv_mfma_scale_f32_32x32x64_f8f6f4 %0, %1, %2, %0, %3, %3 op_sel_hi:[0,0,0]" : "+v"(acc) : "v"(a), "v"(b), "v"(sc));
}
__device__ __forceinline__ void mfma8_z(f32x16& out, const i32x8& a, const i32x8& b, int sc) {
    asm volatile("s_nop 1\n\tv_mfma_scale_f32_32x32x64_f8f6f4 %0, %1, %2, 0, %3, %3 op_sel_hi:[0,0,0]" : "=&v"(out) : "v"(a), "v"(b), "v"(sc));
}
__device__ __forceinline__ void mfma8_c(f32x16& out, const i32x8& a, const i32x8& b, const f32x16& c, int sc) {
    asm volatile("s_nop 1\n\tv_mfma_scale_f32_32x32x64_f8f6f4 %0, %1, %2, %3, %4, %4 op_sel_hi:[0,0,0]" : "=&v"(out) : "v"(a), "v"(b), "v"(c), "v"(sc));
}
__device__ __forceinline__ float max3_(float a, float b, float c) { float r; asm("v_max3_f32 %0, %1, %2, %3" : "=v"(r) : "v"(a), "v"(b), "v"(c)); return r; }
__device__ __forceinline__ i32x8 lds_frag8(LAS const unsigned char* p) { const u32x4 a = *(LAS const u32x4*)p, b = *(LAS const u32x4*)(p + 16); return __builtin_bit_cast(i32x8, __builtin_shufflevector(a, b, 0, 1, 2, 3, 4, 5, 6, 7)); }
constexpr int LP8 = 80;
__device__ __forceinline__ void attn_unit8(unsigned char* R, bf16_t* O, LAS unsigned char* lds, int b, int kvh, int lrow0  , const bool SREF, const float mref) {
    constexpr float CS2 = 0.125f * 1.4426950408889634f;
    const int tid = threadIdx.x, lane = tid & 63, wid = tid >> 6, r32 = lane & 31, hh = lane >> 5; const int sc = 0x7F7F7F7F;
    LAS unsigned char* Kb = lds; LAS unsigned char* Vb = lds + 2 * 64 * LP8; LAS bf16_t* Ost = (LAS bf16_t*)(lds + 4 * 64 * LP8) + wid * 64 * LP;
    const int head = kvh * 4 + (wid >> 1), wrow0 = lrow0 + 64 * (wid & 1);
    const unsigned char* Kg = R + R_K8 + ((size_t)b * 3 + kvh) * NKEY * 64; const unsigned char* Vg = R + R_VT8 + ((size_t)b * 3 + kvh) * 64 * NKEY; const unsigned char* Qg = R + R_Q8;
    i32x8 qf[2];
#pragma unroll
    for (int g = 0; g < 2; ++g) { const unsigned char* qp = Qg + (size_t)(wrow0 + 32 * g + r32) * 768 + head * 64 + 32 * hh; const u32x4 a = *(const u32x4*)qp, c = *(const u32x4*)(qp + 16);
        qf[g] = __builtin_bit_cast(i32x8, __builtin_shufflevector(a, c, 0, 1, 2, 3, 4, 5, 6, 7)); }
    f32x16 o[2][2]; const f32x16 cref = F16ZERO - mref; f32x2 l2[2]; float mrun[2] = {0.f, 0.f};
#pragma unroll
    for (int g = 0; g < 2; ++g) { o[g][0] = F16ZERO; o[g][1] = F16ZERO; l2[g] = (f32x2){0.f, 0.f}; }
    const int st = tid & 255, srow = st >> 2, spc = (st & 3) * 16; const bool isv = tid >= 256;
    const unsigned char* gsrc = isv ? Vg + (size_t)srow * NKEY + spc : Kg + (size_t)srow * 64 + spc; const size_t gstep = isv ? 64 : 64 * 64;
    LAS unsigned char* ldst = (isv ? Vb : Kb) + srow * LP8 + spc;
    int ntile = NCH; asm volatile("" : "+s"(ntile));
    __syncthreads();
    *(LAS u32x4*)ldst = *(const u32x4*)gsrc;
    u32x4 pre0 = *(const u32x4*)(gsrc + gstep);
    __syncthreads();
#pragma unroll 1
    for (int it = 0; it < ntile; ++it) {
        const int cur = it & 1; const bool more = it + 1 < ntile;
        u32x4 pre1 = pre0; if (it + 2 < ntile) pre1 = *(const u32x4*)(gsrc + (size_t)(it + 2) * gstep);
        LAS const unsigned char* Kt = Kb + cur * 64 * LP8; LAS const unsigned char* Vt = Vb + cur * 64 * LP8;
        const i32x8 k0 = lds_frag8(Kt + r32 * LP8 + 32 * hh), k1 = lds_frag8(Kt + (32 + r32) * LP8 + 32 * hh);
        f32x16 s[2][2];
        mfma8_c(s[0][0], k0, qf[0], cref, sc); mfma8_c(s[0][1], k1, qf[0], cref, sc); mfma8_c(s[1][0], k0, qf[1], cref, sc); mfma8_c(s[1][1], k1, qf[1], cref, sc);
        asm volatile("s_nop 15\n\ts_nop 7" : "+v"(s[0][0]), "+v"(s[0][1]), "+v"(s[1][0]), "+v"(s[1][1]));
        const i32x8 v0 = lds_frag8(Vt + r32 * LP8 + 32 * hh), v1 = lds_frag8(Vt + (32 + r32) * LP8 + 32 * hh);
#pragma unroll
        for (int g = 0; g < 2; ++g) {
            if (!SREF) {
                float tmax = -3.0e38f;
#pragma unroll
                for (int r = 0; r < 16; ++r) tmax = max3_(tmax, s[g][0][r], s[g][1][r]);
                tmax = xor32_max(tmax);
                if (it == 0 || !__all(tmax <= mrun[g] + 8.f)) { const float mnew = it == 0 ? tmax : fmaxf(tmax, mrun[g]), alpha = it == 0 ? 1.f : __builtin_amdgcn_exp2f(mrun[g] - mnew);
                    l2[g] = l2[g] * alpha; o[g][0] = o[g][0] * alpha; o[g][1] = o[g][1] * alpha; mrun[g] = mnew; }
                s[g][0] = s[g][0] - mrun[g]; s[g][1] = s[g][1] - mrun[g];
            }
            unsigned pw[8];
#pragma unroll
            for (int q4 = 0; q4 < 4; ++q4) {
                float p0[4], p1[4];
#pragma unroll
                for (int e = 0; e < 4; ++e) { p0[e] = __builtin_amdgcn_exp2f(s[g][0][4 * q4 + e]); p1[e] = __builtin_amdgcn_exp2f(s[g][1][4 * q4 + e]); }
                l2[g] = l2[g] + (f32x2){p0[0], p0[1]}; l2[g] = l2[g] + (f32x2){p0[2], p0[3]}; l2[g] = l2[g] + (f32x2){p1[0], p1[1]}; l2[g] = l2[g] + (f32x2){p1[2], p1[3]};
                int w0 = 0, w1 = 0;
                w0 = __builtin_amdgcn_cvt_pk_fp8_f32(p0[0], p0[1], w0, false); w0 = __builtin_amdgcn_cvt_pk_fp8_f32(p0[2], p0[3], w0, true);
                w1 = __builtin_amdgcn_cvt_pk_fp8_f32(p1[0], p1[1], w1, false); w1 = __builtin_amdgcn_cvt_pk_fp8_f32(p1[2], p1[3], w1, true);
                pw[q4] = (unsigned)w0; pw[4 + q4] = (unsigned)w1; }
            const i32x8 pf = (i32x8){(int)pw[0], (int)pw[1], (int)pw[2], (int)pw[3], (int)pw[4], (int)pw[5], (int)pw[6], (int)pw[7]};
            mfma8_acc(o[g][0], v0, pf, sc); mfma8_acc(o[g][1], v1, pf, sc);
        }
        if (more) *(LAS u32x4*)(ldst + (cur ^ 1) * 64 * LP8) = pre0;
        pre0 = pre1;
        __syncthreads();
    }
    asm volatile("s_nop 15\n\ts_nop 7" : "+v"(o[0][0]), "+v"(o[0][1]), "+v"(o[1][0]), "+v"(o[1][1]));
#pragma unroll
    for (int g = 0; g < 2; ++g) {
        const float inv = 1.f / xor32_sum(l2[g][0] + l2[g][1]);
#pragma unroll
        for (int r = 0; r < 16; ++r) { Ost[(32 * g + r32) * LP + crow(r, hh)] = (bf16_t)f2bf(o[g][0][r] * inv); Ost[(32 * g + r32) * LP + 32 + crow(r, hh)] = (bf16_t)f2bf(o[g][1][r] * inv); }
    }
    asm volatile("s_waitcnt lgkmcnt(0)" ::: "memory");
#pragma unroll
    for (int p = 0; p < 8; ++p) { const int q = p * 8 + (lane >> 3), d8 = (lane & 7) * 8;
        *(u32x4*)(O + (size_t)(NCTX + wrow0 + q) * 1024 + 256 + (wid >> 1) * 64 + kvh * 256 + d8) = *(LAS const u32x4*)(Ost + q * LP + d8); }
}
__device__ __forceinline__ void attn8_reference(unsigned char* ws, const float* gq, const float* gk) {
    if (blockIdx.x == 0 && threadIdx.x < 64) { float mq = fabsf(gq[threadIdx.x]), mk = fabsf(gk[threadIdx.x]);
#pragma unroll
        for (int o = 32; o; o >>= 1) { mq = fmaxf(mq, __shfl_xor(mq, o)); mk = fmaxf(mk, __shfl_xor(mk, o)); }
        if (threadIdx.x == 0) WSP(float, WS_CTL)[CW_CNT + 80] = 1.0625f * 1.0625f * 8.f * 1.4426950408889634f * mq * mk - 8.8f; }
}
__device__ __forceinline__ void phase_attention8(unsigned char* ws, LAS unsigned char* lds, LAS unsigned char* misc, unsigned* qword, const float* gq, const float* gk) {
    constexpr int NQB = SEQ / 128; const int nlat = NB * 3 * NQB;
    LAS int* slot = (LAS int*)(misc + 32);
    (void)gq; (void)gk;
    const float mref = __builtin_bit_cast(float, __builtin_amdgcn_readfirstlane((int)WSP(unsigned, WS_CTL)[CW_CNT + 80]));
    const bool sref = mref <= 8.f;
    for (;;) {
        __syncthreads();
        if (threadIdx.x == 0) *slot = (int)atomicAdd(qword, 1u);
        __syncthreads();
        const int u = *slot;
        if (u >= nlat) break;
        const int qb = u % NQB, kvh = (u / NQB) % 3, b = u / (NQB * 3);
        attn_unit8(ws + WS_R, WSP(bf16_t, WS_XN), lds, b, kvh, b * 8192 + qb * 128, sref, sref ? mref : 0.f);
    }
    __syncthreads();
}

__device__ __forceinline__ void phase_norm2_route(const Params& P, unsigned char* ws, LAS unsigned char* lds, int layer, int row_lo) {
    const int tid = threadIdx.x, lane = tid & 63, wid = tid >> 6, r32 = lane & 31, hh = lane >> 5;
    LAS float* xs = (LAS float*)(lds + wid * 12800);
    LAS float* lg = xs + 32 * 65;
    LAS float* rsd = lg + 32 * 33;
    LAS int* cnt_l = (LAS int*)(lds + 8 * 12800);
    LAS int* base_l = cnt_l + 32;
    const float* mods = WSP(float, WS_MODS) + (size_t)layer * 9 * 6144; const float* gff = P.in[layer ? 22 : 7];
    const bf16_t* GWH = WSP(bf16_t, WS_GW) + (size_t)layer * 9 * 32768; const bf16_t* GWL = GWH + (size_t)2 * 9 * 32 * 1024; const float* CB = WSP(float, WS_CB) + layer * 9 * 32;
    bf16_t* XN = WSP(bf16_t, WS_XN); int* tope = WSP(int, WS_TOPE); float* topg = WSP(float, WS_TOPG); int* rank = WSP(int, WS_RANK); int* rowtok = WSP(int, WS_ROWTOK);
    unsigned* gcnt = WSP(unsigned, WS_CTL) + CW_CNT + layer * 32;
    const float* xlat = P.out; const float* xctx = WSP(float, WS_HCTX);
    for (size_t i = (size_t)blockIdx.x * NTHREADS + tid; i < (size_t)MAXRB * 256; i += (size_t)gridDim.x * NTHREADS) rowtok[i] = row_lo;
    const int ngroups = (NTOK - row_lo) / 256;
    for (int grp = blockIdx.x; grp < ngroups; grp += gridDim.x) {
        const int R0 = row_lo + grp * 256 + wid * 32;
        const int rb = R0 < NCTX ? 8 : (R0 - NCTX) >> 13;
        const float* xb = R0 < NCTX ? xctx + (size_t)R0 * 1024 : xlat + (size_t)(R0 - NCTX) * 1024;
        __syncthreads();
        if (tid < 32) cnt_l[tid] = 0;
        f32x16 acc = F16ZERO; float ss = 0.f;
        const bf16_t* gwh = GWH + (size_t)rb * 32768 + (size_t)r32 * 1024 + 8 * hh; const bf16_t* gwl = GWL + (size_t)rb * 32768 + (size_t)r32 * 1024 + 8 * hh;
        const float* xr = xb + (size_t)r32 * 1024 + 8 * hh;
#pragma unroll 4
        for (int k0 = 0; k0 < 1024; k0 += 16) {
            const f32x4 a0 = *(const f32x4*)(xr + k0), a1 = *(const f32x4*)(xr + k0 + 4);
            const bf16x8 bh = *(const bf16x8*)(gwh + k0), bl = *(const bf16x8*)(gwl + k0);
            ss += a0[0] * a0[0] + a0[1] * a0[1] + a0[2] * a0[2] + a0[3] * a0[3] + a1[0] * a1[0] + a1[1] * a1[1] + a1[2] * a1[2] + a1[3] * a1[3];
            u32x4 hw, lw;
            hw.x = pk2(a0[0], a0[1]); hw.y = pk2(a0[2], a0[3]); hw.z = pk2(a1[0], a1[1]); hw.w = pk2(a1[2], a1[3]);
            lw.x = pk2(a0[0] - bflo(hw.x), a0[1] - bfhi(hw.x)); lw.y = pk2(a0[2] - bflo(hw.y), a0[3] - bfhi(hw.y)); lw.z = pk2(a1[0] - bflo(hw.z), a1[1] - bfhi(hw.z)); lw.w = pk2(a1[2] - bflo(hw.w), a1[3] - bfhi(hw.w));
            const bf16x8 ah = __builtin_bit_cast(bf16x8, hw), al = __builtin_bit_cast(bf16x8, lw);
            acc = __builtin_amdgcn_mfma_f32_32x32x16_bf16(ah, bh, acc, 0, 0, 0); acc = __builtin_amdgcn_mfma_f32_32x32x16_bf16(al, bh, acc, 0, 0, 0); acc = __builtin_amdgcn_mfma_f32_32x32x16_bf16(ah, bl, acc, 0, 0, 0);
        }
        ss += __shfl_xor(ss, 32);
        const float rstd = rsqrtf(ss * (1.f / 1024.f) + 1e-6f);
        if (hh == 0) rsd[r32] = rstd;
        const float cb = CB[rb * 32 + r32];
#pragma unroll
        for (int r = 0; r < 16; ++r) { const int row = crow(r, hh); lg[row * 33 + r32] = rsd[row] * acc[r] + cb; }
        int se[4] = {0, 0, 0, 0}, sr[4] = {0, 0, 0, 0}; float sg[4] = {0.f, 0.f, 0.f, 0.f};
        if (lane < 32) {
            float tv[4];
#pragma unroll
            for (int k = 0; k < 4; ++k) { float best = -3.0e38f; int bi = 0;
                for (int e = 0; e < 32; ++e) { const float v = lg[lane * 33 + e]; if (v > best) { best = v; bi = e; } }
                tv[k] = best; se[k] = bi; lg[lane * 33 + bi] = -3.0e38f; }
            const float e1 = __expf(tv[1] - tv[0]), e2 = __expf(tv[2] - tv[0]), e3 = __expf(tv[3] - tv[0]), inv = 1.f / (1.f + e1 + e2 + e3);
            sg[0] = inv; sg[1] = e1 * inv; sg[2] = e2 * inv; sg[3] = e3 * inv;
        }
        __syncthreads();
        if (lane < 32) {
#pragma unroll
            for (int k = 0; k < 4; ++k) sr[k] = lds_addi(&cnt_l[se[k]], 1);
        }
        __syncthreads();
        if (tid < 32) base_l[tid] = (int)atomicAdd(&gcnt[tid], (unsigned)cnt_l[tid]);
        __syncthreads();
        if (lane < 32) { const size_t row = (size_t)(R0 + lane);
#pragma unroll
            for (int k = 0; k < 4; ++k) { tope[row * 4 + k] = se[k]; topg[row * 4 + k] = sg[k]; rank[row * 4 + k] = base_l[se[k]] + sr[k]; } }
        const float* m = mods + (size_t)rb * 6144;
        f32x4 nx[4][4];
#pragma unroll
        for (int u = 0; u < 4; ++u)
#pragma unroll
            for (int q = 0; q < 4; ++q) nx[u][q] = *(const f32x4*)(xb + (size_t)u * 1024 + q * 256 + lane * 4);
        for (int i0 = 0; i0 < 32; i0 += 4) {
#pragma unroll
            for (int u = 0; u < 4; ++u) { const int i = i0 + u; const float rs_i = rsd[i]; f32x4 v[4];
#pragma unroll
                for (int q = 0; q < 4; ++q) v[q] = nx[u][q];
                if (i + 4 < 32) { const float* x = xb + (size_t)(i + 4) * 1024;
#pragma unroll
                    for (int q = 0; q < 4; ++q) nx[u][q] = *(const f32x4*)(x + q * 256 + lane * 4); }
#pragma unroll
                for (int q = 0; q < 4; ++q) { const int k = q * 256 + lane * 4;
                    const f32x4 o = v[q] * rs_i * *(const f32x4*)(gff + k) * (1.f + *(const f32x4*)(m + 4096 + k)) + *(const f32x4*)(m + 3072 + k);
                    *(unsigned*)((unsigned char*)XN + (size_t)(R0 + i) * 1024 + k) = pk4_fp8(o[0], o[1], o[2], o[3]); } } }
    }
    __syncthreads();
}
__device__ __forceinline__ void phase_moe_scatter(unsigned char* ws, const MoeTab& T, int row_lo) {
    const int* tope = WSP(int, WS_TOPE); const int* rank = WSP(int, WS_RANK); int* rowtok = WSP(int, WS_ROWTOK);
    for (size_t i = (size_t)blockIdx.x * NTHREADS + threadIdx.x + (size_t)row_lo * 4; i < (size_t)NTOK * 4; i += (size_t)gridDim.x * NTHREADS)
        rowtok[T.pad_start[tope[i]] + rank[i]] = (int)(i >> 2);
}
__device__ __forceinline__ void phase_moe_combine_norm(const Params& P, unsigned char* ws, const MoeTab& T, int layer, int row_lo) {
    const int lane = threadIdx.x & 63, gw = blockIdx.x * 8 + (threadIdx.x >> 6), nw = gridDim.x * 8;
    const int* tope = WSP(int, WS_TOPE); const int* rank = WSP(int, WS_RANK); const float* topg = WSP(float, WS_TOPG);
    const unsigned char* OUT = ws + WS_OUT; const float* mods = WSP(float, WS_MODS) + (size_t)layer * 9 * 6144; const float* mods1 = WSP(float, WS_MODS) + (size_t)9 * 6144;
    float* xlat = P.out; float* xctx = WSP(float, WS_HCTX); bf16_t* XN = WSP(bf16_t, WS_XN);
    const float* gn = layer ? P.in[43] : P.in[21];
    for (int row = row_lo + gw; row < NTOK; row += nw) {
        f32x4 a[4];
#pragma unroll
        for (int q = 0; q < 4; ++q) a[q] = (f32x4){0.f, 0.f, 0.f, 0.f};
#pragma unroll
        for (int k = 0; k < 4; ++k) { const int e = tope[(size_t)row * 4 + k], dest = T.pad_start[e] + rank[(size_t)row * 4 + k];
            const float g = topg[(size_t)row * 4 + k]; const unsigned char* o = OUT + (size_t)dest * 1024;
#pragma unroll
            for (int q = 0; q < 4; ++q) { const int w = *(const int*)(o + q * 256 + lane * 4); const f32x2 lo = __builtin_amdgcn_cvt_pk_f32_fp8(w, false), hi = __builtin_amdgcn_cvt_pk_f32_fp8(w, true);
                a[q][0] += g * lo.x; a[q][1] += g * lo.y; a[q][2] += g * hi.x; a[q][3] += g * hi.y; } }
        float* x; int r; if (row < NCTX) { x = xctx + (size_t)row * 1024; r = 8; } else { x = xlat + (size_t)(row - NCTX) * 1024; r = (row - NCTX) >> 13; }
        const float* gt = mods + (size_t)r * 6144 + 5120;
        float ss = 0.f;
#pragma unroll
        for (int q = 0; q < 4; ++q) { const int k = q * 256 + lane * 4; a[q] = *(const f32x4*)(x + k) + *(const f32x4*)(gt + k) * a[q]; ss += a[q][0] * a[q][0] + a[q][1] * a[q][1] + a[q][2] * a[q][2] + a[q][3] * a[q][3]; }
        ss = wave_sum(ss); const float rstd = rsqrtf(ss * (1.f / 1024.f) + 1e-6f);
        if (layer == 0) {
            const float* m = mods1 + (size_t)r * 6144;
#pragma unroll
            for (int q = 0; q < 4; ++q) { const int k = q * 256 + lane * 4; *(f32x4*)(x + k) = a[q];
                const f32x4 o = a[q] * rstd * *(const f32x4*)(gn + k) * (1.f + *(const f32x4*)(m + 1024 + k)) + *(const f32x4*)(m + k);
                *(unsigned*)((unsigned char*)XN + (size_t)row * 1024 + k) = pk4_fp8(o[0], o[1], o[2], o[3]); }
        } else {
#pragma unroll
            for (int q = 0; q < 4; ++q) { const int k = q * 256 + lane * 4; *(f32x4*)(x + k) = a[q] * rstd * *(const f32x4*)(gn + k); }
        }
    }
}

__device__ __forceinline__ void phase_s5_scan(unsigned char* ws) {
    const int gid = blockIdx.x * NTHREADS + threadIdx.x;
    if (gid >= NB * 16 * 2 * 64) return;
    const int p = gid & 63, dir = (gid >> 6) & 1, g = (gid >> 7) & 15, b = gid >> 11;
    const float* A64 = WSP(float, WS_S5A64); const float ar = A64[((dir * 16 + g) * 64 + p) * 2], ai = A64[((dir * 16 + g) * 64 + p) * 2 + 1];
    const float* Sl = (const float*)(ws + WS_R + R_SLOC) + (size_t)g * 1280 * 256 + dir * 128 + p;
    bf16_t* UX = (bf16_t*)(ws + WS_R + R_UX) + (size_t)g * 1280 * 1280 + 1024 + dir * 128 + p;
    float xr = 0.f, xi = 0.f;
    for (int i0 = 0; i0 < NCH; i0 += 12) {
        int nidx[12]; float sr[12], si[12];
#pragma unroll
        for (int q = 0; q < 12; ++q) { const int i = i0 + q; int c, n;
            if (i < 4) { c = dir ? 3 - i : i; n = 1024 + b * 4 + c; } else { c = dir ? 131 - i : i - 4; n = b * 128 + c; }
            nidx[q] = (i < 4) ? -1 - n : n; sr[q] = Sl[(size_t)n * 256]; si[q] = Sl[(size_t)n * 256 + 64]; }
#pragma unroll
        for (int q = 0; q < 12; ++q) {
            if (nidx[q] >= 0) { UX[(size_t)nidx[q] * 1280] = (bf16_t)f2bf(xr); UX[(size_t)nidx[q] * 1280 + 64] = (bf16_t)f2bf(xi); }
            const float nr = ar * xr - ai * xi + sr[q], ni = ar * xi + ai * xr + si[q]; xr = nr; xi = ni; }
    }
}

__device__ __forceinline__ void phase_final_norm(const Params& P) {
    const int lane = threadIdx.x & 63, gw = blockIdx.x * 8 + (threadIdx.x >> 6), nw = gridDim.x * 8; const float* g = P.in[43];
    for (int row = gw; row < NLAT; row += nw) { float* x = P.out + (size_t)row * 1024; f32x4 v[4]; float ss = 0.f;
#pragma unroll
        for (int i = 0; i < 4; ++i) { v[i] = *(const f32x4*)(x + i * 256 + lane * 4); ss += v[i][0] * v[i][0] + v[i][1] * v[i][1] + v[i][2] * v[i][2] + v[i][3] * v[i][3]; }
        ss = wave_sum(ss); const float rstd = rsqrtf(ss * (1.f / 1024.f) + 1e-6f);
#pragma unroll
        for (int i = 0; i < 4; ++i) *(f32x4*)(x + i * 256 + lane * 4) = v[i] * rstd * *(const f32x4*)(g + i * 256 + lane * 4); }
}

constexpr int NPHASE = 23;
__global__ void __launch_bounds__(NTHREADS, 2) hybrid_fwd(Params P) {
    extern __shared__ __attribute__((aligned(16))) unsigned char shm_raw[];
    LAS unsigned char* lds = (LAS unsigned char*)shm_raw;
    LAS unsigned char* misc = lds + LDS_STAGE;
    unsigned char* ws = P.ws; unsigned char* R = ws + WS_R;
    const int lo = P.ph_lo, hi = P.ph_hi;
    if (threadIdx.x == 0) *(LAS u32x4*)misc = (u32x4){0u, 0u, 0u, 0u};
    __syncthreads();
    XcdBarrier bar; bar.bar = WSP(unsigned, WS_CTL); bar.x = 0; bar.st = (volatile LAS unsigned*)misc;
    if (hi - lo > 1) bar = xcd_barrier_post(WSP(unsigned, WS_CTL), (volatile LAS unsigned*)misc);
    const MoeTab T = moe_tab(misc);
    const float* mods = WSP(float, WS_MODS);
#ifndef PHMASK
#define PHMASK 0x7fffffffull
#endif
#define IN(k) ((((PHMASK) >> (k)) & 1ull) != 0ull && lo <= (k) && (k) < hi)
#define SEAM(k) do { if (IN(k) && IN((k) + 1)) xcd_barrier(bar); } while (0)

    if (IN(0)) { attn8_reference(ws, P.in[35], P.in[36]); phase_mods(P, ws, lds); phase_convert_small(P, ws, lds); phase_convert_moe8(P, ws, lds, 0, true); if (REP(0)) phase_convert_moe8(P, ws, lds, 0); phase_s5_kernels(P, ws, lds); }
    SEAM(0);
    if (IN(1)) { phase_router_tables(P, ws, lds); phase_s5_tables(P, ws); if (REP(1)) phase_s5_tables(P, ws); phase_norm1(P, ws, 0, P.in[0], P.in[2]); if (REP(15)) phase_norm1(P, ws, 0, P.in[0], P.in[2]); }
    SEAM(1);
    if (IN(2)) { SchedPlain S; S.init(NTOK / 256, 12, 1); S.A = (const char*)(ws + WS_XN); S.Bt = (const char*)(ws + WS_WIN0T); S.lda_bytes = 2048; S.ldb_bytes = 2048; S.a_gstride = 0; S.b_gstride = 0;
        EpiInProj0 E; E.R = R; E.gate_bias = P.in[10]; pg8::gemm_phase(lds, S, E, 1024); if (REP(2)) pg8::gemm_phase(lds, S, E, 1024); }
    SEAM(2);
    if (IN(3)) { phase_qkv_prep(lds, (const bf16_t*)(R + R_KBR), 128, (const bf16_t*)(R + R_VBR), 128, (bf16_t*)(R + R_QB), 512, 2, 8, (bf16_t*)(R + R_KC0), (bf16_t*)(R + R_VT0), nullptr, nullptr, true);
        phase_mlstm_local2(ws, lds); if (REP(3)) phase_mlstm_local2(ws, lds); }
    SEAM(3);
    if (IN(4)) { phase_mlstm_scan(ws);
        AttnArgs A; A.Q = (const bf16_t*)(R + R_QB); A.qpitch = 512; A.Kc = (const bf16_t*)(R + R_KC0); A.VT = (const bf16_t*)(R + R_VT0); A.O = WSP(bf16_t, WS_XN); A.opitch = 1024; A.ocol0 = 512; A.HKV = 2; A.sink = P.in[12]; A.swa = 1;
        phase_attention_v1(A, lds, misc, WSP(unsigned, WS_CTL) + CW_Q0, true); if (REP(4)) phase_attention_v1(A, lds, misc, WSP(unsigned, WS_CTL) + CW_Q0 + 128, true); }
    SEAM(4);
    if (IN(5)) { phase_mlstm_out2(P, ws, lds); if (REP(5)) phase_mlstm_out2(P, ws, lds); }
    SEAM(5);
    if (IN(6)) { SchedPlain S; S.init(NTOK / 256, 4, 1); S.A = (const char*)(ws + WS_XN); S.Bt = (const char*)(ws + WS_WOUT0T); S.lda_bytes = 1024; S.ldb_bytes = 1024; S.a_gstride = 0; S.b_gstride = 0;
        EpiResid E; E.xin = P.in[0]; E.xout = P.out; E.hin = P.in[2]; E.hout = WSP(float, WS_HCTX); E.gate = mods + 2048; E.row_base = 0; E.scale = W8_INV; pg8::gemm_phase8(lds, S, E, 512); if (REP(6)) pg8::gemm_phase8(lds, S, E, 512); }
    SEAM(6);
#define MOE_LAYER(PH0, LAYER, ROWLO)                                                                                                                              \
    if (IN(PH0)) phase_norm2_route(P, ws, lds, LAYER, ROWLO);                                                                                                     \
    SEAM(PH0);                                                                                                                                                    \
    if (IN(PH0 + 1)) { moe_build_tab(WSP(unsigned, WS_CTL) + CW_CNT + LAYER * 32, T); phase_moe_scatter(ws, T, ROWLO); }                                          \
    SEAM(PH0 + 1);                                                                                                                                                \
    {   if (IN(PH0 + 2) || IN(PH0 + 3) || IN(PH0 + 4)) moe_build_tab(WSP(unsigned, WS_CTL) + CW_CNT + LAYER * 32, T);                                            \
        const int nrb = T.rb_start[NEXP];                                                                                                                         \
        if (IN(PH0 + 2)) { SchedMoe1 S; S.XN = (const char*)(ws + WS_XN); S.rowtok = WSP(int, WS_ROWTOK); S.W = (const char*)(ws + WS_WGU); S.T = T; S.rb_lo = 0; S.rb_hi = nrb; S.G = gridDim.x; S.c = blockIdx.x; S.ldb_bytes = 1024; \
            EpiSwiGLU E; E.ACT = ws + WS_ACT8; E.bgu = P.in[LAYER ? 40 : 16]; E.rb_lo = 0; pg8::gemm_phase8(lds, S, E, 512); if (REP(9)) pg8::gemm_phase8(lds, S, E, 512); }  \
        SEAM(PH0 + 2);                                                                                                                                            \
        if (IN(PH0 + 3)) { SchedMoe2 S; S.ACT = (const char*)(ws + WS_ACT8); S.W = (const char*)(ws + WS_WD); S.T = T; S.rb_lo = 0; S.rb_hi = nrb; S.G = gridDim.x; S.c = blockIdx.x; S.ldb_bytes = 1024; \
            EpiMoeOut E; E.OUT = ws + WS_OUT; E.bd = P.in[LAYER ? 42 : 18]; E.rb_lo = 0; pg8::gemm_phase8(lds, S, E, 512); if (REP(10)) pg8::gemm_phase8(lds, S, E, 512); }  \
        SEAM(PH0 + 3);                                                                                                                                            \
        if (IN(PH0 + 4)) { phase_moe_combine_norm(P, ws, T, LAYER, ROWLO); if (LAYER == 0) phase_convert_moe8(P, ws, lds, 1); }                                    \
    }
    MOE_LAYER(7, 0, 0)
    SEAM(11);
    if (IN(12)) { SchedPlain S; S.init(NTOK / 256, 6, 1); S.A = (const char*)(ws + WS_XN); S.Bt = (const char*)(ws + WS_WIN1T); S.lda_bytes = 1024; S.ldb_bytes = 1024; S.a_gstride = 0; S.b_gstride = 0;
        EpiInProj1 E; E.R = R; pg8::gemm_phase8(lds, S, E, 512); if (REP(16)) pg8::gemm_phase8(lds, S, E, 512); }
    SEAM(12);
    if (IN(13)) { phase_qkv_prep8(ws, lds, P.in[35], P.in[36]);
        SchedPlain S; S.init(5, 1, 16); S.A = (const char*)(R + R_UX); S.Bt = (const char*)(ws + WS_S5F); S.lda_bytes = 2560; S.ldb_bytes = 2048; S.a_gstride = (size_t)1280 * 2560; S.b_gstride = (size_t)256 * 2048;
        EpiS5F E; E.S = (float*)(R + R_SLOC); pg8::gemm_phase(lds, S, E, 1024); }
    SEAM(13);
    if (IN(14)) { phase_s5_scan(ws);
        phase_attention8(ws, lds, misc, WSP(unsigned, WS_CTL) + CW_Q0 + 64, P.in[35], P.in[36]); if (REP(18)) phase_attention8(ws, lds, misc, WSP(unsigned, WS_CTL) + CW_Q0 + 192, P.in[35], P.in[36]); }
    SEAM(14);
    if (IN(15)) { SchedPlain S; S.init(4, 4, 16); S.A = (const char*)(R + R_UX); S.Bt = (const char*)(ws + WS_S5TE); S.lda_bytes = 2560; S.ldb_bytes = 2560; S.a_gstride = (size_t)1280 * 2560; S.b_gstride = (size_t)1024 * 2560;
        EpiS5Y E; E.UX = (const bf16_t*)(R + R_UX); E.Yg = (bf16_t*)(R + R_YG); E.dskip = P.in[32]; pg8::gemm_phase(lds, S, E, 1280); if (REP(19)) pg8::gemm_phase(lds, S, E, 1280); }
    SEAM(15);
    if (IN(16)) { SchedPlain S; S.init(NLAT / 256, 1, 1); S.A = (const char*)(R + R_YG); S.Bt = (const char*)(ws + WS_WGLUT); S.lda_bytes = 512; S.ldb_bytes = 512; S.a_gstride = 0; S.b_gstride = 0;
        EpiGLU E; E.Yg = (const bf16_t*)(R + R_YG); E.MIX = WSP(bf16_t, WS_XN); E.bglu = P.in[34]; pg8::gemm_phase(lds, S, E, 256); if (REP(20)) pg8::gemm_phase(lds, S, E, 256); }
    SEAM(16);
    if (IN(17)) { SchedPlain S; S.init(NLAT / 256, 4, 1); S.A = (const char*)(ws + WS_XN) + (size_t)NCTX * 2048; S.Bt = (const char*)(ws + WS_WOUT1T); S.lda_bytes = 2048; S.ldb_bytes = 2048; S.a_gstride = 0; S.b_gstride = 0;
        EpiResid E; E.xin = P.out; E.xout = P.out; E.hin = WSP(float, WS_HCTX); E.hout = WSP(float, WS_HCTX); E.gate = mods + 9 * 6144 + 2048; E.row_base = NCTX; E.scale = 1.f; pg8::gemm_phase(lds, S, E, 1024); }
    SEAM(17);
    MOE_LAYER(18, 1, NCTX)
#undef IN
#undef SEAM
}

extern "C" void kernel_launch(void* const* d_in, const int* in_sizes, int n_in, void* d_out, int out_size, void* d_ws, size_t ws_size, hipStream_t stream) {
    (void)in_sizes; (void)out_size;
    if (n_in < 44 || ws_size < WS_END) { fprintf(stderr, "kernel_launch: n_in %d ws_size %zu need %zu\n", n_in, ws_size, (size_t)WS_END); return; }
    static int grid = 0;
    if (!grid) {
        int dev = 0, cus = 0, per_cu = 0;
        hipGetDevice(&dev);
        hipDeviceGetAttribute(&cus, hipDeviceAttributeMultiprocessorCount, dev);
        hipFuncSetAttribute((const void*)hybrid_fwd, hipFuncAttributeMaxDynamicSharedMemorySize, LDS_BYTES);
        hipOccupancyMaxActiveBlocksPerMultiprocessor(&per_cu, (const void*)hybrid_fwd, NTHREADS, LDS_BYTES);
        if (per_cu < 1) { fprintf(stderr, "kernel_launch: occupancy query says %d blocks per CU\n", per_cu); per_cu = 1; }
        grid = cus;
    }
    hipMemsetAsync(d_ws, 0, WS_ZERO_BYTES, stream);
    Params p{};
    for (int i = 0; i < 44; ++i) p.in[i] = (const float*)d_in[i];
    p.out = (float*)d_out; p.ws = (unsigned char*)d_ws;
#if MK_MULTI
    for (int ph = 0; ph < NPHASE; ++ph) { p.ph_lo = ph; p.ph_hi = ph + 1; hipLaunchKernelGGL(hybrid_fwd, dim3(grid), dim3(NTHREADS), LDS_BYTES, stream, p); }
#else
    p.ph_lo = 0; p.ph_hi = NPHASE;
    hipLaunchKernelGGL(hybrid_fwd, dim3(grid), dim3(NTHREADS), LDS_BYTES, stream, p);
#endif
}
```

```cpp
#include <hip/hip_runtime.h>
#include <cstdio>
#include <cstdint>

#ifndef DBG_SKIP
#define DBG_SKIP 0
#endif
#ifndef DBG_REP
#define DBG_REP 0ull
#endif
#define REP(k) ((((DBG_REP) >> (k)) & 1ull) != 0ull)
#ifndef MK_MULTI
#define MK_MULTI 0
#endif

#define LAS __attribute__((address_space(3)))
typedef unsigned short bf16_t;
typedef short bf16x8 __attribute__((ext_vector_type(8)));
typedef short bf16x4 __attribute__((ext_vector_type(4)));
typedef float f32x4 __attribute__((ext_vector_type(4)));
typedef float f32x2 __attribute__((ext_vector_type(2)));
typedef float f32x16 __attribute__((ext_vector_type(16)));
typedef unsigned u32x4 __attribute__((ext_vector_type(4)));
typedef unsigned u32x2 __attribute__((ext_vector_type(2)));
typedef int i32x8 __attribute__((ext_vector_type(8)));

constexpr int NB = 8, SEQ = 8192, DM = 1024, CTXL = 256;
constexpr int NCTX = NB * CTXL;
constexpr int NLAT = NB * SEQ;
constexpr int NTOK = NCTX + NLAT;
constexpr int NCH = 132;
constexpr int NKEY = CTXL + SEQ;
constexpr int NEXP = 32;
constexpr int MAXRB = 1088;
constexpr int NTHREADS = 512;
constexpr int LDS_STAGE = 131072;
constexpr int LDS_MISC = 16384;
constexpr int LDS_BYTES = LDS_STAGE + LDS_MISC;

__device__ __forceinline__ unsigned f2bf(float f) { unsigned u = __builtin_bit_cast(unsigned, f); return (u + 0x7fffu + ((u >> 16) & 1u)) >> 16; }
__device__ __forceinline__ unsigned pk2(float lo, float hi) { unsigned r; asm("v_cvt_pk_bf16_f32 %0, %1, %2" : "=v"(r) : "v"(lo), "v"(hi)); return r; }
__device__ __forceinline__ float bf2f(unsigned short b) { return __builtin_bit_cast(float, ((unsigned)b) << 16); }
__device__ __forceinline__ float bflo(unsigned w) { return __builtin_bit_cast(float, w << 16); }
__device__ __forceinline__ float bfhi(unsigned w) { return __builtin_bit_cast(float, w & 0xffff0000u); }
__device__ __forceinline__ float wave_sum(float v) {
#pragma unroll
    for (int o = 32; o >= 1; o >>= 1) v += __shfl_xor(v, o);
    return v;
}
__device__ __forceinline__ float wave_max(float v) {
#pragma unroll
    for (int o = 32; o >= 1; o >>= 1) v = fmaxf(v, __shfl_xor(v, o));
    return v;
}

__device__ __forceinline__ float clamp448(float x) { return __builtin_amdgcn_fmed3f(x, -448.f, 448.f); }
__device__ __forceinline__ unsigned pk4_fp8(float a, float b, float c, float d) {
    int w = 0; w = __builtin_amdgcn_cvt_pk_fp8_f32(clamp448(a), clamp448(b), w, false); w = __builtin_amdgcn_cvt_pk_fp8_f32(clamp448(c), clamp448(d), w, true); return (unsigned)w;
}
__device__ __forceinline__ unsigned pk4_fp8_nc(float a, float b, float c, float d) {
    int w = 0; w = __builtin_amdgcn_cvt_pk_fp8_f32(a, b, w, false); w = __builtin_amdgcn_cvt_pk_fp8_f32(c, d, w, true); return (unsigned)w;
}
__device__ __forceinline__ f32x4 fma4(const f32x4 a, const float s, const f32x4 b) { f32x4 r; r.x = __builtin_fmaf(a.x, s, b.x); r.y = __builtin_fmaf(a.y, s, b.y); r.z = __builtin_fmaf(a.z, s, b.z); r.w = __builtin_fmaf(a.w, s, b.w); return r; }
__device__ __forceinline__ u32x2 bf8_to_fp8(const u32x4 w) { u32x2 o; o.x = pk4_fp8(bflo(w.x), bfhi(w.x), bflo(w.y), bfhi(w.y)); o.y = pk4_fp8(bflo(w.z), bfhi(w.z), bflo(w.w), bfhi(w.w)); return o; }
constexpr float W8_SCALE = 32.f, W8_INV = 1.f / 32.f;
__device__ __forceinline__ float sigmoidf_(float x) { return __builtin_amdgcn_rcpf(1.f + __builtin_amdgcn_exp2f(-1.4426950408889634f * x)); }
__device__ __forceinline__ float logsigmoidf_(float x) { return fminf(x, 0.f) - log1pf(__expf(-fabsf(x))); }

#define XB_TMO      128
#define XB_XCNT(j)  (256  + 64 * (j))
#define XB_XSUB(j)  (1280 + 64 * (j))
#define XB_XGEN(j)  (2304 + 64 * (j))
#define XB_TOP      3328
#define XB_TOPGEN   3392
#define XCD_BAR_WORDS 3456
#define XB_SPIN_CAP (1u << 22)

__device__ __forceinline__ unsigned xb_ld(unsigned* p)              { return __hip_atomic_load(p, __ATOMIC_RELAXED, __HIP_MEMORY_SCOPE_AGENT); }
__device__ __forceinline__ unsigned xb_add(unsigned* p, unsigned v) { return __hip_atomic_fetch_add(p, v, __ATOMIC_RELAXED, __HIP_MEMORY_SCOPE_AGENT); }
__device__ __forceinline__ unsigned xb_xcc_id() { return (unsigned)__builtin_amdgcn_s_getreg((3 << 11) | 20) & 0xFu; }
#define XB_SPIN(cond, bar) do { unsigned _sp = 0; while (cond) { __builtin_amdgcn_s_sleep(1); \
    if ((++_sp & 255u) == 0u) { if (xb_ld(&(bar)[XB_TMO])) break; if (_sp > XB_SPIN_CAP) { atomicAdd(&(bar)[XB_TMO], 1u); break; } } } } while (0)

struct XcdBarrier { unsigned* bar; unsigned x; volatile LAS unsigned* st; };

__device__ __forceinline__ XcdBarrier xcd_barrier_post(unsigned* bar, volatile LAS unsigned* st) {
    XcdBarrier b; b.bar = bar; b.x = xb_xcc_id(); b.st = st;
    if (threadIdx.x == 0) (void)xb_add(&bar[XB_XCNT(b.x)], 1u);
    return b;
}
__device__ __forceinline__ void xcd_barrier_complete(unsigned* bar, unsigned x, unsigned& nloc, unsigned& nx) {
    const unsigned G = gridDim.x * gridDim.y * gridDim.z;
    unsigned sum, cnt, mine, sp = 0u;
    for (;;) {
        sum = 0u; cnt = 0u; mine = 0u;
#pragma unroll
        for (unsigned j = 0; j < 16; ++j) { const unsigned c = xb_ld(&bar[XB_XCNT(j)]); sum += c; cnt += (c > 0u) ? 1u : 0u; mine = (j == x) ? c : mine; }
        if (sum == G) break;
        __builtin_amdgcn_s_sleep(1);
        if ((++sp & 255u) == 0u) { if (xb_ld(&bar[XB_TMO])) break; if (sp > XB_SPIN_CAP) { atomicAdd(&bar[XB_TMO], 1u); break; } }
    }
    nloc = mine > 0u ? mine : 1u; nx = cnt > 0u ? cnt : 1u;
}
__device__ __forceinline__ void xcd_barrier(const XcdBarrier& b) {
    asm volatile("s_waitcnt vmcnt(0)" ::: "memory");
    __syncthreads();
    if (threadIdx.x == 0) {
        unsigned* bar = b.bar;
        __builtin_amdgcn_s_waitcnt(0);
        unsigned nloc = b.st[0], nx = b.st[1];
        if (nloc == 0u) { xcd_barrier_complete(bar, b.x, nloc, nx); b.st[0] = nloc; b.st[1] = nx; }
        const unsigned old = xb_add(&bar[XB_XSUB(b.x)], 1u);
        const unsigned gen = old / nloc;
        if (old + 1u == (gen + 1u) * nloc) {
            __builtin_amdgcn_fence(__ATOMIC_RELEASE, "agent");
            asm volatile("s_waitcnt vmcnt(0)" ::: "memory");
            const unsigned og = xb_add(&bar[XB_TOP], 1u);
            const unsigned tg = og / nx;
            if (og + 1u == (tg + 1u) * nx) xb_add(&bar[XB_TOPGEN], 1u);
            else XB_SPIN(xb_ld(&bar[XB_TOPGEN]) == tg, bar);
            __builtin_amdgcn_fence(__ATOMIC_ACQUIRE, "agent");
            xb_add(&bar[XB_XGEN(b.x)], 1u);
            asm volatile("s_waitcnt vmcnt(0)" ::: "memory");
        } else {
            XB_SPIN(xb_ld(&bar[XB_XGEN(b.x)]) == gen, bar);
            __builtin_amdgcn_fence(__ATOMIC_ACQUIRE, "agent");
            asm volatile("s_waitcnt vmcnt(0)" ::: "memory");
        }
    }
    __syncthreads();
}

constexpr size_t al256(size_t x) { return (x + 255) & ~(size_t)255; }
constexpr size_t WS_CTL    = 0;
constexpr size_t CTL_BYTES = 65536;
constexpr size_t WS_MODS   = WS_CTL + CTL_BYTES;
constexpr size_t MODS_BYTES = al256((size_t)2 * 9 * 6144 * 4);
constexpr size_t WS_ZERO_BYTES = WS_MODS + MODS_BYTES;
constexpr size_t WS_GW     = WS_ZERO_BYTES;
constexpr size_t WS_CB     = WS_GW + (size_t)2 * 9 * 1024 * 32 * 4;
constexpr size_t WS_S5K    = al256(WS_CB + 2 * 9 * 32 * 4);
constexpr size_t WS_S5A64  = WS_S5K + (size_t)16 * 2 * 64 * 256 * 4;
constexpr size_t WS_WIN0T  = al256(WS_S5A64 + 2 * 16 * 64 * 2 * 4);
constexpr size_t WS_WOUT0T = WS_WIN0T + (size_t)3072 * 1024 * 2;
constexpr size_t WS_WIN1T  = WS_WOUT0T + (size_t)1024 * 1024 * 2;
constexpr size_t WS_WOUT1T = WS_WIN1T + (size_t)1536 * 1024 * 2;
constexpr size_t WS_WGLUT  = WS_WOUT1T + (size_t)1024 * 1024 * 2;
constexpr size_t WS_S5TE   = WS_WGLUT + (size_t)256 * 256 * 2;
constexpr size_t WS_S5F    = WS_S5TE + (size_t)16 * 1024 * 1280 * 2;
constexpr size_t WS_WGU    = WS_S5F + (size_t)16 * 256 * 1024 * 2;
constexpr size_t WS_WD     = WS_WGU + (size_t)32 * 2048 * 1024;
constexpr size_t WS_HCTX   = WS_WD + (size_t)32 * 1024 * 1024;
constexpr size_t WS_TOPE   = WS_HCTX + (size_t)NCTX * 1024 * 4;
constexpr size_t WS_TOPG   = WS_TOPE + (size_t)NTOK * 4 * 4;
constexpr size_t WS_RANK   = WS_TOPG + (size_t)NTOK * 4 * 4;
constexpr size_t WS_ROWTOK = WS_RANK + (size_t)NTOK * 4 * 4;
constexpr size_t WS_XN     = al256(WS_ROWTOK + (size_t)MAXRB * 256 * 4);
constexpr size_t WS_R      = WS_XN + (size_t)NTOK * 1024 * 2;
constexpr size_t WS_ACT8   = WS_XN + (size_t)NTOK * 1024;
constexpr size_t WS_OUT    = WS_ACT8 + (size_t)MAXRB * 256 * 1024;
constexpr size_t WS_MOE_END = WS_OUT + (size_t)MAXRB * 256 * 1024 * 2;
constexpr size_t PROJ512   = (size_t)NTOK * 512 * 2;
constexpr size_t R_QA = 0, R_KA = R_QA + PROJ512, R_VA = R_KA + PROJ512, R_OA = R_VA + PROJ512, R_QB = R_OA + PROJ512;
constexpr size_t R_KBR = R_QB + PROJ512;
constexpr size_t R_VBR = R_KBR + (size_t)NTOK * 128 * 2;
constexpr size_t R_G   = R_VBR + (size_t)NTOK * 128 * 2;
constexpr size_t R_KC0 = R_G + (size_t)NTOK * 32 * 4;
constexpr size_t R_VT0 = R_KC0 + (size_t)NB * 2 * NKEY * 64 * 2;
constexpr size_t R_CS  = R_VT0 + (size_t)NB * 2 * NKEY * 64 * 2;
constexpr size_t NSEQ_M = (size_t)NB * 8 * 2 * NCH;
constexpr size_t R_NS  = R_CS + NSEQ_M * 8192;
constexpr size_t R_ML  = R_NS + NSEQ_M * 256;
constexpr size_t R_BL  = R_ML + NSEQ_M * 4;
constexpr size_t R_MP  = R_BL + NSEQ_M * 4;
constexpr size_t R_BT  = R_MP + NSEQ_M * 4;
constexpr size_t R_PM  = R_BT + NSEQ_M * 256;
constexpr size_t R_GC  = R_PM + NSEQ_M * 256;
constexpr size_t R_L0_END = R_GC + NSEQ_M * 256;
constexpr size_t R_UX  = 0;
constexpr size_t R_Q1  = R_UX + (size_t)16 * 1280 * 1280 * 2;
constexpr size_t R_KV1 = R_Q1 + (size_t)NTOK * 768 * 2;
constexpr size_t R_KC1 = R_KV1 + (size_t)NTOK * 384 * 2;
constexpr size_t R_VT1 = R_KC1 + (size_t)NB * 3 * NKEY * 64 * 2;
constexpr size_t R_SLOC = R_VT1 + (size_t)NB * 3 * NKEY * 64 * 2;
constexpr size_t R_YG  = R_SLOC + (size_t)16 * 1280 * 256 * 4;
constexpr size_t R_Q8  = R_YG + (size_t)NLAT * 256 * 2;
constexpr size_t R_K8  = R_Q8 + (size_t)NLAT * 768;
constexpr size_t R_VT8 = R_K8 + (size_t)NB * 3 * NKEY * 64;
constexpr size_t R_L1_END = R_VT8 + (size_t)NB * 3 * NKEY * 64;
constexpr size_t R_BYTES = (R_L0_END > R_L1_END ? R_L0_END : R_L1_END);
constexpr size_t WS_END = (WS_R + R_BYTES > WS_MOE_END ? WS_R + R_BYTES : WS_MOE_END);

constexpr int CW_Q0 = 4096;
constexpr int CW_CNT = 8192;
constexpr int CW_TRIP = 8192 + 128;

struct Params {
    const float* in[44];
    float* out;
    unsigned char* ws;
    int ph_lo, ph_hi;
};

namespace pg8 {
constexpr int BM = 256, BK = 64, HALF = 128, HTB = HALF * BK * 2, NXCD = 8, WGM = 8;
__host__ __device__ __forceinline__ int lds_byte(int r, int c) { const int st = (r >> 4) * 2 + (c >> 5), rr = r & 15, cc = c & 31, ob = rr * 64 + cc * 2; return st * 1024 + (ob ^ (((ob >> 9) & 1) << 5)); }
__host__ __device__ __forceinline__ void stage_rc(int b, int& R, int& C) { const int st = b / 1024, sb = b % 1024, swz = sb ^ (((sb >> 9) & 1) << 5); R = (st >> 1) * 16 + swz / 64; C = (st & 1) * 32 + (swz % 64) / 2; }
__host__ __device__ __forceinline__ int perm32(int rho) { const int n = rho >> 4, i = rho & 15; return 8 * (i >> 2) + 4 * n + (i & 3); }

struct Unit { int pm, pn, g; };

__device__ __forceinline__ unsigned cvt_pk_bf16(float lo, float hi) { unsigned r; asm volatile("v_cvt_pk_bf16_f32 %0, %1, %2" : "=v"(r) : "v"(lo), "v"(hi)); return r; }

template <class Epi, class Sched>
__device__ __forceinline__ void gemm_phase(LAS unsigned char* lds, const Sched& S, const Epi& E, int K) {
    asm volatile("" : "+s"(K));
    const int tid = threadIdx.x, wid = __builtin_amdgcn_readfirstlane(tid >> 6), lane = tid & 63, wr = wid >> 2, wc = wid & 3, fr = lane & 15, fq = lane >> 4;
    const int nt = K / BK;
    int Rr[2], Cc[2]; unsigned voffB[2];
#pragma unroll
    for (int i = 0; i < 2; ++i) { int R, C; stage_rc(tid * 16 + i * 8192, R, C); const int Rb = Epi::PERM ? ((R & ~31) + perm32(R & 31)) : R;
        Rr[i] = R; Cc[i] = C; voffB[i] = (unsigned)Rb * (unsigned)S.ldb_bytes + (unsigned)C * 2u; }
    const size_t kstep = (size_t)(BK * 2);
    const size_t hstepB = (size_t)HALF * S.ldb_bytes;
    const unsigned ldsw = (unsigned)wid * 1024u;
    const int aoff = lds_byte(wr * 64 + fr, fq * 8), boff = lds_byte(wc * 32 + fr, fq * 8);
#define PG8_SA(b, h) (((b) * 2 + (h)) * HTB)
#define PG8_SB(b, h) ((4 + (b) * 2 + (h)) * HTB)
#define PG8_STAGE_B(bufoff, gbase) do { _Pragma("unroll") for (int _i = 0; _i < 2; ++_i) \
        __builtin_amdgcn_global_load_lds((const unsigned*)((const char*)(gbase) + voffB[_i]), (LAS unsigned*)(lds + (bufoff) + ldsw + _i * 8192), 16, 0, 0); } while (0)
#define PG8_STAGE_A(bufoff, gbase, o0, o1) do { \
        __builtin_amdgcn_global_load_lds((const unsigned*)((const char*)(gbase) + (o0)), (LAS unsigned*)(lds + (bufoff) + ldsw), 16, 0, 0); \
        __builtin_amdgcn_global_load_lds((const unsigned*)((const char*)(gbase) + (o1)), (LAS unsigned*)(lds + (bufoff) + ldsw + 8192), 16, 0, 0); } while (0)
#define PG8_LDA(dst, b, h) do { _Pragma("unroll") for (int m = 0; m < 4; ++m) _Pragma("unroll") for (int k = 0; k < 2; ++k) dst[m][k] = *(const LAS bf16x8*)(lds + PG8_SA(b, h) + aoff + m * 2048 + k * 1024); } while (0)
#define PG8_LDB(dst, b, h) do { _Pragma("unroll") for (int n = 0; n < 2; ++n) _Pragma("unroll") for (int k = 0; k < 2; ++k) dst[n][k] = *(const LAS bf16x8*)(lds + PG8_SB(b, h) + boff + n * 2048 + k * 1024); } while (0)
#define PG8_MMA(ai, bj, At, Bt) do { __builtin_amdgcn_s_setprio(1); _Pragma("unroll") for (int m = 0; m < 4; ++m) _Pragma("unroll") for (int n = 0; n < 2; ++n) _Pragma("unroll") for (int k = 0; k < 2; ++k) \
        acc[ai][bj][m][n] = __builtin_amdgcn_mfma_f32_16x16x32_bf16(Bt[n][k], At[m][k], acc[ai][bj][m][n], 0, 0, 0); __builtin_amdgcn_s_setprio(0); } while (0)
#define PG8_WAIT_V(n) asm volatile("s_waitcnt vmcnt(" #n ")" ::: "memory")
#define PG8_WAIT_L(n) asm volatile("s_waitcnt lgkmcnt(" #n ")" ::: "memory")
#define PG8_BAR __builtin_amdgcn_s_barrier()
#define PG8_SCHED __builtin_amdgcn_sched_barrier(0)
    Unit cur, nxt; int ui = 0;
    if (!S.next(0, cur)) return;
    f32x4 acc[2][2][4][2];
#pragma unroll
    for (int a = 0; a < 2; ++a)
#pragma unroll
        for (int b = 0; b < 2; ++b)
#pragma unroll
            for (int m = 0; m < 4; ++m)
#pragma unroll
                for (int n = 0; n < 2; ++n) acc[a][b][m][n] = (f32x4){0.f, 0.f, 0.f, 0.f};
    bf16x8 At[4][2], B0[2][2], B1[2][2];
    const char* cA = S.a_base(cur); const char* cB = S.b_base(cur);
    unsigned c00 = S.a_off(cur, Rr[0]) + Cc[0] * 2u, c01 = S.a_off(cur, Rr[1]) + Cc[1] * 2u, c10 = S.a_off(cur, HALF + Rr[0]) + Cc[0] * 2u, c11 = S.a_off(cur, HALF + Rr[1]) + Cc[1] * 2u;
    PG8_STAGE_B(PG8_SB(0, 0), cB); PG8_STAGE_B(PG8_SB(0, 1), cB + hstepB); PG8_STAGE_A(PG8_SA(0, 0), cA, c00, c01); PG8_STAGE_A(PG8_SA(0, 1), cA, c10, c11);
    if (wr == 1) PG8_BAR;
    PG8_WAIT_V(2); PG8_BAR;
    PG8_STAGE_B(PG8_SB(1, 0), cB + kstep); PG8_STAGE_A(PG8_SA(1, 0), cA + kstep, c00, c01); PG8_STAGE_B(PG8_SB(1, 1), cB + hstepB + kstep);
    PG8_WAIT_V(6); PG8_BAR;
    for (;;) {
        const bool has_next = S.next(ui + 1, nxt);
        const char* nA = has_next ? S.a_base(nxt) : cA; const char* nB = has_next ? S.b_base(nxt) : cB;
        unsigned n00 = c00, n01 = c01, n10 = c10, n11 = c11;
        if (has_next) { n00 = S.a_off(nxt, Rr[0]) + Cc[0] * 2u; n01 = S.a_off(nxt, Rr[1]) + Cc[1] * 2u; n10 = S.a_off(nxt, HALF + Rr[0]) + Cc[0] * 2u; n11 = S.a_off(nxt, HALF + Rr[1]) + Cc[1] * 2u; }
        for (int t = 0; t < nt; t += 2) {
            const bool last = (t == nt - 2);
            const char* a1 = cA + (size_t)(t + 1) * kstep;
            const char* a2 = last ? nA : cA + (size_t)(t + 2) * kstep; const char* b2 = last ? nB : cB + (size_t)(t + 2) * kstep;
            const char* a3 = a2 + kstep; const char* b3 = b2 + kstep;
            const unsigned x00 = last ? n00 : c00, x01 = last ? n01 : c01, x10 = last ? n10 : c10, x11 = last ? n11 : c11;
            PG8_LDB(B0, 0, 0); PG8_LDB(B1, 0, 1); PG8_SCHED; PG8_LDA(At, 0, 0); PG8_STAGE_A(PG8_SA(1, 1), a1, c10, c11);
            PG8_WAIT_V(8); PG8_WAIT_L(0); PG8_BAR; PG8_MMA(0, 0, At, B0); PG8_MMA(0, 1, At, B1); PG8_BAR; PG8_SCHED;
            PG8_LDA(At, 0, 1); PG8_STAGE_B(PG8_SB(0, 0), b2); PG8_STAGE_B(PG8_SB(0, 1), b2 + hstepB); PG8_STAGE_A(PG8_SA(0, 0), a2, x00, x01);
            PG8_WAIT_V(8); PG8_WAIT_L(0); PG8_BAR; PG8_MMA(1, 0, At, B0); PG8_MMA(1, 1, At, B1); PG8_BAR; PG8_SCHED;
            PG8_LDB(B0, 1, 0); PG8_LDB(B1, 1, 1); PG8_SCHED; PG8_LDA(At, 1, 0); PG8_STAGE_A(PG8_SA(0, 1), a2, x10, x11);
            PG8_WAIT_V(8); PG8_WAIT_L(0); PG8_BAR; PG8_MMA(0, 0, At, B0); PG8_MMA(0, 1, At, B1); PG8_BAR; PG8_SCHED;
            PG8_LDA(At, 1, 1); PG8_STAGE_B(PG8_SB(1, 0), b3); PG8_STAGE_B(PG8_SB(1, 1), b3 + hstepB); PG8_STAGE_A(PG8_SA(1, 0), a3, x00, x01);
            PG8_WAIT_V(8); PG8_WAIT_L(0); PG8_BAR; PG8_MMA(1, 0, At, B0); PG8_MMA(1, 1, At, B1); PG8_BAR; PG8_SCHED;
        }
        if (wr == 0) PG8_BAR;
        E(acc, cur, wr, wc, fr, fq);
        if (!has_next) break;
#pragma unroll
        for (int a = 0; a < 2; ++a)
#pragma unroll
            for (int b = 0; b < 2; ++b)
#pragma unroll
                for (int m = 0; m < 4; ++m)
#pragma unroll
                    for (int n = 0; n < 2; ++n) acc[a][b][m][n] = (f32x4){0.f, 0.f, 0.f, 0.f};
        cur = nxt; cA = nA; cB = nB; c00 = n00; c01 = n01; c10 = n10; c11 = n11; ++ui;
        if (wr == 1) PG8_BAR;
    }
    PG8_WAIT_V(0);
    PG8_BAR;
#undef PG8_SA
#undef PG8_SB
#undef PG8_STAGE_A
#undef PG8_STAGE_B
#undef PG8_LDA
#undef PG8_LDB
#undef PG8_MMA
#undef PG8_WAIT_V
#undef PG8_WAIT_L
#undef PG8_BAR
#undef PG8_SCHED
}

template <class Epi, class Sched>
__device__ __forceinline__ void gemm_phase8(LAS unsigned char* lds, const Sched& S, const Epi& E, int K) {
    asm volatile("" : "+s"(K));
    const int tid = threadIdx.x, wid = __builtin_amdgcn_readfirstlane(tid >> 6), lane = tid & 63, wr = wid >> 2, wc = wid & 3, fr = lane & 15, fq = lane >> 4;
    const int nt = K / BK;
    int Rr[2], Cc[2]; unsigned voffB[2];
#pragma unroll
    for (int i = 0; i < 2; ++i) { int R, C; stage_rc(tid * 16 + i * 8192, R, C); const int Rb = Epi::PERM ? ((R & ~31) + perm32(R & 31)) : R;
        Rr[i] = R; Cc[i] = C; voffB[i] = (unsigned)Rb * (unsigned)S.ldb_bytes + (unsigned)C * 2u; }
    const size_t kstep = (size_t)(BK * 2);
    const size_t hstepB = (size_t)HALF * S.ldb_bytes;
    const unsigned ldsw = (unsigned)wid * 1024u;
    const int sl0 = 2 * fq + (fq >> 1), sl1 = 2 * fq + (1 ^ (fq >> 1));
    const int aoff0 = lds_byte(wr * 64 + fr, sl0 * 8), aoff1 = lds_byte(wr * 64 + fr, sl1 * 8), boff0 = lds_byte(wc * 32 + fr, sl0 * 8), boff1 = lds_byte(wc * 32 + fr, sl1 * 8);
#define PG8_SA(b, h) (((b) * 2 + (h)) * HTB)
#define PG8_SB(b, h) ((4 + (b) * 2 + (h)) * HTB)
#define PG8_STAGE_B(bufoff, gbase) do { _Pragma("unroll") for (int _i = 0; _i < 2; ++_i) \
        __builtin_amdgcn_global_load_lds((const unsigned*)((const char*)(gbase) + voffB[_i]), (LAS unsigned*)(lds + (bufoff) + ldsw + _i * 8192), 16, 0, 0); } while (0)
#define PG8_STAGE_A(bufoff, gbase, o0, o1) do { \
        __builtin_amdgcn_global_load_lds((const unsigned*)((const char*)(gbase) + (o0)), (LAS unsigned*)(lds + (bufoff) + ldsw), 16, 0, 0); \
        __builtin_amdgcn_global_load_lds((const unsigned*)((const char*)(gbase) + (o1)), (LAS unsigned*)(lds + (bufoff) + ldsw + 8192), 16, 0, 0); } while (0)
#define PG8_LDA(dst, b, h) do { _Pragma("unroll") for (int m = 0; m < 4; ++m) { const u32x4 p0_ = *(const LAS u32x4*)(lds + PG8_SA(b, h) + aoff0 + m * 2048), p1_ = *(const LAS u32x4*)(lds + PG8_SA(b, h) + aoff1 + m * 2048); \
        dst[m] = __builtin_bit_cast(i32x8, __builtin_shufflevector(p0_, p1_, 0, 1, 2, 3, 4, 5, 6, 7)); } } while (0)
#define PG8_LDB(dst, b, h) do { _Pragma("unroll") for (int n = 0; n < 2; ++n) { const u32x4 p0_ = *(const LAS u32x4*)(lds + PG8_SB(b, h) + boff0 + n * 2048), p1_ = *(const LAS u32x4*)(lds + PG8_SB(b, h) + boff1 + n * 2048); \
        dst[n] = __builtin_bit_cast(i32x8, __builtin_shufflevector(p0_, p1_, 0, 1, 2, 3, 4, 5, 6, 7)); } } while (0)
#define PG8_MMA(ai, bj, At, Bt) do { __builtin_amdgcn_s_setprio(1); _Pragma("unroll") for (int m = 0; m < 4; ++m) _Pragma("unroll") for (int n = 0; n < 2; ++n) \
        asm volatile("v_mfma_scale_f32_16x16x128_f8f6f4 %0, %1, %2, %0, %3, %3 op_sel_hi:[0,0,0]" : "+v"(acc[ai][bj][m][n]) : "v"(Bt[n]), "v"(At[m]), "v"(sc8)); __builtin_amdgcn_s_setprio(0); } while (0)
#define PG8_WAIT_V(n) asm volatile("s_waitcnt vmcnt(" #n ")" ::: "memory")
#define PG8_WAIT_L(n) asm volatile("s_waitcnt lgkmcnt(" #n ")" ::: "memory")
#define PG8_BAR __builtin_amdgcn_s_barrier()
#define PG8_SCHED __builtin_amdgcn_sched_barrier(0)
    Unit cur, nxt; int ui = 0;
    if (!S.next(0, cur)) return;
    f32x4 acc[2][2][4][2];
#pragma unroll
    for (int a = 0; a < 2; ++a)
#pragma unroll
        for (int b = 0; b < 2; ++b)
#pragma unroll
            for (int m = 0; m < 4; ++m)
#pragma unroll
                for (int n = 0; n < 2; ++n) acc[a][b][m][n] = (f32x4){0.f, 0.f, 0.f, 0.f};
    i32x8 At[4], B0[2], B1[2]; const int sc8 = 0x7F7F7F7F;

    const char* cA = S.a_base(cur); const char* cB = S.b_base(cur);
    unsigned c00 = S.a_off(cur, Rr[0]) + Cc[0] * 2u, c01 = S.a_off(cur, Rr[1]) + Cc[1] * 2u, c10 = S.a_off(cur, HALF + Rr[0]) + Cc[0] * 2u, c11 = S.a_off(cur, HALF + Rr[1]) + Cc[1] * 2u;
    PG8_STAGE_B(PG8_SB(0, 0), cB); PG8_STAGE_B(PG8_SB(0, 1), cB + hstepB); PG8_STAGE_A(PG8_SA(0, 0), cA, c00, c01); PG8_STAGE_A(PG8_SA(0, 1), cA, c10, c11);
    if (wr == 1) PG8_BAR;
    PG8_WAIT_V(2); PG8_BAR;
    PG8_STAGE_B(PG8_SB(1, 0), cB + kstep); PG8_STAGE_A(PG8_SA(1, 0), cA + kstep, c00, c01); PG8_STAGE_B(PG8_SB(1, 1), cB + hstepB + kstep);
    PG8_WAIT_V(6); PG8_BAR;
    for (;;) {
        const bool has_next = S.next(ui + 1, nxt);
        const char* nA = has_next ? S.a_base(nxt) : cA; const char* nB = has_next ? S.b_base(nxt) : cB;
        unsigned n00 = c00, n01 = c01, n10 = c10, n11 = c11;
        if (has_next) { n00 = S.a_off(nxt, Rr[0]) + Cc[0] * 2u; n01 = S.a_off(nxt, Rr[1]) + Cc[1] * 2u; n10 = S.a_off(nxt, HALF + Rr[0]) + Cc[0] * 2u; n11 = S.a_off(nxt, HALF + Rr[1]) + Cc[1] * 2u; }
        for (int t = 0; t < nt; t += 2) {
            const bool last = (t == nt - 2);
            const char* a1 = cA + (size_t)(t + 1) * kstep;
            const char* a2 = last ? nA : cA + (size_t)(t + 2) * kstep; const char* b2 = last ? nB : cB + (size_t)(t + 2) * kstep;
            const char* a3 = a2 + kstep; const char* b3 = b2 + kstep;
            const unsigned x00 = last ? n00 : c00, x01 = last ? n01 : c01, x10 = last ? n10 : c10, x11 = last ? n11 : c11;
            PG8_LDB(B0, 0, 0); PG8_LDB(B1, 0, 1); PG8_SCHED; PG8_LDA(At, 0, 0); PG8_STAGE_A(PG8_SA(1, 1), a1, c10, c11);
            PG8_WAIT_V(8); PG8_WAIT_L(0); PG8_BAR; PG8_MMA(0, 0, At, B0); PG8_MMA(0, 1, At, B1); PG8_BAR; PG8_SCHED;
            PG8_LDA(At, 0, 1); PG8_STAGE_B(PG8_SB(0, 0), b2); PG8_STAGE_B(PG8_SB(0, 1), b2 + hstepB); PG8_STAGE_A(PG8_SA(0, 0), a2, x00, x01);
            PG8_WAIT_V(8); PG8_WAIT_L(0); PG8_BAR; PG8_MMA(1, 0, At, B0); PG8_MMA(1, 1, At, B1); PG8_BAR; PG8_SCHED;
            PG8_LDB(B0, 1, 0); PG8_LDB(B1, 1, 1); PG8_SCHED; PG8_LDA(At, 1, 0); PG8_STAGE_A(PG8_SA(0, 1), a2, x10, x11);
            PG8_WAIT_V(8); PG8_WAIT_L(0); PG8_BAR; PG8_MMA(0, 0, At, B0); PG8_MMA(0, 1, At, B1); PG8_BAR; PG8_SCHED;
            PG8_LDA(At, 1, 1); PG8_STAGE_B(PG8_SB(1, 0), b3); PG8_STAGE_B(PG8_SB(1, 1), b3 + hstepB); PG8_STAGE_A(PG8_SA(1, 0), a3, x00, x01);
            PG8_WAIT_V(8); PG8_WAIT_L(0); PG8_BAR; PG8_MMA(1, 0, At, B0); PG8_MMA(1, 1, At, B1); PG8_BAR; PG8_SCHED;
        }
        asm volatile("s_nop 15\n\ts_nop 15" : "+v"(acc[1][1][0][0]), "+v"(acc[1][1][0][1]), "+v"(acc[1][1][1][0]), "+v"(acc[1][1][1][1]), "+v"(acc[1][1][2][0]), "+v"(acc[1][1][2][1]), "+v"(acc[1][1][3][0]), "+v"(acc[1][1][3][1]) :: "memory");
        if (wr == 0) PG8_BAR;
        E(acc, cur, wr, wc, fr, fq);
        if (!has_next) break;
#pragma unroll
        for (int a = 0; a < 2; ++a)
#pragma unroll
            for (int b = 0; b < 2; ++b)
#pragma unroll
                for (int m = 0; m < 4; ++m)
#pragma unroll
                    for (int n = 0; n < 2; ++n) acc[a][b][m][n] = (f32x4){0.f, 0.f, 0.f, 0.f};
        cur = nxt; cA = nA; cB = nB; c00 = n00; c01 = n01; c10 = n10; c11 = n11; ++ui;
        if (wr == 1) PG8_BAR;
    }
    PG8_WAIT_V(0);
    PG8_BAR;
#undef PG8_SA
#undef PG8_SB
#undef PG8_STAGE_A
#undef PG8_STAGE_B
#undef PG8_LDA
#undef PG8_LDB
#undef PG8_MMA
#undef PG8_WAIT_V
#undef PG8_WAIT_L
#undef PG8_BAR
#undef PG8_SCHED
}

struct GridOrder {
    int nM, nN, nG, G, c;
    __device__ __forceinline__ void init(int nM_, int nN_, int nG_) { nM = nM_; nN = nN_; nG = nG_; G = gridDim.x; c = blockIdx.x; }
    __device__ __forceinline__ bool next_mn(int i, Unit& u) const {
        const long L = (long)i * G + c; const int per = nM * nN; if (L >= (long)per * nG) return false;
        u.g = (int)(L / per); int wgid = (int)(L % per);
        if (nG == 1) { const int q = per / NXCD, r = per % NXCD, xcd = wgid % NXCD, off = wgid / NXCD; wgid = (xcd < r ? xcd * (q + 1) : r * (q + 1) + (xcd - r) * q) + off; }
        const int nig = WGM * nN, gid = wgid / nig, fm = gid * WGM, gsz = (nM - fm) < WGM ? (nM - fm) : WGM;
        u.pm = fm + ((wgid % nig) % gsz); u.pn = (wgid % nig) / gsz; return true;
    }
};
}
using pg8::Unit;

struct Frame { const Params* p; unsigned char* ws; LAS unsigned char* lds; int tid, lane, wid; };
#define WSP(T, off) ((T*)(ws + (off)))

__device__ __forceinline__ void phase_mods(const Params& P, unsigned char* ws, LAS unsigned char* lds) {
    const int tid = threadIdx.x;
    LAS float* sil = (LAS float*)lds;
    LAS float* part = sil + 9 * 1024;
    float* mods = WSP(float, WS_MODS);
    __syncthreads();
    for (int i = tid; i < 9 * 1024; i += NTHREADS) { const int r = i >> 10, k = i & 1023; const float v = r < 8 ? P.in[1][r * 1024 + k] : P.in[3][k]; sil[i] = v / (1.f + __expf(-v)); }
    __syncthreads();
    for (int u = blockIdx.x; u < 192; u += gridDim.x) {
        const int layer = u / 96, cb = u % 96;
        const float* W = P.in[layer ? 19 : 4]; const float* bm = P.in[layer ? 20 : 5];
        const int cl = tid & 63, kq = tid >> 6, col = cb * 64 + cl;
        float a0 = 0, a1 = 0, a2 = 0, a3 = 0, a4 = 0, a5 = 0, a6 = 0, a7 = 0, a8 = 0;
#pragma unroll 16
        for (int kk = 0; kk < 128; ++kk) { const int k = kq * 128 + kk;
            const float w = W[(size_t)k * 6144 + col];
            a0 += sil[0 * 1024 + k] * w; a1 += sil[1 * 1024 + k] * w; a2 += sil[2 * 1024 + k] * w; a3 += sil[3 * 1024 + k] * w; a4 += sil[4 * 1024 + k] * w;
            a5 += sil[5 * 1024 + k] * w; a6 += sil[6 * 1024 + k] * w; a7 += sil[7 * 1024 + k] * w; a8 += sil[8 * 1024 + k] * w; }
        __syncthreads();
        LAS float* pp = part + kq * 9 * 64 + cl;
        pp[0 * 64] = a0; pp[1 * 64] = a1; pp[2 * 64] = a2; pp[3 * 64] = a3; pp[4 * 64] = a4; pp[5 * 64] = a5; pp[6 * 64] = a6; pp[7 * 64] = a7; pp[8 * 64] = a8;
        __syncthreads();
        for (int i = tid; i < 9 * 64; i += NTHREADS) { const int r = i >> 6, c = i & 63;
            mods[((size_t)layer * 9 + r) * 6144 + cb * 64 + c] = (((part[0 * 576 + i] + part[1 * 576 + i]) + (part[2 * 576 + i] + part[3 * 576 + i])) + ((part[4 * 576 + i] + part[5 * 576 + i]) + (part[6 * 576 + i] + part[7 * 576 + i]))) + bm[cb * 64 + c]; }
    }
    __syncthreads();
}

__device__ __forceinline__ int cmap_col(int kind, int n, int nsrc) {
    if (kind == 1) {
        if (n < 2048) return n;
        if (n < 2816) return n + 32;
        if (n < 2848) return n - 2816 + 2048;
        return -1;
    }
    return n < nsrc ? n : -1;
}
__device__ __forceinline__ void convert_tile(const float* src, int nsrc, int K, bf16_t* dst, int kind, int tn, int tk, LAS float* tile  , int tid) {
    const int n0 = tn * 64, k0 = tk * 64;
    __syncthreads();
    {
        const int tx = tid & 15, ty = tid >> 4;
        const int n = n0 + tx * 4; const int sc = cmap_col(kind, n, nsrc);
#pragma unroll
        for (int i = 0; i < 2; ++i) { const int k = ty + 32 * i; f32x4 v = (f32x4){0.f, 0.f, 0.f, 0.f};
            if (sc >= 0) v = *(const f32x4*)(src + (size_t)(k0 + k) * nsrc + sc);
            tile[k * 65 + tx * 4 + 0] = v[0]; tile[k * 65 + tx * 4 + 1] = v[1]; tile[k * 65 + tx * 4 + 2] = v[2]; tile[k * 65 + tx * 4 + 3] = v[3]; }
    }
    __syncthreads();
    {
        const int kk = tid & 7, nn = tid >> 3;
        u32x4 w;
        w.x = pk2(tile[(kk * 8 + 0) * 65 + nn], tile[(kk * 8 + 1) * 65 + nn]); w.y = pk2(tile[(kk * 8 + 2) * 65 + nn], tile[(kk * 8 + 3) * 65 + nn]);
        w.z = pk2(tile[(kk * 8 + 4) * 65 + nn], tile[(kk * 8 + 5) * 65 + nn]); w.w = pk2(tile[(kk * 8 + 6) * 65 + nn], tile[(kk * 8 + 7) * 65 + nn]);
        *(u32x4*)(dst + (size_t)(n0 + nn) * K + k0 + kk * 8) = w;
    }
}
__device__ __forceinline__ void convert_tile8(const float* src, int nsrc, int K, unsigned char* dst, int tn, int tk, LAS float* tile  , int tid, int kind = 0) {
    const int n0 = tn * 64, k0 = tk * 64;
    __syncthreads();
    {   const int tx = tid & 15, ty = tid >> 4; const int sc = cmap_col(kind, n0 + tx * 4, nsrc);
#pragma unroll
        for (int i = 0; i < 2; ++i) { const int k = ty + 32 * i; f32x4 v = (f32x4){0.f, 0.f, 0.f, 0.f}; if (sc >= 0) v = *(const f32x4*)(src + (size_t)(k0 + k) * nsrc + sc);
            tile[k * 65 + tx * 4 + 0] = v[0]; tile[k * 65 + tx * 4 + 1] = v[1]; tile[k * 65 + tx * 4 + 2] = v[2]; tile[k * 65 + tx * 4 + 3] = v[3]; }
    }
    __syncthreads();
    {   const int kk = tid & 7, nn = tid >> 3; u32x2 w;
        w.x = pk4_fp8(tile[(kk * 8 + 0) * 65 + nn] * W8_SCALE, tile[(kk * 8 + 1) * 65 + nn] * W8_SCALE, tile[(kk * 8 + 2) * 65 + nn] * W8_SCALE, tile[(kk * 8 + 3) * 65 + nn] * W8_SCALE);
        w.y = pk4_fp8(tile[(kk * 8 + 4) * 65 + nn] * W8_SCALE, tile[(kk * 8 + 5) * 65 + nn] * W8_SCALE, tile[(kk * 8 + 6) * 65 + nn] * W8_SCALE, tile[(kk * 8 + 7) * 65 + nn] * W8_SCALE);
        *(u32x2*)(dst + (size_t)(n0 + nn) * K + k0 + kk * 8) = w;
    }
}
__device__ __forceinline__ void phase_convert_moe8(const Params& P, unsigned char* ws, LAS unsigned char* lds, int layer, bool skew = false) {
    LAS float* tile = (LAS float*)lds; const int tid = threadIdx.x;
    const float* wgu = P.in[layer ? 39 : 15]; const float* wd = P.in[layer ? 41 : 17];
    constexpr int IG = 32 * 32 * 4, ID = 32 * 16 * 4;
    const int tx = tid & 15, ty = tid >> 4;
    f32x4 v[8];
#define CV_DECODE(IT, SRC, NSRC, DST, TN, KB) do { if ((IT) < IG) { const int e_ = (IT) >> 7, r_ = (IT) & 127; SRC = wgu + (size_t)e_ * 1024 * 2048; NSRC = 2048; DST = ws + WS_WGU + (size_t)e_ * 2048 * 1024; TN = r_ >> 2; KB = r_ & 3; } \
        else { const int i2_ = (IT) - IG, e_ = i2_ >> 6, r_ = i2_ & 63; SRC = wd + (size_t)e_ * 1024 * 1024; NSRC = 1024; DST = ws + WS_WD + (size_t)e_ * 1024 * 1024; TN = r_ >> 2; KB = r_ & 3; } } while (0)
#define CV_LOAD(IT) do { const float* s_; int ns_, tn_, kb_; unsigned char* d_; CV_DECODE(IT, s_, ns_, d_, tn_, kb_); (void)d_; \
        _Pragma("unroll") for (int i = 0; i < 8; ++i) v[i] = *(const f32x4*)(s_ + (size_t)(kb_ * 256 + ty + 32 * i) * ns_ + tn_ * 64 + tx * 4); } while (0)
    const bool sk = skew && gridDim.x == 256, two = sk && blockIdx.x >= 192;
    const int stepA = sk ? (two ? 64 : 320) : (int)gridDim.x, stepB = sk ? (two ? 256 : 320) : (int)gridDim.x;
    int it = blockIdx.x, tog = 0;
    if (it < IG + ID) CV_LOAD(it);
    for (; it < IG + ID; it += (tog ? stepB : stepA), tog ^= 1) {
        const float* src; int nsrc, tn, kb; unsigned char* dst; CV_DECODE(it, src, nsrc, dst, tn, kb); (void)src; (void)nsrc;
        __syncthreads();
#pragma unroll
        for (int i = 0; i < 8; ++i) { const int k = ty + 32 * i, sk = 4 * i;
#pragma unroll
            for (int q = 0; q < 4; ++q) tile[k * 65 + ((tx * 4 + q + sk) & 63)] = v[i][q]; }
        __syncthreads();
        { const int itn = it + (tog ? stepB : stepA); if (itn < IG + ID) CV_LOAD(itn); }
        {   const int kq = tid & 7, nn = tid >> 3, col = (nn + 4 * kq) & 63; unsigned w[8];
#pragma unroll
            for (int j = 0; j < 8; ++j) { const int kk = kq * 32 + j * 4;
                w[j] = pk4_fp8(tile[(kk + 0) * 65 + col] * W8_SCALE, tile[(kk + 1) * 65 + col] * W8_SCALE, tile[(kk + 2) * 65 + col] * W8_SCALE, tile[(kk + 3) * 65 + col] * W8_SCALE); }
            unsigned char* o = dst + (size_t)(tn * 64 + nn) * 1024 + kb * 256 + kq * 32;
            *(u32x4*)o = (u32x4){w[0], w[1], w[2], w[3]}; *(u32x4*)(o + 16) = (u32x4){w[4], w[5], w[6], w[7]};
        }
    }
#undef CV_LOAD
#undef CV_DECODE
    __syncthreads();
}
struct CsJob { const float* src; int nsrc, K, kind, tn, tk, fp8; unsigned char* dst; };
__device__ __forceinline__ CsJob cs_job(const Params& P, unsigned char* ws, int t) {
    const int T0 = 48 * 16, T1 = T0 + 256, T2 = T1 + 24 * 16, T3 = T2 + 256; CsJob j;
    if (t < T0)      { j.src = P.in[8];  j.nsrc = 2848; j.K = 1024; j.kind = 1; j.tn = t / 16; j.tk = t % 16; j.fp8 = 0; j.dst = ws + WS_WIN0T; }
    else if (t < T1) { j.src = P.in[9];  j.nsrc = 1024; j.K = 1024; j.kind = 0; j.tn = (t - T0) / 16; j.tk = (t - T0) % 16; j.fp8 = 1; j.dst = ws + WS_WOUT0T; }
    else if (t < T2) { j.src = P.in[23]; j.nsrc = 1408; j.K = 1024; j.kind = 2; j.tn = (t - T1) / 16; j.tk = (t - T1) % 16; j.fp8 = 1; j.dst = ws + WS_WIN1T; }
    else if (t < T3) { j.src = P.in[24]; j.nsrc = 1024; j.K = 1024; j.kind = 0; j.tn = (t - T2) / 16; j.tk = (t - T2) % 16; j.fp8 = 0; j.dst = ws + WS_WOUT1T; }
    else             { j.src = P.in[33]; j.nsrc = 256;  j.K = 256;  j.kind = 0; j.tn = (t - T3) / 4;  j.tk = (t - T3) % 4;  j.fp8 = 0; j.dst = ws + WS_WGLUT; }
    return j;
}
__device__ __forceinline__ void cs_load(const CsJob& j, int tid, f32x4& v0, f32x4& v1) {
    const int tx = tid & 15, ty = tid >> 4; const int sc = cmap_col(j.kind, j.tn * 64 + tx * 4, j.nsrc);
    v0 = (f32x4){0.f, 0.f, 0.f, 0.f}; v1 = v0;
    if (sc >= 0) { v0 = *(const f32x4*)(j.src + (size_t)(j.tk * 64 + ty) * j.nsrc + sc); v1 = *(const f32x4*)(j.src + (size_t)(j.tk * 64 + ty + 32) * j.nsrc + sc); }
}
__device__ __forceinline__ void phase_convert_small(const Params& P, unsigned char* ws, LAS unsigned char* lds) {
    LAS float* tile = (LAS float*)lds; const int tid = threadIdx.x;
    const int T4 = 48 * 16 + 256 + 24 * 16 + 256 + 16;
    int t = blockIdx.x; if (t >= T4) { __syncthreads(); return; }
    CsJob job = cs_job(P, ws, t); f32x4 v0, v1; cs_load(job, tid, v0, v1);
    for (; t < T4; t += gridDim.x) {
        const int tnx = t + gridDim.x; CsJob jn = job; f32x4 n0 = v0, n1 = v1;
        if (tnx < T4) { jn = cs_job(P, ws, tnx); cs_load(jn, tid, n0, n1); }
        __syncthreads();
        {   const int tx = tid & 15, ty = tid >> 4;
            tile[ty * 65 + tx * 4 + 0] = v0[0]; tile[ty * 65 + tx * 4 + 1] = v0[1]; tile[ty * 65 + tx * 4 + 2] = v0[2]; tile[ty * 65 + tx * 4 + 3] = v0[3];
            tile[(ty + 32) * 65 + tx * 4 + 0] = v1[0]; tile[(ty + 32) * 65 + tx * 4 + 1] = v1[1]; tile[(ty + 32) * 65 + tx * 4 + 2] = v1[2]; tile[(ty + 32) * 65 + tx * 4 + 3] = v1[3]; }
        __syncthreads();
        {   const int kk = tid & 7, nn = tid >> 3; const int n0_ = job.tn * 64, k0_ = job.tk * 64;
            if (job.fp8) { u32x2 w;
                w.x = pk4_fp8(tile[(kk * 8 + 0) * 65 + nn] * W8_SCALE, tile[(kk * 8 + 1) * 65 + nn] * W8_SCALE, tile[(kk * 8 + 2) * 65 + nn] * W8_SCALE, tile[(kk * 8 + 3) * 65 + nn] * W8_SCALE);
                w.y = pk4_fp8(tile[(kk * 8 + 4) * 65 + nn] * W8_SCALE, tile[(kk * 8 + 5) * 65 + nn] * W8_SCALE, tile[(kk * 8 + 6) * 65 + nn] * W8_SCALE, tile[(kk * 8 + 7) * 65 + nn] * W8_SCALE);
                *(u32x2*)(job.dst + (size_t)(n0_ + nn) * job.K + k0_ + kk * 8) = w; }
            else { u32x4 w;
                w.x = pk2(tile[(kk * 8 + 0) * 65 + nn], tile[(kk * 8 + 1) * 65 + nn]); w.y = pk2(tile[(kk * 8 + 2) * 65 + nn], tile[(kk * 8 + 3) * 65 + nn]);
                w.z = pk2(tile[(kk * 8 + 4) * 65 + nn], tile[(kk * 8 + 5) * 65 + nn]); w.w = pk2(tile[(kk * 8 + 6) * 65 + nn], tile[(kk * 8 + 7) * 65 + nn]);
                *(u32x4*)((bf16_t*)job.dst + (size_t)(n0_ + nn) * job.K + k0_ + kk * 8) = w; } }
        job = jn; v0 = n0; v1 = n1;
    }
    __syncthreads();
}
__device__ __forceinline__ void phase_convert_moe(const Params& P, unsigned char* ws, LAS unsigned char* lds, int layer) {
    LAS float* tile = (LAS float*)lds; const int tid = threadIdx.x;
    const float* wgu = P.in[layer ? 39 : 15]; const float* wd = P.in[layer ? 41 : 17];
    const int TG = 32 * 32 * 16, TD = 32 * 16 * 16;
    for (int t = blockIdx.x; t < TG + TD; t += gridDim.x) {
        if (t < TG) { const int e = t / 512, r = t % 512; convert_tile(wgu + (size_t)e * 1024 * 2048, 2048, 1024, WSP(bf16_t, WS_WGU) + (size_t)e * 2048 * 1024, 0, r / 16, r % 16, tile, tid); }
        else { const int t2 = t - TG, e = t2 / 256, r = t2 % 256; convert_tile(wd + (size_t)e * 1024 * 1024, 1024, 1024, WSP(bf16_t, WS_WD) + (size_t)e * 1024 * 1024, 0, r / 16, r % 16, tile, tid); }
    }
    __syncthreads();
}


__device__ __forceinline__ void cmul(float ar, float ai, float br, float bi, float& cr, float& ci) { cr = ar * br - ai * bi; ci = ar * bi + ai * br; }
__device__ __forceinline__ void s5_lam(const Params& P, int dir, int g, int p, float& lr, float& li, float& dt) {
    lr = P.in[25][(dir * 16 + g) * 64 + p]; li = P.in[26][(dir * 16 + g) * 64 + p]; dt = expf(P.in[27][dir * 16 + g]);
}
__device__ __forceinline__ void s5_apow(float lr, float li, float dt, float tau, float& re, float& im) {
    const float mag = expf(lr * dt * tau); float s, c; sincosf(li * dt * tau, &s, &c); re = mag * c; im = mag * s;
}
__device__ __forceinline__ void s5_bscale(float lr, float li, float dt, float& re, float& im) {
    float ar, ai; s5_apow(lr, li, dt, 1.f, ar, ai); ar -= 1.f; const float d = lr * lr + li * li; re = (ar * lr + ai * li) / d; im = (ai * lr - ar * li) / d;
}
__device__ __forceinline__ void phase_s5_kernels(const Params& P, unsigned char* ws, LAS unsigned char* lds) {
    const int tid = threadIdx.x;
    LAS float* zr = (LAS float*)lds;
    LAS float* zi = zr + 128;
    float* Kt = WSP(float, WS_S5K);
    for (int u = blockIdx.x; u < 16 * 2 * 32; u += gridDim.x) {
        const int g = u / 64, dir = (u / 32) & 1, tp = u % 32;
        __syncthreads();
        if (tid < 128) { const int sub = tid >> 6, p = tid & 63; float lr, li, dt; s5_lam(P, dir, g, p, lr, li, dt);
            float ar, ai, br, bi, r, i; s5_apow(lr, li, dt, (float)(tp * 2 + sub), ar, ai); s5_bscale(lr, li, dt, br, bi); cmul(ar, ai, br, bi, r, i); zr[tid] = r; zi[tid] = i; }
        __syncthreads();
        const int sub = tid >> 8, cj = tid & 255, c = cj >> 4, j = cj & 15;
        float acc = 0.f;
#pragma unroll 16
        for (int p = 0; p < 64; ++p) {
            const float cr = P.in[30][(g * 16 + c) * 64 + p], ci = P.in[31][(g * 16 + c) * 64 + p];
            const float br = P.in[28][(g * 64 + p) * 16 + j], bi = P.in[29][(g * 64 + p) * 16 + j];
            float tr, ti, ur, ui; cmul(zr[sub * 64 + p], zi[sub * 64 + p], br, bi, tr, ti); cmul(cr, ci, tr, ti, ur, ui); acc += ur;
        }
        Kt[(((size_t)g * 2 + dir) * 64 + tp * 2 + sub) * 256 + cj] = acc;
    }
    if (blockIdx.x == gridDim.x - 1) {
        float* A64 = WSP(float, WS_S5A64);
        for (int i = tid; i < 2 * 16 * 64; i += NTHREADS) { const int dir = i / 1024, g = (i / 64) & 15, p = i & 63; float lr, li, dt, r, im; s5_lam(P, dir, g, p, lr, li, dt); s5_apow(lr, li, dt, 64.f, r, im); A64[i * 2] = r; A64[i * 2 + 1] = im; }
    }
    __syncthreads();
}
__device__ __forceinline__ void phase_s5_tables(const Params& P, unsigned char* ws) {
    const float* __restrict__ Kt = WSP(float, WS_S5K);
    bf16_t* __restrict__ TE = WSP(bf16_t, WS_S5TE); bf16_t* __restrict__ Ft = WSP(bf16_t, WS_S5F);
    const float* __restrict__ Cr = P.in[30]; const float* __restrict__ Ci = P.in[31]; const float* __restrict__ Br = P.in[28]; const float* __restrict__ Bi = P.in[29];
    const size_t gsz = (size_t)gridDim.x * NTHREADS, gid = (size_t)blockIdx.x * NTHREADS + threadIdx.x;
#pragma unroll 4
    for (size_t i = gid; i < (size_t)16 * 1024 * 128; i += gsz) {
        const int g = (int)(i / (1024 * 128)), r = (int)((i / 128) % 1024), k8 = (int)(i % 128);
        const int t = r >> 4, c = r & 15, s = k8 >> 1, j0 = (k8 & 1) * 8;
        const int df = s <= t ? t - s : 0, db = s >= t ? s - t : 0;
        const float* pf = Kt + (((size_t)g * 2 + 0) * 64 + df) * 256 + c * 16 + j0; const float* pb = Kt + (((size_t)g * 2 + 1) * 64 + db) * 256 + c * 16 + j0;
        const f32x4 f0 = *(const f32x4*)pf, f1 = *(const f32x4*)(pf + 4), b0 = *(const f32x4*)pb, b1 = *(const f32x4*)(pb + 4);
        const float mf = s <= t ? 1.f : 0.f, mb = s >= t ? 1.f : 0.f;
        const f32x4 x0 = f0 * mf + b0 * mb, x1 = f1 * mf + b1 * mb;
        u32x4 w; w.x = pk2(x0[0], x0[1]); w.y = pk2(x0[2], x0[3]); w.z = pk2(x1[0], x1[1]); w.w = pk2(x1[2], x1[3]);
        *(u32x4*)(TE + ((size_t)g * 1024 + r) * 1280 + k8 * 8) = w;
    }
#pragma unroll 4
    for (size_t i = gid; i < (size_t)16 * 1024 * 128; i += gsz) {
        const int g = (int)(i / (1024 * 128)), r = (int)((i / 128) % 1024), dp = (int)(i % 128), dir = dp >> 6, p = dp & 63;
        const int t = r >> 4, c = r & 15;
        float lr, li, dt, ar, ai, zr, zi; s5_lam(P, dir, g, p, lr, li, dt);
        s5_apow(lr, li, dt, dir == 0 ? (float)(t + 1) : (float)(64 - t), ar, ai);
        cmul(Cr[(g * 16 + c) * 64 + p], Ci[(g * 16 + c) * 64 + p], ar, ai, zr, zi);
        bf16_t* row = TE + ((size_t)g * 1024 + r) * 1280 + 1024 + dir * 128;
        row[p] = (bf16_t)f2bf(zr); row[64 + p] = (bf16_t)f2bf(-zi);
    }
#pragma unroll 4
    for (size_t i = gid; i < (size_t)16 * 128 * 1024; i += gsz) {
        const int g = (int)(i / (128 * 1024)), dp = (int)((i / 1024) % 128), k = (int)(i % 1024), dir = dp >> 6, p = dp & 63, s = k >> 4, j = k & 15;
        float lr, li, dt, ar, ai, br, bi, tr, ti, zr, zi; s5_lam(P, dir, g, p, lr, li, dt);
        s5_apow(lr, li, dt, dir == 0 ? (float)(63 - s) : (float)s, ar, ai); s5_bscale(lr, li, dt, br, bi); cmul(ar, ai, br, bi, tr, ti);
        cmul(tr, ti, Br[(g * 64 + p) * 16 + j], Bi[(g * 64 + p) * 16 + j], zr, zi);
        Ft[((size_t)g * 256 + dir * 128 + p) * 1024 + k] = (bf16_t)f2bf(zr);
        Ft[((size_t)g * 256 + dir * 128 + 64 + p) * 1024 + k] = (bf16_t)f2bf(zi);
    }
}

__device__ __forceinline__ void phase_router_tables(const Params& P, unsigned char* ws, LAS unsigned char* lds) {
    LAS float* part = (LAS float*)lds;
    const float* mods = WSP(float, WS_MODS); bf16_t* GWH = WSP(bf16_t, WS_GW); bf16_t* GWL = GWH + (size_t)2 * 9 * 32 * 1024; float* CB = WSP(float, WS_CB);
    const size_t gsz = (size_t)gridDim.x * NTHREADS, gid = (size_t)blockIdx.x * NTHREADS + threadIdx.x;
    for (size_t i = gid; i < (size_t)2 * 9 * 1024 * 32; i += gsz) {
        const int layer = (int)(i / (9 * 32768)), r = (int)((i / 32768) % 9), k = (int)((i / 32) % 1024), e = (int)(i % 32);
        const float* m = mods + ((size_t)layer * 9 + r) * 6144;
        const float v = P.in[layer ? 22 : 7][k] * (1.f + m[4096 + k]) * P.in[layer ? 37 : 13][k * 32 + e];
        const unsigned h = f2bf(v), l = f2bf(v - __builtin_bit_cast(float, h << 16)); const size_t o = (((size_t)layer * 9 + r) * 32 + e) * 1024 + k;
        GWH[o] = (bf16_t)h; GWL[o] = (bf16_t)l;
    }
    for (int u = blockIdx.x; u < 18; u += gridDim.x) {
        const int layer = u / 9, r = u % 9, e = threadIdx.x & 31, ks = threadIdx.x >> 5;
        const float* m = mods + ((size_t)layer * 9 + r) * 6144; const float* W = P.in[layer ? 37 : 13];
        float a = 0.f;
#pragma unroll 16
        for (int k = ks * 64; k < ks * 64 + 64; ++k) a += m[3072 + k] * W[k * 32 + e];
        __syncthreads(); part[threadIdx.x] = a; __syncthreads();
        if (threadIdx.x < 32) { float t = P.in[layer ? 38 : 14][e];
            for (int q = 0; q < 16; ++q) t += part[q * 32 + e];
            CB[(layer * 9 + r) * 32 + e] = t; }
    }
}

__device__ __forceinline__ void phase_norm1(const Params& P, unsigned char* ws, int layer, const float* xlat, const float* xctx) {
    const int lane = threadIdx.x & 63, gw = blockIdx.x * 8 + (threadIdx.x >> 6), nw = gridDim.x * 8;
    const float* mods = WSP(float, WS_MODS) + (size_t)layer * 9 * 6144; const float* g = P.in[layer ? 21 : 6];
    bf16_t* XN = WSP(bf16_t, WS_XN);
    f32x4 nx[3][4]; f32x4 gg[4];
#define N1_ROWPTR(ROW) ((ROW) < NCTX ? xctx + (size_t)(ROW) * 1024 : xlat + (size_t)((ROW) - NCTX) * 1024)
#pragma unroll
    for (int i = 0; i < 4; ++i) gg[i] = *(const f32x4*)(g + i * 256 + lane * 4);
#pragma unroll
    for (int u = 0; u < 3; ++u) if (gw + u * nw < NTOK) { const float* x = N1_ROWPTR(gw + u * nw);
#pragma unroll
        for (int i = 0; i < 4; ++i) nx[u][i] = *(const f32x4*)(x + i * 256 + lane * 4); }
    for (int row0 = gw; row0 < NTOK; row0 += 3 * nw) {
#pragma unroll
        for (int u = 0; u < 3; ++u) { const int row = row0 + u * nw; if (row < NTOK) {
            const int r = row < NCTX ? 8 : (row - NCTX) >> 13;
            f32x4 v[4]; float ss = 0.f;
#pragma unroll
            for (int i = 0; i < 4; ++i) { v[i] = nx[u][i]; ss += v[i][0] * v[i][0] + v[i][1] * v[i][1] + v[i][2] * v[i][2] + v[i][3] * v[i][3]; }
            if (row + 3 * nw < NTOK) { const float* x = N1_ROWPTR(row + 3 * nw);
#pragma unroll
                for (int i = 0; i < 4; ++i) nx[u][i] = *(const f32x4*)(x + i * 256 + lane * 4); }
            const float* m = mods + (size_t)r * 6144; f32x4 sh[4], sc[4];
#pragma unroll
            for (int i = 0; i < 4; ++i) { const int k = i * 256 + lane * 4; sh[i] = *(const f32x4*)(m + k); sc[i] = *(const f32x4*)(m + 1024 + k); }
            ss = wave_sum(ss); const float rstd = rsqrtf(ss * (1.f / 1024.f) + 1e-6f);
#pragma unroll
            for (int i = 0; i < 4; ++i) { const int k = i * 256 + lane * 4;
                const f32x4 o = v[i] * rstd * gg[i] * (1.f + sc[i]) + sh[i];
                u32x2 w; w.x = pk2(o[0], o[1]); w.y = pk2(o[2], o[3]); *(u32x2*)(XN + (size_t)row * 1024 + k) = w; } } }
    }
#undef N1_ROWPTR
}

struct SchedPlain : pg8::GridOrder {
    const char* A; const char* Bt; unsigned lda_bytes; int ldb_bytes; size_t a_gstride, b_gstride;
    __device__ __forceinline__ bool next(int i, Unit& u) const { return next_mn(i, u); }
    __device__ __forceinline__ const char* a_base(const Unit& u) const { return A + (size_t)u.g * a_gstride + (size_t)u.pm * 256 * lda_bytes; }
    __device__ __forceinline__ unsigned a_off(const Unit&, int r) const { return (unsigned)r * lda_bytes; }
    __device__ __forceinline__ const char* b_base(const Unit& u) const { return Bt + (size_t)u.g * b_gstride + (size_t)u.pn * 256 * ldb_bytes; }
};
typedef const f32x4 (&AccRef)[2][2][4][2];
__device__ __forceinline__ u32x4 pack8(const f32x4& v0, const f32x4& v1) { u32x4 w; w.x = pg8::cvt_pk_bf16(v0[0], v0[1]); w.y = pg8::cvt_pk_bf16(v0[2], v0[3]); w.z = pg8::cvt_pk_bf16(v1[0], v1[1]); w.w = pg8::cvt_pk_bf16(v1[2], v1[3]); return w; }

struct EpiInProj0 { static constexpr bool PERM = true;
    unsigned char* R; const float* gate_bias;
    __device__ __forceinline__ void operator()(AccRef acc, const Unit& u, int wr, int wc, int fr, int fq) const {
        const int row0 = u.pm * 256 + wr * 64 + fr, c8 = wc * 32 + 8 * fq;
#pragma unroll
        for (int ai = 0; ai < 2; ++ai)
#pragma unroll
            for (int m = 0; m < 4; ++m) { const size_t row = (size_t)(row0 + ai * 128 + m * 16);
#pragma unroll
                for (int bj = 0; bj < 2; ++bj) { f32x4 v0 = acc[ai][bj][m][0], v1 = acc[ai][bj][m][1];
                    if (u.pn < 10) { const int sec = u.pn >> 1, col = (u.pn & 1) * 256 + bj * 128 + c8;
                        if (sec == 1) { v0 = v0 * 0.125f; v1 = v1 * 0.125f; }
                        *(u32x4*)(R + R_QA + (size_t)sec * PROJ512 + (row * 512 + col) * 2) = pack8(v0, v1); }
                    else if (u.pn == 10) { *(u32x4*)(R + (bj == 0 ? R_KBR : R_VBR) + (row * 128 + c8) * 2) = pack8(v0, v1); }
                    else if (bj == 0 && wc == 0) { float* gp = (float*)(R + R_G) + row * 32 + 8 * fq;
                        const f32x4 b0 = *(const f32x4*)(gate_bias + 8 * fq), b1 = *(const f32x4*)(gate_bias + 8 * fq + 4);
                        *(f32x4*)gp = v0 + b0; *(f32x4*)(gp + 4) = v1 + b1; } } }
    }
};
__device__ __forceinline__ void row_to_chunk(int row, int& n, int& s) {
    if (row < NCTX) { const int b = row >> 8, l = row & 255; n = 1024 + b * 4 + (l >> 6); s = l & 63; }
    else { const int r2 = row - NCTX, b = r2 >> 13, st = r2 & 8191; n = b * 128 + (st >> 6); s = st & 63; }
}
struct EpiInProj1 { static constexpr bool PERM = true;
    unsigned char* R;
    __device__ __forceinline__ void operator()(AccRef acc, const Unit& u, int wr, int wc, int fr, int fq) const {
        const int row0 = u.pm * 256 + wr * 64 + fr, c8 = wc * 32 + 8 * fq;
#pragma unroll
        for (int ai = 0; ai < 2; ++ai)
#pragma unroll
            for (int m = 0; m < 4; ++m) { const int rowi = row0 + ai * 128 + m * 16; const size_t row = (size_t)rowi;
#pragma unroll
                for (int bj = 0; bj < 2; ++bj) { const u32x4 w = pack8(acc[ai][bj][m][0] * W8_INV, acc[ai][bj][m][1] * W8_INV);
                    if (u.pn == 0) { const int c0 = bj * 128 + c8, g = c0 >> 4, j0 = c0 & 15; int n, s; row_to_chunk(rowi, n, s);
                        *(u32x4*)(R + R_UX + (((size_t)g * 1280 + n) * 1280 + s * 16 + j0) * 2) = w; }
                    else if (u.pn < 4) { *(u32x4*)(R + R_Q1 + (row * 768 + (u.pn - 1) * 256 + bj * 128 + c8) * 2) = w; }
                    else if (u.pn == 4) { *(u32x4*)(R + R_KV1 + (row * 384 + bj * 128 + c8) * 2) = w; }
                    else if (bj == 0) { *(u32x4*)(R + R_KV1 + (row * 384 + 256 + c8) * 2) = w; } } }
    }
};
struct EpiResid { static constexpr bool PERM = false;
    const float* xin; float* xout; const float* hin; float* hout; const float* gate  ; int row_base; float scale;
    __device__ __forceinline__ void operator()(AccRef acc, const Unit& u, int wr, int wc, int fr, int fq) const {
        const int rowu = row_base + u.pm * 256, row0 = rowu + wr * 64 + fr, col0 = u.pn * 256 + wc * 32 + 4 * fq;
        const float* g = gate + (rowu < NCTX ? 8 : ((rowu - NCTX) >> 13)) * 6144;
        f32x4 gg[2][2];
#pragma unroll
        for (int bj = 0; bj < 2; ++bj)
#pragma unroll
            for (int n = 0; n < 2; ++n) gg[bj][n] = *(const f32x4*)(g + col0 + bj * 128 + n * 16) * scale;
#pragma unroll
        for (int ai = 0; ai < 2; ++ai)
#pragma unroll
            for (int m = 0; m < 4; ++m) { const int row = row0 + ai * 128 + m * 16;
                const float* src; float* dst;
                if (row < NCTX) { src = hin + (size_t)row * 1024; dst = hout + (size_t)row * 1024; }
                else { const int r2 = row - NCTX; src = xin + (size_t)r2 * 1024; dst = xout + (size_t)r2 * 1024; }
#pragma unroll
                for (int bj = 0; bj < 2; ++bj)
#pragma unroll
                    for (int n = 0; n < 2; ++n) { const int c = col0 + bj * 128 + n * 16;
                        *(f32x4*)(dst + c) = *(const f32x4*)(src + c) + gg[bj][n] * acc[ai][bj][m][n]; } }
    }
};
struct EpiS5F { static constexpr bool PERM = false;
    float* S;
    __device__ __forceinline__ void operator()(AccRef acc, const Unit& u, int wr, int wc, int fr, int fq) const {
        const int row0 = u.pm * 256 + wr * 64 + fr, col0 = wc * 32 + 4 * fq;
#pragma unroll
        for (int ai = 0; ai < 2; ++ai)
#pragma unroll
            for (int m = 0; m < 4; ++m) { float* rp = S + ((size_t)u.g * 1280 + row0 + ai * 128 + m * 16) * 256 + col0;
#pragma unroll
                for (int bj = 0; bj < 2; ++bj)
#pragma unroll
                    for (int n = 0; n < 2; ++n) *(f32x4*)(rp + bj * 128 + n * 16) = acc[ai][bj][m][n]; }
    }
};
__device__ __forceinline__ float gelu_tanh(float x) { const float u = 0.7978845608028654f * (x + 0.044715f * x * x * x); const float e = __builtin_amdgcn_exp2f(2.885390081777927f * u); const float th = 1.f - 2.f * __builtin_amdgcn_rcpf(e + 1.f); return 0.5f * x * (1.f + th); }
struct EpiS5Y { static constexpr bool PERM = true;
    const bf16_t* UX; bf16_t* Yg; const float* dskip;
    __device__ __forceinline__ void operator()(AccRef acc, const Unit& u, int wr, int wc, int fr, int fq) const {
        const int row0 = u.pm * 256 + wr * 64 + fr;
#pragma unroll
        for (int ai = 0; ai < 2; ++ai)
#pragma unroll
            for (int m = 0; m < 4; ++m) { const int n = row0 + ai * 128 + m * 16;
#pragma unroll
                for (int bj = 0; bj < 2; ++bj) { const int c0 = u.pn * 256 + bj * 128 + wc * 32 + 8 * fq, t = c0 >> 4, cc = c0 & 15;
                    const u32x4 uw = *(const u32x4*)(UX + ((size_t)u.g * 1280 + n) * 1280 + t * 16 + cc);
                    const float* ds = dskip + u.g * 16 + cc;
                    f32x4 v0 = acc[ai][bj][m][0], v1 = acc[ai][bj][m][1];
                    v0[0] = gelu_tanh(v0[0] + ds[0] * bflo(uw.x)); v0[1] = gelu_tanh(v0[1] + ds[1] * bfhi(uw.x)); v0[2] = gelu_tanh(v0[2] + ds[2] * bflo(uw.y)); v0[3] = gelu_tanh(v0[3] + ds[3] * bfhi(uw.y));
                    v1[0] = gelu_tanh(v1[0] + ds[4] * bflo(uw.z)); v1[1] = gelu_tanh(v1[1] + ds[5] * bfhi(uw.z)); v1[2] = gelu_tanh(v1[2] + ds[6] * bflo(uw.w)); v1[3] = gelu_tanh(v1[3] + ds[7] * bfhi(uw.w));
                    *(u32x4*)(Yg + ((size_t)n * 64 + t) * 256 + u.g * 16 + cc) = pack8(v0, v1); } }
    }
};
struct EpiGLU { static constexpr bool PERM = true;
    const bf16_t* Yg; bf16_t* MIX; const float* bglu;
    __device__ __forceinline__ void operator()(AccRef acc, const Unit& u, int wr, int wc, int fr, int fq) const {
        const int row0 = u.pm * 256 + wr * 64 + fr;
#pragma unroll
        for (int ai = 0; ai < 2; ++ai)
#pragma unroll
            for (int m = 0; m < 4; ++m) { const size_t tok = (size_t)(row0 + ai * 128 + m * 16);
#pragma unroll
                for (int bj = 0; bj < 2; ++bj) { const int c0 = bj * 128 + wc * 32 + 8 * fq;
                    const u32x4 yw = *(const u32x4*)(Yg + tok * 256 + c0); const float* bg = bglu + c0;
                    f32x4 v0 = acc[ai][bj][m][0], v1 = acc[ai][bj][m][1];
                    v0[0] = bflo(yw.x) * sigmoidf_(v0[0] + bg[0]); v0[1] = bfhi(yw.x) * sigmoidf_(v0[1] + bg[1]); v0[2] = bflo(yw.y) * sigmoidf_(v0[2] + bg[2]); v0[3] = bfhi(yw.y) * sigmoidf_(v0[3] + bg[3]);
                    v1[0] = bflo(yw.z) * sigmoidf_(v1[0] + bg[4]); v1[1] = bfhi(yw.z) * sigmoidf_(v1[1] + bg[5]); v1[2] = bflo(yw.w) * sigmoidf_(v1[2] + bg[6]); v1[3] = bfhi(yw.w) * sigmoidf_(v1[3] + bg[7]);
                    if (DBG_SKIP & 8) { v0 = v0 * 0.f; v1 = v1 * 0.f; }
                    *(u32x4*)(MIX + ((size_t)NCTX + tok) * 1024 + c0) = pack8(v0, v1); } }
    }
};

struct MoeTab { LAS int* pad_start  ; LAS int* rb_start  ; LAS unsigned char* rb_exp  ; };
__device__ __forceinline__ MoeTab moe_tab(LAS unsigned char* misc) { MoeTab t; t.pad_start = (LAS int*)(misc + 64); t.rb_start = (LAS int*)(misc + 64 + 256); t.rb_exp = misc + 64 + 512; return t; }
__device__ __forceinline__ void moe_build_tab(const unsigned* cnt, const MoeTab& T) {
    __syncthreads();
    if (threadIdx.x == 0) { int ps = 0, rb = 0; for (int e = 0; e < NEXP; ++e) { T.pad_start[e] = ps; T.rb_start[e] = rb; const int nb = ((int)cnt[e] + 255) >> 8; ps += nb * 256; rb += nb; } T.pad_start[NEXP] = ps; T.rb_start[NEXP] = rb; }
    __syncthreads();
    const int nrb = T.rb_start[NEXP];
    for (int i = threadIdx.x; i < nrb; i += NTHREADS) { int e = 0; while (T.rb_start[e + 1] <= i) ++e; T.rb_exp[i] = (unsigned char)e; }
    __syncthreads();
}
struct SchedMoe1 {
    const char* XN; const int* rowtok; const char* W; MoeTab T; int rb_lo, rb_hi, G, c; int ldb_bytes;
    __device__ __forceinline__ bool next(int i, Unit& u) const { const int x = c & 7, slot = c >> 3, W = G >> 3, nrb = rb_hi - rb_lo, r0 = (int)((long)nrb * x / 8), r1 = (int)((long)nrb * (x + 1) / 8);
        const long j = (long)i * W + slot; const int rbl = (int)(j >> 3); if (r0 + rbl >= r1) return false; u.pm = rb_lo + r0 + rbl; u.pn = (int)(j & 7); u.g = T.rb_exp[u.pm]; return true; }
    __device__ __forceinline__ const char* a_base(const Unit&) const { return XN; }
    __device__ __forceinline__ unsigned a_off(const Unit& u, int r) const { return (unsigned)rowtok[u.pm * 256 + r] * 1024u; }
    __device__ __forceinline__ const char* b_base(const Unit& u) const { return W + ((size_t)u.g * 2048 + (size_t)u.pn * 256) * 1024; }
};
struct EpiSwiGLU { static constexpr bool PERM = true;
    unsigned char* ACT; const float* bgu; int rb_lo;
    __device__ __forceinline__ void operator()(AccRef acc, const Unit& u, int wr, int wc, int fr, int fq) const {
        const int row0 = (u.pm - rb_lo) * 256 + wr * 64 + fr;
#pragma unroll
        for (int bj = 0; bj < 2; ++bj) { const int c0 = u.pn * 256 + bj * 128 + wc * 32 + 8 * fq;
            const f32x4 b0 = *(const f32x4*)(bgu + (size_t)u.g * 2048 + c0), b1 = *(const f32x4*)(bgu + (size_t)u.g * 2048 + c0 + 4);
#pragma unroll
            for (int ai = 0; ai < 2; ++ai)
#pragma unroll
                for (int m = 0; m < 4; ++m) { const f32x4 v0 = fma4(acc[ai][bj][m][0], W8_INV, b0), v1 = fma4(acc[ai][bj][m][1], W8_INV, b1);
                    float o[4];
#pragma unroll
                    for (int q = 0; q < 4; ++q) { const float hg = q < 2 ? v0[2 * q] : v1[2 * q - 4], hl = q < 2 ? v0[2 * q + 1] : v1[2 * q - 3];
                        const float glu = fminf(hg, 7.f), lin1 = __builtin_amdgcn_fmed3f(hl, -7.f, 7.f) + 1.f;
                        o[q] = glu * __builtin_amdgcn_rcpf(1.f + __builtin_amdgcn_exp2f(glu * (-1.702f * 1.4426950408889634f))) * lin1; }
                    *(unsigned*)(ACT + (size_t)(row0 + ai * 128 + m * 16) * 1024 + (c0 >> 1)) = pk4_fp8_nc(o[0], o[1], o[2], o[3]); } }
    }
};
struct SchedMoe2 {
    const char* ACT; const char* W; MoeTab T; int rb_lo, rb_hi, G, c; int ldb_bytes;
    __device__ __forceinline__ bool next(int i, Unit& u) const { const int x = c & 7, slot = c >> 3, W = G >> 3, nrb = rb_hi - rb_lo, r0 = (int)((long)nrb * x / 8), r1 = (int)((long)nrb * (x + 1) / 8);
        const long j = (long)i * W + slot; const int rbl = (int)(j >> 2); if (r0 + rbl >= r1) return false; u.pm = rb_lo + r0 + rbl; u.pn = (int)(j & 3); u.g = T.rb_exp[u.pm]; return true; }
    __device__ __forceinline__ const char* a_base(const Unit& u) const { return ACT + (size_t)(u.pm - rb_lo) * 256 * 1024; }
    __device__ __forceinline__ unsigned a_off(const Unit&, int r) const { return (unsigned)r * 1024u; }
    __device__ __forceinline__ const char* b_base(const Unit& u) const { return W + ((size_t)u.g * 1024 + (size_t)u.pn * 256) * 1024; }
};
struct EpiMoeOut { static constexpr bool PERM = true;
    unsigned char* OUT; const float* bd; int rb_lo;
    __device__ __forceinline__ void operator()(AccRef acc, const Unit& u, int wr, int wc, int fr, int fq) const {
        const int row0 = (u.pm - rb_lo) * 256 + wr * 64 + fr;
#pragma unroll
        for (int bj = 0; bj < 2; ++bj) { const int c0 = u.pn * 256 + bj * 128 + wc * 32 + 8 * fq;
            const f32x4 b0 = *(const f32x4*)(bd + (size_t)u.g * 1024 + c0), b1 = *(const f32x4*)(bd + (size_t)u.g * 1024 + c0 + 4);
#pragma unroll
            for (int ai = 0; ai < 2; ++ai)
#pragma unroll
                for (int m = 0; m < 4; ++m) { const f32x4 v0 = fma4(acc[ai][bj][m][0], W8_INV, b0), v1 = fma4(acc[ai][bj][m][1], W8_INV, b1);
                    *(u32x2*)(OUT + (size_t)(row0 + ai * 128 + m * 16) * 1024 + c0) = (u32x2){pk4_fp8(v0[0], v0[1], v0[2], v0[3]), pk4_fp8(v1[0], v1[1], v1[2], v1[3])}; } }
    }
};

__device__ __forceinline__ int crow(int r, int hi) { return (r & 3) + 8 * (r >> 2) + 4 * hi; }
__device__ __forceinline__ f32x16 mma32(LAS const bf16_t* A, int lda, LAS const bf16_t* Bt, int ldb, int K, f32x16 acc, int lane) {
    const int r = lane & 31, hh = lane >> 5;
    for (int ks = 0; ks < K; ks += 16) {
        const bf16x8 a = *(LAS const bf16x8*)(A + r * lda + ks + hh * 8);
        const bf16x8 b = *(LAS const bf16x8*)(Bt + r * ldb + ks + hh * 8);
        acc = __builtin_amdgcn_mfma_f32_32x32x16_bf16(a, b, acc, 0, 0, 0);
    }
    return acc;
}
__device__ __forceinline__ void lds_addf(LAS float* p, float v) { (void)__hip_atomic_fetch_add(p, v, __ATOMIC_RELAXED, __HIP_MEMORY_SCOPE_WORKGROUP); }
__device__ __forceinline__ int lds_addi(LAS int* p, int v) { return __hip_atomic_fetch_add(p, v, __ATOMIC_RELAXED, __HIP_MEMORY_SCOPE_WORKGROUP); }
constexpr f32x16 F16ZERO = {0.f, 0.f, 0.f, 0.f, 0.f, 0.f, 0.f, 0.f, 0.f, 0.f, 0.f, 0.f, 0.f, 0.f, 0.f, 0.f};

__device__ __forceinline__ int mlstm_row0(int b, int n) { return n < 4 ? b * 256 + n * 64 : NCTX + b * 8192 + (n - 4) * 64; }
__device__ __forceinline__ size_t mlstm_unit(int b, int h, int dir, int n) { return ((size_t)((b * 8 + h) * 2 + dir)) * NCH + n; }
constexpr int LP = 72;

template <bool TR>
__device__ __forceinline__ void load_tile64(const bf16_t* g, size_t ld, LAS bf16_t* dst, int tid) {
    const int row = tid >> 3, c8 = (tid & 7) * 8;
    const u32x4 w = *(const u32x4*)(g + (size_t)row * ld + c8);
    if (!TR) *(LAS u32x4*)(dst + row * LP + c8) = w;
    else { dst[(c8 + 0) * LP + row] = (bf16_t)(w.x & 0xffff); dst[(c8 + 1) * LP + row] = (bf16_t)(w.x >> 16); dst[(c8 + 2) * LP + row] = (bf16_t)(w.y & 0xffff); dst[(c8 + 3) * LP + row] = (bf16_t)(w.y >> 16);
           dst[(c8 + 4) * LP + row] = (bf16_t)(w.z & 0xffff); dst[(c8 + 5) * LP + row] = (bf16_t)(w.z >> 16); dst[(c8 + 6) * LP + row] = (bf16_t)(w.w & 0xffff); dst[(c8 + 7) * LP + row] = (bf16_t)(w.w >> 16); }
}

__device__ __forceinline__ void phase_mlstm_local(unsigned char* ws, LAS unsigned char* lds) {
    const int tid = threadIdx.x, lane = tid & 63, wid = tid >> 6;
    unsigned char* R = ws + WS_R;
    LAS bf16_t* Ks = (LAS bf16_t*)lds; LAS bf16_t* Vt = Ks + 64 * LP; LAS bf16_t* KwT = Vt + 64 * LP;
    LAS float* vec = (LAS float*)(lds + 4 * 64 * LP * 2);
    LAS float* lf_f = vec, *li_f = vec + 64, *lf_b = vec + 128, *li_b = vec + 192, *w_f = vec + 256, *w_b = vec + 320;
    const bf16_t* KA = (const bf16_t*)(R + R_KA); const bf16_t* VA = (const bf16_t*)(R + R_VA); const float* G = (const float*)(R + R_G);
    bf16_t* CS = (bf16_t*)(R + R_CS); float* NS = (float*)(R + R_NS); float* ML = (float*)(R + R_ML); float* BL = (float*)(R + R_BL);
    for (int u = blockIdx.x; u < NB * 8 * NCH; u += gridDim.x) {
        const int n = u % NCH, h = (u / NCH) & 7, b = u / (NCH * 8); const int row0 = mlstm_row0(b, n);
        __syncthreads();
        load_tile64<false>(KA + (size_t)row0 * 512 + h * 64, 512, Ks, tid);
        load_tile64<true>(VA + (size_t)row0 * 512 + h * 64, 512, Vt, tid);
        if (tid < 64) { const float* gp = G + (size_t)(row0 + tid) * 32 + h; li_f[tid] = gp[0]; lf_f[tid] = logsigmoidf_(gp[8]); li_b[tid] = gp[16]; lf_b[tid] = logsigmoidf_(gp[24]); }
        __syncthreads();
        if (tid < 64) {
            float bf = 0.f, tot_f = 0.f, bb = 0.f, tot_b = 0.f;
            for (int r = 0; r < 64; ++r) { const float a = lf_f[r], c = lf_b[r]; tot_f += a; tot_b += c; if (r <= tid) bf += a; if (r >= tid) bb += c; }
            const float wl_f = tot_f - bf + li_f[tid], wl_b = tot_b - bb + li_b[tid];
            const float mf = wave_max(wl_f), mb = wave_max(wl_b);
            w_f[tid] = __expf(wl_f - mf); w_b[tid] = __expf(wl_b - mb);
            if (tid == 0) { ML[mlstm_unit(b, h, 0, n)] = mf; ML[mlstm_unit(b, h, 1, n)] = mb; BL[mlstm_unit(b, h, 0, n)] = tot_f; BL[mlstm_unit(b, h, 1, n)] = tot_b; }
        }
        __syncthreads();
        {
            const int s = tid >> 3, c8 = (tid & 7) * 8; const float wf = w_f[s], wb = w_b[s];
#pragma unroll
            for (int q = 0; q < 8; ++q) { const float kv = bf2f(Ks[s * LP + c8 + q]); KwT[(c8 + q) * LP + s] = (bf16_t)f2bf(kv * wf); KwT[64 * LP + (c8 + q) * LP + s] = (bf16_t)f2bf(kv * wb); }
        }
        __syncthreads();
        {
            const int dir = wid >> 2, dvb = (wid >> 1) & 1, dkb = wid & 1;
            const f32x16 acc = mma32(Vt + dvb * 32 * LP, LP, KwT + dir * 64 * LP + dkb * 32 * LP, LP, 64, F16ZERO, lane);
            bf16_t* cs = CS + mlstm_unit(b, h, dir, n) * 4096;
#pragma unroll
            for (int r = 0; r < 16; ++r) cs[(dvb * 32 + crow(r, lane >> 5)) * 64 + dkb * 32 + (lane & 31)] = (bf16_t)f2bf(acc[r]);
        }
        if (tid < 128) { const int dir = tid >> 6, dk = tid & 63; float a = 0.f; for (int s = 0; s < 64; ++s) a += bf2f(KwT[dir * 64 * LP + dk * LP + s]); NS[mlstm_unit(b, h, dir, n) * 64 + dk] = a; }
    }
    __syncthreads();
}

__device__ __forceinline__ void phase_mlstm_scan(unsigned char* ws) {
    const int tid = threadIdx.x;
    unsigned char* R = ws + WS_R;
    bf16_t* CS = (bf16_t*)(R + R_CS); float* NS = (float*)(R + R_NS); const float* ML = (const float*)(R + R_ML); const float* BL = (const float*)(R + R_BL); float* MP = (float*)(R + R_MP);
    for (int q = blockIdx.x; q < NB * 8 * 2; q += gridDim.x) {
        const int dir = q & 1; const size_t base = (size_t)q * NCH;
        float C[8]; float nst = 0.f, m = -1e30f;
#pragma unroll
        for (int i = 0; i < 8; ++i) C[i] = 0.f;
        int n = dir ? 3 : 0;
        u32x4 cl = *(const u32x4*)(CS + (base + n) * 4096 + tid * 8); float nl = tid < 64 ? NS[(base + n) * 64 + tid] : 0.f; float ml = ML[base + n], bl = BL[base + n];
        for (int i = 0; i < NCH; ++i) {
            const int nn = (i + 1 < NCH) ? (dir ? ((i + 1) < 4 ? 3 - (i + 1) : 135 - (i + 1)) : i + 1) : n;
            const u32x4 cl2 = *(const u32x4*)(CS + (base + nn) * 4096 + tid * 8); const float nl2 = tid < 64 ? NS[(base + nn) * 64 + tid] : 0.f; const float ml2 = ML[base + nn], bl2 = BL[base + nn];
            float clf[8] = {bflo(cl.x), bfhi(cl.x), bflo(cl.y), bfhi(cl.y), bflo(cl.z), bfhi(cl.z), bflo(cl.w), bfhi(cl.w)};
            u32x4 st; st.x = pk2(C[0], C[1]); st.y = pk2(C[2], C[3]); st.z = pk2(C[4], C[5]); st.w = pk2(C[6], C[7]);
            *(u32x4*)(CS + (base + n) * 4096 + tid * 8) = st;
            if (tid < 64) NS[(base + n) * 64 + tid] = nst;
            if (tid == 0) MP[base + n] = m;
            const float mnew = fmaxf(bl + m, ml), dec = __expf(bl + m - mnew), fre = __expf(ml - mnew);
#pragma unroll
            for (int k = 0; k < 8; ++k) C[k] = dec * C[k] + fre * clf[k];
            nst = dec * nst + fre * nl; m = mnew;
            n = nn; cl = cl2; nl = nl2; ml = ml2; bl = bl2;
        }
    }
}

__device__ __forceinline__ void phase_mlstm_out(const Params& P, unsigned char* ws, LAS unsigned char* lds) {
    const int tid = threadIdx.x, lane = tid & 63, wid = tid >> 6;
    unsigned char* R = ws + WS_R;
    LAS bf16_t* Qs = (LAS bf16_t*)lds; LAS bf16_t* Ks = Qs + 64 * LP; LAS bf16_t* Vt = Ks + 64 * LP; LAS bf16_t* Cst = Vt + 64 * LP  ; LAS bf16_t* sW = Cst + 2 * 64 * LP  ;
    LAS float* H = (LAS float*)(lds + 7 * 64 * LP * 2);
    LAS float* vec = H + 2 * 64 * 65;
    LAS float* lf_f = vec, *li_f = vec + 64, *lf_b = vec + 128, *li_b = vec + 192;
    LAS float* rowc = vec + 256  , *colc = vec + 384  , *inter = vec + 512  , *emm = vec + 640  , *qn = vec + 768  , *rs = vec + 896  , *nsv = vec + 1024  ;
    const bf16_t* QA = (const bf16_t*)(R + R_QA); const bf16_t* KA = (const bf16_t*)(R + R_KA); const bf16_t* VA = (const bf16_t*)(R + R_VA); const bf16_t* OA = (const bf16_t*)(R + R_OA);
    const float* G = (const float*)(R + R_G); const bf16_t* CS = (const bf16_t*)(R + R_CS); const float* NS = (const float*)(R + R_NS); const float* MP = (const float*)(R + R_MP);
    bf16_t* MIX = WSP(bf16_t, WS_XN); const float* mnorm = P.in[11];
    for (int u = blockIdx.x; u < NB * 8 * NCH; u += gridDim.x) {
        const int n = u % NCH, h = (u / NCH) & 7, b = u / (NCH * 8); const int row0 = mlstm_row0(b, n);
        __syncthreads();
        load_tile64<false>(QA + (size_t)row0 * 512 + h * 64, 512, Qs, tid);
        load_tile64<false>(KA + (size_t)row0 * 512 + h * 64, 512, Ks, tid);
        load_tile64<true>(VA + (size_t)row0 * 512 + h * 64, 512, Vt, tid);
        load_tile64<false>(CS + mlstm_unit(b, h, 0, n) * 4096, 64, Cst, tid);
        load_tile64<false>(CS + mlstm_unit(b, h, 1, n) * 4096, 64, Cst + 64 * LP, tid);
        if (tid < 64) { const float* gp = G + (size_t)(row0 + tid) * 32 + h; li_f[tid] = gp[0]; lf_f[tid] = logsigmoidf_(gp[8]); li_b[tid] = gp[16]; lf_b[tid] = logsigmoidf_(gp[24]); }
        if (tid >= 64 && tid < 192) { const int d = (tid - 64) >> 6, k = (tid - 64) & 63; nsv[d * 64 + k] = NS[mlstm_unit(b, h, d, n) * 64 + k]; rs[d * 64 + k] = 0.f; }
        __syncthreads();
        if (tid < 128) {
            const int dir = tid >> 6, t = tid & 63; const float mprev = MP[mlstm_unit(b, h, dir, n)];
            float bt = 0.f, pm = -3.0e38f, bs = 0.f;
            if (dir == 0) { for (int s = 0; s <= t; ++s) { bs += lf_f[s]; pm = fmaxf(pm, li_f[s] - bs); } bt = bs; colc[t] = li_f[t] - bt; }
            else { for (int s = 63; s >= t; --s) { bs += lf_b[s]; pm = fmaxf(pm, li_b[s] - bs); } bt = bs; colc[64 + t] = li_b[t] - bt; }
            const float il = bt + mprev, mt = fmaxf(il, bt + pm);
            rowc[dir * 64 + t] = bt - mt; inter[dir * 64 + t] = __expf(il - mt); emm[dir * 64 + t] = __expf(-mt);
            float a = 0.f; for (int k = 0; k < 64; ++k) a += bf2f(Qs[t * LP + k]) * nsv[dir * 64 + k]; qn[dir * 64 + t] = a;
        }
        __syncthreads();
        {
            const int dir = wid >> 2, ti = (wid >> 1) & 1, sj = wid & 1, hi = lane >> 5, sl = lane & 31, s = sj * 32 + sl;
            const f32x16 acc = mma32(Qs + ti * 32 * LP, LP, Ks + sj * 32 * LP, LP, 64, F16ZERO, lane);
            const float cc = colc[dir * 64 + s];
#pragma unroll
            for (int r = 0; r < 16; ++r) { const int t = ti * 32 + crow(r, hi);
                const bool ok = dir == 0 ? (s <= t) : (s >= t);
                float v = ok ? acc[r] * __expf(rowc[dir * 64 + t] + cc) : 0.f;
                sW[dir * 64 * LP + t * LP + s] = (bf16_t)f2bf(v);
                v += __shfl_xor(v, 16); v += __shfl_xor(v, 8); v += __shfl_xor(v, 4); v += __shfl_xor(v, 2); v += __shfl_xor(v, 1);
                if (sl == 0) lds_addf(&rs[dir * 64 + t], v); }
        }
        __syncthreads();
        {
            const int dir = wid >> 2, ti = (wid >> 1) & 1, dj = wid & 1, hi = lane >> 5, dv = dj * 32 + (lane & 31);
            const f32x16 aqc = mma32(Qs + ti * 32 * LP, LP, Cst + dir * 64 * LP + dj * 32 * LP, LP, 64, F16ZERO, lane);
            const f32x16 asv = mma32(sW + dir * 64 * LP + ti * 32 * LP, LP, Vt + dj * 32 * LP, LP, 64, F16ZERO, lane);
#pragma unroll
            for (int r = 0; r < 16; ++r) { const int t = ti * 32 + crow(r, hi); const float it = (DBG_SKIP & 128) ? 0.f : inter[dir * 64 + t];
                const float den = fmaxf(fabsf(it * qn[dir * 64 + t] + rs[dir * 64 + t]), emm[dir * 64 + t]);
                H[(dir * 64 + t) * 65 + dv] = (it * aqc[r] + asv[r]) / den; }
        }
        __syncthreads();
        {
            const int t = tid >> 3, d8 = (tid & 7) * 8; float hv[8], ss = 0.f;
#pragma unroll
            for (int q = 0; q < 8; ++q) { hv[q] = ((DBG_SKIP & 256) ? 0.f : H[t * 65 + d8 + q]) + ((DBG_SKIP & 64) ? 0.f : H[(64 + t) * 65 + d8 + q]); ss += hv[q] * hv[q]; }
            ss += __shfl_xor(ss, 1); ss += __shfl_xor(ss, 2); ss += __shfl_xor(ss, 4);
            const float rstd = rsqrtf(ss * (1.f / 64.f) + 1e-6f);
            const u32x4 ow = *(const u32x4*)(OA + (size_t)(row0 + t) * 512 + h * 64 + d8);
            const float og[8] = {bflo(ow.x), bfhi(ow.x), bflo(ow.y), bfhi(ow.y), bflo(ow.z), bfhi(ow.z), bflo(ow.w), bfhi(ow.w)};
            float o[8];
#pragma unroll
            for (int q = 0; q < 8; ++q) o[q] = hv[q] * rstd * mnorm[h * 64 + d8 + q] * sigmoidf_(og[q]);
            u32x4 w; w.x = pk2(o[0], o[1]); w.y = pk2(o[2], o[3]); w.z = pk2(o[4], o[5]); w.w = pk2(o[6], o[7]);
            if (DBG_SKIP & 1) w = (u32x4){0u, 0u, 0u, 0u};
            *(u32x2*)((unsigned char*)MIX + (size_t)(row0 + t) * 1024 + h * 64 + d8) = bf8_to_fp8(w);
        }
    }
    __syncthreads();
}


__device__ __forceinline__ float wave_psum(float v, int lane) {
#pragma unroll
    for (int d = 1; d < 64; d <<= 1) { const float t = __shfl_up(v, d); if (lane >= d) v += t; }
    return v;
}
__device__ __forceinline__ float wave_pmax(float v, int lane) {
#pragma unroll
    for (int d = 1; d < 64; d <<= 1) { const float t = __shfl_up(v, d); if (lane >= d) v = fmaxf(v, t); }
    return v;
}
__device__ __forceinline__ float wave_smax(float v, int lane) {
#pragma unroll
    for (int d = 1; d < 64; d <<= 1) { const float t = __shfl_down(v, d); if (lane + d < 64) v = fmaxf(v, t); }
    return v;
}
__device__ __forceinline__ void st_tile_T(LAS bf16_t* dst, const u32x4 w, int row, int c8) {
    dst[(c8 + 0) * LP + row] = (bf16_t)(w.x & 0xffff); dst[(c8 + 1) * LP + row] = (bf16_t)(w.x >> 16); dst[(c8 + 2) * LP + row] = (bf16_t)(w.y & 0xffff); dst[(c8 + 3) * LP + row] = (bf16_t)(w.y >> 16);
    dst[(c8 + 4) * LP + row] = (bf16_t)(w.z & 0xffff); dst[(c8 + 5) * LP + row] = (bf16_t)(w.z >> 16); dst[(c8 + 6) * LP + row] = (bf16_t)(w.w & 0xffff); dst[(c8 + 7) * LP + row] = (bf16_t)(w.w >> 16);
}
__device__ __forceinline__ void phase_mlstm_local2(unsigned char* ws, LAS unsigned char* lds) {
    const int tid = threadIdx.x, lane = tid & 63, wid = tid >> 6, row = tid >> 3, c8 = (tid & 7) * 8;
    unsigned char* R = ws + WS_R;
    LAS bf16_t* Ks = (LAS bf16_t*)lds; LAS bf16_t* Vt = Ks + 64 * LP; LAS bf16_t* KwT = Vt + 64 * LP;
    LAS float* vec = (LAS float*)(lds + 4 * 64 * LP * 2); LAS float* w_f = vec, *w_b = vec + 64;
    const bf16_t* KA = (const bf16_t*)(R + R_KA); const bf16_t* VA = (const bf16_t*)(R + R_VA); const float* G = (const float*)(R + R_G);
    bf16_t* CS = (bf16_t*)(R + R_CS); float* NS = (float*)(R + R_NS); float* ML = (float*)(R + R_ML); float* BL = (float*)(R + R_BL);
    float* BT = (float*)(R + R_BT); float* PM = (float*)(R + R_PM); float* GC = (float*)(R + R_GC);
    const int NU = NB * 8 * NCH;
    int u = blockIdx.x;
    u32x4 kw = (u32x4){0u, 0u, 0u, 0u}, vw = kw; float g0 = 0.f, g1 = 0.f, g2 = 0.f, g3 = 0.f;
    if (u < NU) { const int n = u % NCH, h = (u / NCH) & 7, b = u / (NCH * 8), row0 = mlstm_row0(b, n);
        kw = *(const u32x4*)(KA + (size_t)(row0 + row) * 512 + h * 64 + c8); vw = *(const u32x4*)(VA + (size_t)(row0 + row) * 512 + h * 64 + c8);
        if (wid == 0) { const float* gp = G + (size_t)(row0 + lane) * 32 + h; g0 = gp[0]; g1 = gp[8]; g2 = gp[16]; g3 = gp[24]; } }
    for (; u < NU; u += gridDim.x) {
        const int n = u % NCH, h = (u / NCH) & 7, b = u / (NCH * 8);
        __syncthreads();
        *(LAS u32x4*)(Ks + row * LP + c8) = kw; st_tile_T(Vt, vw, row, c8);
        if (wid == 0) {
            const float li_f = g0, lf_f = logsigmoidf_(g1), li_b = g2, lf_b = logsigmoidf_(g3);
            const float bf = wave_psum(lf_f, lane), pb = wave_psum(lf_b, lane);
            const float tot_f = __shfl(bf, 63), tot_b = __shfl(pb, 63), bb = tot_b - pb + lf_b;
            const float wl_f = tot_f - bf + li_f, wl_b = tot_b - bb + li_b, mf = wave_max(wl_f), mb = wave_max(wl_b);
            w_f[lane] = __expf(wl_f - mf); w_b[lane] = __expf(wl_b - mb);
            const float gf = li_f - bf, gb = li_b - bb, pmf = wave_pmax(gf, lane), pmb = wave_smax(gb, lane);
            const size_t uf = mlstm_unit(b, h, 0, n), ub = mlstm_unit(b, h, 1, n);
            BT[uf * 64 + lane] = bf; BT[ub * 64 + lane] = bb; PM[uf * 64 + lane] = pmf; PM[ub * 64 + lane] = pmb; GC[uf * 64 + lane] = gf; GC[ub * 64 + lane] = gb;
            if (lane == 0) { ML[uf] = mf; ML[ub] = mb; BL[uf] = tot_f; BL[ub] = tot_b; }
        }
        __syncthreads();
        const int un = u + gridDim.x;
        if (un < NU) { const int n2 = un % NCH, h2 = (un / NCH) & 7, b2 = un / (NCH * 8), r2 = mlstm_row0(b2, n2);
            kw = *(const u32x4*)(KA + (size_t)(r2 + row) * 512 + h2 * 64 + c8); vw = *(const u32x4*)(VA + (size_t)(r2 + row) * 512 + h2 * 64 + c8);
            if (wid == 0) { const float* gp = G + (size_t)(r2 + lane) * 32 + h2; g0 = gp[0]; g1 = gp[8]; g2 = gp[16]; g3 = gp[24]; } }
        {   const float wf = w_f[row], wb = w_b[row];
#pragma unroll
            for (int q = 0; q < 8; ++q) { const float kv = bf2f(Ks[row * LP + c8 + q]); KwT[(c8 + q) * LP + row] = (bf16_t)f2bf(kv * wf); KwT[64 * LP + (c8 + q) * LP + row] = (bf16_t)f2bf(kv * wb); } }
        __syncthreads();
        {   const int dir = wid >> 2, dvb = (wid >> 1) & 1, dkb = wid & 1;
            const f32x16 acc = mma32(Vt + dvb * 32 * LP, LP, KwT + dir * 64 * LP + dkb * 32 * LP, LP, 64, F16ZERO, lane);
            bf16_t* cs = CS + mlstm_unit(b, h, dir, n) * 4096;
#pragma unroll
            for (int r = 0; r < 16; ++r) cs[(dvb * 32 + crow(r, lane >> 5)) * 64 + dkb * 32 + (lane & 31)] = (bf16_t)f2bf(acc[r]); }
        if (tid < 128) { const int dir = tid >> 6, dk = tid & 63; float a = 0.f;
#pragma unroll 8
            for (int s8 = 0; s8 < 64; s8 += 8) { const u32x4 w = *(LAS const u32x4*)(KwT + dir * 64 * LP + dk * LP + s8); a += ((bflo(w.x) + bfhi(w.x)) + (bflo(w.y) + bfhi(w.y))) + ((bflo(w.z) + bfhi(w.z)) + (bflo(w.w) + bfhi(w.w))); }
            NS[mlstm_unit(b, h, dir, n) * 64 + dk] = a; }
    }
    __syncthreads();
}

__device__ __forceinline__ void phase_mlstm_out2(const Params& P, unsigned char* ws, LAS unsigned char* lds) {
    const int tid = threadIdx.x, lane = tid & 63, wid = tid >> 6, row = tid >> 3, c8 = (tid & 7) * 8;
    unsigned char* R = ws + WS_R;
    LAS bf16_t* Qs = (LAS bf16_t*)lds; LAS bf16_t* Ks = Qs + 64 * LP; LAS bf16_t* Vt = Ks + 64 * LP; LAS bf16_t* Cst = Vt + 64 * LP  ; LAS bf16_t* sW = Cst + 2 * 64 * LP  ;
    LAS bf16_t* NsT = sW + 2 * 64 * LP  ; LAS bf16_t* Ones = NsT + 2 * 32 * LP  ;
    LAS float* H = (LAS float*)(lds + (7 * 64 + 3 * 32) * LP * 2);
    LAS float* vec = H + 2 * 64 * 65; LAS float* BTv = vec, *PMv = vec + 128, *GCv = vec + 256, *MPv = vec + 384;
    const bf16_t* QA = (const bf16_t*)(R + R_QA); const bf16_t* KA = (const bf16_t*)(R + R_KA); const bf16_t* VA = (const bf16_t*)(R + R_VA); const bf16_t* OA = (const bf16_t*)(R + R_OA);
    const bf16_t* CS = (const bf16_t*)(R + R_CS); const float* NS = (const float*)(R + R_NS); const float* MP = (const float*)(R + R_MP);
    const float* BT = (const float*)(R + R_BT); const float* PM = (const float*)(R + R_PM); const float* GC = (const float*)(R + R_GC);
    bf16_t* MIX = WSP(bf16_t, WS_XN); const float* mnorm = P.in[11];
    __syncthreads();
    for (int i = tid; i < 3 * 32 * LP; i += NTHREADS) NsT[i] = (bf16_t)((i >= 2 * 32 * LP && i < 2 * 32 * LP + 64) ? 0x3f80 : 0);
    const int NU = NB * 8 * NCH;
    int u = blockIdx.x;
    u32x4 qw = (u32x4){0u, 0u, 0u, 0u}, kw = qw, vw = qw, cfw = qw, cbw = qw, ow = qw; float pbt = 0.f, ppm = 0.f, pgc = 0.f, pns = 0.f, pmp = 0.f;
#define M3_PREFETCH(UU) do { const int n_ = (UU) % NCH, h_ = ((UU) / NCH) & 7, b_ = (UU) / (NCH * 8), r_ = mlstm_row0(b_, n_); const size_t go_ = (size_t)(r_ + row) * 512 + h_ * 64 + c8; \
        qw = *(const u32x4*)(QA + go_); kw = *(const u32x4*)(KA + go_); vw = *(const u32x4*)(VA + go_); ow = *(const u32x4*)(OA + go_); \
        cfw = *(const u32x4*)(CS + mlstm_unit(b_, h_, 0, n_) * 4096 + row * 64 + c8); cbw = *(const u32x4*)(CS + mlstm_unit(b_, h_, 1, n_) * 4096 + row * 64 + c8); \
        if (tid < 128) { const size_t uu_ = mlstm_unit(b_, h_, tid >> 6, n_); pbt = BT[uu_ * 64 + (tid & 63)]; ppm = PM[uu_ * 64 + (tid & 63)]; pgc = GC[uu_ * 64 + (tid & 63)]; pns = NS[uu_ * 64 + (tid & 63)]; pmp = MP[uu_]; } } while (0)
    if (u < NU) M3_PREFETCH(u);
    for (; u < NU; u += gridDim.x) {
        const int n = u % NCH, h = (u / NCH) & 7, b = u / (NCH * 8); const int row0 = mlstm_row0(b, n);
        __syncthreads();
        *(LAS u32x4*)(Qs + row * LP + c8) = qw; *(LAS u32x4*)(Ks + row * LP + c8) = kw; st_tile_T(Vt, vw, row, c8);
        *(LAS u32x4*)(Cst + row * LP + c8) = cfw; *(LAS u32x4*)(Cst + 64 * LP + row * LP + c8) = cbw;
        const u32x4 ocur = ow;
        if (tid < 128) { BTv[tid] = pbt; PMv[tid] = ppm; GCv[tid] = pgc; NsT[(tid >> 6) * 32 * LP + (tid & 63)] = (bf16_t)f2bf(pns); if ((tid & 63) == 0) MPv[tid >> 6] = pmp; }
        __syncthreads();
        if (u + (int)gridDim.x < NU) M3_PREFETCH(u + (int)gridDim.x);
        {
            const int dir = wid >> 2, ti = (wid >> 1) & 1, sj = wid & 1, hi = lane >> 5, s = sj * 32 + (lane & 31);
            const f32x16 acc = mma32(Qs + ti * 32 * LP, LP, Ks + sj * 32 * LP, LP, 64, F16ZERO, lane);
            const float cc = GCv[dir * 64 + s], mprev = MPv[dir];
#pragma unroll
            for (int r = 0; r < 16; ++r) { const int t = ti * 32 + crow(r, hi); const float bt = BTv[dir * 64 + t], mt = fmaxf(bt + mprev, bt + PMv[dir * 64 + t]);
                const bool ok = dir == 0 ? (s <= t) : (s >= t);
                const float v = ok ? acc[r] * __expf((bt - mt) + cc) : 0.f;
                sW[dir * 64 * LP + t * LP + s] = (bf16_t)f2bf(v); }
        }
        __syncthreads();
        {
            const int dir = wid >> 2, ti = (wid >> 1) & 1, dj = wid & 1, hi = lane >> 5, dv = dj * 32 + (lane & 31);
            const f32x16 aqc = mma32(Qs + ti * 32 * LP, LP, Cst + dir * 64 * LP + dj * 32 * LP, LP, 64, F16ZERO, lane);
            const f32x16 asv = mma32(sW + dir * 64 * LP + ti * 32 * LP, LP, Vt + dj * 32 * LP, LP, 64, F16ZERO, lane);
            const f32x16 aqn = mma32(Qs + ti * 32 * LP, LP, NsT + dir * 32 * LP, LP, 64, F16ZERO, lane);
            const f32x16 ars = mma32(sW + dir * 64 * LP + ti * 32 * LP, LP, Ones, LP, 64, F16ZERO, lane);
            const float mprev = MPv[dir];
#pragma unroll
            for (int r = 0; r < 16; ++r) { const int t = ti * 32 + crow(r, hi); const float bt = BTv[dir * 64 + t], il = bt + mprev, mt = fmaxf(il, bt + PMv[dir * 64 + t]), it = __expf(il - mt);
                const float qn = __shfl(aqn[r], hi * 32), rs = __shfl(ars[r], hi * 32);
                const float den = fmaxf(fabsf(it * qn + rs), __expf(-mt)), rden = __builtin_amdgcn_rcpf(den);
                H[(dir * 64 + t) * 65 + dv] = (it * aqc[r] + asv[r]) * rden; }
        }
        __syncthreads();
        {   const int t = row, d8 = c8; float hv[8], ss = 0.f;
#pragma unroll
            for (int q = 0; q < 8; ++q) { hv[q] = H[t * 65 + d8 + q] + H[(64 + t) * 65 + d8 + q]; ss += hv[q] * hv[q]; }
            ss += __shfl_xor(ss, 1); ss += __shfl_xor(ss, 2); ss += __shfl_xor(ss, 4);
            const float rstd = rsqrtf(ss * (1.f / 64.f) + 1e-6f);
            const float og[8] = {bflo(ocur.x), bfhi(ocur.x), bflo(ocur.y), bfhi(ocur.y), bflo(ocur.z), bfhi(ocur.z), bflo(ocur.w), bfhi(ocur.w)};
            float o[8];
#pragma unroll
            for (int q = 0; q < 8; ++q) o[q] = hv[q] * rstd * mnorm[h * 64 + d8 + q] * sigmoidf_(og[q]);
            u32x4 w; w.x = pk2(o[0], o[1]); w.y = pk2(o[2], o[3]); w.z = pk2(o[4], o[5]); w.w = pk2(o[6], o[7]);
            *(u32x2*)((unsigned char*)MIX + (size_t)(row0 + t) * 1024 + h * 64 + d8) = bf8_to_fp8(w);
        }
    }
#undef M3_PREFETCH
    __syncthreads();
}

__device__ __forceinline__ void qk_prep_tile(const bf16_t* src, size_t spitch, bf16_t* dst, size_t dpitch, const float* gain, bool rope, int pos0, int tid) {
    const int r = tid >> 3, q = tid & 7, i0 = (q & 3) * 4, d1 = (q >> 2) * 32 + i0, d2 = d1 + 16;
    const u32x2 w1 = *(const u32x2*)(src + (size_t)r * spitch + d1), w2 = *(const u32x2*)(src + (size_t)r * spitch + d2);
    float a[4] = {bflo(w1.x), bfhi(w1.x), bflo(w1.y), bfhi(w1.y)}, c[4] = {bflo(w2.x), bfhi(w2.x), bflo(w2.y), bfhi(w2.y)};
    if (gain) {
        float ss = 0.f;
#pragma unroll
        for (int i = 0; i < 4; ++i) ss += a[i] * a[i] + c[i] * c[i];
        ss += __shfl_xor(ss, 1); ss += __shfl_xor(ss, 2); ss += __shfl_xor(ss, 4);
        const float rstd = rsqrtf(ss * (1.f / 64.f) + 1e-6f);
#pragma unroll
        for (int i = 0; i < 4; ++i) { a[i] = (float)bf2f((bf16_t)f2bf(a[i] * rstd * gain[d1 + i])); c[i] = (float)bf2f((bf16_t)f2bf(c[i] * rstd * gain[d2 + i])); }
    }
    if (rope) {
        const int pos = pos0 + r; const float pc = (float)((q >> 2) ? (pos & 63) : (pos >> 6));
#pragma unroll
        for (int i = 0; i < 4; ++i) { const float inv = exp2f(-(float)(i0 + i) * (13.287712379549449f / 16.f)); float sn, cs; __sincosf(pc * inv, &sn, &cs);
            const float t1 = a[i], t2 = c[i]; a[i] = t1 * cs - t2 * sn; c[i] = t2 * cs + t1 * sn; }
    }
    u32x2 o1, o2; o1.x = pk2(a[0], a[1]); o1.y = pk2(a[2], a[3]); o2.x = pk2(c[0], c[1]); o2.y = pk2(c[2], c[3]);
    *(u32x2*)(dst + (size_t)r * dpitch + d1) = o1; *(u32x2*)(dst + (size_t)r * dpitch + d2) = o2;
}
__device__ __forceinline__ void phase_qkv_prep(LAS unsigned char* lds, const bf16_t* ksrc, size_t kpitch, const bf16_t* vsrc, size_t vpitch, bf16_t* qbuf, size_t qpitch, int HKV, int HQ,
                                               bf16_t* Kc, bf16_t* VT, const float* qgain, const float* kgain, bool ctx_q) {
    const int tid = threadIdx.x;
    LAS bf16_t* tl = (LAS bf16_t*)lds;
    const int nkv = NB * HKV * NCH;
    for (int u = blockIdx.x; u < nkv; u += gridDim.x) {
        const int j = u % NCH, kvh = (u / NCH) % HKV, b = u / (NCH * HKV);
        const int row0 = j < 4 ? b * 256 + j * 64 : NCTX + b * 8192 + (j - 4) * 64;
        const size_t key0 = (size_t)j * 64;
        qk_prep_tile(ksrc + (size_t)row0 * kpitch + kvh * 64, kpitch, Kc + (((size_t)b * HKV + kvh) * NKEY + key0) * 64, 64, kgain, j >= 4, (j - 4) * 64, tid);
        __syncthreads();
        { const int r = tid >> 3, c8 = (tid & 7) * 8; *(LAS u32x4*)(tl + r * LP + c8) = *(const u32x4*)(vsrc + (size_t)(row0 + r) * vpitch + kvh * 64 + c8); }
        __syncthreads();
        { const int dv = tid >> 3, k8 = (tid & 7) * 8; u32x4 w;
          w.x = (unsigned)tl[(k8 + 0) * LP + dv] | ((unsigned)tl[(k8 + 1) * LP + dv] << 16); w.y = (unsigned)tl[(k8 + 2) * LP + dv] | ((unsigned)tl[(k8 + 3) * LP + dv] << 16);
          w.z = (unsigned)tl[(k8 + 4) * LP + dv] | ((unsigned)tl[(k8 + 5) * LP + dv] << 16); w.w = (unsigned)tl[(k8 + 6) * LP + dv] | ((unsigned)tl[(k8 + 7) * LP + dv] << 16);
          *(u32x4*)(VT + (((size_t)b * HKV + kvh) * 64 + dv) * NKEY + key0 + k8) = w; }
    }
    const int ntile = (ctx_q ? NTOK : NLAT) / 64;
    for (int u = blockIdx.x; u < ntile * HQ; u += gridDim.x) {
        const int hq = u % HQ, tI = u / HQ; const int row0 = ctx_q ? tI * 64 : NCTX + tI * 64; const bool lat = row0 >= NCTX;
        if (!lat && !qgain) continue;
        bf16_t* qp = qbuf + (size_t)row0 * qpitch + hq * 64;
        qk_prep_tile(qp, qpitch, qp, qpitch, qgain, lat, lat ? ((row0 - NCTX) & 8191) : 0, tid);
    }
    __syncthreads();
}

struct AttnArgs {
    const bf16_t* Q; size_t qpitch; const bf16_t* Kc; const bf16_t* VT; bf16_t* O; size_t opitch; int ocol0; int HKV; const float* sink; int swa;
};
__device__ __forceinline__ void attn_unit_v1(const AttnArgs& A, LAS unsigned char* lds, int b, int kvh, int qrow0, int qpos0  ) {
    const int tid = threadIdx.x, lane = tid & 63, wid = tid >> 6, r32 = lane & 31, hh = lane >> 5;
    LAS bf16_t* Kb = (LAS bf16_t*)lds; LAS bf16_t* Vb = Kb + 2 * 64 * LP; LAS bf16_t* Ost = Vb + 2 * 64 * LP + wid * 32 * LP;
    const int head = kvh * 4 + (wid >> 1);
    const int qrow = qrow0 + 32 * (wid & 1) + r32;
    const bf16_t* Kg = A.Kc + ((size_t)b * A.HKV + kvh) * NKEY * 64; const bf16_t* Vg = A.VT + ((size_t)b * A.HKV + kvh) * 64 * NKEY;
    int lt0 = 4, lt1 = 4;
    if (qpos0 >= 0) { if (A.swa) { const int qb = qpos0 >> 6; lt0 = 4 + (qb - 2 < 0 ? 0 : qb - 2); lt1 = 4 + (qb + 3 > 128 ? 128 : qb + 3); } else { lt0 = 4; lt1 = NCH; } }
    const int ntile = 4 + (lt1 - lt0);
    bf16x8 qf[4];
#pragma unroll
    for (int ks = 0; ks < 4; ++ks) qf[ks] = *(const bf16x8*)(A.Q + (size_t)qrow * A.qpitch + head * 64 + ks * 16 + hh * 8);
    f32x16 o0 = F16ZERO, o1 = F16ZERO; float m = -1e30f, l = 0.f;
    const int lr = tid >> 3, lc = (tid & 7) * 8;
    __syncthreads();
    { const int j = 0; *(LAS u32x4*)(Kb + lr * LP + lc) = *(const u32x4*)(Kg + ((size_t)j * 64 + lr) * 64 + lc); *(LAS u32x4*)(Vb + lr * LP + lc) = *(const u32x4*)(Vg + (size_t)lr * NKEY + j * 64 + lc); }
    u32x4 kn = *(const u32x4*)(Kg + ((size_t)1 * 64 + lr) * 64 + lc), vn = *(const u32x4*)(Vg + (size_t)lr * NKEY + 1 * 64 + lc);
    u32x4 kn2 = *(const u32x4*)(Kg + ((size_t)2 * 64 + lr) * 64 + lc), vn2 = *(const u32x4*)(Vg + (size_t)lr * NKEY + 2 * 64 + lc);
    u32x4 kn3 = *(const u32x4*)(Kg + ((size_t)3 * 64 + lr) * 64 + lc), vn3 = *(const u32x4*)(Vg + (size_t)lr * NKEY + 3 * 64 + lc);
    __syncthreads();
    for (int it = 0; it < ntile; ++it) {
        const int cur = it & 1, j = it < 4 ? it : lt0 + (it - 4);
        u32x4 kn4 = kn3, vn4 = vn3; const bool more = it + 1 < ntile;
        if (it + 4 < ntile) { const int jn = lt0 + it; kn4 = *(const u32x4*)(Kg + ((size_t)jn * 64 + lr) * 64 + lc); vn4 = *(const u32x4*)(Vg + (size_t)lr * NKEY + jn * 64 + lc); }
        LAS const bf16_t* Kt = Kb + cur * 64 * LP; LAS const bf16_t* Vt = Vb + cur * 64 * LP;
        f32x16 s0 = F16ZERO, s1 = F16ZERO;
#pragma unroll
        for (int ks = 0; ks < 4; ++ks) {
            const bf16x8 k0 = *(LAS const bf16x8*)(Kt + r32 * LP + ks * 16 + hh * 8), k1 = *(LAS const bf16x8*)(Kt + (32 + r32) * LP + ks * 16 + hh * 8);
            s0 = __builtin_amdgcn_mfma_f32_32x32x16_bf16(k0, qf[ks], s0, 0, 0, 0); s1 = __builtin_amdgcn_mfma_f32_32x32x16_bf16(k1, qf[ks], s1, 0, 0, 0);
        }
        constexpr float SC = 0.125f * 1.4426950408889634f;
        const int dt_ = (j - 4) - (qpos0 >> 6); const bool edge = A.swa && j >= 4 && (dt_ == 2 || dt_ == -2);
        float tmax = -1e30f;
        if (edge) {
#pragma unroll
            for (int r = 0; r < 16; ++r) { float a = s0[r] * SC, c = s1[r] * SC;
                const int kp = (j - 4) * 64 + crow(r, hh), qp = qpos0 + 32 * (wid & 1) + r32; const int d0 = qp - kp, d1 = qp - (kp + 32);
                if (d0 > 128 || d0 < -128) a = -1e30f; if (d1 > 128 || d1 < -128) c = -1e30f;
                s0[r] = a; s1[r] = c; tmax = fmaxf(tmax, fmaxf(a, c)); }
        } else {
#pragma unroll
            for (int r = 0; r < 16; ++r) { const float a = s0[r] * SC, c = s1[r] * SC; s0[r] = a; s1[r] = c; tmax = fmaxf(tmax, fmaxf(a, c)); }
        }
        tmax = fmaxf(tmax, __shfl_xor(tmax, 32));
        if (!__all(tmax <= m)) {
            const float mnew = fmaxf(m, tmax), alpha = __builtin_amdgcn_exp2f(m - mnew);
            l *= alpha; m = mnew;
#pragma unroll
            for (int r = 0; r < 16; ++r) { o0[r] *= alpha; o1[r] *= alpha; }
        }
        float ps = 0.f;
#pragma unroll
        for (int r = 0; r < 16; ++r) { s0[r] = __builtin_amdgcn_exp2f(s0[r] - m); s1[r] = __builtin_amdgcn_exp2f(s1[r] - m); ps += s0[r] + s1[r]; }
        ps += __shfl_xor(ps, 32);
        l += ps;
#pragma unroll
        for (int sub = 0; sub < 2; ++sub)
#pragma unroll
            for (int s2 = 0; s2 < 2; ++s2) {
                const f32x16& sp = sub ? s1 : s0;
                u32x4 pw; pw.x = pg8::cvt_pk_bf16(sp[8 * s2 + 0], sp[8 * s2 + 1]); pw.y = pg8::cvt_pk_bf16(sp[8 * s2 + 2], sp[8 * s2 + 3]); pw.z = pg8::cvt_pk_bf16(sp[8 * s2 + 4], sp[8 * s2 + 5]); pw.w = pg8::cvt_pk_bf16(sp[8 * s2 + 6], sp[8 * s2 + 7]);
                const bf16x8 pf = __builtin_bit_cast(bf16x8, pw);
                const int kof = sub * 32 + s2 * 16 + 4 * hh;
                u32x4 v0w, v1w;
                { const u32x2 a = *(LAS const u32x2*)(Vt + r32 * LP + kof), c = *(LAS const u32x2*)(Vt + r32 * LP + kof + 8); v0w.x = a.x; v0w.y = a.y; v0w.z = c.x; v0w.w = c.y; }
                { const u32x2 a = *(LAS const u32x2*)(Vt + (32 + r32) * LP + kof), c = *(LAS const u32x2*)(Vt + (32 + r32) * LP + kof + 8); v1w.x = a.x; v1w.y = a.y; v1w.z = c.x; v1w.w = c.y; }
                o0 = __builtin_amdgcn_mfma_f32_32x32x16_bf16(__builtin_bit_cast(bf16x8, v0w), pf, o0, 0, 0, 0);
                o1 = __builtin_amdgcn_mfma_f32_32x32x16_bf16(__builtin_bit_cast(bf16x8, v1w), pf, o1, 0, 0, 0);
            }
        if (more) { *(LAS u32x4*)(Kb + (cur ^ 1) * 64 * LP + lr * LP + lc) = kn; *(LAS u32x4*)(Vb + (cur ^ 1) * 64 * LP + lr * LP + lc) = vn; }
        kn = kn2; vn = vn2; kn2 = kn3; vn2 = vn3; kn3 = kn4; vn3 = vn4;
        __syncthreads();
    }
    if (A.sink) l += __builtin_amdgcn_exp2f(A.sink[head] * 1.4426950408889634f - m);
    const float inv = 1.f / l;
#pragma unroll
    for (int r = 0; r < 16; ++r) { Ost[r32 * LP + crow(r, hh)] = (bf16_t)f2bf(o0[r] * inv); Ost[r32 * LP + 32 + crow(r, hh)] = (bf16_t)f2bf(o1[r] * inv); }
    asm volatile("s_waitcnt lgkmcnt(0)" ::: "memory");
#pragma unroll
    for (int p = 0; p < 4; ++p) { const int q = p * 8 + (lane >> 3), d8 = (lane & 7) * 8;
        u32x4 ov = *(LAS const u32x4*)(Ost + q * LP + d8); if ((DBG_SKIP & 2) && A.swa) ov = (u32x4){0u, 0u, 0u, 0u}; if ((DBG_SKIP & 16) && !A.swa) ov = (u32x4){0u, 0u, 0u, 0u};
        *(u32x2*)((unsigned char*)A.O + (size_t)(qrow0 + 32 * (wid & 1) + q) * A.opitch + A.ocol0 + (wid >> 1) * 64 + kvh * 256 + d8) = bf8_to_fp8(ov); }
}
__device__ __forceinline__ float xor32_max(float v) { float a = v, b = v; asm volatile("v_nop\n\tv_nop\n\tv_permlane32_swap_b32 %0, %1\n\tv_nop\n\tv_nop" : "+v"(a), "+v"(b)); return fmaxf(a, b); }
__device__ __forceinline__ float xor32_sum(float v) { float a = v, b = v; asm volatile("v_nop\n\tv_nop\n\tv_permlane32_swap_b32 %0, %1\n\tv_nop\n\tv_nop" : "+v"(a), "+v"(b)); return a + b; }
template <int NG>
__device__ __forceinline__ void attn_unit(const AttnArgs& A, LAS unsigned char* lds, int b, int kvh, int qrow0, int qpos0  ) {
    const int tid = threadIdx.x, lane = tid & 63, wid = tid >> 6, r32 = lane & 31, hh = lane >> 5;
    constexpr int RW = 32 * NG;
    constexpr float CS2 = 0.125f * 1.4426950408889634f;
    LAS bf16_t* Kb = (LAS bf16_t*)lds; LAS bf16_t* Vb = Kb + 2 * 64 * LP; LAS bf16_t* Ost = Vb + 2 * 64 * LP + wid * RW * LP;
    const int head = kvh * 4 + (wid >> 1);
    const int wrow0 = qrow0 + RW * (wid & 1);
    const bf16_t* Kg = A.Kc + ((size_t)b * A.HKV + kvh) * NKEY * 64; const bf16_t* Vg = A.VT + ((size_t)b * A.HKV + kvh) * 64 * NKEY;
    int lt0 = 4, lt1 = 4;
    if (qpos0 >= 0) { if (A.swa) { const int k0 = qpos0 - 128, k1 = qpos0 + 64 * NG + 128; lt0 = 4 + (k0 < 0 ? 0 : k0 >> 6); lt1 = 4 + (k1 > SEQ ? SEQ >> 6 : k1 >> 6); } else { lt0 = 4; lt1 = NCH; } }
    const int ntile = 4 + (lt1 - lt0);
    bf16x8 qf[NG][4];
#pragma unroll
    for (int g = 0; g < NG; ++g)
#pragma unroll
        for (int ks = 0; ks < 4; ++ks) qf[g][ks] = *(const bf16x8*)(A.Q + (size_t)(wrow0 + 32 * g + r32) * A.qpitch + head * 64 + ks * 16 + hh * 8);
    f32x16 o[NG][2]; float m[NG], l[NG];
#pragma unroll
    for (int g = 0; g < NG; ++g) { o[g][0] = F16ZERO; o[g][1] = F16ZERO; m[g] = -1e30f; l[g] = 0.f; }
    const int lr = tid >> 3, lc = (tid & 7) * 8;
    __syncthreads();
    { *(LAS u32x4*)(Kb + lr * LP + lc) = *(const u32x4*)(Kg + (size_t)lr * 64 + lc); *(LAS u32x4*)(Vb + lr * LP + lc) = *(const u32x4*)(Vg + (size_t)lr * NKEY + lc); }
    __syncthreads();
    for (int it = 0; it < ntile; ++it) {
        const int cur = it & 1, j = it < 4 ? it : lt0 + (it - 4);
        u32x4 kn, vn; const bool more = it + 1 < ntile;
        if (more) { const int jn = (it + 1) < 4 ? it + 1 : lt0 + (it + 1 - 4); kn = *(const u32x4*)(Kg + ((size_t)jn * 64 + lr) * 64 + lc); vn = *(const u32x4*)(Vg + (size_t)lr * NKEY + jn * 64 + lc); }
        LAS const bf16_t* Kt = Kb + cur * 64 * LP; LAS const bf16_t* Vt = Vb + cur * 64 * LP;
        f32x16 s[NG][2];
#pragma unroll
        for (int g = 0; g < NG; ++g) { s[g][0] = F16ZERO; s[g][1] = F16ZERO; }
#pragma unroll
        for (int ks = 0; ks < 4; ++ks) {
            const bf16x8 k0 = *(LAS const bf16x8*)(Kt + r32 * LP + ks * 16 + hh * 8), k1 = *(LAS const bf16x8*)(Kt + (32 + r32) * LP + ks * 16 + hh * 8);
#pragma unroll
            for (int g = 0; g < NG; ++g) { s[g][0] = __builtin_amdgcn_mfma_f32_32x32x16_bf16(k0, qf[g][ks], s[g][0], 0, 0, 0); s[g][1] = __builtin_amdgcn_mfma_f32_32x32x16_bf16(k1, qf[g][ks], s[g][1], 0, 0, 0); }
        }
        const bool masked = A.swa && j >= 4;
#pragma unroll
        for (int g = 0; g < NG; ++g) {
            float tmax = -1e30f;
            const int qp = qpos0 + RW * (wid & 1) + 32 * g + r32, kb0 = (j - 4) * 64;
#pragma unroll
            for (int r = 0; r < 16; ++r) { float a = s[g][0][r], c = s[g][1][r];
                if (masked) { const int d0 = qp - (kb0 + crow(r, hh)), d1 = d0 - 32; if (d0 > 128 || d0 < -128) a = -1e30f; if (d1 > 128 || d1 < -128) c = -1e30f; }
                s[g][0][r] = a; s[g][1][r] = c; tmax = fmaxf(tmax, fmaxf(a, c)); }
            tmax = xor32_max(tmax);
            const bool keep = __all((tmax - m[g]) * CS2 <= 8.f);
            if (!keep) { const float mnew = fmaxf(m[g], tmax), alpha = __builtin_amdgcn_exp2f((m[g] - mnew) * CS2);
                l[g] *= alpha; m[g] = mnew;
#pragma unroll
                for (int r = 0; r < 16; ++r) { o[g][0][r] *= alpha; o[g][1][r] *= alpha; } }
            const float mc = m[g] * CS2;
            float ps = 0.f;
#pragma unroll
            for (int r = 0; r < 16; ++r) { const float p0 = __builtin_amdgcn_exp2f(s[g][0][r] * CS2 - mc), p1 = __builtin_amdgcn_exp2f(s[g][1][r] * CS2 - mc); s[g][0][r] = p0; s[g][1][r] = p1; ps += p0 + p1; }
            l[g] += ps;
        }
#pragma unroll
        for (int sub = 0; sub < 2; ++sub)
#pragma unroll
            for (int s2 = 0; s2 < 2; ++s2) {
                const int kof = sub * 32 + s2 * 16 + 4 * hh;
                u32x4 v0w, v1w;
                { const u32x2 a = *(LAS const u32x2*)(Vt + r32 * LP + kof), c = *(LAS const u32x2*)(Vt + r32 * LP + kof + 8); v0w.x = a.x; v0w.y = a.y; v0w.z = c.x; v0w.w = c.y; }
                { const u32x2 a = *(LAS const u32x2*)(Vt + (32 + r32) * LP + kof), c = *(LAS const u32x2*)(Vt + (32 + r32) * LP + kof + 8); v1w.x = a.x; v1w.y = a.y; v1w.z = c.x; v1w.w = c.y; }
#pragma unroll
                for (int g = 0; g < NG; ++g) {
                    const f32x16& sp = s[g][sub];
                    u32x4 pw; pw.x = pg8::cvt_pk_bf16(sp[8 * s2 + 0], sp[8 * s2 + 1]); pw.y = pg8::cvt_pk_bf16(sp[8 * s2 + 2], sp[8 * s2 + 3]); pw.z = pg8::cvt_pk_bf16(sp[8 * s2 + 4], sp[8 * s2 + 5]); pw.w = pg8::cvt_pk_bf16(sp[8 * s2 + 6], sp[8 * s2 + 7]);
                    const bf16x8 pf = __builtin_bit_cast(bf16x8, pw);
                    o[g][0] = __builtin_amdgcn_mfma_f32_32x32x16_bf16(__builtin_bit_cast(bf16x8, v0w), pf, o[g][0], 0, 0, 0);
                    o[g][1] = __builtin_amdgcn_mfma_f32_32x32x16_bf16(__builtin_bit_cast(bf16x8, v1w), pf, o[g][1], 0, 0, 0);
                }
            }
        if (more) { *(LAS u32x4*)(Kb + (cur ^ 1) * 64 * LP + lr * LP + lc) = kn; *(LAS u32x4*)(Vb + (cur ^ 1) * 64 * LP + lr * LP + lc) = vn; }
        __syncthreads();
    }
#pragma unroll
    for (int g = 0; g < NG; ++g) {
        float lt = xor32_sum(l[g]);
        if (A.sink) lt += __builtin_amdgcn_exp2f(A.sink[head] * 1.4426950408889634f - m[g] * CS2);
        const float inv = 1.f / lt;
#pragma unroll
        for (int r = 0; r < 16; ++r) { Ost[(32 * g + r32) * LP + crow(r, hh)] = (bf16_t)f2bf(o[g][0][r] * inv); Ost[(32 * g + r32) * LP + 32 + crow(r, hh)] = (bf16_t)f2bf(o[g][1][r] * inv); }
    }
    asm volatile("s_waitcnt lgkmcnt(0)" ::: "memory");
#pragma unroll
    for (int p = 0; p < 4 * NG; ++p) { const int q = p * 8 + (lane >> 3), d8 = (lane & 7) * 8;
        u32x4 ov = *(LAS const u32x4*)(Ost + q * LP + d8); if ((DBG_SKIP & 2) && A.swa) ov = (u32x4){0u, 0u, 0u, 0u}; if ((DBG_SKIP & 16) && !A.swa) ov = (u32x4){0u, 0u, 0u, 0u};
        *(u32x2*)((unsigned char*)A.O + (size_t)(wrow0 + q) * A.opitch + A.ocol0 + (wid >> 1) * 64 + kvh * 256 + d8) = bf8_to_fp8(ov); }
}
#define ATT_BAR() do { asm volatile("s_waitcnt lgkmcnt(0)" ::: "memory"); __builtin_amdgcn_s_barrier(); asm volatile("" ::: "memory"); } while (0)
__device__ __forceinline__ void attn_unit_ph(const AttnArgs& A, LAS unsigned char* lds, int b, int kvh, int qrow0) {
    constexpr int NG = 2, RW = 64;
    constexpr float CS2 = 0.125f * 1.4426950408889634f;
    const int tid = threadIdx.x, lane = tid & 63, wid = tid >> 6, r32 = lane & 31, hh = lane >> 5, half = wid & 1;
    const int hl = wid >> 1, rh = wid & 1;
    LAS bf16_t* Kb = (LAS bf16_t*)lds; LAS bf16_t* Vb = Kb + 2 * 64 * LP; LAS bf16_t* Ost = Vb + 2 * 64 * LP + wid * RW * LP;
    const int head = kvh * 4 + hl;
    const int wrow0 = qrow0 + RW * rh;
    const bf16_t* Kg = A.Kc + ((size_t)b * A.HKV + kvh) * NKEY * 64; const bf16_t* Vg = A.VT + ((size_t)b * A.HKV + kvh) * 64 * NKEY;
    int ntile = NCH; asm volatile("" : "+s"(ntile));
    bf16x8 qf[NG][4];
#pragma unroll
    for (int g = 0; g < NG; ++g)
#pragma unroll
        for (int ks = 0; ks < 4; ++ks) qf[g][ks] = *(const bf16x8*)(A.Q + (size_t)(wrow0 + 32 * g + r32) * A.qpitch + head * 64 + ks * 16 + hh * 8);
    f32x16 o[NG][2]; float m[NG], l[NG];
#pragma unroll
    for (int g = 0; g < NG; ++g) { o[g][0] = F16ZERO; o[g][1] = F16ZERO; m[g] = -1e30f; l[g] = 0.f; }
    const int lr = tid >> 3, lc = (tid & 7) * 8;
    u32x4 kn, vn;
#define ATT_LOAD(J) do { kn = *(const u32x4*)(Kg + ((size_t)(J) * 64 + lr) * 64 + lc); vn = *(const u32x4*)(Vg + (size_t)lr * NKEY + (J) * 64 + lc); } while (0)
#define ATT_WRITE(J) do { *(LAS u32x4*)(Kb + ((J) & 1) * 64 * LP + lr * LP + lc) = kn; *(LAS u32x4*)(Vb + ((J) & 1) * 64 * LP + lr * LP + lc) = vn; } while (0)
    __syncthreads();
    ATT_LOAD(0); ATT_WRITE(0); ATT_LOAD(1); ATT_WRITE(1); ATT_LOAD(2);
    ATT_BAR();
    if (half == 1) ATT_BAR();
#pragma unroll 1
    for (int t = 0; t < ntile; ++t) {
        LAS const bf16_t* Kt = Kb + (t & 1) * 64 * LP; LAS const bf16_t* Vt = Vb + (t & 1) * 64 * LP;
        if (half == 1 && t >= 1 && t + 1 < ntile) { ATT_WRITE(t + 1); if (t + 2 < ntile) ATT_LOAD(t + 2); }
        f32x16 s[NG][2];
#pragma unroll
        for (int g = 0; g < NG; ++g) { s[g][0] = F16ZERO; s[g][1] = F16ZERO; }
#pragma unroll
        for (int ks = 0; ks < 4; ++ks) {
            const bf16x8 k0 = *(LAS const bf16x8*)(Kt + r32 * LP + ks * 16 + hh * 8), k1 = *(LAS const bf16x8*)(Kt + (32 + r32) * LP + ks * 16 + hh * 8);
#pragma unroll
            for (int g = 0; g < NG; ++g) { s[g][0] = __builtin_amdgcn_mfma_f32_32x32x16_bf16(k0, qf[g][ks], s[g][0], 0, 0, 0); s[g][1] = __builtin_amdgcn_mfma_f32_32x32x16_bf16(k1, qf[g][ks], s[g][1], 0, 0, 0); }
        }
        ATT_BAR();
        if (half == 0 && t >= 1 && t + 1 < ntile) { ATT_WRITE(t + 1); if (t + 2 < ntile) ATT_LOAD(t + 2); }
#pragma unroll
        for (int g = 0; g < NG; ++g) {
            float tmax = -1e30f;
#pragma unroll
            for (int r = 0; r < 16; ++r) tmax = fmaxf(tmax, fmaxf(s[g][0][r], s[g][1][r]));
            tmax = fmaxf(tmax, __shfl_xor(tmax, 32));
            const float mnew = fmaxf(m[g], tmax), alpha = __builtin_amdgcn_exp2f((m[g] - mnew) * CS2), mc = mnew * CS2;
            float ps = 0.f;
#pragma unroll
            for (int r = 0; r < 16; ++r) { const float p0 = __builtin_amdgcn_exp2f(s[g][0][r] * CS2 - mc), p1 = __builtin_amdgcn_exp2f(s[g][1][r] * CS2 - mc); s[g][0][r] = p0; s[g][1][r] = p1; ps += p0 + p1; }
            ps += __shfl_xor(ps, 32);
            l[g] = l[g] * alpha + ps; m[g] = mnew;
#pragma unroll
            for (int r = 0; r < 16; ++r) { o[g][0][r] *= alpha; o[g][1][r] *= alpha; }
        }
#pragma unroll
        for (int sub = 0; sub < 2; ++sub)
#pragma unroll
            for (int s2 = 0; s2 < 2; ++s2) {
                const int kof = sub * 32 + s2 * 16 + 4 * hh;
                u32x4 v0w, v1w;
                { const u32x2 a = *(LAS const u32x2*)(Vt + r32 * LP + kof), c = *(LAS const u32x2*)(Vt + r32 * LP + kof + 8); v0w.x = a.x; v0w.y = a.y; v0w.z = c.x; v0w.w = c.y; }
                { const u32x2 a = *(LAS const u32x2*)(Vt + (32 + r32) * LP + kof), c = *(LAS const u32x2*)(Vt + (32 + r32) * LP + kof + 8); v1w.x = a.x; v1w.y = a.y; v1w.z = c.x; v1w.w = c.y; }
#pragma unroll
                for (int g = 0; g < NG; ++g) {
                    const f32x16& sp = s[g][sub];
                    u32x4 pw; pw.x = pg8::cvt_pk_bf16(sp[8 * s2 + 0], sp[8 * s2 + 1]); pw.y = pg8::cvt_pk_bf16(sp[8 * s2 + 2], sp[8 * s2 + 3]); pw.z = pg8::cvt_pk_bf16(sp[8 * s2 + 4], sp[8 * s2 + 5]); pw.w = pg8::cvt_pk_bf16(sp[8 * s2 + 6], sp[8 * s2 + 7]);
                    const bf16x8 pf = __builtin_bit_cast(bf16x8, pw);
                    o[g][0] = __builtin_amdgcn_mfma_f32_32x32x16_bf16(__builtin_bit_cast(bf16x8, v0w), pf, o[g][0], 0, 0, 0);
                    o[g][1] = __builtin_amdgcn_mfma_f32_32x32x16_bf16(__builtin_bit_cast(bf16x8, v1w), pf, o[g][1], 0, 0, 0);
                }
            }
        ATT_BAR();
    }
    if (half == 0) ATT_BAR();
#undef ATT_LOAD
#undef ATT_WRITE
#pragma unroll
    for (int g = 0; g < NG; ++g) {
        const float inv = 1.f / l[g];
#pragma unroll
        for (int r = 0; r < 16; ++r) { Ost[(32 * g + r32) * LP + crow(r, hh)] = (bf16_t)f2bf(o[g][0][r] * inv); Ost[(32 * g + r32) * LP + 32 + crow(r, hh)] = (bf16_t)f2bf(o[g][1][r] * inv); }
    }
    asm volatile("s_waitcnt lgkmcnt(0)" ::: "memory");
#pragma unroll
    for (int p = 0; p < 4 * NG; ++p) { const int q = p * 8 + (lane >> 3), d8 = (lane & 7) * 8;
        *(u32x2*)((unsigned char*)A.O + (size_t)(wrow0 + q) * A.opitch + A.ocol0 + hl * 64 + kvh * 256 + d8) = bf8_to_fp8(*(LAS const u32x4*)(Ost + q * LP + d8)); }
}
__device__ __forceinline__ void phase_attention_dense(const AttnArgs& A, LAS unsigned char* lds, LAS unsigned char* misc, unsigned* qword) {
    constexpr int QR = 128, NQB = SEQ / QR;
    const int nlat = NB * A.HKV * NQB;
    LAS int* slot = (LAS int*)(misc + 32);
    for (;;) {
        __syncthreads();
        if (threadIdx.x == 0) *slot = (int)atomicAdd(qword, 1u);
        __syncthreads();
        const int u = *slot;
        if (u >= nlat) break;
        const int qb = u % NQB, kvh = (u / NQB) % A.HKV, b = u / (NQB * A.HKV);
        attn_unit_ph(A, lds, b, kvh, NCTX + b * 8192 + qb * QR);
    }
    __syncthreads();
}
template <int NG>
__device__ __forceinline__ void phase_attention(const AttnArgs& A, LAS unsigned char* lds, LAS unsigned char* misc, unsigned* qword, bool ctx_q) {
    constexpr int QR = 64 * NG, NQB = SEQ / QR, NCB = CTXL / QR;
    const int nlat = NB * A.HKV * NQB, nctx = ctx_q ? NB * A.HKV * NCB : 0;
    LAS int* slot = (LAS int*)(misc + 32);
    for (;;) {
        __syncthreads();
        if (threadIdx.x == 0) *slot = (int)atomicAdd(qword, 1u);
        __syncthreads();
        const int u = *slot;
        if (u >= nlat + nctx) break;
        if (u < nlat) { const int qb = u % NQB, kvh = (u / NQB) % A.HKV, b = u / (NQB * A.HKV); attn_unit<NG>(A, lds, b, kvh, NCTX + b * 8192 + qb * QR, qb * QR); }
        else { const int v = u - nlat, qb = v % NCB, kvh = (v / NCB) % A.HKV, b = v / (NCB * A.HKV); attn_unit<NG>(A, lds, b, kvh, b * 256 + qb * QR, -1); }
    }
    __syncthreads();
}

__device__ __forceinline__ void phase_attention_v1(const AttnArgs& A, LAS unsigned char* lds, LAS unsigned char* misc, unsigned* qword, bool ctx_q) {
    const int nlat = NB * A.HKV * 128, nctx = ctx_q ? NB * A.HKV * 4 : 0;
    LAS int* slot = (LAS int*)(misc + 32);
    for (;;) {
        __syncthreads();
        if (threadIdx.x == 0) *slot = (int)atomicAdd(qword, 1u);
        __syncthreads();
        const int u = *slot;
        if (u >= nlat + nctx) break;
        if (u < nlat) { const int qb = u & 127, kvh = (u >> 7) % A.HKV, b = u / (128 * A.HKV); attn_unit_v1(A, lds, b, kvh, NCTX + b * 8192 + qb * 64, qb * 64); }
        else { const int v = u - nlat, qb = v & 3, kvh = (v >> 2) % A.HKV, b = v / (4 * A.HKV); attn_unit_v1(A, lds, b, kvh, b * 256 + qb * 64, -1); }
    }
    __syncthreads();
}


__device__ __forceinline__ void qk_load_tile8(const bf16_t* src, size_t spitch, int tid, u32x2& w1, u32x2& w2) {
    const int r = tid >> 3, q = tid & 7, i0 = (q & 3) * 4, d1 = (q >> 2) * 32 + i0, d2 = d1 + 16;
    w1 = *(const u32x2*)(src + (size_t)r * spitch + d1); w2 = *(const u32x2*)(src + (size_t)r * spitch + d2);
}
__device__ __forceinline__ void qk_finish_tile8(const u32x2 w1, const u32x2 w2, unsigned char* dst, size_t dpitch, const float* gain, bool rope, int pos0, int tid, float oscale) {
    const int r = tid >> 3, q = tid & 7, i0 = (q & 3) * 4, d1 = (q >> 2) * 32 + i0, d2 = d1 + 16;
    float a[4] = {bflo(w1.x), bfhi(w1.x), bflo(w1.y), bfhi(w1.y)}, c[4] = {bflo(w2.x), bfhi(w2.x), bflo(w2.y), bfhi(w2.y)};
    float ss = 0.f;
#pragma unroll
    for (int i = 0; i < 4; ++i) ss += a[i] * a[i] + c[i] * c[i];
    ss += __shfl_xor(ss, 1); ss += __shfl_xor(ss, 2); ss += __shfl_xor(ss, 4);
    const float rstd = rsqrtf(ss * (1.f / 64.f) + 1e-6f);
#pragma unroll
    for (int i = 0; i < 4; ++i) { a[i] = a[i] * rstd * gain[d1 + i]; c[i] = c[i] * rstd * gain[d2 + i]; }
    if (rope) {
        const int pos = pos0 + r; const float pc = (float)((q >> 2) ? (pos & 63) : (pos >> 6));
#pragma unroll
        for (int i = 0; i < 4; ++i) { const float inv = exp2f(-(float)(i0 + i) * (13.287712379549449f / 16.f)); float sn, cs; __sincosf(pc * inv, &sn, &cs);
            const float t1 = a[i], t2 = c[i]; a[i] = t1 * cs - t2 * sn; c[i] = t2 * cs + t1 * sn; }
    }
    *(unsigned*)(dst + (size_t)r * dpitch + d1) = pk4_fp8(a[0] * oscale, a[1] * oscale, a[2] * oscale, a[3] * oscale); *(unsigned*)(dst + (size_t)r * dpitch + d2) = pk4_fp8(c[0] * oscale, c[1] * oscale, c[2] * oscale, c[3] * oscale);
}
__device__ __forceinline__ void qk_prep_tile8(const bf16_t* src, size_t spitch, unsigned char* dst, size_t dpitch, const float* gain, bool rope, int pos0, int tid, float oscale) {
    u32x2 w1, w2; qk_load_tile8(src, spitch, tid, w1, w2); qk_finish_tile8(w1, w2, dst, dpitch, gain, rope, pos0, tid, oscale);
}
__device__ __forceinline__ void phase_qkv_prep8(unsigned char* ws, LAS unsigned char* lds, const float* qgain, const float* kgain) {
    const int tid = threadIdx.x; unsigned char* R = ws + WS_R;
    const bf16_t* kv = (const bf16_t*)(R + R_KV1); const bf16_t* q1 = (const bf16_t*)(R + R_Q1);
    unsigned char* K8 = R + R_K8; unsigned char* VT8 = R + R_VT8; unsigned char* Q8 = R + R_Q8;
    LAS bf16_t* tl = (LAS bf16_t*)lds;
    for (int u = blockIdx.x; u < NB * 3 * NCH; u += gridDim.x) {
        const int j = u % NCH, kvh = (u / NCH) % 3, b = u / (NCH * 3);
        const int row0 = j < 4 ? b * 256 + j * 64 : NCTX + b * 8192 + (j - 4) * 64;
        const size_t key0 = (size_t)j * 64;
        qk_prep_tile8(kv + (size_t)row0 * 384 + kvh * 64, 384, K8 + (((size_t)b * 3 + kvh) * NKEY + key0) * 64, 64, kgain, j >= 4, (j - 4) * 64, tid, 0.25f);
        __syncthreads();
        { const int r = tid >> 3, c8 = (tid & 7) * 8; *(LAS u32x4*)(tl + r * LP + c8) = *(const u32x4*)(kv + (size_t)(row0 + r) * 384 + 192 + kvh * 64 + c8); }
        __syncthreads();
        { const int dv = tid >> 3, p8 = (tid & 7) * 8, hh = p8 >> 5, sub = (p8 >> 4) & 1, ka = 32 * sub + 4 * hh + ((p8 & 8) ? 16 : 0);
          u32x2 w;
          w.x = pk4_fp8(bf2f(tl[(ka + 0) * LP + dv]), bf2f(tl[(ka + 1) * LP + dv]), bf2f(tl[(ka + 2) * LP + dv]), bf2f(tl[(ka + 3) * LP + dv]));
          w.y = pk4_fp8(bf2f(tl[(ka + 8) * LP + dv]), bf2f(tl[(ka + 9) * LP + dv]), bf2f(tl[(ka + 10) * LP + dv]), bf2f(tl[(ka + 11) * LP + dv]));
          *(u32x2*)(VT8 + (((size_t)b * 3 + kvh) * 64 + dv) * NKEY + key0 + p8) = w; }
    }
    const int skipq = gridDim.x == 256 ? 80 : 0, gq_ = (int)gridDim.x - skipq;
    for (int u0 = (int)blockIdx.x - skipq; u0 >= 0 && u0 < (NLAT / 64) * 12; u0 += 4 * gq_) {
        u32x2 w1[4], w2[4];
#pragma unroll
        for (int k = 0; k < 4; ++k) { const int u = u0 + k * gq_; if (u < (NLAT / 64) * 12) { const int hq = u % 12, tI = u / 12; qk_load_tile8(q1 + (size_t)(NCTX + tI * 64) * 768 + hq * 64, 768, tid, w1[k], w2[k]); } }
#pragma unroll
        for (int k = 0; k < 4; ++k) { const int u = u0 + k * gq_; if (u < (NLAT / 64) * 12) { const int hq = u % 12, tI = u / 12; const int lrow0 = tI * 64;
            qk_finish_tile8(w1[k], w2[k], Q8 + (size_t)lrow0 * 768 + hq * 64, 768, qgain, true, lrow0 & 8191, tid, 4.f * 0.125f * 1.4426950408889634f); } }
    }
    __syncthreads();
}
__device__ __forceinline__ void mfma8_acc(f32x16& acc, const i32x8& a, const i32x8& b, int sc) {
    asm volatile("s_nop 1\n\tv_mfma_scale_f32_32x32x64_f8f6f4 %0, %1, %2, %0, %3, %3 op_sel_hi:[0,0,0]" : "+v"(acc) : "v"(a), "v"(b), "v"(sc));
}
__device__ __forceinline__ void mfma8_z(f32x16& out, const i32x8& a, const i32x8& b, int sc) {
    asm volatile("s_nop 1\n\tv_mfma_scale_f32_32x32x64_f8f6f4 %0, %1, %2, 0, %3, %3 op_sel_hi:[0,0,0]" : "=&v"(out) : "v"(a), "v"(b), "v"(sc));
}
__device__ __forceinline__ void mfma8_c(f32x16& out, const i32x8& a, const i32x8& b, const f32x16& c, int sc) {
    asm volatile("s_nop 1\n\tv_mfma_scale_f32_32x32x64_f8f6f4 %0, %1, %2, %3, %4, %4 op_sel_hi:[0,0,0]" : "=&v"(out) : "v"(a), "v"(b), "v"(c), "v"(sc));
}
__device__ __forceinline__ float max3_(float a, float b, float c) { float r; asm("v_max3_f32 %0, %1, %2, %3" : "=v"(r) : "v"(a), "v"(b), "v"(c)); return r; }
__device__ __forceinline__ i32x8 lds_frag8(LAS const unsigned char* p) { const u32x4 a = *(LAS const u32x4*)p, b = *(LAS const u32x4*)(p + 16); return __builtin_bit_cast(i32x8, __builtin_shufflevector(a, b, 0, 1, 2, 3, 4, 5, 6, 7)); }
constexpr int LP8 = 80;
__device__ __forceinline__ void attn_unit8(unsigned char* R, bf16_t* O, LAS unsigned char* lds, int b, int kvh, int lrow0  , const bool SREF, const float mref) {
    constexpr float CS2 = 0.125f * 1.4426950408889634f;
    const int tid = threadIdx.x, lane = tid & 63, wid = tid >> 6, r32 = lane & 31, hh = lane >> 5; const int sc = 0x7F7F7F7F;
    LAS unsigned char* Kb = lds; LAS unsigned char* Vb = lds + 2 * 64 * LP8; LAS bf16_t* Ost = (LAS bf16_t*)(lds + 4 * 64 * LP8) + wid * 64 * LP;
    const int head = kvh * 4 + (wid >> 1), wrow0 = lrow0 + 64 * (wid & 1);
    const unsigned char* Kg = R + R_K8 + ((size_t)b * 3 + kvh) * NKEY * 64; const unsigned char* Vg = R + R_VT8 + ((size_t)b * 3 + kvh) * 64 * NKEY; const unsigned char* Qg = R + R_Q8;
    i32x8 qf[2];
#pragma unroll
    for (int g = 0; g < 2; ++g) { const unsigned char* qp = Qg + (size_t)(wrow0 + 32 * g + r32) * 768 + head * 64 + 32 * hh; const u32x4 a = *(const u32x4*)qp, c = *(const u32x4*)(qp + 16);
        qf[g] = __builtin_bit_cast(i32x8, __builtin_shufflevector(a, c, 0, 1, 2, 3, 4, 5, 6, 7)); }
    f32x16 o[2][2]; const f32x16 cref = F16ZERO - mref; f32x2 l2[2]; float mrun[2] = {0.f, 0.f};
#pragma unroll
    for (int g = 0; g < 2; ++g) { o[g][0] = F16ZERO; o[g][1] = F16ZERO; l2[g] = (f32x2){0.f, 0.f}; }
    const int st = tid & 255, srow = st >> 2, spc = (st & 3) * 16; const bool isv = tid >= 256;
    const unsigned char* gsrc = isv ? Vg + (size_t)srow * NKEY + spc : Kg + (size_t)srow * 64 + spc; const size_t gstep = isv ? 64 : 64 * 64;
    LAS unsigned char* ldst = (isv ? Vb : Kb) + srow * LP8 + spc;
    int ntile = NCH; asm volatile("" : "+s"(ntile));
    __syncthreads();
    *(LAS u32x4*)ldst = *(const u32x4*)gsrc;
    u32x4 pre0 = *(const u32x4*)(gsrc + gstep);
    __syncthreads();
#pragma unroll 1
    for (int it = 0; it < ntile; ++it) {
        const int cur = it & 1; const bool more = it + 1 < ntile;
        u32x4 pre1 = pre0; if (it + 2 < ntile) pre1 = *(const u32x4*)(gsrc + (size_t)(it + 2) * gstep);
        LAS const unsigned char* Kt = Kb + cur * 64 * LP8; LAS const unsigned char* Vt = Vb + cur * 64 * LP8;
        const i32x8 k0 = lds_frag8(Kt + r32 * LP8 + 32 * hh), k1 = lds_frag8(Kt + (32 + r32) * LP8 + 32 * hh);
        f32x16 s[2][2];
        mfma8_c(s[0][0], k0, qf[0], cref, sc); mfma8_c(s[0][1], k1, qf[0], cref, sc); mfma8_c(s[1][0], k0, qf[1], cref, sc); mfma8_c(s[1][1], k1, qf[1], cref, sc);
        asm volatile("s_nop 15\n\ts_nop 7" : "+v"(s[0][0]), "+v"(s[0][1]), "+v"(s[1][0]), "+v"(s[1][1]));
        const i32x8 v0 = lds_frag8(Vt + r32 * LP8 + 32 * hh), v1 = lds_frag8(Vt + (32 + r32) * LP8 + 32 * hh);
#pragma unroll
        for (int g = 0; g < 2; ++g) {
            if (!SREF) {
                float tmax = -3.0e38f;
#pragma unroll
                for (int r = 0; r < 16; ++r) tmax = max3_(tmax, s[g][0][r], s[g][1][r]);
                tmax = xor32_max(tmax);
                if (it == 0 || !__all(tmax <= mrun[g] + 8.f)) { const float mnew = it == 0 ? tmax : fmaxf(tmax, mrun[g]), alpha = it == 0 ? 1.f : __builtin_amdgcn_exp2f(mrun[g] - mnew);
                    l2[g] = l2[g] * alpha; o[g][0] = o[g][0] * alpha; o[g][1] = o[g][1] * alpha; mrun[g] = mnew; }
                s[g][0] = s[g][0] - mrun[g]; s[g][1] = s[g][1] - mrun[g];
            }
            unsigned pw[8];
#pragma unroll
            for (int q4 = 0; q4 < 4; ++q4) {
                float p0[4], p1[4];
#pragma unroll
                for (int e = 0; e < 4; ++e) { p0[e] = __builtin_amdgcn_exp2f(s[g][0][4 * q4 + e]); p1[e] = __builtin_amdgcn_exp2f(s[g][1][4 * q4 + e]); }
                l2[g] = l2[g] + (f32x2){p0[0], p0[1]}; l2[g] = l2[g] + (f32x2){p0[2], p0[3]}; l2[g] = l2[g] + (f32x2){p1[0], p1[1]}; l2[g] = l2[g] + (f32x2){p1[2], p1[3]};
                int w0 = 0, w1 = 0;
                w0 = __builtin_amdgcn_cvt_pk_fp8_f32(p0[0], p0[1], w0, false); w0 = __builtin_amdgcn_cvt_pk_fp8_f32(p0[2], p0[3], w0, true);
                w1 = __builtin_amdgcn_cvt_pk_fp8_f32(p1[0], p1[1], w1, false); w1 = __builtin_amdgcn_cvt_pk_fp8_f32(p1[2], p1[3], w1, true);
                pw[q4] = (unsigned)w0; pw[4 + q4] = (unsigned)w1; }
            const i32x8 pf = (i32x8){(int)pw[0], (int)pw[1], (int)pw[2], (int)pw[3], (int)pw[4], (int)pw[5], (int)pw[6], (int)pw[7]};
            mfma8_acc(o[g][0], v0, pf, sc); mfma8_acc(o[g][1], v1, pf, sc);
        }
        if (more) *(LAS u32x4*)(ldst + (cur ^ 1) * 64 * LP8) = pre0;
        pre0 = pre1;
        __syncthreads();
    }
    asm volatile("s_nop 15\n\ts_nop 7" : "+v"(o[0][0]), "+v"(o[0][1]), "+v"(o[1][0]), "+v"(o[1][1]));
#pragma unroll
    for (int g = 0; g < 2; ++g) {
        const float inv = 1.f / xor32_sum(l2[g][0] + l2[g][1]);
#pragma unroll
        for (int r = 0; r < 16; ++r) { Ost[(32 * g + r32) * LP + crow(r, hh)] = (bf16_t)f2bf(o[g][0][r] * inv); Ost[(32 * g + r32) * LP + 32 + crow(r, hh)] = (bf16_t)f2bf(o[g][1][r] * inv); }
    }
    asm volatile("s_waitcnt lgkmcnt(0)" ::: "memory");
#pragma unroll
    for (int p = 0; p < 8; ++p) { const int q = p * 8 + (lane >> 3), d8 = (lane & 7) * 8;
        *(u32x4*)(O + (size_t)(NCTX + wrow0 + q) * 1024 + 256 + (wid >> 1) * 64 + kvh * 256 + d8) = *(LAS const u32x4*)(Ost + q * LP + d8); }
}
__device__ __forceinline__ void attn8_reference(unsigned char* ws, const float* gq, const float* gk) {
    if (blockIdx.x == 0 && threadIdx.x < 64) { float mq = fabsf(gq[threadIdx.x]), mk = fabsf(gk[threadIdx.x]);
#pragma unroll
        for (int o = 32; o; o >>= 1) { mq = fmaxf(mq, __shfl_xor(mq, o)); mk = fmaxf(mk, __shfl_xor(mk, o)); }
        if (threadIdx.x == 0) WSP(float, WS_CTL)[CW_CNT + 80] = 1.0625f * 1.0625f * 8.f * 1.4426950408889634f * mq * mk - 8.8f; }
}
__device__ __forceinline__ void phase_attention8(unsigned char* ws, LAS unsigned char* lds, LAS unsigned char* misc, unsigned* qword, const float* gq, const float* gk) {
    constexpr int NQB = SEQ / 128; const int nlat = NB * 3 * NQB;
    LAS int* slot = (LAS int*)(misc + 32);
    (void)gq; (void)gk;
    const float mref = __builtin_bit_cast(float, __builtin_amdgcn_readfirstlane((int)WSP(unsigned, WS_CTL)[CW_CNT + 80]));
    const bool sref = mref <= 8.f;
    for (;;) {
        __syncthreads();
        if (threadIdx.x == 0) *slot = (int)atomicAdd(qword, 1u);
        __syncthreads();
        const int u = *slot;
        if (u >= nlat) break;
        const int qb = u % NQB, kvh = (u / NQB) % 3, b = u / (NQB * 3);
        attn_unit8(ws + WS_R, WSP(bf16_t, WS_XN), lds, b, kvh, b * 8192 + qb * 128, sref, sref ? mref : 0.f);
    }
    __syncthreads();
}

__device__ __forceinline__ void phase_norm2_route(const Params& P, unsigned char* ws, LAS unsigned char* lds, int layer, int row_lo) {
    const int tid = threadIdx.x, lane = tid & 63, wid = tid >> 6, r32 = lane & 31, hh = lane >> 5;
    LAS float* xs = (LAS float*)(lds + wid * 12800);
    LAS float* lg = xs + 32 * 65;
    LAS float* rsd = lg + 32 * 33;
    LAS int* cnt_l = (LAS int*)(lds + 8 * 12800);
    LAS int* base_l = cnt_l + 32;
    const float* mods = WSP(float, WS_MODS) + (size_t)layer * 9 * 6144; const float* gff = P.in[layer ? 22 : 7];
    const bf16_t* GWH = WSP(bf16_t, WS_GW) + (size_t)layer * 9 * 32768; const bf16_t* GWL = GWH + (size_t)2 * 9 * 32 * 1024; const float* CB = WSP(float, WS_CB) + layer * 9 * 32;
    bf16_t* XN = WSP(bf16_t, WS_XN); int* tope = WSP(int, WS_TOPE); float* topg = WSP(float, WS_TOPG); int* rank = WSP(int, WS_RANK); int* rowtok = WSP(int, WS_ROWTOK);
    unsigned* gcnt = WSP(unsigned, WS_CTL) + CW_CNT + layer * 32;
    const float* xlat = P.out; const float* xctx = WSP(float, WS_HCTX);
    for (size_t i = (size_t)blockIdx.x * NTHREADS + tid; i < (size_t)MAXRB * 256; i += (size_t)gridDim.x * NTHREADS) rowtok[i] = row_lo;
    const int ngroups = (NTOK - row_lo) / 256;
    for (int grp = blockIdx.x; grp < ngroups; grp += gridDim.x) {
        const int R0 = row_lo + grp * 256 + wid * 32;
        const int rb = R0 < NCTX ? 8 : (R0 - NCTX) >> 13;
        const float* xb = R0 < NCTX ? xctx + (size_t)R0 * 1024 : xlat + (size_t)(R0 - NCTX) * 1024;
        __syncthreads();
        if (tid < 32) cnt_l[tid] = 0;
        f32x16 acc = F16ZERO; float ss = 0.f;
        const bf16_t* gwh = GWH + (size_t)rb * 32768 + (size_t)r32 * 1024 + 8 * hh; const bf16_t* gwl = GWL + (size_t)rb * 32768 + (size_t)r32 * 1024 + 8 * hh;
        const float* xr = xb + (size_t)r32 * 1024 + 8 * hh;
#pragma unroll 4
        for (int k0 = 0; k0 < 1024; k0 += 16) {
            const f32x4 a0 = *(const f32x4*)(xr + k0), a1 = *(const f32x4*)(xr + k0 + 4);
            const bf16x8 bh = *(const bf16x8*)(gwh + k0), bl = *(const bf16x8*)(gwl + k0);
            ss += a0[0] * a0[0] + a0[1] * a0[1] + a0[2] * a0[2] + a0[3] * a0[3] + a1[0] * a1[0] + a1[1] * a1[1] + a1[2] * a1[2] + a1[3] * a1[3];
            u32x4 hw, lw;
            hw.x = pk2(a0[0], a0[1]); hw.y = pk2(a0[2], a0[3]); hw.z = pk2(a1[0], a1[1]); hw.w = pk2(a1[2], a1[3]);
            lw.x = pk2(a0[0] - bflo(hw.x), a0[1] - bfhi(hw.x)); lw.y = pk2(a0[2] - bflo(hw.y), a0[3] - bfhi(hw.y)); lw.z = pk2(a1[0] - bflo(hw.z), a1[1] - bfhi(hw.z)); lw.w = pk2(a1[2] - bflo(hw.w), a1[3] - bfhi(hw.w));
            const bf16x8 ah = __builtin_bit_cast(bf16x8, hw), al = __builtin_bit_cast(bf16x8, lw);
            acc = __builtin_amdgcn_mfma_f32_32x32x16_bf16(ah, bh, acc, 0, 0, 0); acc = __builtin_amdgcn_mfma_f32_32x32x16_bf16(al, bh, acc, 0, 0, 0); acc = __builtin_amdgcn_mfma_f32_32x32x16_bf16(ah, bl, acc, 0, 0, 0);
        }
        ss += __shfl_xor(ss, 32);
        const float rstd = rsqrtf(ss * (1.f / 1024.f) + 1e-6f);
        if (hh == 0) rsd[r32] = rstd;
        const float cb = CB[rb * 32 + r32];
#pragma unroll
        for (int r = 0; r < 16; ++r) { const int row = crow(r, hh); lg[row * 33 + r32] = rsd[row] * acc[r] + cb; }
        int se[4] = {0, 0, 0, 0}, sr[4] = {0, 0, 0, 0}; float sg[4] = {0.f, 0.f, 0.f, 0.f};
        if (lane < 32) {
            float tv[4];
#pragma unroll
            for (int k = 0; k < 4; ++k) { float best = -3.0e38f; int bi = 0;
                for (int e = 0; e < 32; ++e) { const float v = lg[lane * 33 + e]; if (v > best) { best = v; bi = e; } }
                tv[k] = best; se[k] = bi; lg[lane * 33 + bi] = -3.0e38f; }
            const float e1 = __expf(tv[1] - tv[0]), e2 = __expf(tv[2] - tv[0]), e3 = __expf(tv[3] - tv[0]), inv = 1.f / (1.f + e1 + e2 + e3);
            sg[0] = inv; sg[1] = e1 * inv; sg[2] = e2 * inv; sg[3] = e3 * inv;
        }
        __syncthreads();
        if (lane < 32) {
#pragma unroll
            for (int k = 0; k < 4; ++k) sr[k] = lds_addi(&cnt_l[se[k]], 1);
        }
        __syncthreads();
        if (tid < 32) base_l[tid] = (int)atomicAdd(&gcnt[tid], (unsigned)cnt_l[tid]);
        __syncthreads();
        if (lane < 32) { const size_t row = (size_t)(R0 + lane);
#pragma unroll
            for (int k = 0; k < 4; ++k) { tope[row * 4 + k] = se[k]; topg[row * 4 + k] = sg[k]; rank[row * 4 + k] = base_l[se[k]] + sr[k]; } }
        const float* m = mods + (size_t)rb * 6144;
        f32x4 nx[4][4];
#pragma unroll
        for (int u = 0; u < 4; ++u)
#pragma unroll
            for (int q = 0; q < 4; ++q) nx[u][q] = *(const f32x4*)(xb + (size_t)u * 1024 + q * 256 + lane * 4);
        for (int i0 = 0; i0 < 32; i0 += 4) {
#pragma unroll
            for (int u = 0; u < 4; ++u) { const int i = i0 + u; const float rs_i = rsd[i]; f32x4 v[4];
#pragma unroll
                for (int q = 0; q < 4; ++q) v[q] = nx[u][q];
                if (i + 4 < 32) { const float* x = xb + (size_t)(i + 4) * 1024;
#pragma unroll
                    for (int q = 0; q < 4; ++q) nx[u][q] = *(const f32x4*)(x + q * 256 + lane * 4); }
#pragma unroll
                for (int q = 0; q < 4; ++q) { const int k = q * 256 + lane * 4;
                    const f32x4 o = v[q] * rs_i * *(const f32x4*)(gff + k) * (1.f + *(const f32x4*)(m + 4096 + k)) + *(const f32x4*)(m + 3072 + k);
                    *(unsigned*)((unsigned char*)XN + (size_t)(R0 + i) * 1024 + k) = pk4_fp8(o[0], o[1], o[2], o[3]); } } }
    }
    __syncthreads();
}
__device__ __forceinline__ void phase_moe_scatter(unsigned char* ws, const MoeTab& T, int row_lo) {
    const int* tope = WSP(int, WS_TOPE); const int* rank = WSP(int, WS_RANK); int* rowtok = WSP(int, WS_ROWTOK);
    for (size_t i = (size_t)blockIdx.x * NTHREADS + threadIdx.x + (size_t)row_lo * 4; i < (size_t)NTOK * 4; i += (size_t)gridDim.x * NTHREADS)
        rowtok[T.pad_start[tope[i]] + rank[i]] = (int)(i >> 2);
}
__device__ __forceinline__ void phase_moe_combine_norm(const Params& P, unsigned char* ws, const MoeTab& T, int layer, int row_lo) {
    const int lane = threadIdx.x & 63, gw = blockIdx.x * 8 + (threadIdx.x >> 6), nw = gridDim.x * 8;
    const int* tope = WSP(int, WS_TOPE); const int* rank = WSP(int, WS_RANK); const float* topg = WSP(float, WS_TOPG);
    const unsigned char* OUT = ws + WS_OUT; const float* mods = WSP(float, WS_MODS) + (size_t)layer * 9 * 6144; const float* mods1 = WSP(float, WS_MODS) + (size_t)9 * 6144;
    float* xlat = P.out; float* xctx = WSP(float, WS_HCTX); bf16_t* XN = WSP(bf16_t, WS_XN);
    const float* gn = layer ? P.in[43] : P.in[21];
    for (int row = row_lo + gw; row < NTOK; row += nw) {
        f32x4 a[4];
#pragma unroll
        for (int q = 0; q < 4; ++q) a[q] = (f32x4){0.f, 0.f, 0.f, 0.f};
#pragma unroll
        for (int k = 0; k < 4; ++k) { const int e = tope[(size_t)row * 4 + k], dest = T.pad_start[e] + rank[(size_t)row * 4 + k];
            const float g = topg[(size_t)row * 4 + k]; const unsigned char* o = OUT + (size_t)dest * 1024;
#pragma unroll
            for (int q = 0; q < 4; ++q) { const int w = *(const int*)(o + q * 256 + lane * 4); const f32x2 lo = __builtin_amdgcn_cvt_pk_f32_fp8(w, false), hi = __builtin_amdgcn_cvt_pk_f32_fp8(w, true);
                a[q][0] += g * lo.x; a[q][1] += g * lo.y; a[q][2] += g * hi.x; a[q][3] += g * hi.y; } }
        float* x; int r; if (row < NCTX) { x = xctx + (size_t)row * 1024; r = 8; } else { x = xlat + (size_t)(row - NCTX) * 1024; r = (row - NCTX) >> 13; }
        const float* gt = mods + (size_t)r * 6144 + 5120;
        float ss = 0.f;
#pragma unroll
        for (int q = 0; q < 4; ++q) { const int k = q * 256 + lane * 4; a[q] = *(const f32x4*)(x + k) + *(const f32x4*)(gt + k) * a[q]; ss += a[q][0] * a[q][0] + a[q][1] * a[q][1] + a[q][2] * a[q][2] + a[q][3] * a[q][3]; }
        ss = wave_sum(ss); const float rstd = rsqrtf(ss * (1.f / 1024.f) + 1e-6f);
        if (layer == 0) {
            const float* m = mods1 + (size_t)r * 6144;
#pragma unroll
            for (int q = 0; q < 4; ++q) { const int k = q * 256 + lane * 4; *(f32x4*)(x + k) = a[q];
                const f32x4 o = a[q] * rstd * *(const f32x4*)(gn + k) * (1.f + *(const f32x4*)(m + 1024 + k)) + *(const f32x4*)(m + k);
                *(unsigned*)((unsigned char*)XN + (size_t)row * 1024 + k) = pk4_fp8(o[0], o[1], o[2], o[3]); }
        } else {
#pragma unroll
            for (int q = 0; q < 4; ++q) { const int k = q * 256 + lane * 4; *(f32x4*)(x + k) = a[q] * rstd * *(const f32x4*)(gn + k); }
        }
    }
}

__device__ __forceinline__ void phase_s5_scan(unsigned char* ws) {
    const int gid = blockIdx.x * NTHREADS + threadIdx.x;
    if (gid >= NB * 16 * 2 * 64) return;
    const int p = gid & 63, dir = (gid >> 6) & 1, g = (gid >> 7) & 15, b = gid >> 11;
    const float* A64 = WSP(float, WS_S5A64); const float ar = A64[((dir * 16 + g) * 64 + p) * 2], ai = A64[((dir * 16 + g) * 64 + p) * 2 + 1];
    const float* Sl = (const float*)(ws + WS_R + R_SLOC) + (size_t)g * 1280 * 256 + dir * 128 + p;
    bf16_t* UX = (bf16_t*)(ws + WS_R + R_UX) + (size_t)g * 1280 * 1280 + 1024 + dir * 128 + p;
    float xr = 0.f, xi = 0.f;
    for (int i0 = 0; i0 < NCH; i0 += 12) {
        int nidx[12]; float sr[12], si[12];
#pragma unroll
        for (int q = 0; q < 12; ++q) { const int i = i0 + q; int c, n;
            if (i < 4) { c = dir ? 3 - i : i; n = 1024 + b * 4 + c; } else { c = dir ? 131 - i : i - 4; n = b * 128 + c; }
            nidx[q] = (i < 4) ? -1 - n : n; sr[q] = Sl[(size_t)n * 256]; si[q] = Sl[(size_t)n * 256 + 64]; }
#pragma unroll
        for (int q = 0; q < 12; ++q) {
            if (nidx[q] >= 0) { UX[(size_t)nidx[q] * 1280] = (bf16_t)f2bf(xr); UX[(size_t)nidx[q] * 1280 + 64] = (bf16_t)f2bf(xi); }
            const float nr = ar * xr - ai * xi + sr[q], ni = ar * xi + ai * xr + si[q]; xr = nr; xi = ni; }
    }
}

__device__ __forceinline__ void phase_final_norm(const Params& P) {
    const int lane = threadIdx.x & 63, gw = blockIdx.x * 8 + (threadIdx.x >> 6), nw = gridDim.x * 8; const float* g = P.in[43];
    for (int row = gw; row < NLAT; row += nw) { float* x = P.out + (size_t)row * 1024; f32x4 v[4]; float ss = 0.f;
#pragma unroll
        for (int i = 0; i < 4; ++i) { v[i] = *(const f32x4*)(x + i * 256 + lane * 4); ss += v[i][0] * v[i][0] + v[i][1] * v[i][1] + v[i][2] * v[i][2] + v[i][3] * v[i][3]; }
        ss = wave_sum(ss); const float rstd = rsqrtf(ss * (1.f / 1024.f) + 1e-6f);
#pragma unroll
        for (int i = 0; i < 4; ++i) *(f32x4*)(x + i * 256 + lane * 4) = v[i] * rstd * *(const f32x4*)(g + i * 256 + lane * 4); }
}

constexpr int NPHASE = 23;
__global__ void __launch_bounds__(NTHREADS, 2) hybrid_fwd(Params P) {
    extern __shared__ __attribute__((aligned(16))) unsigned char shm_raw[];
    LAS unsigned char* lds = (LAS unsigned char*)shm_raw;
    LAS unsigned char* misc = lds + LDS_STAGE;
    unsigned char* ws = P.ws; unsigned char* R = ws + WS_R;
    const int lo = P.ph_lo, hi = P.ph_hi;
    if (threadIdx.x == 0) *(LAS u32x4*)misc = (u32x4){0u, 0u, 0u, 0u};
    __syncthreads();
    XcdBarrier bar; bar.bar = WSP(unsigned, WS_CTL); bar.x = 0; bar.st = (volatile LAS unsigned*)misc;
    if (hi - lo > 1) bar = xcd_barrier_post(WSP(unsigned, WS_CTL), (volatile LAS unsigned*)misc);
    const MoeTab T = moe_tab(misc);
    const float* mods = WSP(float, WS_MODS);
#ifndef PHMASK
#define PHMASK 0x7fffffffull
#endif
#define IN(k) ((((PHMASK) >> (k)) & 1ull) != 0ull && lo <= (k) && (k) < hi)
#define SEAM(k) do { if (IN(k) && IN((k) + 1)) xcd_barrier(bar); } while (0)

    if (IN(0)) { attn8_reference(ws, P.in[35], P.in[36]); phase_mods(P, ws, lds); phase_convert_small(P, ws, lds); phase_convert_moe8(P, ws, lds, 0, true); if (REP(0)) phase_convert_moe8(P, ws, lds, 0); phase_s5_kernels(P, ws, lds); }
    SEAM(0);
    if (IN(1)) { phase_router_tables(P, ws, lds); phase_s5_tables(P, ws); if (REP(1)) phase_s5_tables(P, ws); phase_norm1(P, ws, 0, P.in[0], P.in[2]); if (REP(15)) phase_norm1(P, ws, 0, P.in[0], P.in[2]); }
    SEAM(1);
    if (IN(2)) { SchedPlain S; S.init(NTOK / 256, 12, 1); S.A = (const char*)(ws + WS_XN); S.Bt = (const char*)(ws + WS_WIN0T); S.lda_bytes = 2048; S.ldb_bytes = 2048; S.a_gstride = 0; S.b_gstride = 0;
        EpiInProj0 E; E.R = R; E.gate_bias = P.in[10]; pg8::gemm_phase(lds, S, E, 1024); if (REP(2)) pg8::gemm_phase(lds, S, E, 1024); }
    SEAM(2);
    if (IN(3)) { phase_qkv_prep(lds, (const bf16_t*)(R + R_KBR), 128, (const bf16_t*)(R + R_VBR), 128, (bf16_t*)(R + R_QB), 512, 2, 8, (bf16_t*)(R + R_KC0), (bf16_t*)(R + R_VT0), nullptr, nullptr, true);
        phase_mlstm_local2(ws, lds); if (REP(3)) phase_mlstm_local2(ws, lds); }
    SEAM(3);
    if (IN(4)) { phase_mlstm_scan(ws);
        AttnArgs A; A.Q = (const bf16_t*)(R + R_QB); A.qpitch = 512; A.Kc = (const bf16_t*)(R + R_KC0); A.VT = (const bf16_t*)(R + R_VT0); A.O = WSP(bf16_t, WS_XN); A.opitch = 1024; A.ocol0 = 512; A.HKV = 2; A.sink = P.in[12]; A.swa = 1;
        phase_attention_v1(A, lds, misc, WSP(unsigned, WS_CTL) + CW_Q0, true); if (REP(4)) phase_attention_v1(A, lds, misc, WSP(unsigned, WS_CTL) + CW_Q0 + 128, true); }
    SEAM(4);
    if (IN(5)) { phase_mlstm_out2(P, ws, lds); if (REP(5)) phase_mlstm_out2(P, ws, lds); }
    SEAM(5);
    if (IN(6)) { SchedPlain S; S.init(NTOK / 256, 4, 1); S.A = (const char*)(ws + WS_XN); S.Bt = (const char*)(ws + WS_WOUT0T); S.lda_bytes = 1024; S.ldb_bytes = 1024; S.a_gstride = 0; S.b_gstride = 0;
        EpiResid E; E.xin = P.in[0]; E.xout = P.out; E.hin = P.in[2]; E.hout = WSP(float, WS_HCTX); E.gate = mods + 2048; E.row_base = 0; E.scale = W8_INV; pg8::gemm_phase8(lds, S, E, 512); if (REP(6)) pg8::gemm_phase8(lds, S, E, 512); }
    SEAM(6);
#define MOE_LAYER(PH0, LAYER, ROWLO)                                                                                                                              \
    if (IN(PH0)) phase_norm2_route(P, ws, lds, LAYER, ROWLO);                                                                                                     \
    SEAM(PH0);                                                                                                                                                    \
    if (IN(PH0 + 1)) { moe_build_tab(WSP(unsigned, WS_CTL) + CW_CNT + LAYER * 32, T); phase_moe_scatter(ws, T, ROWLO); }                                          \
    SEAM(PH0 + 1);                                                                                                                                                \
    {   if (IN(PH0 + 2) || IN(PH0 + 3) || IN(PH0 + 4)) moe_build_tab(WSP(unsigned, WS_CTL) + CW_CNT + LAYER * 32, T);                                            \
        const int nrb = T.rb_start[NEXP];                                                                                                                         \
        if (IN(PH0 + 2)) { SchedMoe1 S; S.XN = (const char*)(ws + WS_XN); S.rowtok = WSP(int, WS_ROWTOK); S.W = (const char*)(ws + WS_WGU); S.T = T; S.rb_lo = 0; S.rb_hi = nrb; S.G = gridDim.x; S.c = blockIdx.x; S.ldb_bytes = 1024; \
            EpiSwiGLU E; E.ACT = ws + WS_ACT8; E.bgu = P.in[LAYER ? 40 : 16]; E.rb_lo = 0; pg8::gemm_phase8(lds, S, E, 512); if (REP(9)) pg8::gemm_phase8(lds, S, E, 512); }  \
        SEAM(PH0 + 2);                                                                                                                                            \
        if (IN(PH0 + 3)) { SchedMoe2 S; S.ACT = (const char*)(ws + WS_ACT8); S.W = (const char*)(ws + WS_WD); S.T = T; S.rb_lo = 0; S.rb_hi = nrb; S.G = gridDim.x; S.c = blockIdx.x; S.ldb_bytes = 1024; \
            EpiMoeOut E; E.OUT = ws + WS_OUT; E.bd = P.in[LAYER ? 42 : 18]; E.rb_lo = 0; pg8::gemm_phase8(lds, S, E, 512); if (REP(10)) pg8::gemm_phase8(lds, S, E, 512); }  \
        SEAM(PH0 + 3);                                                                                                                                            \
        if (IN(PH0 + 4)) { phase_moe_combine_norm(P, ws, T, LAYER, ROWLO); if (LAYER == 0) phase_convert_moe8(P, ws, lds, 1); }                                    \
    }
    MOE_LAYER(7, 0, 0)
    SEAM(11);
    if (IN(12)) { SchedPlain S; S.init(NTOK / 256, 6, 1); S.A = (const char*)(ws + WS_XN); S.Bt = (const char*)(ws + WS_WIN1T); S.lda_bytes = 1024; S.ldb_bytes = 1024; S.a_gstride = 0; S.b_gstride = 0;
        EpiInProj1 E; E.R = R; pg8::gemm_phase8(lds, S, E, 512); if (REP(16)) pg8::gemm_phase8(lds, S, E, 512); }
    SEAM(12);
    if (IN(13)) { phase_qkv_prep8(ws, lds, P.in[35], P.in[36]);
        SchedPlain S; S.init(5, 1, 16); S.A = (const char*)(R + R_UX); S.Bt = (const char*)(ws + WS_S5F); S.lda_bytes = 2560; S.ldb_bytes = 2048; S.a_gstride = (size_t)1280 * 2560; S.b_gstride = (size_t)256 * 2048;
        EpiS5F E; E.S = (float*)(R + R_SLOC); pg8::gemm_phase(lds, S, E, 1024); }
    SEAM(13);
    if (IN(14)) { phase_s5_scan(ws);
        phase_attention8(ws, lds, misc, WSP(unsigned, WS_CTL) + CW_Q0 + 64, P.in[35], P.in[36]); if (REP(18)) phase_attention8(ws, lds, misc, WSP(unsigned, WS_CTL) + CW_Q0 + 192, P.in[35], P.in[36]); }
    SEAM(14);
    if (IN(15)) { SchedPlain S; S.init(4, 4, 16); S.A = (const char*)(R + R_UX); S.Bt = (const char*)(ws + WS_S5TE); S.lda_bytes = 2560; S.ldb_bytes = 2560; S.a_gstride = (size_t)1280 * 2560; S.b_gstride = (size_t)1024 * 2560;
        EpiS5Y E; E.UX = (const bf16_t*)(R + R_UX); E.Yg = (bf16_t*)(R + R_YG); E.dskip = P.in[32]; pg8::gemm_phase(lds, S, E, 1280); if (REP(19)) pg8::gemm_phase(lds, S, E, 1280); }
    SEAM(15);
    if (IN(16)) { SchedPlain S; S.init(NLAT / 256, 1, 1); S.A = (const char*)(R + R_YG); S.Bt = (const char*)(ws + WS_WGLUT); S.lda_bytes = 512; S.ldb_bytes = 512; S.a_gstride = 0; S.b_gstride = 0;
        EpiGLU E; E.Yg = (const bf16_t*)(R + R_YG); E.MIX = WSP(bf16_t, WS_XN); E.bglu = P.in[34]; pg8::gemm_phase(lds, S, E, 256); if (REP(20)) pg8::gemm_phase(lds, S, E, 256); }
    SEAM(16);
    if (IN(17)) { SchedPlain S; S.init(NLAT / 256, 4, 1); S.A = (const char*)(ws + WS_XN) + (size_t)NCTX * 2048; S.Bt = (const char*)(ws + WS_WOUT1T); S.lda_bytes = 2048; S.ldb_bytes = 2048; S.a_gstride = 0; S.b_gstride = 0;
        EpiResid E; E.xin = P.out; E.xout = P.out; E.hin = WSP(float, WS_HCTX); E.hout = WSP(float, WS_HCTX); E.gate = mods + 9 * 6144 + 2048; E.row_base = NCTX; E.scale = 1.f; pg8::gemm_phase(lds, S, E, 1024); }
    SEAM(17);
    MOE_LAYER(18, 1, NCTX)
#undef IN
#undef SEAM
}

extern "C" void kernel_launch(void* const* d_in, const int* in_sizes, int n_in, void* d_out, int out_size, void* d_ws, size_t ws_size, hipStream_t stream) {
    (void)in_sizes; (void)out_size;
    if (n_in < 44 || ws_size < WS_END) { fprintf(stderr, "kernel_launch: n_in %d ws_size %zu need %zu\n", n_in, ws_size, (size_t)WS_END); return; }
    static int grid = 0;
    if (!grid) {
        int dev = 0, cus = 0, per_cu = 0;
        hipGetDevice(&dev);
        hipDeviceGetAttribute(&cus, hipDeviceAttributeMultiprocessorCount, dev);
        hipFuncSetAttribute((const void*)hybrid_fwd, hipFuncAttributeMaxDynamicSharedMemorySize, LDS_BYTES);
        hipOccupancyMaxActiveBlocksPerMultiprocessor(&per_cu, (const void*)hybrid_fwd, NTHREADS, LDS_BYTES);
        if (per_cu < 1) { fprintf(stderr, "kernel_launch: occupancy query says %d blocks per CU\n", per_cu); per_cu = 1; }
        grid = cus;
    }
    hipMemsetAsync(d_ws, 0, WS_ZERO_BYTES, stream);
    Params p{};
    for (int i = 0; i < 44; ++i) p.in[i] = (const float*)d_in[i];
    p.out = (float*)d_out; p.ws = (unsigned char*)d_ws;
#if MK_MULTI
    for (int ph = 0; ph < NPHASE; ++ph) { p.ph_lo = ph; p.ph_hi = ph + 1; hipLaunchKernelGGL(hybrid_fwd, dim3(grid), dim3(NTHREADS), LDS_BYTES, stream, p); }
#else
    p.ph_lo = 0; p.ph_hi = NPHASE;
    hipLaunchKernelGGL(hybrid_fwd, dim3(grid), dim3(NTHREADS), LDS_BYTES, stream, p);
#endif
}
```

```cpp
#include <hip/hip_runtime.h>
#include <cstdio>
#include <cstdint>

#ifndef DBG_SKIP
#define DBG_SKIP 0
#endif
#ifndef DBG_REP
#define DBG_REP 0ull
#endif
#define REP(k) ((((DBG_REP) >> (k)) & 1ull) != 0ull)
#ifndef MK_MULTI
#define MK_MULTI 0
#endif

#define LAS __attribute__((address_space(3)))
typedef unsigned short bf16_t;
typedef short bf16x8 __attribute__((ext_vector_type(8)));
typedef short bf16x4 __attribute__((ext_vector_type(4)));
typedef float f32x4 __attribute__((ext_vector_type(4)));
typedef float f32x2 __attribute__((ext_vector_type(2)));
typedef float f32x16 __attribute__((ext_vector_type(16)));
typedef unsigned u32x4 __attribute__((ext_vector_type(4)));
typedef unsigned u32x2 __attribute__((ext_vector_type(2)));
typedef int i32x8 __attribute__((ext_vector_type(8)));

constexpr int NB = 8, SEQ = 8192, DM = 1024, CTXL = 256;
constexpr int NCTX = NB * CTXL;
constexpr int NLAT = NB * SEQ;
constexpr int NTOK = NCTX + NLAT;
constexpr int NCH = 132;
constexpr int NKEY = CTXL + SEQ;
constexpr int NEXP = 32;
constexpr int MAXRB = 1088;
constexpr int NTHREADS = 512;
constexpr int LDS_STAGE = 131072;
constexpr int LDS_MISC = 16384;
constexpr int LDS_BYTES = LDS_STAGE + LDS_MISC;

__device__ __forceinline__ unsigned f2bf(float f) { unsigned u = __builtin_bit_cast(unsigned, f); return (u + 0x7fffu + ((u >> 16) & 1u)) >> 16; }
__device__ __forceinline__ unsigned pk2(float lo, float hi) { unsigned r; asm("v_cvt_pk_bf16_f32 %0, %1, %2" : "=v"(r) : "v"(lo), "v"(hi)); return r; }
__device__ __forceinline__ float bf2f(unsigned short b) { return __builtin_bit_cast(float, ((unsigned)b) << 16); }
__device__ __forceinline__ float bflo(unsigned w) { return __builtin_bit_cast(float, w << 16); }
__device__ __forceinline__ float bfhi(unsigned w) { return __builtin_bit_cast(float, w & 0xffff0000u); }
__device__ __forceinline__ float wave_sum(float v) {
#pragma unroll
    for (int o = 32; o >= 1; o >>= 1) v += __shfl_xor(v, o);
    return v;
}
__device__ __forceinline__ float wave_max(float v) {
#pragma unroll
    for (int o = 32; o >= 1; o >>= 1) v = fmaxf(v, __shfl_xor(v, o));
    return v;
}

__device__ __forceinline__ float clamp448(float x) { return __builtin_amdgcn_fmed3f(x, -448.f, 448.f); }
__device__ __forceinline__ unsigned pk4_fp8(float a, float b, float c, float d) {
    int w = 0; w = __builtin_amdgcn_cvt_pk_fp8_f32(clamp448(a), clamp448(b), w, false); w = __builtin_amdgcn_cvt_pk_fp8_f32(clamp448(c), clamp448(d), w, true); return (unsigned)w;
}
__device__ __forceinline__ unsigned pk4_fp8_nc(float a, float b, float c, float d) {
    int w = 0; w = __builtin_amdgcn_cvt_pk_fp8_f32(a, b, w, false); w = __builtin_amdgcn_cvt_pk_fp8_f32(c, d, w, true); return (unsigned)w;
}
__device__ __forceinline__ f32x4 fma4(const f32x4 a, const float s, const f32x4 b) { f32x4 r; r.x = __builtin_fmaf(a.x, s, b.x); r.y = __builtin_fmaf(a.y, s, b.y); r.z = __builtin_fmaf(a.z, s, b.z); r.w = __builtin_fmaf(a.w, s, b.w); return r; }
__device__ __forceinline__ u32x2 bf8_to_fp8(const u32x4 w) { u32x2 o; o.x = pk4_fp8(bflo(w.x), bfhi(w.x), bflo(w.y), bfhi(w.y)); o.y = pk4_fp8(bflo(w.z), bfhi(w.z), bflo(w.w), bfhi(w.w)); return o; }
constexpr float W8_SCALE = 32.f, W8_INV = 1.f / 32.f;
__device__ __forceinline__ float sigmoidf_(float x) { return __builtin_amdgcn_rcpf(1.f + __builtin_amdgcn_exp2f(-1.4426950408889634f * x)); }
__device__ __forceinline__ float logsigmoidf_(float x) { return fminf(x, 0.f) - log1pf(__expf(-fabsf(x))); }

#define XB_TMO      128
#define XB_XCNT(j)  (256  + 64 * (j))
#define XB_XSUB(j)  (1280 + 64 * (j))
#define XB_XGEN(j)  (2304 + 64 * (j))
#define XB_TOP      3328
#define XB_TOPGEN   3392
#define XCD_BAR_WORDS 3456
#define XB_SPIN_CAP (1u << 22)

__device__ __forceinline__ unsigned xb_ld(unsigned* p)              { return __hip_atomic_load(p, __ATOMIC_RELAXED, __HIP_MEMORY_SCOPE_AGENT); }
__device__ __forceinline__ unsigned xb_add(unsigned* p, unsigned v) { return __hip_atomic_fetch_add(p, v, __ATOMIC_RELAXED, __HIP_MEMORY_SCOPE_AGENT); }
__device__ __forceinline__ unsigned xb_xcc_id() { return (unsigned)__builtin_amdgcn_s_getreg((3 << 11) | 20) & 0xFu; }
#define XB_SPIN(cond, bar) do { unsigned _sp = 0; while (cond) { __builtin_amdgcn_s_sleep(1); \
    if ((++_sp & 255u) == 0u) { if (xb_ld(&(bar)[XB_TMO])) break; if (_sp > XB_SPIN_CAP) { atomicAdd(&(bar)[XB_TMO], 1u); break; } } } } while (0)

struct XcdBarrier { unsigned* bar; unsigned x; volatile LAS unsigned* st; };

__device__ __forceinline__ XcdBarrier xcd_barrier_post(unsigned* bar, volatile LAS unsigned* st) {
    XcdBarrier b; b.bar = bar; b.x = xb_xcc_id(); b.st = st;
    if (threadIdx.x == 0) (void)xb_add(&bar[XB_XCNT(b.x)], 1u);
    return b;
}
__device__ __forceinline__ void xcd_barrier_complete(unsigned* bar, unsigned x, unsigned& nloc, unsigned& nx) {
    const unsigned G = gridDim.x * gridDim.y * gridDim.z;
    unsigned sum, cnt, mine, sp = 0u;
    for (;;) {
        sum = 0u; cnt = 0u; mine = 0u;
#pragma unroll
        for (unsigned j = 0; j < 16; ++j) { const unsigned c = xb_ld(&bar[XB_XCNT(j)]); sum += c; cnt += (c > 0u) ? 1u : 0u; mine = (j == x) ? c : mine; }
        if (sum == G) break;
        __builtin_amdgcn_s_sleep(1);
        if ((++sp & 255u) == 0u) { if (xb_ld(&bar[XB_TMO])) break; if (sp > XB_SPIN_CAP) { atomicAdd(&bar[XB_TMO], 1u); break; } }
    }
    nloc = mine > 0u ? mine : 1u; nx = cnt > 0u ? cnt : 1u;
}
__device__ __forceinline__ void xcd_barrier(const XcdBarrier& b) {
    asm volatile("s_waitcnt vmcnt(0)" ::: "memory");
    __syncthreads();
    if (threadIdx.x == 0) {
        unsigned* bar = b.bar;
        __builtin_amdgcn_s_waitcnt(0);
        unsigned nloc = b.st[0], nx = b.st[1];
        if (nloc == 0u) { xcd_barrier_complete(bar, b.x, nloc, nx); b.st[0] = nloc; b.st[1] = nx; }
        const unsigned old = xb_add(&bar[XB_XSUB(b.x)], 1u);
        const unsigned gen = old / nloc;
        if (old + 1u == (gen + 1u) * nloc) {
            __builtin_amdgcn_fence(__ATOMIC_RELEASE, "agent");
            asm volatile("s_waitcnt vmcnt(0)" ::: "memory");
            const unsigned og = xb_add(&bar[XB_TOP], 1u);
            const unsigned tg = og / nx;
            if (og + 1u == (tg + 1u) * nx) xb_add(&bar[XB_TOPGEN], 1u);
            else XB_SPIN(xb_ld(&bar[XB_TOPGEN]) == tg, bar);
            __builtin_amdgcn_fence(__ATOMIC_ACQUIRE, "agent");
            xb_add(&bar[XB_XGEN(b.x)], 1u);
            asm volatile("s_waitcnt vmcnt(0)" ::: "memory");
        } else {
            XB_SPIN(xb_ld(&bar[XB_XGEN(b.x)]) == gen, bar);
            __builtin_amdgcn_fence(__ATOMIC_ACQUIRE, "agent");
            asm volatile("s_waitcnt vmcnt(0)" ::: "memory");
        }
    }
    __syncthreads();
}

constexpr size_t al256(size_t x) { return (x + 255) & ~(size_t)255; }
constexpr size_t WS_CTL    = 0;
constexpr size_t CTL_BYTES = 65536;
constexpr size_t WS_MODS   = WS_CTL + CTL_BYTES;
constexpr size_t MODS_BYTES = al256((size_t)2 * 9 * 6144 * 4);
constexpr size_t WS_ZERO_BYTES = WS_MODS + MODS_BYTES;
constexpr size_t WS_GW     = WS_ZERO_BYTES;
constexpr size_t WS_CB     = WS_GW + (size_t)2 * 9 * 1024 * 32 * 4;
constexpr size_t WS_S5K    = al256(WS_CB + 2 * 9 * 32 * 4);
constexpr size_t WS_S5A64  = WS_S5K + (size_t)16 * 2 * 64 * 256 * 4;
constexpr size_t WS_WIN0T  = al256(WS_S5A64 + 2 * 16 * 64 * 2 * 4);
constexpr size_t WS_WOUT0T = WS_WIN0T + (size_t)3072 * 1024 * 2;
constexpr size_t WS_WIN1T  = WS_WOUT0T + (size_t)1024 * 1024 * 2;
constexpr size_t WS_WOUT1T = WS_WIN1T + (size_t)1536 * 1024 * 2;
constexpr size_t WS_WGLUT  = WS_WOUT1T + (size_t)1024 * 1024 * 2;
constexpr size_t WS_S5TE   = WS_WGLUT + (size_t)256 * 256 * 2;
constexpr size_t WS_S5F    = WS_S5TE + (size_t)16 * 1024 * 1280 * 2;
constexpr size_t WS_WGU    = WS_S5F + (size_t)16 * 256 * 1024 * 2;
constexpr size_t WS_WD     = WS_WGU + (size_t)32 * 2048 * 1024;
constexpr size_t WS_HCTX   = WS_WD + (size_t)32 * 1024 * 1024;
constexpr size_t WS_TOPE   = WS_HCTX + (size_t)NCTX * 1024 * 4;
constexpr size_t WS_TOPG   = WS_TOPE + (size_t)NTOK * 4 * 4;
constexpr size_t WS_RANK   = WS_TOPG + (size_t)NTOK * 4 * 4;
constexpr size_t WS_ROWTOK = WS_RANK + (size_t)NTOK * 4 * 4;
constexpr size_t WS_XN     = al256(WS_ROWTOK + (size_t)MAXRB * 256 * 4);
constexpr size_t WS_R      = WS_XN + (size_t)NTOK * 1024 * 2;
constexpr size_t WS_ACT8   = WS_XN + (size_t)NTOK * 1024;
constexpr size_t WS_OUT    = WS_ACT8 + (size_t)MAXRB * 256 * 1024;
constexpr size_t WS_MOE_END = WS_OUT + (size_t)MAXRB * 256 * 1024 * 2;
constexpr size_t PROJ512   = (size_t)NTOK * 512 * 2;
constexpr size_t R_QA = 0, R_KA = R_QA + PROJ512, R_VA = R_KA + PROJ512, R_OA = R_VA + PROJ512, R_QB = R_OA + PROJ512;
constexpr size_t R_KBR = R_QB + PROJ512;
constexpr size_t R_VBR = R_KBR + (size_t)NTOK * 128 * 2;
constexpr size_t R_G   = R_VBR + (size_t)NTOK * 128 * 2;
constexpr size_t R_KC0 = R_G + (size_t)NTOK * 32 * 4;
constexpr size_t R_VT0 = R_KC0 + (size_t)NB * 2 * NKEY * 64 * 2;
constexpr size_t R_CS  = R_VT0 + (size_t)NB * 2 * NKEY * 64 * 2;
constexpr size_t NSEQ_M = (size_t)NB * 8 * 2 * NCH;
constexpr size_t R_NS  = R_CS + NSEQ_M * 8192;
constexpr size_t R_ML  = R_NS + NSEQ_M * 256;
constexpr size_t R_BL  = R_ML + NSEQ_M * 4;
constexpr size_t R_MP  = R_BL + NSEQ_M * 4;
constexpr size_t R_BT  = R_MP + NSEQ_M * 4;
constexpr size_t R_PM  = R_BT + NSEQ_M * 256;
constexpr size_t R_GC  = R_PM + NSEQ_M * 256;
constexpr size_t R_L0_END = R_GC + NSEQ_M * 256;
constexpr size_t R_UX  = 0;
constexpr size_t R_Q1  = R_UX + (size_t)16 * 1280 * 1280 * 2;
constexpr size_t R_KV1 = R_Q1 + (size_t)NTOK * 768 * 2;
constexpr size_t R_KC1 = R_KV1 + (size_t)NTOK * 384 * 2;
constexpr size_t R_VT1 = R_KC1 + (size_t)NB * 3 * NKEY * 64 * 2;
constexpr size_t R_SLOC = R_VT1 + (size_t)NB * 3 * NKEY * 64 * 2;
constexpr size_t R_YG  = R_SLOC + (size_t)16 * 1280 * 256 * 4;
constexpr size_t R_Q8  = R_YG + (size_t)NLAT * 256 * 2;
constexpr size_t R_K8  = R_Q8 + (size_t)NLAT * 768;
constexpr size_t R_VT8 = R_K8 + (size_t)NB * 3 * NKEY * 64;
constexpr size_t R_L1_END = R_VT8 + (size_t)NB * 3 * NKEY * 64;
constexpr size_t R_BYTES = (R_L0_END > R_L1_END ? R_L0_END : R_L1_END);
constexpr size_t WS_END = (WS_R + R_BYTES > WS_MOE_END ? WS_R + R_BYTES : WS_MOE_END);

constexpr int CW_Q0 = 4096;
constexpr int CW_CNT = 8192;
constexpr int CW_TRIP = 8192 + 128;

struct Params {
    const float* in[44];
    float* out;
    unsigned char* ws;
    int ph_lo, ph_hi;
};

namespace pg8 {
constexpr int BM = 256, BK = 64, HALF = 128, HTB = HALF * BK * 2, NXCD = 8, WGM = 8;
__host__ __device__ __forceinline__ int lds_byte(int r, int c) { const int st = (r >> 4) * 2 + (c >> 5), rr = r & 15, cc = c & 31, ob = rr * 64 + cc * 2; return st * 1024 + (ob ^ (((ob >> 9) & 1) << 5)); }
__host__ __device__ __forceinline__ void stage_rc(int b, int& R, int& C) { const int st = b / 1024, sb = b % 1024, swz = sb ^ (((sb >> 9) & 1) << 5); R = (st >> 1) * 16 + swz / 64; C = (st & 1) * 32 + (swz % 64) / 2; }
__host__ __device__ __forceinline__ int perm32(int rho) { const int n = rho >> 4, i = rho & 15; return 8 * (i >> 2) + 4 * n + (i & 3); }

struct Unit { int pm, pn, g; };

__device__ __forceinline__ unsigned cvt_pk_bf16(float lo, float hi) { unsigned r; asm volatile("v_cvt_pk_bf16_f32 %0, %1, %2" : "=v"(r) : "v"(lo), "v"(hi)); return r; }

template <class Epi, class Sched>
__device__ __forceinline__ void gemm_phase(LAS unsigned char* lds, const Sched& S, const Epi& E, int K) {
    asm volatile("" : "+s"(K));
    const int tid = threadIdx.x, wid = __builtin_amdgcn_readfirstlane(tid >> 6), lane = tid & 63, wr = wid >> 2, wc = wid & 3, fr = lane & 15, fq = lane >> 4;
    const int nt = K / BK;
    int Rr[2], Cc[2]; unsigned voffB[2];
#pragma unroll
    for (int i = 0; i < 2; ++i) { int R, C; stage_rc(tid * 16 + i * 8192, R, C); const int Rb = Epi::PERM ? ((R & ~31) + perm32(R & 31)) : R;
        Rr[i] = R; Cc[i] = C; voffB[i] = (unsigned)Rb * (unsigned)S.ldb_bytes + (unsigned)C * 2u; }
    const size_t kstep = (size_t)(BK * 2);
    const size_t hstepB = (size_t)HALF * S.ldb_bytes;
    const unsigned ldsw = (unsigned)wid * 1024u;
    const int aoff = lds_byte(wr * 64 + fr, fq * 8), boff = lds_byte(wc * 32 + fr, fq * 8);
#define PG8_SA(b, h) (((b) * 2 + (h)) * HTB)
#define PG8_SB(b, h) ((4 + (b) * 2 + (h)) * HTB)
#define PG8_STAGE_B(bufoff, gbase) do { _Pragma("unroll") for (int _i = 0; _i < 2; ++_i) \
        __builtin_amdgcn_global_load_lds((const unsigned*)((const char*)(gbase) + voffB[_i]), (LAS unsigned*)(lds + (bufoff) + ldsw + _i * 8192), 16, 0, 0); } while (0)
#define PG8_STAGE_A(bufoff, gbase, o0, o1) do { \
        __builtin_amdgcn_global_load_lds((const unsigned*)((const char*)(gbase) + (o0)), (LAS unsigned*)(lds + (bufoff) + ldsw), 16, 0, 0); \
        __builtin_amdgcn_global_load_lds((const unsigned*)((const char*)(gbase) + (o1)), (LAS unsigned*)(lds + (bufoff) + ldsw + 8192), 16, 0, 0); } while (0)
#define PG8_LDA(dst, b, h) do { _Pragma("unroll") for (int m = 0; m < 4; ++m) _Pragma("unroll") for (int k = 0; k < 2; ++k) dst[m][k] = *(const LAS bf16x8*)(lds + PG8_SA(b, h) + aoff + m * 2048 + k * 1024); } while (0)
#define PG8_LDB(dst, b, h) do { _Pragma("unroll") for (int n = 0; n < 2; ++n) _Pragma("unroll") for (int k = 0; k < 2; ++k) dst[n][k] = *(const LAS bf16x8*)(lds + PG8_SB(b, h) + boff + n * 2048 + k * 1024); } while (0)
#define PG8_MMA(ai, bj, At, Bt) do { __builtin_amdgcn_s_setprio(1); _Pragma("unroll") for (int m = 0; m < 4; ++m) _Pragma("unroll") for (int n = 0; n < 2; ++n) _Pragma("unroll") for (int k = 0; k < 2; ++k) \
        acc[ai][bj][m][n] = __builtin_amdgcn_mfma_f32_16x16x32_bf16(Bt[n][k], At[m][k], acc[ai][bj][m][n], 0, 0, 0); __builtin_amdgcn_s_setprio(0); } while (0)
#define PG8_WAIT_V(n) asm volatile("s_waitcnt vmcnt(" #n ")" ::: "memory")
#define PG8_WAIT_L(n) asm volatile("s_waitcnt lgkmcnt(" #n ")" ::: "memory")
#define PG8_BAR __builtin_amdgcn_s_barrier()
#define PG8_SCHED __builtin_amdgcn_sched_barrier(0)
    Unit cur, nxt; int ui = 0;
    if (!S.next(0, cur)) return;
    f32x4 acc[2][2][4][2];
#pragma unroll
    for (int a = 0; a < 2; ++a)
#pragma unroll
        for (int b = 0; b < 2; ++b)
#pragma unroll
            for (int m = 0; m < 4; ++m)
#pragma unroll
                for (int n = 0; n < 2; ++n) acc[a][b][m][n] = (f32x4){0.f, 0.f, 0.f, 0.f};
    bf16x8 At[4][2], B0[2][2], B1[2][2];
    const char* cA = S.a_base(cur); const char* cB = S.b_base(cur);
    unsigned c00 = S.a_off(cur, Rr[0]) + Cc[0] * 2u, c01 = S.a_off(cur, Rr[1]) + Cc[1] * 2u, c10 = S.a_off(cur, HALF + Rr[0]) + Cc[0] * 2u, c11 = S.a_off(cur, HALF + Rr[1]) + Cc[1] * 2u;
    PG8_STAGE_B(PG8_SB(0, 0), cB); PG8_STAGE_B(PG8_SB(0, 1), cB + hstepB); PG8_STAGE_A(PG8_SA(0, 0), cA, c00, c01); PG8_STAGE_A(PG8_SA(0, 1), cA, c10, c11);
    if (wr == 1) PG8_BAR;
    PG8_WAIT_V(2); PG8_BAR;
    PG8_STAGE_B(PG8_SB(1, 0), cB + kstep); PG8_STAGE_A(PG8_SA(1, 0), cA + kstep, c00, c01); PG8_STAGE_B(PG8_SB(1, 1), cB + hstepB + kstep);
    PG8_WAIT_V(6); PG8_BAR;
    for (;;) {
        const bool has_next = S.next(ui + 1, nxt);
        const char* nA = has_next ? S.a_base(nxt) : cA; const char* nB = has_next ? S.b_base(nxt) : cB;
        unsigned n00 = c00, n01 = c01, n10 = c10, n11 = c11;
        if (has_next) { n00 = S.a_off(nxt, Rr[0]) + Cc[0] * 2u; n01 = S.a_off(nxt, Rr[1]) + Cc[1] * 2u; n10 = S.a_off(nxt, HALF + Rr[0]) + Cc[0] * 2u; n11 = S.a_off(nxt, HALF + Rr[1]) + Cc[1] * 2u; }
        for (int t = 0; t < nt; t += 2) {
            const bool last = (t == nt - 2);
            const char* a1 = cA + (size_t)(t + 1) * kstep;
            const char* a2 = last ? nA : cA + (size_t)(t + 2) * kstep; const char* b2 = last ? nB : cB + (size_t)(t + 2) * kstep;
            const char* a3 = a2 + kstep; const char* b3 = b2 + kstep;
            const unsigned x00 = last ? n00 : c00, x01 = last ? n01 : c01, x10 = last ? n10 : c10, x11 = last ? n11 : c11;
            PG8_LDB(B0, 0, 0); PG8_LDB(B1, 0, 1); PG8_SCHED; PG8_LDA(At, 0, 0); PG8_STAGE_A(PG8_SA(1, 1), a1, c10, c11);
            PG8_WAIT_V(8); PG8_WAIT_L(0); PG8_BAR; PG8_MMA(0, 0, At, B0); PG8_MMA(0, 1, At, B1); PG8_BAR; PG8_SCHED;
            PG8_LDA(At, 0, 1); PG8_STAGE_B(PG8_SB(0, 0), b2); PG8_STAGE_B(PG8_SB(0, 1), b2 + hstepB); PG8_STAGE_A(PG8_SA(0, 0), a2, x00, x01);
            PG8_WAIT_V(8); PG8_WAIT_L(0); PG8_BAR; PG8_MMA(1, 0, At, B0); PG8_MMA(1, 1, At, B1); PG8_BAR; PG8_SCHED;
            PG8_LDB(B0, 1, 0); PG8_LDB(B1, 1, 1); PG8_SCHED; PG8_LDA(At, 1, 0); PG8_STAGE_A(PG8_SA(0, 1), a2, x10, x11);
            PG8_WAIT_V(8); PG8_WAIT_L(0); PG8_BAR; PG8_MMA(0, 0, At, B0); PG8_MMA(0, 1, At, B1); PG8_BAR; PG8_SCHED;
            PG8_LDA(At, 1, 1); PG8_STAGE_B(PG8_SB(1, 0), b3); PG8_STAGE_B(PG8_SB(1, 1), b3 + hstepB); PG8_STAGE_A(PG8_SA(1, 0), a3, x00, x01);
            PG8_WAIT_V(8); PG8_WAIT_L(0); PG8_BAR; PG8_MMA(1, 0, At, B0); PG8_MMA(1, 1, At, B1); PG8_BAR; PG8_SCHED;
        }
        if (wr == 0) PG8_BAR;
        E(acc, cur, wr, wc, fr, fq);
        if (!has_next) break;
#pragma unroll
        for (int a = 0; a < 2; ++a)
#pragma unroll
            for (int b = 0; b < 2; ++b)
#pragma unroll
                for (int m = 0; m < 4; ++m)
#pragma unroll
                    for (int n = 0; n < 2; ++n) acc[a][b][m][n] = (f32x4){0.f, 0.f, 0.f, 0.f};
        cur = nxt; cA = nA; cB = nB; c00 = n00; c01 = n01; c10 = n10; c11 = n11; ++ui;
        if (wr == 1) PG8_BAR;
    }
    PG8_WAIT_V(0);
    PG8_BAR;
#undef PG8_SA
#undef PG8_SB
#undef PG8_STAGE_A
#undef PG8_STAGE_B
#undef PG8_LDA
#undef PG8_LDB
#undef PG8_MMA
#undef PG8_WAIT_V
#undef PG8_WAIT_L
#undef PG8_BAR
#undef PG8_SCHED
}

template <class Epi, class Sched>
__device__ __forceinline__ void gemm_phase8(LAS unsigned char* lds, const Sched& S, const Epi& E, int K) {
    asm volatile("" : "+s"(K));
    const int tid = threadIdx.x, wid = __builtin_amdgcn_readfirstlane(tid >> 6), lane = tid & 63, wr = wid >> 2, wc = wid & 3, fr = lane & 15, fq = lane >> 4;
    const int nt = K / BK;
    int Rr[2], Cc[2]; unsigned voffB[2];
#pragma unroll
    for (int i = 0; i < 2; ++i) { int R, C; stage_rc(tid * 16 + i * 8192, R, C); const int Rb = Epi::PERM ? ((R & ~31) + perm32(R & 31)) : R;
        Rr[i] = R; Cc[i] = C; voffB[i] = (unsigned)Rb * (unsigned)S.ldb_bytes + (unsigned)C * 2u; }
    const size_t kstep = (size_t)(BK * 2);
    const size_t hstepB = (size_t)HALF * S.ldb_bytes;
    const unsigned ldsw = (unsigned)wid * 1024u;
    const int sl0 = 2 * fq + (fq >> 1), sl1 = 2 * fq + (1 ^ (fq >> 1));
    const int aoff0 = lds_byte(wr * 64 + fr, sl0 * 8), aoff1 = lds_byte(wr * 64 + fr, sl1 * 8), boff0 = lds_byte(wc * 32 + fr, sl0 * 8), boff1 = lds_byte(wc * 32 + fr, sl1 * 8);
#define PG8_SA(b, h) (((b) * 2 + (h)) * HTB)
#define PG8_SB(b, h) ((4 + (b) * 2 + (h)) * HTB)
#define PG8_STAGE_B(bufoff, gbase) do { _Pragma("unroll") for (int _i = 0; _i < 2; ++_i) \
        __builtin_amdgcn_global_load_lds((const unsigned*)((const char*)(gbase) + voffB[_i]), (LAS unsigned*)(lds + (bufoff) + ldsw + _i * 8192), 16, 0, 0); } while (0)
#define PG8_STAGE_A(bufoff, gbase, o0, o1) do { \
        __builtin_amdgcn_global_load_lds((const unsigned*)((const char*)(gbase) + (o0)), (LAS unsigned*)(lds + (bufoff) + ldsw), 16, 0, 0); \
        __builtin_amdgcn_global_load_lds((const unsigned*)((const char*)(gbase) + (o1)), (LAS unsigned*)(lds + (bufoff) + ldsw + 8192), 16, 0, 0); } while (0)
#define PG8_LDA(dst, b, h) do { _Pragma("unroll") for (int m = 0; m < 4; ++m) { const u32x4 p0_ = *(const LAS u32x4*)(lds + PG8_SA(b, h) + aoff0 + m * 2048), p1_ = *(const LAS u32x4*)(lds + PG8_SA(b, h) + aoff1 + m * 2048); \
        dst[m] = __builtin_bit_cast(i32x8, __builtin_shufflevector(p0_, p1_, 0, 1, 2, 3, 4, 5, 6, 7)); } } while (0)
#define PG8_LDB(dst, b, h) do { _Pragma("unroll") for (int n = 0; n < 2; ++n) { const u32x4 p0_ = *(const LAS u32x4*)(lds + PG8_SB(b, h) + boff0 + n * 2048), p1_ = *(const LAS u32x4*)(lds + PG8_SB(b, h) + boff1 + n * 2048); \
        dst[n] = __builtin_bit_cast(i32x8, __builtin_shufflevector(p0_, p1_, 0, 1, 2, 3, 4, 5, 6, 7)); } } while (0)
#define PG8_MMA(ai, bj, At, Bt) do { __builtin_amdgcn_s_setprio(1); _Pragma("unroll") for (int m = 0; m < 4; ++m) _Pragma("unroll") for (int n = 0; n < 2; ++n) \
        asm volatile("v_mfma_scale_f32_16x16x128_f8f6f4 %0, %1, %2, %0, %3, %3 op_sel_hi:[0,0,0]" : "+v"(acc[ai][bj][m][n]) : "v"(Bt[n]), "v"(At[m]), "v"(sc8)); __builtin_amdgcn_s_setprio(0); } while (0)
#define PG8_WAIT_V(n) asm volatile("s_waitcnt vmcnt(" #n ")" ::: "memory")
#define PG8_WAIT_L(n) asm volatile("s_waitcnt lgkmcnt(" #n ")" ::: "memory")
#define PG8_BAR __builtin_amdgcn_s_barrier()
#define PG8_SCHED __builtin_amdgcn_sched_barrier(0)
    Unit cur, nxt; int ui = 0;
    if (!S.next(0, cur)) return;
    f32x4 acc[2][2][4][2];
#pragma unroll
    for (int a = 0; a < 2; ++a)
#pragma unroll
        for (int b = 0; b < 2; ++b)
#pragma unroll
            for (int m = 0; m < 4; ++m)
#pragma unroll
                for (int n = 0; n < 2; ++n) acc[a][b][m][n] = (f32x4){0.f, 0.f, 0.f, 0.f};
    i32x8 At[4], B0[2], B1[2]; const int sc8 = 0x7F7F7F7F;

    const char* cA = S.a_base(cur); const char* cB = S.b_base(cur);
    unsigned c00 = S.a_off(cur, Rr[0]) + Cc[0] * 2u, c01 = S.a_off(cur, Rr[1]) + Cc[1] * 2u, c10 = S.a_off(cur, HALF + Rr[0]) + Cc[0] * 2u, c11 = S.a_off(cur, HALF + Rr[1]) + Cc[1] * 2u;
    PG8_STAGE_B(PG8_SB(0, 0), cB); PG8_STAGE_B(PG8_SB(0, 1), cB + hstepB); PG8_STAGE_A(PG8_SA(0, 0), cA, c00, c01); PG8_STAGE_A(PG8_SA(0, 1), cA, c10, c11);
    if (wr == 1) PG8_BAR;
    PG8_WAIT_V(2); PG8_BAR;
    PG8_STAGE_B(PG8_SB(1, 0), cB + kstep); PG8_STAGE_A(PG8_SA(1, 0), cA + kstep, c00, c01); PG8_STAGE_B(PG8_SB(1, 1), cB + hstepB + kstep);
    PG8_WAIT_V(6); PG8_BAR;
    for (;;) {
        const bool has_next = S.next(ui + 1, nxt);
        const char* nA = has_next ? S.a_base(nxt) : cA; const char* nB = has_next ? S.b_base(nxt) : cB;
        unsigned n00 = c00, n01 = c01, n10 = c10, n11 = c11;
        if (has_next) { n00 = S.a_off(nxt, Rr[0]) + Cc[0] * 2u; n01 = S.a_off(nxt, Rr[1]) + Cc[1] * 2u; n10 = S.a_off(nxt, HALF + Rr[0]) + Cc[0] * 2u; n11 = S.a_off(nxt, HALF + Rr[1]) + Cc[1] * 2u; }
        for (int t = 0; t < nt; t += 2) {
            const bool last = (t == nt - 2);
            const char* a1 = cA + (size_t)(t + 1) * kstep;
            const char* a2 = last ? nA : cA + (size_t)(t + 2) * kstep; const char* b2 = last ? nB : cB + (size_t)(t + 2) * kstep;
            const char* a3 = a2 + kstep; const char* b3 = b2 + kstep;
            const unsigned x00 = last ? n00 : c00, x01 = last ? n01 : c01, x10 = last ? n10 : c10, x11 = last ? n11 : c11;
            PG8_LDB(B0, 0, 0); PG8_LDB(B1, 0, 1); PG8_SCHED; PG8_LDA(At, 0, 0); PG8_STAGE_A(PG8_SA(1, 1), a1, c10, c11);
            PG8_WAIT_V(8); PG8_WAIT_L(0); PG8_BAR; PG8_MMA(0, 0, At, B0); PG8_MMA(0, 1, At, B1); PG8_BAR; PG8_SCHED;
            PG8_LDA(At, 0, 1); PG8_STAGE_B(PG8_SB(0, 0), b2); PG8_STAGE_B(PG8_SB(0, 1), b2 + hstepB); PG8_STAGE_A(PG8_SA(0, 0), a2, x00, x01);
            PG8_WAIT_V(8); PG8_WAIT_L(0); PG8_BAR; PG8_MMA(1, 0, At, B0); PG8_MMA(1, 1, At, B1); PG8_BAR; PG8_SCHED;
            PG8_LDB(B0, 1, 0); PG8_LDB(B1, 1, 1); PG8_SCHED; PG8_LDA(At, 1, 0); PG8_STAGE_A(PG8_SA(0, 1), a2, x10, x11);
            PG8_WAIT_V(8); PG8_WAIT_L(0); PG8_BAR; PG8_MMA(0, 0, At, B0); PG8_MMA(0, 1, At, B1); PG8_BAR; PG8_SCHED;
            PG8_LDA(At, 1, 1); PG8_STAGE_B(PG8_SB(1, 0), b3); PG8_STAGE_B(PG8_SB(1, 1), b3 + hstepB); PG8_STAGE_A(PG8_SA(1, 0), a3, x00, x01);
            PG8_WAIT_V(8); PG8_WAIT_L(0); PG8_BAR; PG8_MMA(1, 0, At, B0); PG8_MMA(1, 1, At, B1); PG8_BAR; PG8_SCHED;
        }
        asm volatile("s_nop 15\n\ts_nop 15" : "+v"(acc[1][1][0][0]), "+v"(acc[1][1][0][1]), "+v"(acc[1][1][1][0]), "+v"(acc[1][1][1][1]), "+v"(acc[1][1][2][0]), "+v"(acc[1][1][2][1]), "+v"(acc[1][1][3][0]), "+v"(acc[1][1][3][1]) :: "memory");
        if (wr == 0) PG8_BAR;
        E(acc, cur, wr, wc, fr, fq);
        if (!has_next) break;
#pragma unroll
        for (int a = 0; a < 2; ++a)
#pragma unroll
            for (int b = 0; b < 2; ++b)
#pragma unroll
                for (int m = 0; m < 4; ++m)
#pragma unroll
                    for (int n = 0; n < 2; ++n) acc[a][b][m][n] = (f32x4){0.f, 0.f, 0.f, 0.f};
        cur = nxt; cA = nA; cB = nB; c00 = n00; c01 = n01; c10 = n10; c11 = n11; ++ui;
        if (wr == 1) PG8_BAR;
    }
    PG8_WAIT_V(0);
    PG8_BAR;
#undef PG8_SA
#undef PG8_SB
#undef PG8_STAGE_A
#undef PG8_STAGE_B
#undef PG8_LDA
#undef PG8_LDB
#undef PG8_MMA
#undef PG8_WAIT_V
#undef PG8_WAIT_L
#undef PG8_BAR
#undef PG8_SCHED
}

struct GridOrder {
    int nM, nN, nG, G, c;
    __device__ __forceinline__ void init(int nM_, int nN_, int nG_) { nM = nM_; nN = nN_; nG = nG_; G = gridDim.x; c = blockIdx.x; }
    __device__ __forceinline__ bool next_mn(int i, Unit& u) const {
        const long L = (long)i * G + c; const int per = nM * nN; if (L >= (long)per * nG) return false;
        u.g = (int)(L / per); int wgid = (int)(L % per);
        if (nG == 1) { const int q = per / NXCD, r = per % NXCD, xcd = wgid % NXCD, off = wgid / NXCD; wgid = (xcd < r ? xcd * (q + 1) : r * (q + 1) + (xcd - r) * q) + off; }
        const int nig = WGM * nN, gid = wgid / nig, fm = gid * WGM, gsz = (nM - fm) < WGM ? (nM - fm) : WGM;
        u.pm = fm + ((wgid % nig) % gsz); u.pn = (wgid % nig) / gsz; return true;
    }
};
}
using pg8::Unit;

struct Frame { const Params* p; unsigned char* ws; LAS unsigned char* lds; int tid, lane, wid; };
#define WSP(T, off) ((T*)(ws + (off)))

__device__ __forceinline__ void phase_mods(const Params& P, unsigned char* ws, LAS unsigned char* lds) {
    const int tid = threadIdx.x;
    LAS float* sil = (LAS float*)lds;
    LAS float* part = sil + 9 * 1024;
    float* mods = WSP(float, WS_MODS);
    __syncthreads();
    for (int i = tid; i < 9 * 1024; i += NTHREADS) { const int r = i >> 10, k = i & 1023; const float v = r < 8 ? P.in[1][r * 1024 + k] : P.in[3][k]; sil[i] = v / (1.f + __expf(-v)); }
    __syncthreads();
    for (int u = blockIdx.x; u < 192; u += gridDim.x) {
        const int layer = u / 96, cb = u % 96;
        const float* W = P.in[layer ? 19 : 4]; const float* bm = P.in[layer ? 20 : 5];
        const int cl = tid & 63, kq = tid >> 6, col = cb * 64 + cl;
        float a0 = 0, a1 = 0, a2 = 0, a3 = 0, a4 = 0, a5 = 0, a6 = 0, a7 = 0, a8 = 0;
#pragma unroll 16
        for (int kk = 0; kk < 128; ++kk) { const int k = kq * 128 + kk;
            const float w = W[(size_t)k * 6144 + col];
            a0 += sil[0 * 1024 + k] * w; a1 += sil[1 * 1024 + k] * w; a2 += sil[2 * 1024 + k] * w; a3 += sil[3 * 1024 + k] * w; a4 += sil[4 * 1024 + k] * w;
            a5 += sil[5 * 1024 + k] * w; a6 += sil[6 * 1024 + k] * w; a7 += sil[7 * 1024 + k] * w; a8 += sil[8 * 1024 + k] * w; }
        __syncthreads();
        LAS float* pp = part + kq * 9 * 64 + cl;
        pp[0 * 64] = a0; pp[1 * 64] = a1; pp[2 * 64] = a2; pp[3 * 64] = a3; pp[4 * 64] = a4; pp[5 * 64] = a5; pp[6 * 64] = a6; pp[7 * 64] = a7; pp[8 * 64] = a8;
        __syncthreads();
        for (int i = tid; i < 9 * 64; i += NTHREADS) { const int r = i >> 6, c = i & 63;
            mods[((size_t)layer * 9 + r) * 6144 + cb * 64 + c] = (((part[0 * 576 + i] + part[1 * 576 + i]) + (part[2 * 576 + i] + part[3 * 576 + i])) + ((part[4 * 576 + i] + part[5 * 576 + i]) + (part[6 * 576 + i] + part[7 * 576 + i]))) + bm[cb * 64 + c]; }
    }
    __syncthreads();
}

__device__ __forceinline__ int cmap_col(int kind, int n, int nsrc) {
    if (kind == 1) {
        if (n < 2048) return n;
        if (n < 2816) return n + 32;
        if (n < 2848) return n - 2816 + 2048;
        return -1;
    }
    return n < nsrc ? n : -1;
}
__device__ __forceinline__ void convert_tile(const float* src, int nsrc, int K, bf16_t* dst, int kind, int tn, int tk, LAS float* tile  , int tid) {
    const int n0 = tn * 64, k0 = tk * 64;
    __syncthreads();
    {
        const int tx = tid & 15, ty = tid >> 4;
        const int n = n0 + tx * 4; const int sc = cmap_col(kind, n, nsrc);
#pragma unroll
        for (int i = 0; i < 2; ++i) { const int k = ty + 32 * i; f32x4 v = (f32x4){0.f, 0.f, 0.f, 0.f};
            if (sc >= 0) v = *(const f32x4*)(src + (size_t)(k0 + k) * nsrc + sc);
            tile[k * 65 + tx * 4 + 0] = v[0]; tile[k * 65 + tx * 4 + 1] = v[1]; tile[k * 65 + tx * 4 + 2] = v[2]; tile[k * 65 + tx * 4 + 3] = v[3]; }
    }
    __syncthreads();
    {
        const int kk = tid & 7, nn = tid >> 3;
        u32x4 w;
        w.x = pk2(tile[(kk * 8 + 0) * 65 + nn], tile[(kk * 8 + 1) * 65 + nn]); w.y = pk2(tile[(kk * 8 + 2) * 65 + nn], tile[(kk * 8 + 3) * 65 + nn]);
        w.z = pk2(tile[(kk * 8 + 4) * 65 + nn], tile[(kk * 8 + 5) * 65 + nn]); w.w = pk2(tile[(kk * 8 + 6) * 65 + nn], tile[(kk * 8 + 7) * 65 + nn]);
        *(u32x4*)(dst + (size_t)(n0 + nn) * K + k0 + kk * 8) = w;
    }
}
__device__ __forceinline__ void convert_tile8(const float* src, int nsrc, int K, unsigned char* dst, int tn, int tk, LAS float* tile  , int tid, int kind = 0) {
    const int n0 = tn * 64, k0 = tk * 64;
    __syncthreads();
    {   const int tx = tid & 15, ty = tid >> 4; const int sc = cmap_col(kind, n0 + tx * 4, nsrc);
#pragma unroll
        for (int i = 0; i < 2; ++i) { const int k = ty + 32 * i; f32x4 v = (f32x4){0.f, 0.f, 0.f, 0.f}; if (sc >= 0) v = *(const f32x4*)(src + (size_t)(k0 + k) * nsrc + sc);
            tile[k * 65 + tx * 4 + 0] = v[0]; tile[k * 65 + tx * 4 + 1] = v[1]; tile[k * 65 + tx * 4 + 2] = v[2]; tile[k * 65 + tx * 4 + 3] = v[3]; }
    }
    __syncthreads();
    {   const int kk = tid & 7, nn = tid >> 3; u32x2 w;
        w.x = pk4_fp8(tile[(kk * 8 + 0) * 65 + nn] * W8_SCALE, tile[(kk * 8 + 1) * 65 + nn] * W8_SCALE, tile[(kk * 8 + 2) * 65 + nn] * W8_SCALE, tile[(kk * 8 + 3) * 65 + nn] * W8_SCALE);
        w.y = pk4_fp8(tile[(kk * 8 + 4) * 65 + nn] * W8_SCALE, tile[(kk * 8 + 5) * 65 + nn] * W8_SCALE, tile[(kk * 8 + 6) * 65 + nn] * W8_SCALE, tile[(kk * 8 + 7) * 65 + nn] * W8_SCALE);
        *(u32x2*)(dst + (size_t)(n0 + nn) * K + k0 + kk * 8) = w;
    }
}
__device__ __forceinline__ void phase_convert_moe8(const Params& P, unsigned char* ws, LAS unsigned char* lds, int layer, bool skew = false) {
    LAS float* tile = (LAS float*)lds; const int tid = threadIdx.x;
    const float* wgu = P.in[layer ? 39 : 15]; const float* wd = P.in[layer ? 41 : 17];
    constexpr int IG = 32 * 32 * 4, ID = 32 * 16 * 4;
    const int tx = tid & 15, ty = tid >> 4;
    f32x4 v[8];
#define CV_DECODE(IT, SRC, NSRC, DST, TN, KB) do { if ((IT) < IG) { const int e_ = (IT) >> 7, r_ = (IT) & 127; SRC = wgu + (size_t)e_ * 1024 * 2048; NSRC = 2048; DST = ws + WS_WGU + (size_t)e_ * 2048 * 1024; TN = r_ >> 2; KB = r_ & 3; } \
        else { const int i2_ = (IT) - IG, e_ = i2_ >> 6, r_ = i2_ & 63; SRC = wd + (size_t)e_ * 1024 * 1024; NSRC = 1024; DST = ws + WS_WD + (size_t)e_ * 1024 * 1024; TN = r_ >> 2; KB = r_ & 3; } } while (0)
#define CV_LOAD(IT) do { const float* s_; int ns_, tn_, kb_; unsigned char* d_; CV_DECODE(IT, s_, ns_, d_, tn_, kb_); (void)d_; \
        _Pragma("unroll") for (int i = 0; i < 8; ++i) v[i] = *(const f32x4*)(s_ + (size_t)(kb_ * 256 + ty + 32 * i) * ns_ + tn_ * 64 + tx * 4); } while (0)
    const bool sk = skew && gridDim.x == 256, two = sk && blockIdx.x >= 192;
    const int stepA = sk ? (two ? 64 : 320) : (int)gridDim.x, stepB = sk ? (two ? 256 : 320) : (int)gridDim.x;
    int it = blockIdx.x, tog = 0;
    if (it < IG + ID) CV_LOAD(it);
    for (; it < IG + ID; it += (tog ? stepB : stepA), tog ^= 1) {
        const float* src; int nsrc, tn, kb; unsigned char* dst; CV_DECODE(it, src, nsrc, dst, tn, kb); (void)src; (void)nsrc;
        __syncthreads();
#pragma unroll
        for (int i = 0; i < 8; ++i) { const int k = ty + 32 * i, sk = 4 * i;
#pragma unroll
            for (int q = 0; q < 4; ++q) tile[k * 65 + ((tx * 4 + q + sk) & 63)] = v[i][q]; }
        __syncthreads();
        { const int itn = it + (tog ? stepB : stepA); if (itn < IG + ID) CV_LOAD(itn); }
        {   const int kq = tid & 7, nn = tid >> 3, col = (nn + 4 * kq) & 63; unsigned w[8];
#pragma unroll
            for (int j = 0; j < 8; ++j) { const int kk = kq * 32 + j * 4;
                w[j] = pk4_fp8(tile[(kk + 0) * 65 + col] * W8_SCALE, tile[(kk + 1) * 65 + col] * W8_SCALE, tile[(kk + 2) * 65 + col] * W8_SCALE, tile[(kk + 3) * 65 + col] * W8_SCALE); }
            unsigned char* o = dst + (size_t)(tn * 64 + nn) * 1024 + kb * 256 + kq * 32;
            *(u32x4*)o = (u32x4){w[0], w[1], w[2], w[3]}; *(u32x4*)(o + 16) = (u32x4){w[4], w[5], w[6], w[7]};
        }
    }
#undef CV_LOAD
#undef CV_DECODE
    __syncthreads();
}
struct CsJob { const float* src; int nsrc, K, kind, tn, tk, fp8; unsigned char* dst; };
__device__ __forceinline__ CsJob cs_job(const Params& P, unsigned char* ws, int t) {
    const int T0 = 48 * 16, T1 = T0 + 256, T2 = T1 + 24 * 16, T3 = T2 + 256; CsJob j;
    if (t < T0)      { j.src = P.in[8];  j.nsrc = 2848; j.K = 1024; j.kind = 1; j.tn = t / 16; j.tk = t % 16; j.fp8 = 0; j.dst = ws + WS_WIN0T; }
    else if (t < T1) { j.src = P.in[9];  j.nsrc = 1024; j.K = 1024; j.kind = 0; j.tn = (t - T0) / 16; j.tk = (t - T0) % 16; j.fp8 = 1; j.dst = ws + WS_WOUT0T; }
    else if (t < T2) { j.src = P.in[23]; j.nsrc = 1408; j.K = 1024; j.kind = 2; j.tn = (t - T1) / 16; j.tk = (t - T1) % 16; j.fp8 = 1; j.dst = ws + WS_WIN1T; }
    else if (t < T3) { j.src = P.in[24]; j.nsrc = 1024; j.K = 1024; j.kind = 0; j.tn = (t - T2) / 16; j.tk = (t - T2) % 16; j.fp8 = 0; j.dst = ws + WS_WOUT1T; }
    else             { j.src = P.in[33]; j.nsrc = 256;  j.K = 256;  j.kind = 0; j.tn = (t - T3) / 4;  j.tk = (t - T3) % 4;  j.fp8 = 0; j.dst = ws + WS_WGLUT; }
    return j;
}
__device__ __forceinline__ void cs_load(const CsJob& j, int tid, f32x4& v0, f32x4& v1) {
    const int tx = tid & 15, ty = tid >> 4; const int sc = cmap_col(j.kind, j.tn * 64 + tx * 4, j.nsrc);
    v0 = (f32x4){0.f, 0.f, 0.f, 0.f}; v1 = v0;
    if (sc >= 0) { v0 = *(const f32x4*)(j.src + (size_t)(j.tk * 64 + ty) * j.nsrc + sc); v1 = *(const f32x4*)(j.src + (size_t)(j.tk * 64 + ty + 32) * j.nsrc + sc); }
}
__device__ __forceinline__ void phase_convert_small(const Params& P, unsigned char* ws, LAS unsigned char* lds) {
    LAS float* tile = (LAS float*)lds; const int tid = threadIdx.x;
    const int T4 = 48 * 16 + 256 + 24 * 16 + 256 + 16;
    int t = blockIdx.x; if (t >= T4) { __syncthreads(); return; }
    CsJob job = cs_job(P, ws, t); f32x4 v0, v1; cs_load(job, tid, v0, v1);
    for (; t < T4; t += gridDim.x) {
        const int tnx = t + gridDim.x; CsJob jn = job; f32x4 n0 = v0, n1 = v1;
        if (tnx < T4) { jn = cs_job(P, ws, tnx); cs_load(jn, tid, n0, n1); }
        __syncthreads();
        {   const int tx = tid & 15, ty = tid >> 4;
            tile[ty * 65 + tx * 4 + 0] = v0[0]; tile[ty * 65 + tx * 4 + 1] = v0[1]; tile[ty * 65 + tx * 4 + 2] = v0[2]; tile[ty * 65 + tx * 4 + 3] = v0[3];
            tile[(ty + 32) * 65 + tx * 4 + 0] = v1[0]; tile[(ty + 32) * 65 + tx * 4 + 1] = v1[1]; tile[(ty + 32) * 65 + tx * 4 + 2] = v1[2]; tile[(ty + 32) * 65 + tx * 4 + 3] = v1[3]; }
        __syncthreads();
        {   const int kk = tid & 7, nn = tid >> 3; const int n0_ = job.tn * 64, k0_ = job.tk * 64;
            if (job.fp8) { u32x2 w;
                w.x = pk4_fp8(tile[(kk * 8 + 0) * 65 + nn] * W8_SCALE, tile[(kk * 8 + 1) * 65 + nn] * W8_SCALE, tile[(kk * 8 + 2) * 65 + nn] * W8_SCALE, tile[(kk * 8 + 3) * 65 + nn] * W8_SCALE);
                w.y = pk4_fp8(tile[(kk * 8 + 4) * 65 + nn] * W8_SCALE, tile[(kk * 8 + 5) * 65 + nn] * W8_SCALE, tile[(kk * 8 + 6) * 65 + nn] * W8_SCALE, tile[(kk * 8 + 7) * 65 + nn] * W8_SCALE);
                *(u32x2*)(job.dst + (size_t)(n0_ + nn) * job.K + k0_ + kk * 8) = w; }
            else { u32x4 w;
                w.x = pk2(tile[(kk * 8 + 0) * 65 + nn], tile[(kk * 8 + 1) * 65 + nn]); w.y = pk2(tile[(kk * 8 + 2) * 65 + nn], tile[(kk * 8 + 3) * 65 + nn]);
                w.z = pk2(tile[(kk * 8 + 4) * 65 + nn], tile[(kk * 8 + 5) * 65 + nn]); w.w = pk2(tile[(kk * 8 + 6) * 65 + nn], tile[(kk * 8 + 7) * 65 + nn]);
                *(u32x4*)((bf16_t*)job.dst + (size_t)(n0_ + nn) * job.K + k0_ + kk * 8) = w; } }
        job = jn; v0 = n0; v1 = n1;
    }
    __syncthreads();
}
__device__ __forceinline__ void phase_convert_moe(const Params& P, unsigned char* ws, LAS unsigned char* lds, int layer) {
    LAS float* tile = (LAS float*)lds; const int tid = threadIdx.x;
    const float* wgu = P.in[layer ? 39 : 15]; const float* wd = P.in[layer ? 41 : 17];
    const int TG = 32 * 32 * 16, TD = 32 * 16 * 16;
    for (int t = blockIdx.x; t < TG + TD; t += gridDim.x) {
        if (t < TG) { const int e = t / 512, r = t % 512; convert_tile(wgu + (size_t)e * 1024 * 2048, 2048, 1024, WSP(bf16_t, WS_WGU) + (size_t)e * 2048 * 1024, 0, r / 16, r % 16, tile, tid); }
        else { const int t2 = t - TG, e = t2 / 256, r = t2 % 256; convert_tile(wd + (size_t)e * 1024 * 1024, 1024, 1024, WSP(bf16_t, WS_WD) + (size_t)e * 1024 * 1024, 0, r / 16, r % 16, tile, tid); }
    }
    __syncthreads();
}


__device__ __forceinline__ void cmul(float ar, float ai, float br, float bi, float& cr, float& ci) { cr = ar * br - ai * bi; ci = ar * bi + ai * br; }
__device__ __forceinline__ void s5_lam(const Params& P, int dir, int g, int p, float& lr, float& li, float& dt) {
    lr = P.in[25][(dir * 16 + g) * 64 + p]; li = P.in[26][(dir * 16 + g) * 64 + p]; dt = expf(P.in[27][dir * 16 + g]);
}
__device__ __forceinline__ void s5_apow(float lr, float li, float dt, float tau, float& re, float& im) {
    const float mag = expf(lr * dt * tau); float s, c; sincosf(li * dt * tau, &s, &c); re = mag * c; im = mag * s;
}
__device__ __forceinline__ void s5_bscale(float lr, float li, float dt, float& re, float& im) {
    float ar, ai; s5_apow(lr, li, dt, 1.f, ar, ai); ar -= 1.f; const float d = lr * lr + li * li; re = (ar * lr + ai * li) / d; im = (ai * lr - ar * li) / d;
}
__device__ __forceinline__ void phase_s5_kernels(const Params& P, unsigned char* ws, LAS unsigned char* lds) {
    const int tid = threadIdx.x;
    LAS float* zr = (LAS float*)lds;
    LAS float* zi = zr + 128;
    float* Kt = WSP(float, WS_S5K);
    for (int u = blockIdx.x; u < 16 * 2 * 32; u += gridDim.x) {
        const int g = u / 64, dir = (u / 32) & 1, tp = u % 32;
        __syncthreads();
        if (tid < 128) { const int sub = tid >> 6, p = tid & 63; float lr, li, dt; s5_lam(P, dir, g, p, lr, li, dt);
            float ar, ai, br, bi, r, i; s5_apow(lr, li, dt, (float)(tp * 2 + sub), ar, ai); s5_bscale(lr, li, dt, br, bi); cmul(ar, ai, br, bi, r, i); zr[tid] = r; zi[tid] = i; }
        __syncthreads();
        const int sub = tid >> 8, cj = tid & 255, c = cj >> 4, j = cj & 15;
        float acc = 0.f;
#pragma unroll 16
        for (int p = 0; p < 64; ++p) {
            const float cr = P.in[30][(g * 16 + c) * 64 + p], ci = P.in[31][(g * 16 + c) * 64 + p];
            const float br = P.in[28][(g * 64 + p) * 16 + j], bi = P.in[29][(g * 64 + p) * 16 + j];
            float tr, ti, ur, ui; cmul(zr[sub * 64 + p], zi[sub * 64 + p], br, bi, tr, ti); cmul(cr, ci, tr, ti, ur, ui); acc += ur;
        }
        Kt[(((size_t)g * 2 + dir) * 64 + tp * 2 + sub) * 256 + cj] = acc;
    }
    if (blockIdx.x == gridDim.x - 1) {
        float* A64 = WSP(float, WS_S5A64);
        for (int i = tid; i < 2 * 16 * 64; i += NTHREADS) { const int dir = i / 1024, g = (i / 64) & 15, p = i & 63; float lr, li, dt, r, im; s5_lam(P, dir, g, p, lr, li, dt); s5_apow(lr, li, dt, 64.f, r, im); A64[i * 2] = r; A64[i * 2 + 1] = im; }
    }
    __syncthreads();
}
__device__ __forceinline__ void phase_s5_tables(const Params& P, unsigned char* ws) {
    const float* __restrict__ Kt = WSP(float, WS_S5K);
    bf16_t* __restrict__ TE = WSP(bf16_t, WS_S5TE); bf16_t* __restrict__ Ft = WSP(bf16_t, WS_S5F);
    const float* __restrict__ Cr = P.in[30]; const float* __restrict__ Ci = P.in[31]; const float* __restrict__ Br = P.in[28]; const float* __restrict__ Bi = P.in[29];
    const size_t gsz = (size_t)gridDim.x * NTHREADS, gid = (size_t)blockIdx.x * NTHREADS + threadIdx.x;
#pragma unroll 4
    for (size_t i = gid; i < (size_t)16 * 1024 * 128; i += gsz) {
        const int g = (int)(i / (1024 * 128)), r = (int)((i / 128) % 1024), k8 = (int)(i % 128);
        const int t = r >> 4, c = r & 15, s = k8 >> 1, j0 = (k8 & 1) * 8;
        const int df = s <= t ? t - s : 0, db = s >= t ? s - t : 0;
        const float* pf = Kt + (((size_t)g * 2 + 0) * 64 + df) * 256 + c * 16 + j0; const float* pb = Kt + (((size_t)g * 2 + 1) * 64 + db) * 256 + c * 16 + j0;
        const f32x4 f0 = *(const f32x4*)pf, f1 = *(const f32x4*)(pf + 4), b0 = *(const f32x4*)pb, b1 = *(const f32x4*)(pb + 4);
        const float mf = s <= t ? 1.f : 0.f, mb = s >= t ? 1.f : 0.f;
        const f32x4 x0 = f0 * mf + b0 * mb, x1 = f1 * mf + b1 * mb;
        u32x4 w; w.x = pk2(x0[0], x0[1]); w.y = pk2(x0[2], x0[3]); w.z = pk2(x1[0], x1[1]); w.w = pk2(x1[2], x1[3]);
        *(u32x4*)(TE + ((size_t)g * 1024 + r) * 1280 + k8 * 8) = w;
    }
#pragma unroll 4
    for (size_t i = gid; i < (size_t)16 * 1024 * 128; i += gsz) {
        const int g = (int)(i / (1024 * 128)), r = (int)((i / 128) % 1024), dp = (int)(i % 128), dir = dp >> 6, p = dp & 63;
        const int t = r >> 4, c = r & 15;
        float lr, li, dt, ar, ai, zr, zi; s5_lam(P, dir, g, p, lr, li, dt);
        s5_apow(lr, li, dt, dir == 0 ? (float)(t + 1) : (float)(64 - t), ar, ai);
        cmul(Cr[(g * 16 + c) * 64 + p], Ci[(g * 16 + c) * 64 + p], ar, ai, zr, zi);
        bf16_t* row = TE + ((size_t)g * 1024 + r) * 1280 + 1024 + dir * 128;
        row[p] = (bf16_t)f2bf(zr); row[64 + p] = (bf16_t)f2bf(-zi);
    }
#pragma unroll 4
    for (size_t i = gid; i < (size_t)16 * 128 * 1024; i += gsz) {
        const int g = (int)(i / (128 * 1024)), dp = (int)((i / 1024) % 128), k = (int)(i % 1024), dir = dp >> 6, p = dp & 63, s = k >> 4, j = k & 15;
        float lr, li, dt, ar, ai, br, bi, tr, ti, zr, zi; s5_lam(P, dir, g, p, lr, li, dt);
        s5_apow(lr, li, dt, dir == 0 ? (float)(63 - s) : (float)s, ar, ai); s5_bscale(lr, li, dt, br, bi); cmul(ar, ai, br, bi, tr, ti);
        cmul(tr, ti, Br[(g * 64 + p) * 16 + j], Bi[(g * 64 + p) * 16 + j], zr, zi);
        Ft[((size_t)g * 256 + dir * 128 + p) * 1024 + k] = (bf16_t)f2bf(zr);
        Ft[((size_t)g * 256 + dir * 128 + 64 + p) * 1024 + k] = (bf16_t)f2bf(zi);
    }
}

__device__ __forceinline__ void phase_router_tables(const Params& P, unsigned char* ws, LAS unsigned char* lds) {
    LAS float* part = (LAS float*)lds;
    const float* mods = WSP(float, WS_MODS); bf16_t* GWH = WSP(bf16_t, WS_GW); bf16_t* GWL = GWH + (size_t)2 * 9 * 32 * 1024; float* CB = WSP(float, WS_CB);
    const size_t gsz = (size_t)gridDim.x * NTHREADS, gid = (size_t)blockIdx.x * NTHREADS + threadIdx.x;
    for (size_t i = gid; i < (size_t)2 * 9 * 1024 * 32; i += gsz) {
        const int layer = (int)(i / (9 * 32768)), r = (int)((i / 32768) % 9), k = (int)((i / 32) % 1024), e = (int)(i % 32);
        const float* m = mods + ((size_t)layer * 9 + r) * 6144;
        const float v = P.in[layer ? 22 : 7][k] * (1.f + m[4096 + k]) * P.in[layer ? 37 : 13][k * 32 + e];
        const unsigned h = f2bf(v), l = f2bf(v - __builtin_bit_cast(float, h << 16)); const size_t o = (((size_t)layer * 9 + r) * 32 + e) * 1024 + k;
        GWH[o] = (bf16_t)h; GWL[o] = (bf16_t)l;
    }
    for (int u = blockIdx.x; u < 18; u += gridDim.x) {
        const int layer = u / 9, r = u % 9, e = threadIdx.x & 31, ks = threadIdx.x >> 5;
        const float* m = mods + ((size_t)layer * 9 + r) * 6144; const float* W = P.in[layer ? 37 : 13];
        float a = 0.f;
#pragma unroll 16
        for (int k = ks * 64; k < ks * 64 + 64; ++k) a += m[3072 + k] * W[k * 32 + e];
        __syncthreads(); part[threadIdx.x] = a; __syncthreads();
        if (threadIdx.x < 32) { float t = P.in[layer ? 38 : 14][e];
            for (int q = 0; q < 16; ++q) t += part[q * 32 + e];
            CB[(layer * 9 + r) * 32 + e] = t; }
    }
}

__device__ __forceinline__ void phase_norm1(const Params& P, unsigned char* ws, int layer, const float* xlat, const float* xctx) {
    const int lane = threadIdx.x & 63, gw = blockIdx.x * 8 + (threadIdx.x >> 6), nw = gridDim.x * 8;
    const float* mods = WSP(float, WS_MODS) + (size_t)layer * 9 * 6144; const float* g = P.in[layer ? 21 : 6];
    bf16_t* XN = WSP(bf16_t, WS_XN);
    f32x4 nx[3][4]; f32x4 gg[4];
#define N1_ROWPTR(ROW) ((ROW) < NCTX ? xctx + (size_t)(ROW) * 1024 : xlat + (size_t)((ROW) - NCTX) * 1024)
#pragma unroll
    for (int i = 0; i < 4; ++i) gg[i] = *(const f32x4*)(g + i * 256 + lane * 4);
#pragma unroll
    for (int u = 0; u < 3; ++u) if (gw + u * nw < NTOK) { const float* x = N1_ROWPTR(gw + u * nw);
#pragma unroll
        for (int i = 0; i < 4; ++i) nx[u][i] = *(const f32x4*)(x + i * 256 + lane * 4); }
    for (int row0 = gw; row0 < NTOK; row0 += 3 * nw) {
#pragma unroll
        for (int u = 0; u < 3; ++u) { const int row = row0 + u * nw; if (row < NTOK) {
            const int r = row < NCTX ? 8 : (row - NCTX) >> 13;
            f32x4 v[4]; float ss = 0.f;
#pragma unroll
            for (int i = 0; i < 4; ++i) { v[i] = nx[u][i]; ss += v[i][0] * v[i][0] + v[i][1] * v[i][1] + v[i][2] * v[i][2] + v[i][3] * v[i][3]; }
            if (row + 3 * nw < NTOK) { const float* x = N1_ROWPTR(row + 3 * nw);
#pragma unroll
                for (int i = 0; i < 4; ++i) nx[u][i] = *(const f32x4*)(x + i * 256 + lane * 4); }
            const float* m = mods + (size_t)r * 6144; f32x4 sh[4], sc[4];
#pragma unroll
            for (int i = 0; i < 4; ++i) { const int k = i * 256 + lane * 4; sh[i] = *(const f32x4*)(m + k); sc[i] = *(const f32x4*)(m + 1024 + k); }
            ss = wave_sum(ss); const float rstd = rsqrtf(ss * (1.f / 1024.f) + 1e-6f);
#pragma unroll
            for (int i = 0; i < 4; ++i) { const int k = i * 256 + lane * 4;
                const f32x4 o = v[i] * rstd * gg[i] * (1.f + sc[i]) + sh[i];
                u32x2 w; w.x = pk2(o[0], o[1]); w.y = pk2(o[2], o[3]); *(u32x2*)(XN + (size_t)row * 1024 + k) = w; } } }
    }
#undef N1_ROWPTR
}

struct SchedPlain : pg8::GridOrder {
    const char* A; const char* Bt; unsigned lda_bytes; int ldb_bytes; size_t a_gstride, b_gstride;
    __device__ __forceinline__ bool next(int i, Unit& u) const { return next_mn(i, u); }
    __device__ __forceinline__ const char* a_base(const Unit& u) const { return A + (size_t)u.g * a_gstride + (size_t)u.pm * 256 * lda_bytes; }
    __device__ __forceinline__ unsigned a_off(const Unit&, int r) const { return (unsigned)r * lda_bytes; }
    __device__ __forceinline__ const char* b_base(const Unit& u) const { return Bt + (size_t)u.g * b_gstride + (size_t)u.pn * 256 * ldb_bytes; }
};
typedef const f32x4 (&AccRef)[2][2][4][2];
__device__ __forceinline__ u32x4 pack8(const f32x4& v0, const f32x4& v1) { u32x4 w; w.x = pg8::cvt_pk_bf16(v0[0], v0[1]); w.y = pg8::cvt_pk_bf16(v0[2], v0[3]); w.z = pg8::cvt_pk_bf16(v1[0], v1[1]); w.w = pg8::cvt_pk_bf16(v1[2], v1[3]); return w; }

struct EpiInProj0 { static constexpr bool PERM = true;
    unsigned char* R; const float* gate_bias;
    __device__ __forceinline__ void operator()(AccRef acc, const Unit& u, int wr, int wc, int fr, int fq) const {
        const int row0 = u.pm * 256 + wr * 64 + fr, c8 = wc * 32 + 8 * fq;
#pragma unroll
        for (int ai = 0; ai < 2; ++ai)
#pragma unroll
            for (int m = 0; m < 4; ++m) { const size_t row = (size_t)(row0 + ai * 128 + m * 16);
#pragma unroll
                for (int bj = 0; bj < 2; ++bj) { f32x4 v0 = acc[ai][bj][m][0], v1 = acc[ai][bj][m][1];
                    if (u.pn < 10) { const int sec = u.pn >> 1, col = (u.pn & 1) * 256 + bj * 128 + c8;
                        if (sec == 1) { v0 = v0 * 0.125f; v1 = v1 * 0.125f; }
                        *(u32x4*)(R + R_QA + (size_t)sec * PROJ512 + (row * 512 + col) * 2) = pack8(v0, v1); }
                    else if (u.pn == 10) { *(u32x4*)(R + (bj == 0 ? R_KBR : R_VBR) + (row * 128 + c8) * 2) = pack8(v0, v1); }
                    else if (bj == 0 && wc == 0) { float* gp = (float*)(R + R_G) + row * 32 + 8 * fq;
                        const f32x4 b0 = *(const f32x4*)(gate_bias + 8 * fq), b1 = *(const f32x4*)(gate_bias + 8 * fq + 4);
                        *(f32x4*)gp = v0 + b0; *(f32x4*)(gp + 4) = v1 + b1; } } }
    }
};
__device__ __forceinline__ void row_to_chunk(int row, int& n, int& s) {
    if (row < NCTX) { const int b = row >> 8, l = row & 255; n = 1024 + b * 4 + (l >> 6); s = l & 63; }
    else { const int r2 = row - NCTX, b = r2 >> 13, st = r2 & 8191; n = b * 128 + (st >> 6); s = st & 63; }
}
struct EpiInProj1 { static constexpr bool PERM = true;
    unsigned char* R;
    __device__ __forceinline__ void operator()(AccRef acc, const Unit& u, int wr, int wc, int fr, int fq) const {
        const int row0 = u.pm * 256 + wr * 64 + fr, c8 = wc * 32 + 8 * fq;
#pragma unroll
        for (int ai = 0; ai < 2; ++ai)
#pragma unroll
            for (int m = 0; m < 4; ++m) { const int rowi = row0 + ai * 128 + m * 16; const size_t row = (size_t)rowi;
#pragma unroll
                for (int bj = 0; bj < 2; ++bj) { const u32x4 w = pack8(acc[ai][bj][m][0] * W8_INV, acc[ai][bj][m][1] * W8_INV);
                    if (u.pn == 0) { const int c0 = bj * 128 + c8, g = c0 >> 4, j0 = c0 & 15; int n, s; row_to_chunk(rowi, n, s);
                        *(u32x4*)(R + R_UX + (((size_t)g * 1280 + n) * 1280 + s * 16 + j0) * 2) = w; }
                    else if (u.pn < 4) { *(u32x4*)(R + R_Q1 + (row * 768 + (u.pn - 1) * 256 + bj * 128 + c8) * 2) = w; }
                    else if (u.pn == 4) { *(u32x4*)(R + R_KV1 + (row * 384 + bj * 128 + c8) * 2) = w; }
                    else if (bj == 0) { *(u32x4*)(R + R_KV1 + (row * 384 + 256 + c8) * 2) = w; } } }
    }
};
struct EpiResid { static constexpr bool PERM = false;
    const float* xin; float* xout; const float* hin; float* hout; const float* gate  ; int row_base; float scale;
    __device__ __forceinline__ void operator()(AccRef acc, const Unit& u, int wr, int wc, int fr, int fq) const {
        const int rowu = row_base + u.pm * 256, row0 = rowu + wr * 64 + fr, col0 = u.pn * 256 + wc * 32 + 4 * fq;
        const float* g = gate + (rowu < NCTX ? 8 : ((rowu - NCTX) >> 13)) * 6144;
        f32x4 gg[2][2];
#pragma unroll
        for (int bj = 0; bj < 2; ++bj)
#pragma unroll
            for (int n = 0; n < 2; ++n) gg[bj][n] = *(const f32x4*)(g + col0 + bj * 128 + n * 16) * scale;
#pragma unroll
        for (int ai = 0; ai < 2; ++ai)
#pragma unroll
            for (int m = 0; m < 4; ++m) { const int row = row0 + ai * 128 + m * 16;
                const float* src; float* dst;
                if (row < NCTX) { src = hin + (size_t)row * 1024; dst = hout + (size_t)row * 1024; }
                else { const int r2 = row - NCTX; src = xin + (size_t)r2 * 1024; dst = xout + (size_t)r2 * 1024; }
#pragma unroll
                for (int bj = 0; bj < 2; ++bj)
#pragma unroll
                    for (int n = 0; n < 2; ++n) { const int c = col0 + bj * 128 + n * 16;
                        *(f32x4*)(dst + c) = *(const f32x4*)(src + c) + gg[bj][n] * acc[ai][bj][m][n]; } }
    }
};
struct EpiS5F { static constexpr bool PERM = false;
    float* S;
    __device__ __forceinline__ void operator()(AccRef acc, const Unit& u, int wr, int wc, int fr, int fq) const {
        const int row0 = u.pm * 256 + wr * 64 + fr, col0 = wc * 32 + 4 * fq;
#pragma unroll
        for (int ai = 0; ai < 2; ++ai)
#pragma unroll
            for (int m = 0; m < 4; ++m) { float* rp = S + ((size_t)u.g * 1280 + row0 + ai * 128 + m * 16) * 256 + col0;
#pragma unroll
                for (int bj = 0; bj < 2; ++bj)
#pragma unroll
                    for (int n = 0; n < 2; ++n) *(f32x4*)(rp + bj * 128 + n * 16) = acc[ai][bj][m][n]; }
    }
};
__device__ __forceinline__ float gelu_tanh(float x) { const float u = 0.7978845608028654f * (x + 0.044715f * x * x * x); const float e = __builtin_amdgcn_exp2f(2.885390081777927f * u); const float th = 1.f - 2.f * __builtin_amdgcn_rcpf(e + 1.f); return 0.5f * x * (1.f + th); }
struct EpiS5Y { static constexpr bool PERM = true;
    const bf16_t* UX; bf16_t* Yg; const float* dskip;
    __device__ __forceinline__ void operator()(AccRef acc, const Unit& u, int wr, int wc, int fr, int fq) const {
        const int row0 = u.pm * 256 + wr * 64 + fr;
#pragma unroll
        for (int ai = 0; ai < 2; ++ai)
#pragma unroll
            for (int m = 0; m < 4; ++m) { const int n = row0 + ai * 128 + m * 16;
#pragma unroll
                for (int bj = 0; bj < 2; ++bj) { const int c0 = u.pn * 256 + bj * 128 + wc * 32 + 8 * fq, t = c0 >> 4, cc = c0 & 15;
                    const u32x4 uw = *(const u32x4*)(UX + ((size_t)u.g * 1280 + n) * 1280 + t * 16 + cc);
                    const float* ds = dskip + u.g * 16 + cc;
                    f32x4 v0 = acc[ai][bj][m][0], v1 = acc[ai][bj][m][1];
                    v0[0] = gelu_tanh(v0[0] + ds[0] * bflo(uw.x)); v0[1] = gelu_tanh(v0[1] + ds[1] * bfhi(uw.x)); v0[2] = gelu_tanh(v0[2] + ds[2] * bflo(uw.y)); v0[3] = gelu_tanh(v0[3] + ds[3] * bfhi(uw.y));
                    v1[0] = gelu_tanh(v1[0] + ds[4] * bflo(uw.z)); v1[1] = gelu_tanh(v1[1] + ds[5] * bfhi(uw.z)); v1[2] = gelu_tanh(v1[2] + ds[6] * bflo(uw.w)); v1[3] = gelu_tanh(v1[3] + ds[7] * bfhi(uw.w));
                    *(u32x4*)(Yg + ((size_t)n * 64 + t) * 256 + u.g * 16 + cc) = pack8(v0, v1); } }
    }
};
struct EpiGLU { static constexpr bool PERM = true;
    const bf16_t* Yg; bf16_t* MIX; const float* bglu;
    __device__ __forceinline__ void operator()(AccRef acc, const Unit& u, int wr, int wc, int fr, int fq) const {
        const int row0 = u.pm * 256 + wr * 64 + fr;
#pragma unroll
        for (int ai = 0; ai < 2; ++ai)
#pragma unroll
            for (int m = 0; m < 4; ++m) { const size_t tok = (size_t)(row0 + ai * 128 + m * 16);
#pragma unroll
                for (int bj = 0; bj < 2; ++bj) { const int c0 = bj * 128 + wc * 32 + 8 * fq;
                    const u32x4 yw = *(const u32x4*)(Yg + tok * 256 + c0); const float* bg = bglu + c0;
                    f32x4 v0 = acc[ai][bj][m][0], v1 = acc[ai][bj][m][1];
                    v0[0] = bflo(yw.x) * sigmoidf_(v0[0] + bg[0]); v0[1] = bfhi(yw.x) * sigmoidf_(v0[1] + bg[1]); v0[2] = bflo(yw.y) * sigmoidf_(v0[2] + bg[2]); v0[3] = bfhi(yw.y) * sigmoidf_(v0[3] + bg[3]);
                    v1[0] = bflo(yw.z) * sigmoidf_(v1[0] + bg[4]); v1[1] = bfhi(yw.z) * sigmoidf_(v1[1] + bg[5]); v1[2] = bflo(yw.w) * sigmoidf_(v1[2] + bg[6]); v1[3] = bfhi(yw.w) * sigmoidf_(v1[3] + bg[7]);
                    if (DBG_SKIP & 8) { v0 = v0 * 0.f; v1 = v1 * 0.f; }
                    *(u32x4*)(MIX + ((size_t)NCTX + tok) * 1024 + c0) = pack8(v0, v1); } }
    }
};

struct MoeTab { LAS int* pad_start  ; LAS int* rb_start  ; LAS unsigned char* rb_exp  ; };
__device__ __forceinline__ MoeTab moe_tab(LAS unsigned char* misc) { MoeTab t; t.pad_start = (LAS int*)(misc + 64); t.rb_start = (LAS int*)(misc + 64 + 256); t.rb_exp = misc + 64 + 512; return t; }
__device__ __forceinline__ void moe_build_tab(const unsigned* cnt, const MoeTab& T) {
    __syncthreads();
    if (threadIdx.x == 0) { int ps = 0, rb = 0; for (int e = 0; e < NEXP; ++e) { T.pad_start[e] = ps; T.rb_start[e] = rb; const int nb = ((int)cnt[e] + 255) >> 8; ps += nb * 256; rb += nb; } T.pad_start[NEXP] = ps; T.rb_start[NEXP] = rb; }
    __syncthreads();
    const int nrb = T.rb_start[NEXP];
    for (int i = threadIdx.x; i < nrb; i += NTHREADS) { int e = 0; while (T.rb_start[e + 1] <= i) ++e; T.rb_exp[i] = (unsigned char)e; }
    __syncthreads();
}
struct SchedMoe1 {
    const char* XN; const int* rowtok; const char* W; MoeTab T; int rb_lo, rb_hi, G, c; int ldb_bytes;
    __device__ __forceinline__ bool next(int i, Unit& u) const { const int x = c & 7, slot = c >> 3, W = G >> 3, nrb = rb_hi - rb_lo, r0 = (int)((long)nrb * x / 8), r1 = (int)((long)nrb * (x + 1) / 8);
        const long j = (long)i * W + slot; const int rbl = (int)(j >> 3); if (r0 + rbl >= r1) return false; u.pm = rb_lo + r0 + rbl; u.pn = (int)(j & 7); u.g = T.rb_exp[u.pm]; return true; }
    __device__ __forceinline__ const char* a_base(const Unit&) const { return XN; }
    __device__ __forceinline__ unsigned a_off(const Unit& u, int r) const { return (unsigned)rowtok[u.pm * 256 + r] * 1024u; }
    __device__ __forceinline__ const char* b_base(const Unit& u) const { return W + ((size_t)u.g * 2048 + (size_t)u.pn * 256) * 1024; }
};
struct EpiSwiGLU { static constexpr bool PERM = true;
    unsigned char* ACT; const float* bgu; int rb_lo;
    __device__ __forceinline__ void operator()(AccRef acc, const Unit& u, int wr, int wc, int fr, int fq) const {
        const int row0 = (u.pm - rb_lo) * 256 + wr * 64 + fr;
#pragma unroll
        for (int bj = 0; bj < 2; ++bj) { const int c0 = u.pn * 256 + bj * 128 + wc * 32 + 8 * fq;
            const f32x4 b0 = *(const f32x4*)(bgu + (size_t)u.g * 2048 + c0), b1 = *(const f32x4*)(bgu + (size_t)u.g * 2048 + c0 + 4);
#pragma unroll
            for (int ai = 0; ai < 2; ++ai)
#pragma unroll
                for (int m = 0; m < 4; ++m) { const f32x4 v0 = fma4(acc[ai][bj][m][0], W8_INV, b0), v1 = fma4(acc[ai][bj][m][1], W8_INV, b1);
                    float o[4];
#pragma unroll
                    for (int q = 0; q < 4; ++q) { const float hg = q < 2 ? v0[2 * q] : v1[2 * q - 4], hl = q < 2 ? v0[2 * q + 1] : v1[2 * q - 3];
                        const float glu = fminf(hg, 7.f), lin1 = __builtin_amdgcn_fmed3f(hl, -7.f, 7.f) + 1.f;
                        o[q] = glu * __builtin_amdgcn_rcpf(1.f + __builtin_amdgcn_exp2f(glu * (-1.702f * 1.4426950408889634f))) * lin1; }
                    *(unsigned*)(ACT + (size_t)(row0 + ai * 128 + m * 16) * 1024 + (c0 >> 1)) = pk4_fp8_nc(o[0], o[1], o[2], o[3]); } }
    }
};
struct SchedMoe2 {
    const char* ACT; const char* W; MoeTab T; int rb_lo, rb_hi, G, c; int ldb_bytes;
    __device__ __forceinline__ bool next(int i, Unit& u) const { const int x = c & 7, slot = c >> 3, W = G >> 3, nrb = rb_hi - rb_lo, r0 = (int)((long)nrb * x / 8), r1 = (int)((long)nrb * (x + 1) / 8);
        const long j = (long)i * W + slot; const int rbl = (int)(j >> 2); if (r0 + rbl >= r1) return false; u.pm = rb_lo + r0 + rbl; u.pn = (int)(j & 3); u.g = T.rb_exp[u.pm]; return true; }
    __device__ __forceinline__ const char* a_base(const Unit& u) const { return ACT + (size_t)(u.pm - rb_lo) * 256 * 1024; }
    __device__ __forceinline__ unsigned a_off(const Unit&, int r) const { return (unsigned)r * 1024u; }
    __device__ __forceinline__ const char* b_base(const Unit& u) const { return W + ((size_t)u.g * 1024 + (size_t)u.pn * 256) * 1024; }
};
struct EpiMoeOut { static constexpr bool PERM = true;
    unsigned char* OUT; const float* bd; int rb_lo;
    __device__ __forceinline__ void operator()(AccRef acc, const Unit& u, int wr, int wc, int fr, int fq) const {
        const int row0 = (u.pm - rb_lo) * 256 + wr * 64 + fr;
#pragma unroll
        for (int bj = 0; bj < 2; ++bj) { const int c0 = u.pn * 256 + bj * 128 + wc * 32 + 8 * fq;
            const f32x4 b0 = *(const f32x4*)(bd + (size_t)u.g * 1024 + c0), b1 = *(const f32x4*)(bd + (size_t)u.g * 1024 + c0 + 4);
#pragma unroll
            for (int ai = 0; ai < 2; ++ai)
#pragma unroll
                for (int m = 0; m < 4; ++m) { const f32x4 v0 = fma4(acc[ai][bj][m][0], W8_INV, b0), v1 = fma4(acc[ai][bj][m][1], W8_INV, b1);
                    *(u32x2*)(OUT + (size_t)(row0 + ai * 128 + m * 16) * 1024 + c0) = (u32x2){pk4_fp8(v0[0], v0[1], v0[2], v0[3]), pk4_fp8(v1[0], v1[1], v1[2], v1[3])}; } }
    }
};

__device__ __forceinline__ int crow(int r, int hi) { return (r & 3) + 8 * (r >> 2) + 4 * hi; }
__device__ __forceinline__ f32x16 mma32(LAS const bf16_t* A, int lda, LAS const bf16_t* Bt, int ldb, int K, f32x16 acc, int lane) {
    const int r = lane & 31, hh = lane >> 5;
    for (int ks = 0; ks < K; ks += 16) {
        const bf16x8 a = *(LAS const bf16x8*)(A + r * lda + ks + hh * 8);
        const bf16x8 b = *(LAS const bf16x8*)(Bt + r * ldb + ks + hh * 8);
        acc = __builtin_amdgcn_mfma_f32_32x32x16_bf16(a, b, acc, 0, 0, 0);
    }
    return acc;
}
__device__ __forceinline__ void lds_addf(LAS float* p, float v) { (void)__hip_atomic_fetch_add(p, v, __ATOMIC_RELAXED, __HIP_MEMORY_SCOPE_WORKGROUP); }
__device__ __forceinline__ int lds_addi(LAS int* p, int v) { return __hip_atomic_fetch_add(p, v, __ATOMIC_RELAXED, __HIP_MEMORY_SCOPE_WORKGROUP); }
constexpr f32x16 F16ZERO = {0.f, 0.f, 0.f, 0.f, 0.f, 0.f, 0.f, 0.f, 0.f, 0.f, 0.f, 0.f, 0.f, 0.f, 0.f, 0.f};

__device__ __forceinline__ int mlstm_row0(int b, int n) { return n < 4 ? b * 256 + n * 64 : NCTX + b * 8192 + (n - 4) * 64; }
__device__ __forceinline__ size_t mlstm_unit(int b, int h, int dir, int n) { return ((size_t)((b * 8 + h) * 2 + dir)) * NCH + n; }
constexpr int LP = 72;

template <bool TR>
__device__ __forceinline__ void load_tile64(const bf16_t* g, size_t ld, LAS bf16_t* dst, int tid) {
    const int row = tid >> 3, c8 = (tid & 7) * 8;
    const u32x4 w = *(const u32x4*)(g + (size_t)row * ld + c8);
    if (!TR) *(LAS u32x4*)(dst + row * LP + c8) = w;
    else { dst[(c8 + 0) * LP + row] = (bf16_t)(w.x & 0xffff); dst[(c8 + 1) * LP + row] = (bf16_t)(w.x >> 16); dst[(c8 + 2) * LP + row] = (bf16_t)(w.y & 0xffff); dst[(c8 + 3) * LP + row] = (bf16_t)(w.y >> 16);
           dst[(c8 + 4) * LP + row] = (bf16_t)(w.z & 0xffff); dst[(c8 + 5) * LP + row] = (bf16_t)(w.z >> 16); dst[(c8 + 6) * LP + row] = (bf16_t)(w.w & 0xffff); dst[(c8 + 7) * LP + row] = (bf16_t)(w.w >> 16); }
}

__device__ __forceinline__ void phase_mlstm_local(unsigned char* ws, LAS unsigned char* lds) {
    const int tid = threadIdx.x, lane = tid & 63, wid = tid >> 6;
    unsigned char* R = ws + WS_R;
    LAS bf16_t* Ks = (LAS bf16_t*)lds; LAS bf16_t* Vt = Ks + 64 * LP; LAS bf16_t* KwT = Vt + 64 * LP;
    LAS float* vec = (LAS float*)(lds + 4 * 64 * LP * 2);
    LAS float* lf_f = vec, *li_f = vec + 64, *lf_b = vec + 128, *li_b = vec + 192, *w_f = vec + 256, *w_b = vec + 320;
    const bf16_t* KA = (const bf16_t*)(R + R_KA); const bf16_t* VA = (const bf16_t*)(R + R_VA); const float* G = (const float*)(R + R_G);
    bf16_t* CS = (bf16_t*)(R + R_CS); float* NS = (float*)(R + R_NS); float* ML = (float*)(R + R_ML); float* BL = (float*)(R + R_BL);
    for (int u = blockIdx.x; u < NB * 8 * NCH; u += gridDim.x) {
        const int n = u % NCH, h = (u / NCH) & 7, b = u / (NCH * 8); const int row0 = mlstm_row0(b, n);
        __syncthreads();
        load_tile64<false>(KA + (size_t)row0 * 512 + h * 64, 512, Ks, tid);
        load_tile64<true>(VA + (size_t)row0 * 512 + h * 64, 512, Vt, tid);
        if (tid < 64) { const float* gp = G + (size_t)(row0 + tid) * 32 + h; li_f[tid] = gp[0]; lf_f[tid] = logsigmoidf_(gp[8]); li_b[tid] = gp[16]; lf_b[tid] = logsigmoidf_(gp[24]); }
        __syncthreads();
        if (tid < 64) {
            float bf = 0.f, tot_f = 0.f, bb = 0.f, tot_b = 0.f;
            for (int r = 0; r < 64; ++r) { const float a = lf_f[r], c = lf_b[r]; tot_f += a; tot_b += c; if (r <= tid) bf += a; if (r >= tid) bb += c; }
            const float wl_f = tot_f - bf + li_f[tid], wl_b = tot_b - bb + li_b[tid];
            const float mf = wave_max(wl_f), mb = wave_max(wl_b);
            w_f[tid] = __expf(wl_f - mf); w_b[tid] = __expf(wl_b - mb);
            if (tid == 0) { ML[mlstm_unit(b, h, 0, n)] = mf; ML[mlstm_unit(b, h, 1, n)] = mb; BL[mlstm_unit(b, h, 0, n)] = tot_f; BL[mlstm_unit(b, h, 1, n)] = tot_b; }
        }
        __syncthreads();
        {
            const int s = tid >> 3, c8 = (tid & 7) * 8; const float wf = w_f[s], wb = w_b[s];
#pragma unroll
            for (int q = 0; q < 8; ++q) { const float kv = bf2f(Ks[s * LP + c8 + q]); KwT[(c8 + q) * LP + s] = (bf16_t)f2bf(kv * wf); KwT[64 * LP + (c8 + q) * LP + s] = (bf16_t)f2bf(kv * wb); }
        }
        __syncthreads();
        {
            const int dir = wid >> 2, dvb = (wid >> 1) & 1, dkb = wid & 1;
            const f32x16 acc = mma32(Vt + dvb * 32 * LP, LP, KwT + dir * 64 * LP + dkb * 32 * LP, LP, 64, F16ZERO, lane);
            bf16_t* cs = CS + mlstm_unit(b, h, dir, n) * 4096;
#pragma unroll
            for (int r = 0; r < 16; ++r) cs[(dvb * 32 + crow(r, lane >> 5)) * 64 + dkb * 32 + (lane & 31)] = (bf16_t)f2bf(acc[r]);
        }
        if (tid < 128) { const int dir = tid >> 6, dk = tid & 63; float a = 0.f; for (int s = 0; s < 64; ++s) a += bf2f(KwT[dir * 64 * LP + dk * LP + s]); NS[mlstm_unit(b, h, dir, n) * 64 + dk] = a; }
    }
    __syncthreads();
}

__device__ __forceinline__ void phase_mlstm_scan(unsigned char* ws) {
    const int tid = threadIdx.x;
    unsigned char* R = ws + WS_R;
    bf16_t* CS = (bf16_t*)(R + R_CS); float* NS = (float*)(R + R_NS); const float* ML = (const float*)(R + R_ML); const float* BL = (const float*)(R + R_BL); float* MP = (float*)(R + R_MP);
    for (int q = blockIdx.x; q < NB * 8 * 2; q += gridDim.x) {
        const int dir = q & 1; const size_t base = (size_t)q * NCH;
        float C[8]; float nst = 0.f, m = -1e30f;
#pragma unroll
        for (int i = 0; i < 8; ++i) C[i] = 0.f;
        int n = dir ? 3 : 0;
        u32x4 cl = *(const u32x4*)(CS + (base + n) * 4096 + tid * 8); float nl = tid < 64 ? NS[(base + n) * 64 + tid] : 0.f; float ml = ML[base + n], bl = BL[base + n];
        for (int i = 0; i < NCH; ++i) {
            const int nn = (i + 1 < NCH) ? (dir ? ((i + 1) < 4 ? 3 - (i + 1) : 135 - (i + 1)) : i + 1) : n;
            const u32x4 cl2 = *(const u32x4*)(CS + (base + nn) * 4096 + tid * 8); const float nl2 = tid < 64 ? NS[(base + nn) * 64 + tid] : 0.f; const float ml2 = ML[base + nn], bl2 = BL[base + nn];
            float clf[8] = {bflo(cl.x), bfhi(cl.x), bflo(cl.y), bfhi(cl.y), bflo(cl.z), bfhi(cl.z), bflo(cl.w), bfhi(cl.w)};
            u32x4 st; st.x = pk2(C[0], C[1]); st.y = pk2(C[2], C[3]); st.z = pk2(C[4], C[5]); st.w = pk2(C[6], C[7]);
            *(u32x4*)(CS + (base + n) * 4096 + tid * 8) = st;
            if (tid < 64) NS[(base + n) * 64 + tid] = nst;
            if (tid == 0) MP[base + n] = m;
            const float mnew = fmaxf(bl + m, ml), dec = __expf(bl + m - mnew), fre = __expf(ml - mnew);
#pragma unroll
            for (int k = 0; k < 8; ++k) C[k] = dec * C[k] + fre * clf[k];
            nst = dec * nst + fre * nl; m = mnew;
            n = nn; cl = cl2; nl = nl2; ml = ml2; bl = bl2;
        }
    }
}

__device__ __forceinline__ void phase_mlstm_out(const Params& P, unsigned char* ws, LAS unsigned char* lds) {
    const int tid = threadIdx.x, lane = tid & 63, wid = tid >> 6;
    unsigned char* R = ws + WS_R;
    LAS bf16_t* Qs = (LAS bf16_t*)lds; LAS bf16_t* Ks = Qs + 64 * LP; LAS bf16_t* Vt = Ks + 64 * LP; LAS bf16_t* Cst = Vt + 64 * LP  ; LAS bf16_t* sW = Cst + 2 * 64 * LP  ;
    LAS float* H = (LAS float*)(lds + 7 * 64 * LP * 2);
    LAS float* vec = H + 2 * 64 * 65;
    LAS float* lf_f = vec, *li_f = vec + 64, *lf_b = vec + 128, *li_b = vec + 192;
    LAS float* rowc = vec + 256  , *colc = vec + 384  , *inter = vec + 512  , *emm = vec + 640  , *qn = vec + 768  , *rs = vec + 896  , *nsv = vec + 1024  ;
    const bf16_t* QA = (const bf16_t*)(R + R_QA); const bf16_t* KA = (const bf16_t*)(R + R_KA); const bf16_t* VA = (const bf16_t*)(R + R_VA); const bf16_t* OA = (const bf16_t*)(R + R_OA);
    const float* G = (const float*)(R + R_G); const bf16_t* CS = (const bf16_t*)(R + R_CS); const float* NS = (const float*)(R + R_NS); const float* MP = (const float*)(R + R_MP);
    bf16_t* MIX = WSP(bf16_t, WS_XN); const float* mnorm = P.in[11];
    for (int u = blockIdx.x; u < NB * 8 * NCH; u += gridDim.x) {
        const int n = u % NCH, h = (u / NCH) & 7, b = u / (NCH * 8); const int row0 = mlstm_row0(b, n);
        __syncthreads();
        load_tile64<false>(QA + (size_t)row0 * 512 + h * 64, 512, Qs, tid);
        load_tile64<false>(KA + (size_t)row0 * 512 + h * 64, 512, Ks, tid);
        load_tile64<true>(VA + (size_t)row0 * 512 + h * 64, 512, Vt, tid);
        load_tile64<false>(CS + mlstm_unit(b, h, 0, n) * 4096, 64, Cst, tid);
        load_tile64<false>(CS + mlstm_unit(b, h, 1, n) * 4096, 64, Cst + 64 * LP, tid);
        if (tid < 64) { const float* gp = G + (size_t)(row0 + tid) * 32 + h; li_f[tid] = gp[0]; lf_f[tid] = logsigmoidf_(gp[8]); li_b[tid] = gp[16]; lf_b[tid] = logsigmoidf_(gp[24]); }
        if (tid >= 64 && tid < 192) { const int d = (tid - 64) >> 6, k = (tid - 64) & 63; nsv[d * 64 + k] = NS[mlstm_unit(b, h, d, n) * 64 + k]; rs[d * 64 + k] = 0.f; }
        __syncthreads();
        if (tid < 128) {
            const int dir = tid >> 6, t = tid & 63; const float mprev = MP[mlstm_unit(b, h, dir, n)];
            float bt = 0.f, pm = -3.0e38f, bs = 0.f;
            if (dir == 0) { for (int s = 0; s <= t; ++s) { bs += lf_f[s]; pm = fmaxf(pm, li_f[s] - bs); } bt = bs; colc[t] = li_f[t] - bt; }
            else { for (int s = 63; s >= t; --s) { bs += lf_b[s]; pm = fmaxf(pm, li_b[s] - bs); } bt = bs; colc[64 + t] = li_b[t] - bt; }
            const float il = bt + mprev, mt = fmaxf(il, bt + pm);
            rowc[dir * 64 + t] = bt - mt; inter[dir * 64 + t] = __expf(il - mt); emm[dir * 64 + t] = __expf(-mt);
            float a = 0.f; for (int k = 0; k < 64; ++k) a += bf2f(Qs[t * LP + k]) * nsv[dir * 64 + k]; qn[dir * 64 + t] = a;
        }
        __syncthreads();
        {
            const int dir = wid >> 2, ti = (wid >> 1) & 1, sj = wid & 1, hi = lane >> 5, sl = lane & 31, s = sj * 32 + sl;
            const f32x16 acc = mma32(Qs + ti * 32 * LP, LP, Ks + sj * 32 * LP, LP, 64, F16ZERO, lane);
            const float cc = colc[dir * 64 + s];
#pragma unroll
            for (int r = 0; r < 16; ++r) { const int t = ti * 32 + crow(r, hi);
                const bool ok = dir == 0 ? (s <= t) : (s >= t);
                float v = ok ? acc[r] * __expf(rowc[dir * 64 + t] + cc) : 0.f;
                sW[dir * 64 * LP + t * LP + s] = (bf16_t)f2bf(v);
                v += __shfl_xor(v, 16); v += __shfl_xor(v, 8); v += __shfl_xor(v, 4); v += __shfl_xor(v, 2); v += __shfl_xor(v, 1);
                if (sl == 0) lds_addf(&rs[dir * 64 + t], v); }
        }
        __syncthreads();
        {
            const int dir = wid >> 2, ti = (wid >> 1) & 1, dj = wid & 1, hi = lane >> 5, dv = dj * 32 + (lane & 31);
            const f32x16 aqc = mma32(Qs + ti * 32 * LP, LP, Cst + dir * 64 * LP + dj * 32 * LP, LP, 64, F16ZERO, lane);
            const f32x16 asv = mma32(sW + dir * 64 * LP + ti * 32 * LP, LP, Vt + dj * 32 * LP, LP, 64, F16ZERO, lane);
#pragma unroll
            for (int r = 0; r < 16; ++r) { const int t = ti * 32 + crow(r, hi); const float it = (DBG_SKIP & 128) ? 0.f : inter[dir * 64 + t];
                const float den = fmaxf(fabsf(it * qn[dir * 64 + t] + rs[dir * 64 + t]), emm[dir * 64 + t]);
                H[(dir * 64 + t) * 65 + dv] = (it * aqc[r] + asv[r]) / den; }
        }
        __syncthreads();
        {
            const int t = tid >> 3, d8 = (tid & 7) * 8; float hv[8], ss = 0.f;
#pragma unroll
            for (int q = 0; q < 8; ++q) { hv[q] = ((DBG_SKIP & 256) ? 0.f : H[t * 65 + d8 + q]) + ((DBG_SKIP & 64) ? 0.f : H[(64 + t) * 65 + d8 + q]); ss += hv[q] * hv[q]; }
            ss += __shfl_xor(ss, 1); ss += __shfl_xor(ss, 2); ss += __shfl_xor(ss, 4);
            const float rstd = rsqrtf(ss * (1.f / 64.f) + 1e-6f);
            const u32x4 ow = *(const u32x4*)(OA + (size_t)(row0 + t) * 512 + h * 64 + d8);
            const float og[8] = {bflo(ow.x), bfhi(ow.x), bflo(ow.y), bfhi(ow.y), bflo(ow.z), bfhi(ow.z), bflo(ow.w), bfhi(ow.w)};
            float o[8];
#pragma unroll
            for (int q = 0; q < 8; ++q) o[q] = hv[q] * rstd * mnorm[h * 64 + d8 + q] * sigmoidf_(og[q]);
            u32x4 w; w.x = pk2(o[0], o[1]); w.y = pk2(o[2], o[3]); w.z = pk2(o[4], o[5]); w.w = pk2(o[6], o[7]);
            if (DBG_SKIP & 1) w = (u32x4){0u, 0u, 0u, 0u};
            *(u32x2*)((unsigned char*)MIX + (size_t)(row0 + t) * 1024 + h * 64 + d8) = bf8_to_fp8(w);
        }
    }
    __syncthreads();
}


__device__ __forceinline__ float wave_psum(float v, int lane) {
#pragma unroll
    for (int d = 1; d < 64; d <<= 1) { const float t = __shfl_up(v, d); if (lane >= d) v += t; }
    return v;
}
__device__ __forceinline__ float wave_pmax(float v, int lane) {
#pragma unroll
    for (int d = 1; d < 64; d <<= 1) { const float t = __shfl_up(v, d); if (lane >= d) v = fmaxf(v, t); }
    return v;
}
__device__ __forceinline__ float wave_smax(float v, int lane) {
#pragma unroll
    for (int d = 1; d < 64; d <<= 1) { const float t = __shfl_down(v, d); if (lane + d < 64) v = fmaxf(v, t); }
    return v;
}
__device__ __forceinline__ void st_tile_T(LAS bf16_t* dst, const u32x4 w, int row, int c8) {
    dst[(c8 + 0) * LP + row] = (bf16_t)(w.x & 0xffff); dst[(c8 + 1) * LP + row] = (bf16_t)(w.x >> 16); dst[(c8 + 2) * LP + row] = (bf16_t)(w.y & 0xffff); dst[(c8 + 3) * LP + row] = (bf16_t)(w.y >> 16);
    dst[(c8 + 4) * LP + row] = (bf16_t)(w.z & 0xffff); dst[(c8 + 5) * LP + row] = (bf16_t)(w.z >> 16); dst[(c8 + 6) * LP + row] = (bf16_t)(w.w & 0xffff); dst[(c8 + 7) * LP + row] = (bf16_t)(w.w >> 16);
}
__device__ __forceinline__ void phase_mlstm_local2(unsigned char* ws, LAS unsigned char* lds) {
    const int tid = threadIdx.x, lane = tid & 63, wid = tid >> 6, row = tid >> 3, c8 = (tid & 7) * 8;
    unsigned char* R = ws + WS_R;
    LAS bf16_t* Ks = (LAS bf16_t*)lds; LAS bf16_t* Vt = Ks + 64 * LP; LAS bf16_t* KwT = Vt + 64 * LP;
    LAS float* vec = (LAS float*)(lds + 4 * 64 * LP * 2); LAS float* w_f = vec, *w_b = vec + 64;
    const bf16_t* KA = (const bf16_t*)(R + R_KA); const bf16_t* VA = (const bf16_t*)(R + R_VA); const float* G = (const float*)(R + R_G);
    bf16_t* CS = (bf16_t*)(R + R_CS); float* NS = (float*)(R + R_NS); float* ML = (float*)(R + R_ML); float* BL = (float*)(R + R_BL);
    float* BT = (float*)(R + R_BT); float* PM = (float*)(R + R_PM); float* GC = (float*)(R + R_GC);
    const int NU = NB * 8 * NCH;
    int u = blockIdx.x;
    u32x4 kw = (u32x4){0u, 0u, 0u, 0u}, vw = kw; float g0 = 0.f, g1 = 0.f, g2 = 0.f, g3 = 0.f;
    if (u < NU) { const int n = u % NCH, h = (u / NCH) & 7, b = u / (NCH * 8), row0 = mlstm_row0(b, n);
        kw = *(const u32x4*)(KA + (size_t)(row0 + row) * 512 + h * 64 + c8); vw = *(const u32x4*)(VA + (size_t)(row0 + row) * 512 + h * 64 + c8);
        if (wid == 0) { const float* gp = G + (size_t)(row0 + lane) * 32 + h; g0 = gp[0]; g1 = gp[8]; g2 = gp[16]; g3 = gp[24]; } }
    for (; u < NU; u += gridDim.x) {
        const int n = u % NCH, h = (u / NCH) & 7, b = u / (NCH * 8);
        __syncthreads();
        *(LAS u32x4*)(Ks + row * LP + c8) = kw; st_tile_T(Vt, vw, row, c8);
        if (wid == 0) {
            const float li_f = g0, lf_f = logsigmoidf_(g1), li_b = g2, lf_b = logsigmoidf_(g3);
            const float bf = wave_psum(lf_f, lane), pb = wave_psum(lf_b, lane);
            const float tot_f = __shfl(bf, 63), tot_b = __shfl(pb, 63), bb = tot_b - pb + lf_b;
            const float wl_f = tot_f - bf + li_f, wl_b = tot_b - bb + li_b, mf = wave_max(wl_f), mb = wave_max(wl_b);
            w_f[lane] = __expf(wl_f - mf); w_b[lane] = __expf(wl_b - mb);
            const float gf = li_f - bf, gb = li_b - bb, pmf = wave_pmax(gf, lane), pmb = wave_smax(gb, lane);
            const size_t uf = mlstm_unit(b, h, 0, n), ub = mlstm_unit(b, h, 1, n);
            BT[uf * 64 + lane] = bf; BT[ub * 64 + lane] = bb; PM[uf * 64 + lane] = pmf; PM[ub * 64 + lane] = pmb; GC[uf * 64 + lane] = gf; GC[ub * 64 + lane] = gb;
            if (lane == 0) { ML[uf] = mf; ML[ub] = mb; BL[uf] = tot_f; BL[ub] = tot_b; }
        }
        __syncthreads();
        const int un = u + gridDim.x;
        if (un < NU) { const int n2 = un % NCH, h2 = (un / NCH) & 7, b2 = un / (NCH * 8), r2 = mlstm_row0(b2, n2);
            kw = *(const u32x4*)(KA + (size_t)(r2 + row) * 512 + h2 * 64 + c8); vw = *(const u32x4*)(VA + (size_t)(r2 + row) * 512 + h2 * 64 + c8);
            if (wid == 0) { const float* gp = G + (size_t)(r2 + lane) * 32 + h2; g0 = gp[0]; g1 = gp[8]; g2 = gp[16]; g3 = gp[24]; } }
        {   const float wf = w_f[row], wb = w_b[row];
#pragma unroll
            for (int q = 0; q < 8; ++q) { const float kv = bf2f(Ks[row * LP + c8 + q]); KwT[(c8 + q) * LP + row] = (bf16_t)f2bf(kv * wf); KwT[64 * LP + (c8 + q) * LP + row] = (bf16_t)f2bf(kv * wb); } }
        __syncthreads();
        {   const int dir = wid >> 2, dvb = (wid >> 1) & 1, dkb = wid & 1;
            const f32x16 acc = mma32(Vt + dvb * 32 * LP, LP, KwT + dir * 64 * LP + dkb * 32 * LP, LP, 64, F16ZERO, lane);
            bf16_t* cs = CS + mlstm_unit(b, h, dir, n) * 4096;
#pragma unroll
            for (int r = 0; r < 16; ++r) cs[(dvb * 32 + crow(r, lane >> 5)) * 64 + dkb * 32 + (lane & 31)] = (bf16_t)f2bf(acc[r]); }
        if (tid < 128) { const int dir = tid >> 6, dk = tid & 63; float a = 0.f;
#pragma unroll 8
            for (int s8 = 0; s8 < 64; s8 += 8) { const u32x4 w = *(LAS const u32x4*)(KwT + dir * 64 * LP + dk * LP + s8); a += ((bflo(w.x) + bfhi(w.x)) + (bflo(w.y) + bfhi(w.y))) + ((bflo(w.z) + bfhi(w.z)) + (bflo(w.w) + bfhi(w.w))); }
            NS[mlstm_unit(b, h, dir, n) * 64 + dk] = a; }
    }
    __syncthreads();
}

__device__ __forceinline__ void phase_mlstm_out2(const Params& P, unsigned char* ws, LAS unsigned char* lds) {
    const int tid = threadIdx.x, lane = tid & 63, wid = tid >> 6, row = tid >> 3, c8 = (tid & 7) * 8;
    unsigned char* R = ws + WS_R;
    LAS bf16_t* Qs = (LAS bf16_t*)lds; LAS bf16_t* Ks = Qs + 64 * LP; LAS bf16_t* Vt = Ks + 64 * LP; LAS bf16_t* Cst = Vt + 64 * LP  ; LAS bf16_t* sW = Cst + 2 * 64 * LP  ;
    LAS bf16_t* NsT = sW + 2 * 64 * LP  ; LAS bf16_t* Ones = NsT + 2 * 32 * LP  ;
    LAS float* H = (LAS float*)(lds + (7 * 64 + 3 * 32) * LP * 2);
    LAS float* vec = H + 2 * 64 * 65; LAS float* BTv = vec, *PMv = vec + 128, *GCv = vec + 256, *MPv = vec + 384;
    const bf16_t* QA = (const bf16_t*)(R + R_QA); const bf16_t* KA = (const bf16_t*)(R + R_KA); const bf16_t* VA = (const bf16_t*)(R + R_VA); const bf16_t* OA = (const bf16_t*)(R + R_OA);
    const bf16_t* CS = (const bf16_t*)(R + R_CS); const float* NS = (const float*)(R + R_NS); const float* MP = (const float*)(R + R_MP);
    const float* BT = (const float*)(R + R_BT); const float* PM = (const float*)(R + R_PM); const float* GC = (const float*)(R + R_GC);
    bf16_t* MIX = WSP(bf16_t, WS_XN); const float* mnorm = P.in[11];
    __syncthreads();
    for (int i = tid; i < 3 * 32 * LP; i += NTHREADS) NsT[i] = (bf16_t)((i >= 2 * 32 * LP && i < 2 * 32 * LP + 64) ? 0x3f80 : 0);
    const int NU = NB * 8 * NCH;
    int u = blockIdx.x;
    u32x4 qw = (u32x4){0u, 0u, 0u, 0u}, kw = qw, vw = qw, cfw = qw, cbw = qw, ow = qw; float pbt = 0.f, ppm = 0.f, pgc = 0.f, pns = 0.f, pmp = 0.f;
#define M3_PREFETCH(UU) do { const int n_ = (UU) % NCH, h_ = ((UU) / NCH) & 7, b_ = (UU) / (NCH * 8), r_ = mlstm_row0(b_, n_); const size_t go_ = (size_t)(r_ + row) * 512 + h_ * 64 + c8; \
        qw = *(const u32x4*)(QA + go_); kw = *(const u32x4*)(KA + go_); vw = *(const u32x4*)(VA + go_); ow = *(const u32x4*)(OA + go_); \
        cfw = *(const u32x4*)(CS + mlstm_unit(b_, h_, 0, n_) * 4096 + row * 64 + c8); cbw = *(const u32x4*)(CS + mlstm_unit(b_, h_, 1, n_) * 4096 + row * 64 + c8); \
        if (tid < 128) { const size_t uu_ = mlstm_unit(b_, h_, tid >> 6, n_); pbt = BT[uu_ * 64 + (tid & 63)]; ppm = PM[uu_ * 64 + (tid & 63)]; pgc = GC[uu_ * 64 + (tid & 63)]; pns = NS[uu_ * 64 + (tid & 63)]; pmp = MP[uu_]; } } while (0)
    if (u < NU) M3_PREFETCH(u);
    for (; u < NU; u += gridDim.x) {
        const int n = u % NCH, h = (u / NCH) & 7, b = u / (NCH * 8); const int row0 = mlstm_row0(b, n);
        __syncthreads();
        *(LAS u32x4*)(Qs + row * LP + c8) = qw; *(LAS u32x4*)(Ks + row * LP + c8) = kw; st_tile_T(Vt, vw, row, c8);
        *(LAS u32x4*)(Cst + row * LP + c8) = cfw; *(LAS u32x4*)(Cst + 64 * LP + row * LP + c8) = cbw;
        const u32x4 ocur = ow;
        if (tid < 128) { BTv[tid] = pbt; PMv[tid] = ppm; GCv[tid] = pgc; NsT[(tid >> 6) * 32 * LP + (tid & 63)] = (bf16_t)f2bf(pns); if ((tid & 63) == 0) MPv[tid >> 6] = pmp; }
        __syncthreads();
        if (u + (int)gridDim.x < NU) M3_PREFETCH(u + (int)gridDim.x);
        {
            const int dir = wid >> 2, ti = (wid >> 1) & 1, sj = wid & 1, hi = lane >> 5, s = sj * 32 + (lane & 31);
            const f32x16 acc = mma32(Qs + ti * 32 * LP, LP, Ks + sj * 32 * LP, LP, 64, F16ZERO, lane);
            const float cc = GCv[dir * 64 + s], mprev = MPv[dir];
#pragma unroll
            for (int r = 0; r < 16; ++r) { const int t = ti * 32 + crow(r, hi); const float bt = BTv[dir * 64 + t], mt = fmaxf(bt + mprev, bt + PMv[dir * 64 + t]);
                const bool ok = dir == 0 ? (s <= t) : (s >= t);
                const float v = ok ? acc[r] * __expf((bt - mt) + cc) : 0.f;
                sW[dir * 64 * LP + t * LP + s] = (bf16_t)f2bf(v); }
        }
        __syncthreads();
        {
            const int dir = wid >> 2, ti = (wid >> 1) & 1, dj = wid & 1, hi = lane >> 5, dv = dj * 32 + (lane & 31);
            const f32x16 aqc = mma32(Qs + ti * 32 * LP, LP, Cst + dir * 64 * LP + dj * 32 * LP, LP, 64, F16ZERO, lane);
            const f32x16 asv = mma32(sW + dir * 64 * LP + ti * 32 * LP, LP, Vt + dj * 32 * LP, LP, 64, F16ZERO, lane);
            const f32x16 aqn = mma32(Qs + ti * 32 * LP, LP, NsT + dir * 32 * LP, LP, 64, F16ZERO, lane);
            const f32x16 ars = mma32(sW + dir * 64 * LP + ti * 32 * LP, LP, Ones, LP, 64, F16ZERO, lane);
            const float mprev = MPv[dir];
#pragma unroll
            for (int r = 0; r < 16; ++r) { const int t = ti * 32 + crow(r, hi); const float bt = BTv[dir * 64 + t], il = bt + mprev, mt = fmaxf(il, bt + PMv[dir * 64 + t]), it = __expf(il - mt);
                const float qn = __shfl(aqn[r], hi * 32), rs = __shfl(ars[r], hi * 32);
                const float den = fmaxf(fabsf(it * qn + rs), __expf(-mt)), rden = __builtin_amdgcn_rcpf(den);
                H[(dir * 64 + t) * 65 + dv] = (it * aqc[r] + asv[r]) * rden; }
        }
        __syncthreads();
        {   const int t = row, d8 = c8; float hv[8], ss = 0.f;
#pragma unroll
            for (int q = 0; q < 8; ++q) { hv[q] = H[t * 65 + d8 + q] + H[(64 + t) * 65 + d8 + q]; ss += hv[q] * hv[q]; }
            ss += __shfl_xor(ss, 1); ss += __shfl_xor(ss, 2); ss += __shfl_xor(ss, 4);
            const float rstd = rsqrtf(ss * (1.f / 64.f) + 1e-6f);
            const float og[8] = {bflo(ocur.x), bfhi(ocur.x), bflo(ocur.y), bfhi(ocur.y), bflo(ocur.z), bfhi(ocur.z), bflo(ocur.w), bfhi(ocur.w)};
            float o[8];
#pragma unroll
            for (int q = 0; q < 8; ++q) o[q] = hv[q] * rstd * mnorm[h * 64 + d8 + q] * sigmoidf_(og[q]);
            u32x4 w; w.x = pk2(o[0], o[1]); w.y = pk2(o[2], o[3]); w.z = pk2(o[4], o[5]); w.w = pk2(o[6], o[7]);
            *(u32x2*)((unsigned char*)MIX + (size_t)(row0 + t) * 1024 + h * 64 + d8) = bf8_to_fp8(w);
        }
    }
#undef M3_PREFETCH
    __syncthreads();
}

__device__ __forceinline__ void qk_prep_tile(const bf16_t* src, size_t spitch, bf16_t* dst, size_t dpitch, const float* gain, bool rope, int pos0, int tid) {
    const int r = tid >> 3, q = tid & 7, i0 = (q & 3) * 4, d1 = (q >> 2) * 32 + i0, d2 = d1 + 16;
    const u32x2 w1 = *(const u32x2*)(src + (size_t)r * spitch + d1), w2 = *(const u32x2*)(src + (size_t)r * spitch + d2);
    float a[4] = {bflo(w1.x), bfhi(w1.x), bflo(w1.y), bfhi(w1.y)}, c[4] = {bflo(w2.x), bfhi(w2.x), bflo(w2.y), bfhi(w2.y)};
    if (gain) {
        float ss = 0.f;
#pragma unroll
        for (int i = 0; i < 4; ++i) ss += a[i] * a[i] + c[i] * c[i];
        ss += __shfl_xor(ss, 1); ss += __shfl_xor(ss, 2); ss += __shfl_xor(ss, 4);
        const float rstd = rsqrtf(ss * (1.f / 64.f) + 1e-6f);
#pragma unroll
        for (int i = 0; i < 4; ++i) { a[i] = (float)bf2f((bf16_t)f2bf(a[i] * rstd * gain[d1 + i])); c[i] = (float)bf2f((bf16_t)f2bf(c[i] * rstd * gain[d2 + i])); }
    }
    if (rope) {
        const int pos = pos0 + r; const float pc = (float)((q >> 2) ? (pos & 63) : (pos >> 6));
#pragma unroll
        for (int i = 0; i < 4; ++i) { const float inv = exp2f(-(float)(i0 + i) * (13.287712379549449f / 16.f)); float sn, cs; __sincosf(pc * inv, &sn, &cs);
            const float t1 = a[i], t2 = c[i]; a[i] = t1 * cs - t2 * sn; c[i] = t2 * cs + t1 * sn; }
    }
    u32x2 o1, o2; o1.x = pk2(a[0], a[1]); o1.y = pk2(a[2], a[3]); o2.x = pk2(c[0], c[1]); o2.y = pk2(c[2], c[3]);
    *(u32x2*)(dst + (size_t)r * dpitch + d1) = o1; *(u32x2*)(dst + (size_t)r * dpitch + d2) = o2;
}
__device__ __forceinline__ void phase_qkv_prep(LAS unsigned char* lds, const bf16_t* ksrc, size_t kpitch, const bf16_t* vsrc, size_t vpitch, bf16_t* qbuf, size_t qpitch, int HKV, int HQ,
                                               bf16_t* Kc, bf16_t* VT, const float* qgain, const float* kgain, bool ctx_q) {
    const int tid = threadIdx.x;
    LAS bf16_t* tl = (LAS bf16_t*)lds;
    const int nkv = NB * HKV * NCH;
    for (int u = blockIdx.x; u < nkv; u += gridDim.x) {
        const int j = u % NCH, kvh = (u / NCH) % HKV, b = u / (NCH * HKV);
        const int row0 = j < 4 ? b * 256 + j * 64 : NCTX + b * 8192 + (j - 4) * 64;
        const size_t key0 = (size_t)j * 64;
        qk_prep_tile(ksrc + (size_t)row0 * kpitch + kvh * 64, kpitch, Kc + (((size_t)b * HKV + kvh) * NKEY + key0) * 64, 64, kgain, j >= 4, (j - 4) * 64, tid);
        __syncthreads();
        { const int r = tid >> 3, c8 = (tid & 7) * 8; *(LAS u32x4*)(tl + r * LP + c8) = *(const u32x4*)(vsrc + (size_t)(row0 + r) * vpitch + kvh * 64 + c8); }
        __syncthreads();
        { const int dv = tid >> 3, k8 = (tid & 7) * 8; u32x4 w;
          w.x = (unsigned)tl[(k8 + 0) * LP + dv] | ((unsigned)tl[(k8 + 1) * LP + dv] << 16); w.y = (unsigned)tl[(k8 + 2) * LP + dv] | ((unsigned)tl[(k8 + 3) * LP + dv] << 16);
          w.z = (unsigned)tl[(k8 + 4) * LP + dv] | ((unsigned)tl[(k8 + 5) * LP + dv] << 16); w.w = (unsigned)tl[(k8 + 6) * LP + dv] | ((unsigned)tl[(k8 + 7) * LP + dv] << 16);
          *(u32x4*)(VT + (((size_t)b * HKV + kvh) * 64 + dv) * NKEY + key0 + k8) = w; }
    }
    const int ntile = (ctx_q ? NTOK : NLAT) / 64;
    for (int u = blockIdx.x; u < ntile * HQ; u += gridDim.x) {
        const int hq = u % HQ, tI = u / HQ; const int row0 = ctx_q ? tI * 64 : NCTX + tI * 64; const bool lat = row0 >= NCTX;
        if (!lat && !qgain) continue;
        bf16_t* qp = qbuf + (size_t)row0 * qpitch + hq * 64;
        qk_prep_tile(qp, qpitch, qp, qpitch, qgain, lat, lat ? ((row0 - NCTX) & 8191) : 0, tid);
    }
    __syncthreads();
}

struct AttnArgs {
    const bf16_t* Q; size_t qpitch; const bf16_t* Kc; const bf16_t* VT; bf16_t* O; size_t opitch; int ocol0; int HKV; const float* sink; int swa;
};
__device__ __forceinline__ void attn_unit_v1(const AttnArgs& A, LAS unsigned char* lds, int b, int kvh, int qrow0, int qpos0  ) {
    const int tid = threadIdx.x, lane = tid & 63, wid = tid >> 6, r32 = lane & 31, hh = lane >> 5;
    LAS bf16_t* Kb = (LAS bf16_t*)lds; LAS bf16_t* Vb = Kb + 2 * 64 * LP; LAS bf16_t* Ost = Vb + 2 * 64 * LP + wid * 32 * LP;
    const int head = kvh * 4 + (wid >> 1);
    const int qrow = qrow0 + 32 * (wid & 1) + r32;
    const bf16_t* Kg = A.Kc + ((size_t)b * A.HKV + kvh) * NKEY * 64; const bf16_t* Vg = A.VT + ((size_t)b * A.HKV + kvh) * 64 * NKEY;
    int lt0 = 4, lt1 = 4;
    if (qpos0 >= 0) { if (A.swa) { const int qb = qpos0 >> 6; lt0 = 4 + (qb - 2 < 0 ? 0 : qb - 2); lt1 = 4 + (qb + 3 > 128 ? 128 : qb + 3); } else { lt0 = 4; lt1 = NCH; } }
    const int ntile = 4 + (lt1 - lt0);
    bf16x8 qf[4];
#pragma unroll
    for (int ks = 0; ks < 4; ++ks) qf[ks] = *(const bf16x8*)(A.Q + (size_t)qrow * A.qpitch + head * 64 + ks * 16 + hh * 8);
    f32x16 o0 = F16ZERO, o1 = F16ZERO; float m = -1e30f, l = 0.f;
    const int lr = tid >> 3, lc = (tid & 7) * 8;
    __syncthreads();
    { const int j = 0; *(LAS u32x4*)(Kb + lr * LP + lc) = *(const u32x4*)(Kg + ((size_t)j * 64 + lr) * 64 + lc); *(LAS u32x4*)(Vb + lr * LP + lc) = *(const u32x4*)(Vg + (size_t)lr * NKEY + j * 64 + lc); }
    u32x4 kn = *(const u32x4*)(Kg + ((size_t)1 * 64 + lr) * 64 + lc), vn = *(const u32x4*)(Vg + (size_t)lr * NKEY + 1 * 64 + lc);
    u32x4 kn2 = *(const u32x4*)(Kg + ((size_t)2 * 64 + lr) * 64 + lc), vn2 = *(const u32x4*)(Vg + (size_t)lr * NKEY + 2 * 64 + lc);
    u32x4 kn3 = *(const u32x4*)(Kg + ((size_t)3 * 64 + lr) * 64 + lc), vn3 = *(const u32x4*)(Vg + (size_t)lr * NKEY + 3 * 64 + lc);
    __syncthreads();
    for (int it = 0; it < ntile; ++it) {
        const int cur = it & 1, j = it < 4 ? it : lt0 + (it - 4);
        u32x4 kn4 = kn3, vn4 = vn3; const bool more = it + 1 < ntile;
        if (it + 4 < ntile) { const int jn = lt0 + it; kn4 = *(const u32x4*)(Kg + ((size_t)jn * 64 + lr) * 64 + lc); vn4 = *(const u32x4*)(Vg + (size_t)lr * NKEY + jn * 64 + lc); }
        LAS const bf16_t* Kt = Kb + cur * 64 * LP; LAS const bf16_t* Vt = Vb + cur * 64 * LP;
        f32x16 s0 = F16ZERO, s1 = F16ZERO;
#pragma unroll
        for (int ks = 0; ks < 4; ++ks) {
            const bf16x8 k0 = *(LAS const bf16x8*)(Kt + r32 * LP + ks * 16 + hh * 8), k1 = *(LAS const bf16x8*)(Kt + (32 + r32) * LP + ks * 16 + hh * 8);
            s0 = __builtin_amdgcn_mfma_f32_32x32x16_bf16(k0, qf[ks], s0, 0, 0, 0); s1 = __builtin_amdgcn_mfma_f32_32x32x16_bf16(k1, qf[ks], s1, 0, 0, 0);
        }
        constexpr float SC = 0.125f * 1.4426950408889634f;
        const int dt_ = (j - 4) - (qpos0 >> 6); const bool edge = A.swa && j >= 4 && (dt_ == 2 || dt_ == -2);
        float tmax = -1e30f;
        if (edge) {
#pragma unroll
            for (int r = 0; r < 16; ++r) { float a = s0[r] * SC, c = s1[r] * SC;
                const int kp = (j - 4) * 64 + crow(r, hh), qp = qpos0 + 32 * (wid & 1) + r32; const int d0 = qp - kp, d1 = qp - (kp + 32);
                if (d0 > 128 || d0 < -128) a = -1e30f; if (d1 > 128 || d1 < -128) c = -1e30f;
                s0[r] = a; s1[r] = c; tmax = fmaxf(tmax, fmaxf(a, c)); }
        } else {
#pragma unroll
            for (int r = 0; r < 16; ++r) { const float a = s0[r] * SC, c = s1[r] * SC; s0[r] = a; s1[r] = c; tmax = fmaxf(tmax, fmaxf(a, c)); }
        }
        tmax = fmaxf(tmax, __shfl_xor(tmax, 32));
        if (!__all(tmax <= m)) {
            const float mnew = fmaxf(m, tmax), alpha = __builtin_amdgcn_exp2f(m - mnew);
            l *= alpha; m = mnew;
#pragma unroll
            for (int r = 0; r < 16; ++r) { o0[r] *= alpha; o1[r] *= alpha; }
        }
        float ps = 0.f;
#pragma unroll
        for (int r = 0; r < 16; ++r) { s0[r] = __builtin_amdgcn_exp2f(s0[r] - m); s1[r] = __builtin_amdgcn_exp2f(s1[r] - m); ps += s0[r] + s1[r]; }
        ps += __shfl_xor(ps, 32);
        l += ps;
#pragma unroll
        for (int sub = 0; sub < 2; ++sub)
#pragma unroll
            for (int s2 = 0; s2 < 2; ++s2) {
                const f32x16& sp = sub ? s1 : s0;
                u32x4 pw; pw.x = pg8::cvt_pk_bf16(sp[8 * s2 + 0], sp[8 * s2 + 1]); pw.y = pg8::cvt_pk_bf16(sp[8 * s2 + 2], sp[8 * s2 + 3]); pw.z = pg8::cvt_pk_bf16(sp[8 * s2 + 4], sp[8 * s2 + 5]); pw.w = pg8::cvt_pk_bf16(sp[8 * s2 + 6], sp[8 * s2 + 7]);
                const bf16x8 pf = __builtin_bit_cast(bf16x8, pw);
                const int kof = sub * 32 + s2 * 16 + 4 * hh;
                u32x4 v0w, v1w;
                { const u32x2 a = *(LAS const u32x2*)(Vt + r32 * LP + kof), c = *(LAS const u32x2*)(Vt + r32 * LP + kof + 8); v0w.x = a.x; v0w.y = a.y; v0w.z = c.x; v0w.w = c.y; }
                { const u32x2 a = *(LAS const u32x2*)(Vt + (32 + r32) * LP + kof), c = *(LAS const u32x2*)(Vt + (32 + r32) * LP + kof + 8); v1w.x = a.x; v1w.y = a.y; v1w.z = c.x; v1w.w = c.y; }
                o0 = __builtin_amdgcn_mfma_f32_32x32x16_bf16(__builtin_bit_cast(bf16x8, v0w), pf, o0, 0, 0, 0);
                o1 = __builtin_amdgcn_mfma_f32_32x32x16_bf16(__builtin_bit_cast(bf16x8, v1w), pf, o1, 0, 0, 0);
            }
        if (more) { *(LAS u32x4*)(Kb + (cur ^ 1) * 64 * LP + lr * LP + lc) = kn; *(LAS u32x4*)(Vb + (cur ^ 1) * 64 * LP + lr * LP + lc) = vn; }
        kn = kn2; vn = vn2; kn2 = kn3; vn2 = vn3; kn3 = kn4; vn3 = vn4;
        __syncthreads();
    }
    if (A.sink) l += __builtin_amdgcn_exp2f(A.sink[head] * 1.4426950408889634f - m);
    const float inv = 1.f / l;
#pragma unroll
    for (int r = 0; r < 16; ++r) { Ost[r32 * LP + crow(r, hh)] = (bf16_t)f2bf(o0[r] * inv); Ost[r32 * LP + 32 + crow(r, hh)] = (bf16_t)f2bf(o1[r] * inv); }
    asm volatile("s_waitcnt lgkmcnt(0)" ::: "memory");
#pragma unroll
    for (int p = 0; p < 4; ++p) { const int q = p * 8 + (lane >> 3), d8 = (lane & 7) * 8;
        u32x4 ov = *(LAS const u32x4*)(Ost + q * LP + d8); if ((DBG_SKIP & 2) && A.swa) ov = (u32x4){0u, 0u, 0u, 0u}; if ((DBG_SKIP & 16) && !A.swa) ov = (u32x4){0u, 0u, 0u, 0u};
        *(u32x2*)((unsigned char*)A.O + (size_t)(qrow0 + 32 * (wid & 1) + q) * A.opitch + A.ocol0 + (wid >> 1) * 64 + kvh * 256 + d8) = bf8_to_fp8(ov); }
}
__device__ __forceinline__ float xor32_max(float v) { float a = v, b = v; asm volatile("v_nop\n\tv_nop\n\tv_permlane32_swap_b32 %0, %1\n\tv_nop\n\tv_nop" : "+v"(a), "+v"(b)); return fmaxf(a, b); }
__device__ __forceinline__ float xor32_sum(float v) { float a = v, b = v; asm volatile("v_nop\n\tv_nop\n\tv_permlane32_swap_b32 %0, %1\n\tv_nop\n\tv_nop" : "+v"(a), "+v"(b)); return a + b; }
template <int NG>
__device__ __forceinline__ void attn_unit(const AttnArgs& A, LAS unsigned char* lds, int b, int kvh, int qrow0, int qpos0  ) {
    const int tid = threadIdx.x, lane = tid & 63, wid = tid >> 6, r32 = lane & 31, hh = lane >> 5;
    constexpr int RW = 32 * NG;
    constexpr float CS2 = 0.125f * 1.4426950408889634f;
    LAS bf16_t* Kb = (LAS bf16_t*)lds; LAS bf16_t* Vb = Kb + 2 * 64 * LP; LAS bf16_t* Ost = Vb + 2 * 64 * LP + wid * RW * LP;
    const int head = kvh * 4 + (wid >> 1);
    const int wrow0 = qrow0 + RW * (wid & 1);
    const bf16_t* Kg = A.Kc + ((size_t)b * A.HKV + kvh) * NKEY * 64; const bf16_t* Vg = A.VT + ((size_t)b * A.HKV + kvh) * 64 * NKEY;
    int lt0 = 4, lt1 = 4;
    if (qpos0 >= 0) { if (A.swa) { const int k0 = qpos0 - 128, k1 = qpos0 + 64 * NG + 128; lt0 = 4 + (k0 < 0 ? 0 : k0 >> 6); lt1 = 4 + (k1 > SEQ ? SEQ >> 6 : k1 >> 6); } else { lt0 = 4; lt1 = NCH; } }
    const int ntile = 4 + (lt1 - lt0);
    bf16x8 qf[NG][4];
#pragma unroll
    for (int g = 0; g < NG; ++g)
#pragma unroll
        for (int ks = 0; ks < 4; ++ks) qf[g][ks] = *(const bf16x8*)(A.Q + (size_t)(wrow0 + 32 * g + r32) * A.qpitch + head * 64 + ks * 16 + hh * 8);
    f32x16 o[NG][2]; float m[NG], l[NG];
#pragma unroll
    for (int g = 0; g < NG; ++g) { o[g][0] = F16ZERO; o[g][1] = F16ZERO; m[g] = -1e30f; l[g] = 0.f; }
    const int lr = tid >> 3, lc = (tid & 7) * 8;
    __syncthreads();
    { *(LAS u32x4*)(Kb + lr * LP + lc) = *(const u32x4*)(Kg + (size_t)lr * 64 + lc); *(LAS u32x4*)(Vb + lr * LP + lc) = *(const u32x4*)(Vg + (size_t)lr * NKEY + lc); }
    __syncthreads();
    for (int it = 0; it < ntile; ++it) {
        const int cur = it & 1, j = it < 4 ? it : lt0 + (it - 4);
        u32x4 kn, vn; const bool more = it + 1 < ntile;
        if (more) { const int jn = (it + 1) < 4 ? it + 1 : lt0 + (it + 1 - 4); kn = *(const u32x4*)(Kg + ((size_t)jn * 64 + lr) * 64 + lc); vn = *(const u32x4*)(Vg + (size_t)lr * NKEY + jn * 64 + lc); }
        LAS const bf16_t* Kt = Kb + cur * 64 * LP; LAS const bf16_t* Vt = Vb + cur * 64 * LP;
        f32x16 s[NG][2];
#pragma unroll
        for (int g = 0; g < NG; ++g) { s[g][0] = F16ZERO; s[g][1] = F16ZERO; }
#pragma unroll
        for (int ks = 0; ks < 4; ++ks) {
            const bf16x8 k0 = *(LAS const bf16x8*)(Kt + r32 * LP + ks * 16 + hh * 8), k1 = *(LAS const bf16x8*)(Kt + (32 + r32) * LP + ks * 16 + hh * 8);
#pragma unroll
            for (int g = 0; g < NG; ++g) { s[g][0] = __builtin_amdgcn_mfma_f32_32x32x16_bf16(k0, qf[g][ks], s[g][0], 0, 0, 0); s[g][1] = __builtin_amdgcn_mfma_f32_32x32x16_bf16(k1, qf[g][ks], s[g][1], 0, 0, 0); }
        }
        const bool masked = A.swa && j >= 4;
#pragma unroll
        for (int g = 0; g < NG; ++g) {
            float tmax = -1e30f;
            const int qp = qpos0 + RW * (wid & 1) + 32 * g + r32, kb0 = (j - 4) * 64;
#pragma unroll
            for (int r = 0; r < 16; ++r) { float a = s[g][0][r], c = s[g][1][r];
                if (masked) { const int d0 = qp - (kb0 + crow(r, hh)), d1 = d0 - 32; if (d0 > 128 || d0 < -128) a = -1e30f; if (d1 > 128 || d1 < -128) c = -1e30f; }
                s[g][0][r] = a; s[g][1][r] = c; tmax = fmaxf(tmax, fmaxf(a, c)); }
            tmax = xor32_max(tmax);
            const bool keep = __all((tmax - m[g]) * CS2 <= 8.f);
            if (!keep) { const float mnew = fmaxf(m[g], tmax), alpha = __builtin_amdgcn_exp2f((m[g] - mnew) * CS2);
                l[g] *= alpha; m[g] = mnew;
#pragma unroll
                for (int r = 0; r < 16; ++r) { o[g][0][r] *= alpha; o[g][1][r] *= alpha; } }
            const float mc = m[g] * CS2;
            float ps = 0.f;
#pragma unroll
            for (int r = 0; r < 16; ++r) { const float p0 = __builtin_amdgcn_exp2f(s[g][0][r] * CS2 - mc), p1 = __builtin_amdgcn_exp2f(s[g][1][r] * CS2 - mc); s[g][0][r] = p0; s[g][1][r] = p1; ps += p0 + p1; }
            l[g] += ps;
        }
#pragma unroll
        for (int sub = 0; sub < 2; ++sub)
#pragma unroll
            for (int s2 = 0; s2 < 2; ++s2) {
                const int kof = sub * 32 + s2 * 16 + 4 * hh;
                u32x4 v0w, v1w;
                { const u32x2 a = *(LAS const u32x2*)(Vt + r32 * LP + kof), c = *(LAS const u32x2*)(Vt + r32 * LP + kof + 8); v0w.x = a.x; v0w.y = a.y; v0w.z = c.x; v0w.w = c.y; }
                { const u32x2 a = *(LAS const u32x2*)(Vt + (32 + r32) * LP + kof), c = *(LAS const u32x2*)(Vt + (32 + r32) * LP + kof + 8); v1w.x = a.x; v1w.y = a.y; v1w.z = c.x; v1w.w = c.y; }
#pragma unroll
                for (int g = 0; g < NG; ++g) {
                    const f32x16& sp = s[g][sub];
                    u32x4 pw; pw.x = pg8::cvt_pk_bf16(sp[8 * s2 + 0], sp[8 * s2 + 1]); pw.y = pg8::cvt_pk_bf16(sp[8 * s2 + 2], sp[8 * s2 + 3]); pw.z = pg8::cvt_pk_bf16(sp[8 * s2 + 4], sp[8 * s2 + 5]); pw.w = pg8::cvt_pk_bf16(sp[8 * s2 + 6], sp[8 * s2 + 7]);
                    const bf16x8 pf = __builtin_bit_cast(bf16x8, pw);
                    o[g][0] = __builtin_amdgcn_mfma_f32_32x32x16_bf16(__builtin_bit_cast(bf16x8, v0w), pf, o[g][0], 0, 0, 0);
                    o[g][1] = __builtin_amdgcn_mfma_f32_32x32x16_bf16(__builtin_bit_cast(bf16x8, v1w), pf, o[g][1], 0, 0, 0);
                }
            }
        if (more) { *(LAS u32x4*)(Kb + (cur ^ 1) * 64 * LP + lr * LP + lc) = kn; *(LAS u32x4*)(Vb + (cur ^ 1) * 64 * LP + lr * LP + lc) = vn; }
        __syncthreads();
    }
#pragma unroll
    for (int g = 0; g < NG; ++g) {
        float lt = xor32_sum(l[g]);
        if (A.sink) lt += __builtin_amdgcn_exp2f(A.sink[head] * 1.4426950408889634f - m[g] * CS2);
        const float inv = 1.f / lt;
#pragma unroll
        for (int r = 0; r < 16; ++r) { Ost[(32 * g + r32) * LP + crow(r, hh)] = (bf16_t)f2bf(o[g][0][r] * inv); Ost[(32 * g + r32) * LP + 32 + crow(r, hh)] = (bf16_t)f2bf(o[g][1][r] * inv); }
    }
    asm volatile("s_waitcnt lgkmcnt(0)" ::: "memory");
#pragma unroll
    for (int p = 0; p < 4 * NG; ++p) { const int q = p * 8 + (lane >> 3), d8 = (lane & 7) * 8;
        u32x4 ov = *(LAS const u32x4*)(Ost + q * LP + d8); if ((DBG_SKIP & 2) && A.swa) ov = (u32x4){0u, 0u, 0u, 0u}; if ((DBG_SKIP & 16) && !A.swa) ov = (u32x4){0u, 0u, 0u, 0u};
        *(u32x2*)((unsigned char*)A.O + (size_t)(wrow0 + q) * A.opitch + A.ocol0 + (wid >> 1) * 64 + kvh * 256 + d8) = bf8_to_fp8(ov); }
}
#define ATT_BAR() do { asm volatile("s_waitcnt lgkmcnt(0)" ::: "memory"); __builtin_amdgcn_s_barrier(); asm volatile("" ::: "memory"); } while (0)
__device__ __forceinline__ void attn_unit_ph(const AttnArgs& A, LAS unsigned char* lds, int b, int kvh, int qrow0) {
    constexpr int NG = 2, RW = 64;
    constexpr float CS2 = 0.125f * 1.4426950408889634f;
    const int tid = threadIdx.x, lane = tid & 63, wid = tid >> 6, r32 = lane & 31, hh = lane >> 5, half = wid & 1;
    const int hl = wid >> 1, rh = wid & 1;
    LAS bf16_t* Kb = (LAS bf16_t*)lds; LAS bf16_t* Vb = Kb + 2 * 64 * LP; LAS bf16_t* Ost = Vb + 2 * 64 * LP + wid * RW * LP;
    const int head = kvh * 4 + hl;
    const int wrow0 = qrow0 + RW * rh;
    const bf16_t* Kg = A.Kc + ((size_t)b * A.HKV + kvh) * NKEY * 64; const bf16_t* Vg = A.VT + ((size_t)b * A.HKV + kvh) * 64 * NKEY;
    int ntile = NCH; asm volatile("" : "+s"(ntile));
    bf16x8 qf[NG][4];
#pragma unroll
    for (int g = 0; g < NG; ++g)
#pragma unroll
        for (int ks = 0; ks < 4; ++ks) qf[g][ks] = *(const bf16x8*)(A.Q + (size_t)(wrow0 + 32 * g + r32) * A.qpitch + head * 64 + ks * 16 + hh * 8);
    f32x16 o[NG][2]; float m[NG], l[NG];
#pragma unroll
    for (int g = 0; g < NG; ++g) { o[g][0] = F16ZERO; o[g][1] = F16ZERO; m[g] = -1e30f; l[g] = 0.f; }
    const int lr = tid >> 3, lc = (tid & 7) * 8;
    u32x4 kn, vn;
#define ATT_LOAD(J) do { kn = *(const u32x4*)(Kg + ((size_t)(J) * 64 + lr) * 64 + lc); vn = *(const u32x4*)(Vg + (size_t)lr * NKEY + (J) * 64 + lc); } while (0)
#define ATT_WRITE(J) do { *(LAS u32x4*)(Kb + ((J) & 1) * 64 * LP + lr * LP + lc) = kn; *(LAS u32x4*)(Vb + ((J) & 1) * 64 * LP + lr * LP + lc) = vn; } while (0)
    __syncthreads();
    ATT_LOAD(0); ATT_WRITE(0); ATT_LOAD(1); ATT_WRITE(1); ATT_LOAD(2);
    ATT_BAR();
    if (half == 1) ATT_BAR();
#pragma unroll 1
    for (int t = 0; t < ntile; ++t) {
        LAS const bf16_t* Kt = Kb + (t & 1) * 64 * LP; LAS const bf16_t* Vt = Vb + (t & 1) * 64 * LP;
        if (half == 1 && t >= 1 && t + 1 < ntile) { ATT_WRITE(t + 1); if (t + 2 < ntile) ATT_LOAD(t + 2); }
        f32x16 s[NG][2];
#pragma unroll
        for (int g = 0; g < NG; ++g) { s[g][0] = F16ZERO; s[g][1] = F16ZERO; }
#pragma unroll
        for (int ks = 0; ks < 4; ++ks) {
            const bf16x8 k0 = *(LAS const bf16x8*)(Kt + r32 * LP + ks * 16 + hh * 8), k1 = *(LAS const bf16x8*)(Kt + (32 + r32) * LP + ks * 16 + hh * 8);
#pragma unroll
            for (int g = 0; g < NG; ++g) { s[g][0] = __builtin_amdgcn_mfma_f32_32x32x16_bf16(k0, qf[g][ks], s[g][0], 0, 0, 0); s[g][1] = __builtin_amdgcn_mfma_f32_32x32x16_bf16(k1, qf[g][ks], s[g][1], 0, 0, 0); }
        }
        ATT_BAR();
        if (half == 0 && t >= 1 && t + 1 < ntile) { ATT_WRITE(t + 1); if (t + 2 < ntile) ATT_LOAD(t + 2); }
#pragma unroll
        for (int g = 0; g < NG; ++g) {
            float tmax = -1e30f;
#pragma unroll
            for (int r = 0; r < 16; ++r) tmax = fmaxf(tmax, fmaxf(s[g][0][r], s[g][1][r]));
            tmax = fmaxf(tmax, __shfl_xor(tmax, 32));
            const float mnew = fmaxf(m[g], tmax), alpha = __builtin_amdgcn_exp2f((m[g] - mnew) * CS2), mc = mnew * CS2;
            float ps = 0.f;
#pragma unroll
            for (int r = 0; r < 16; ++r) { const float p0 = __builtin_amdgcn_exp2f(s[g][0][r] * CS2 - mc), p1 = __builtin_amdgcn_exp2f(s[g][1][r] * CS2 - mc); s[g][0][r] = p0; s[g][1][r] = p1; ps += p0 + p1; }
            ps += __shfl_xor(ps, 32);
            l[g] = l[g] * alpha + ps; m[g] = mnew;
#pragma unroll
            for (int r = 0; r < 16; ++r) { o[g][0][r] *= alpha; o[g][1][r] *= alpha; }
        }
#pragma unroll
        for (int sub = 0; sub < 2; ++sub)
#pragma unroll
            for (int s2 = 0; s2 < 2; ++s2) {
                const int kof = sub * 32 + s2 * 16 + 4 * hh;
                u32x4 v0w, v1w;
                { const u32x2 a = *(LAS const u32x2*)(Vt + r32 * LP + kof), c = *(LAS const u32x2*)(Vt + r32 * LP + kof + 8); v0w.x = a.x; v0w.y = a.y; v0w.z = c.x; v0w.w = c.y; }
                { const u32x2 a = *(LAS const u32x2*)(Vt + (32 + r32) * LP + kof), c = *(LAS const u32x2*)(Vt + (32 + r32) * LP + kof + 8); v1w.x = a.x; v1w.y = a.y; v1w.z = c.x; v1w.w = c.y; }
#pragma unroll
                for (int g = 0; g < NG; ++g) {
                    const f32x16& sp = s[g][sub];
                    u32x4 pw; pw.x = pg8::cvt_pk_bf16(sp[8 * s2 + 0], sp[8 * s2 + 1]); pw.y = pg8::cvt_pk_bf16(sp[8 * s2 + 2], sp[8 * s2 + 3]); pw.z = pg8::cvt_pk_bf16(sp[8 * s2 + 4], sp[8 * s2 + 5]); pw.w = pg8::cvt_pk_bf16(sp[8 * s2 + 6], sp[8 * s2 + 7]);
                    const bf16x8 pf = __builtin_bit_cast(bf16x8, pw);
                    o[g][0] = __builtin_amdgcn_mfma_f32_32x32x16_bf16(__builtin_bit_cast(bf16x8, v0w), pf, o[g][0], 0, 0, 0);
                    o[g][1] = __builtin_amdgcn_mfma_f32_32x32x16_bf16(__builtin_bit_cast(bf16x8, v1w), pf, o[g][1], 0, 0, 0);
                }
            }
        ATT_BAR();
    }
    if (half == 0) ATT_BAR();
#undef ATT_LOAD
#undef ATT_WRITE
#pragma unroll
    for (int g = 0; g < NG; ++g) {
        const float inv = 1.f / l[g];
#pragma unroll
        for (int r = 0; r < 16; ++r) { Ost[(32 * g + r32) * LP + crow(r, hh)] = (bf16_t)f2bf(o[g][0][r] * inv); Ost[(32 * g + r32) * LP + 32 + crow(r, hh)] = (bf16_t)f2bf(o[g][1][r] * inv); }
    }
    asm volatile("s_waitcnt lgkmcnt(0)" ::: "memory");
#pragma unroll
    for (int p = 0; p < 4 * NG; ++p) { const int q = p * 8 + (lane >> 3), d8 = (lane & 7) * 8;
        *(u32x2*)((unsigned char*)A.O + (size_t)(wrow0 + q) * A.opitch + A.ocol0 + hl * 64 + kvh * 256 + d8) = bf8_to_fp8(*(LAS const u32x4*)(Ost + q * LP + d8)); }
}
__device__ __forceinline__ void phase_attention_dense(const AttnArgs& A, LAS unsigned char* lds, LAS unsigned char* misc, unsigned* qword) {
    constexpr int QR = 128, NQB = SEQ / QR;
    const int nlat = NB * A.HKV * NQB;
    LAS int* slot = (LAS int*)(misc + 32);
    for (;;) {
        __syncthreads();
        if (threadIdx.x == 0) *slot = (int)atomicAdd(qword, 1u);
        __syncthreads();
        const int u = *slot;
        if (u >= nlat) break;
        const int qb = u % NQB, kvh = (u / NQB) % A.HKV, b = u / (NQB * A.HKV);
        attn_unit_ph(A, lds, b, kvh, NCTX + b * 8192 + qb * QR);
    }
    __syncthreads();
}
template <int NG>
__device__ __forceinline__ void phase_attention(const AttnArgs& A, LAS unsigned char* lds, LAS unsigned char* misc, unsigned* qword, bool ctx_q) {
    constexpr int QR = 64 * NG, NQB = SEQ / QR, NCB = CTXL / QR;
    const int nlat = NB * A.HKV * NQB, nctx = ctx_q ? NB * A.HKV * NCB : 0;
    LAS int* slot = (LAS int*)(misc + 32);
    for (;;) {
        __syncthreads();
        if (threadIdx.x == 0) *slot = (int)atomicAdd(qword, 1u);
        __syncthreads();
        const int u = *slot;
        if (u >= nlat + nctx) break;
        if (u < nlat) { const int qb = u % NQB, kvh = (u / NQB) % A.HKV, b = u / (NQB * A.HKV); attn_unit<NG>(A, lds, b, kvh, NCTX + b * 8192 + qb * QR, qb * QR); }
        else { const int v = u - nlat, qb = v % NCB, kvh = (v / NCB) % A.HKV, b = v / (NCB * A.HKV); attn_unit<NG>(A, lds, b, kvh, b * 256 + qb * QR, -1); }
    }
    __syncthreads();
}

__device__ __forceinline__ void phase_attention_v1(const AttnArgs& A, LAS unsigned char* lds, LAS unsigned char* misc, unsigned* qword, bool ctx_q) {
    const int nlat = NB * A.HKV * 128, nctx = ctx_q ? NB * A.HKV * 4 : 0;
    LAS int* slot = (LAS int*)(misc + 32);
    for (;;) {
        __syncthreads();
        if (threadIdx.x == 0) *slot = (int)atomicAdd(qword, 1u);
        __syncthreads();
        const int u = *slot;
        if (u >= nlat + nctx) break;
        if (u < nlat) { const int qb = u & 127, kvh = (u >> 7) % A.HKV, b = u / (128 * A.HKV); attn_unit_v1(A, lds, b, kvh, NCTX + b * 8192 + qb * 64, qb * 64); }
        else { const int v = u - nlat, qb = v & 3, kvh = (v >> 2) % A.HKV, b = v / (4 * A.HKV); attn_unit_v1(A, lds, b, kvh, b * 256 + qb * 64, -1); }
    }
    __syncthreads();
}


__device__ __forceinline__ void qk_load_tile8(const bf16_t* src, size_t spitch, int tid, u32x2& w1, u32x2& w2) {
    const int r = tid >> 3, q = tid & 7, i0 = (q & 3) * 4, d1 = (q >> 2) * 32 + i0, d2 = d1 + 16;
    w1 = *(const u32x2*)(src + (size_t)r * spitch + d1); w2 = *(const u32x2*)(src + (size_t)r * spitch + d2);
}
__device__ __forceinline__ void qk_finish_tile8(const u32x2 w1, const u32x2 w2, unsigned char* dst, size_t dpitch, const float* gain, bool rope, int pos0, int tid, float oscale) {
    const int r = tid >> 3, q = tid & 7, i0 = (q & 3) * 4, d1 = (q >> 2) * 32 + i0, d2 = d1 + 16;
    float a[4] = {bflo(w1.x), bfhi(w1.x), bflo(w1.y), bfhi(w1.y)}, c[4] = {bflo(w2.x), bfhi(w2.x), bflo(w2.y), bfhi(w2.y)};
    float ss = 0.f;
#pragma unroll
    for (int i = 0; i < 4; ++i) ss += a[i] * a[i] + c[i] * c[i];
    ss += __shfl_xor(ss, 1); ss += __shfl_xor(ss, 2); ss += __shfl_xor(ss, 4);
    const float rstd = rsqrtf(ss * (1.f / 64.f) + 1e-6f);
#pragma unroll
    for (int i = 0; i < 4; ++i) { a[i] = a[i] * rstd * gain[d1 + i]; c[i] = c[i] * rstd * gain[d2 + i]; }
    if (rope) {
        const int pos = pos0 + r; const float pc = (float)((q >> 2) ? (pos & 63) : (pos >> 6));
#pragma unroll
        for (int i = 0; i < 4; ++i) { const float inv = exp2f(-(float)(i0 + i) * (13.287712379549449f / 16.f)); float sn, cs; __sincosf(pc * inv, &sn, &cs);
            const float t1 = a[i], t2 = c[i]; a[i] = t1 * cs - t2 * sn; c[i] = t2 * cs + t1 * sn; }
    }
    *(unsigned*)(dst + (size_t)r * dpitch + d1) = pk4_fp8(a[0] * oscale, a[1] * oscale, a[2] * oscale, a[3] * oscale); *(unsigned*)(dst + (size_t)r * dpitch + d2) = pk4_fp8(c[0] * oscale, c[1] * oscale, c[2] * oscale, c[3] * oscale);
}
__device__ __forceinline__ void qk_prep_tile8(const bf16_t* src, size_t spitch, unsigned char* dst, size_t dpitch, const float* gain, bool rope, int pos0, int tid, float oscale) {
    u32x2 w1, w2; qk_load_tile8(src, spitch, tid, w1, w2); qk_finish_tile8(w1, w2, dst, dpitch, gain, rope, pos0, tid, oscale);
}
__device__ __forceinline__ void phase_qkv_prep8(unsigned char* ws, LAS unsigned char* lds, const float* qgain, const float* kgain) {
    const int tid = threadIdx.x; unsigned char* R = ws + WS_R;
    const bf16_t* kv = (const bf16_t*)(R + R_KV1); const bf16_t* q1 = (const bf16_t*)(R + R_Q1);
    unsigned char* K8 = R + R_K8; unsigned char* VT8 = R + R_VT8; unsigned char* Q8 = R + R_Q8;
    LAS bf16_t* tl = (LAS bf16_t*)lds;
    for (int u = blockIdx.x; u < NB * 3 * NCH; u += gridDim.x) {
        const int j = u % NCH, kvh = (u / NCH) % 3, b = u / (NCH * 3);
        const int row0 = j < 4 ? b * 256 + j * 64 : NCTX + b * 8192 + (j - 4) * 64;
        const size_t key0 = (size_t)j * 64;
        qk_prep_tile8(kv + (size_t)row0 * 384 + kvh * 64, 384, K8 + (((size_t)b * 3 + kvh) * NKEY + key0) * 64, 64, kgain, j >= 4, (j - 4) * 64, tid, 0.25f);
        __syncthreads();
        { const int r = tid >> 3, c8 = (tid & 7) * 8; *(LAS u32x4*)(tl + r * LP + c8) = *(const u32x4*)(kv + (size_t)(row0 + r) * 384 + 192 + kvh * 64 + c8); }
        __syncthreads();
        { const int dv = tid >> 3, p8 = (tid & 7) * 8, hh = p8 >> 5, sub = (p8 >> 4) & 1, ka = 32 * sub + 4 * hh + ((p8 & 8) ? 16 : 0);
          u32x2 w;
          w.x = pk4_fp8(bf2f(tl[(ka + 0) * LP + dv]), bf2f(tl[(ka + 1) * LP + dv]), bf2f(tl[(ka + 2) * LP + dv]), bf2f(tl[(ka + 3) * LP + dv]));
          w.y = pk4_fp8(bf2f(tl[(ka + 8) * LP + dv]), bf2f(tl[(ka + 9) * LP + dv]), bf2f(tl[(ka + 10) * LP + dv]), bf2f(tl[(ka + 11) * LP + dv]));
          *(u32x2*)(VT8 + (((size_t)b * 3 + kvh) * 64 + dv) * NKEY + key0 + p8) = w; }
    }
    const int skipq = gridDim.x == 256 ? 80 : 0, gq_ = (int)gridDim.x - skipq;
    for (int u0 = (int)blockIdx.x - skipq; u0 >= 0 && u0 < (NLAT / 64) * 12; u0 += 4 * gq_) {
        u32x2 w1[4], w2[4];
#pragma unroll
        for (int k = 0; k < 4; ++k) { const int u = u0 + k * gq_; if (u < (NLAT / 64) * 12) { const int hq = u % 12, tI = u / 12; qk_load_tile8(q1 + (size_t)(NCTX + tI * 64) * 768 + hq * 64, 768, tid, w1[k], w2[k]); } }
#pragma unroll
        for (int k = 0; k < 4; ++k) { const int u = u0 + k * gq_; if (u < (NLAT / 64) * 12) { const int hq = u % 12, tI = u / 12; const int lrow0 = tI * 64;
            qk_finish_tile8(w1[k], w2[k], Q8 + (size_t)lrow0 * 768 + hq * 64, 768, qgain, true, lrow0 & 8191, tid, 4.f * 0.125f * 1.4426950408889634f); } }
    }
    __syncthreads();
}
__device__ __forceinline__ void mfma8_acc(f32x16& acc, const i32x8& a, const i32x8& b, int sc) {
    asm volatile("s_nop 1\n\tv_mfma_scale_f32_32x32x64_f8f6f4 %0, %1, %2, %0, %3, %3 op_sel_hi:[0,0,0]" : "+v"(acc) : "v"(a), "v"(b), "v"(sc));
}
__device__ __forceinline__ void mfma8_z(f32x16& out, const i32x8& a, const i32x8& b, int sc) {
    asm volatile("s_nop 1\n\tv_mfma_scale_f32_32x32x64_f8f6f4 %0, %1, %2, 0, %3, %3 op_sel_hi:[0,0,0]" : "=&v"(out) : "v"(a), "v"(b), "v"(sc));
}
__device__ __forceinline__ void mfma8_c(f32x16& out, const i32x8& a, const i32x8& b, const f32x16& c, int sc) {
    asm volatile("s_nop 1\n\tv_mfma_scale_f32_32x32x64_f8f6f4 %0, %1, %2, %3, %4, %4 op_sel_hi:[0,0,0]" : "=&v"(out) : "v"(a), "v"(b), "v"(c), "v"(sc));
}
__device__ __forceinline__ float max3_(float a, float b, float c) { float r; asm("v_max3_f32 %0, %1, %2, %3" : "=v"(r) : "v"(a), "v"(b), "v"(c)); return r; }
__device__ __forceinline__ i32x8 lds_frag8(LAS const unsigned char* p) { const u32x4 a = *(LAS const u32x4*)p, b = *(LAS const u32x4*)(p + 16); return __builtin_bit_cast(i32x8, __builtin_shufflevector(a, b, 0, 1, 2, 3, 4, 5, 6, 7)); }
constexpr int LP8 = 80;
__device__ __forceinline__ void attn_unit8(unsigned char* R, bf16_t* O, LAS unsigned char* lds, int b, int kvh, int lrow0  , const bool SREF, const float mref) {
    constexpr float CS2 = 0.125f * 1.4426950408889634f;
    const int tid = threadIdx.x, lane = tid & 63, wid = tid >> 6, r32 = lane & 31, hh = lane >> 5; const int sc = 0x7F7F7F7F;
    LAS unsigned char* Kb = lds; LAS unsigned char* Vb = lds + 2 * 64 * LP8; LAS bf16_t* Ost = (LAS bf16_t*)(lds + 4 * 64 * LP8) + wid * 64 * LP;
    const int head = kvh * 4 + (wid >> 1), wrow0 = lrow0 + 64 * (wid & 1);
    const unsigned char* Kg = R + R_K8 + ((size_t)b * 3 + kvh) * NKEY * 64; const unsigned char* Vg = R + R_VT8 + ((size_t)b * 3 + kvh) * 64 * NKEY; const unsigned char* Qg = R + R_Q8;
    i32x8 qf[2];
#pragma unroll
    for (int g = 0; g < 2; ++g) { const unsigned char* qp = Qg + (size_t)(wrow0 + 32 * g + r32) * 768 + head * 64 + 32 * hh; const u32x4 a = *(const u32x4*)qp, c = *(const u32x4*)(qp + 16);
        qf[g] = __builtin_bit_cast(i32x8, __builtin_shufflevector(a, c, 0, 1, 2, 3, 4, 5, 6, 7)); }
    f32x16 o[2][2]; const f32x16 cref = F16ZERO - mref; f32x2 l2[2]; float mrun[2] = {0.f, 0.f};
#pragma unroll
    for (int g = 0; g < 2; ++g) { o[g][0] = F16ZERO; o[g][1] = F16ZERO; l2[g] = (f32x2){0.f, 0.f}; }
    const int st = tid & 255, srow = st >> 2, spc = (st & 3) * 16; const bool isv = tid >= 256;
    const unsigned char* gsrc = isv ? Vg + (size_t)srow * NKEY + spc : Kg + (size_t)srow * 64 + spc; const size_t gstep = isv ? 64 : 64 * 64;
    LAS unsigned char* ldst = (isv ? Vb : Kb) + srow * LP8 + spc;
    int ntile = NCH; asm volatile("" : "+s"(ntile));
    __syncthreads();
    *(LAS u32x4*)ldst = *(const u32x4*)gsrc;
    u32x4 pre0 = *(const u32x4*)(gsrc + gstep);
    __syncthreads();
#pragma unroll 1
    for (int it = 0; it < ntile; ++it) {
        const int cur = it & 1; const bool more = it + 1 < ntile;
        u32x4 pre1 = pre0; if (it + 2 < ntile) pre1 = *(const u32x4*)(gsrc + (size_t)(it + 2) * gstep);
        LAS const unsigned char* Kt = Kb + cur * 64 * LP8; LAS const unsigned char* Vt = Vb + cur * 64 * LP8;
        const i32x8 k0 = lds_frag8(Kt + r32 * LP8 + 32 * hh), k1 = lds_frag8(Kt + (32 + r32) * LP8 + 32 * hh);
        f32x16 s[2][2];
        mfma8_c(s[0][0], k0, qf[0], cref, sc); mfma8_c(s[0][1], k1, qf[0], cref, sc); mfma8_c(s[1][0], k0, qf[1], cref, sc); mfma8_c(s[1][1], k1, qf[1], cref, sc);
        asm volatile("s_nop 15\n\ts_nop 7" : "+v"(s[0][0]), "+v"(s[0][1]), "+v"(s[1][0]), "+v"(s[1][1]));
        const i32x8 v0 = lds_frag8(Vt + r32 * LP8 + 32 * hh), v1 = lds_frag8(Vt + (32 + r32) * LP8 + 32 * hh);
#pragma unroll
        for (int g = 0; g < 2; ++g) {
            if (!SREF) {
                float tmax = -3.0e38f;
#pragma unroll
                for (int r = 0; r < 16; ++r) tmax = max3_(tmax, s[g][0][r], s[g][1][r]);
                tmax = xor32_max(tmax);
                if (it == 0 || !__all(tmax <= mrun[g] + 8.f)) { const float mnew = it == 0 ? tmax : fmaxf(tmax, mrun[g]), alpha = it == 0 ? 1.f : __builtin_amdgcn_exp2f(mrun[g] - mnew);
                    l2[g] = l2[g] * alpha; o[g][0] = o[g][0] * alpha; o[g][1] = o[g][1] * alpha; mrun[g] = mnew; }
                s[g][0] = s[g][0] - mrun[g]; s[g][1] = s[g][1] - mrun[g];
            }
            unsigned pw[8];
#pragma unroll
            for (int q4 = 0; q4 < 4; ++q4) {
                float p0[4], p1[4];
#pragma unroll
                for (int e = 0; e < 4; ++e) { p0[e] = __builtin_amdgcn_exp2f(s[g][0][4 * q4 + e]); p1[e] = __builtin_amdgcn_exp2f(s[g][1][4 * q4 + e]); }
                l2[g] = l2[g] + (f32x2){p0[0], p0[1]}; l2[g] = l2[g] + (f32x2){p0[2], p0[3]}; l2[g] = l2[g] + (f32x2){p1[0], p1[1]}; l2[g] = l2[g] + (f32x2){p1[2], p1[3]};
                int w0 = 0, w1 = 0;
                w0 = __builtin_amdgcn_cvt_pk_fp8_f32(p0[0], p0[1], w0, false); w0 = __builtin_amdgcn_cvt_pk_fp8_f32(p0[2], p0[3], w0, true);
                w1 = __builtin_amdgcn_cvt_pk_fp8_f32(p1[0], p1[1], w1, false); w1 = __builtin_amdgcn_cvt_pk_fp8_f32(p1[2], p1[3], w1, true);
                pw[q4] = (unsigned)w0; pw[4 + q4] = (unsigned)w1; }
            const i32x8 pf = (i32x8){(int)pw[0], (int)pw[1], (int)pw[2], (int)pw[3], (int)pw[4], (int)pw[5], (int)pw[6], (int)pw[7]};
            mfma8_acc(o[g][0], v0, pf, sc); mfma8_acc(o[g][1], v1, pf, sc);
        }
        if (more) *(LAS u32x4*)(ldst + (cur ^ 1) * 64 * LP8) = pre0;
        pre0 = pre1;
        __syncthreads();
    }
    asm volatile("s_nop 15\n\ts_nop 7" : "+v"(o[0][0]), "+v"(o[0][1]), "+v"(o[1][0]), "+v"(o[1][1]));
#pragma unroll
    for (int g = 0; g < 2; ++g) {
        const float inv = 1.f / xor32_sum(l2[g][0] + l2[g][1]);
#pragma unroll
        for (int r = 0; r < 16; ++r) { Ost[(32 * g + r32) * LP + crow(r, hh)] = (bf16_t)f2bf(o[g][0][r] * inv); Ost[(32 * g + r32) * LP + 32 + crow(r, hh)] = (bf16_t)f2bf(o[g][1][r] * inv); }
    }
    asm volatile("s_waitcnt lgkmcnt(0)" ::: "memory");
#pragma unroll
    for (int p = 0; p < 8; ++p) { const int q = p * 8 + (lane >> 3), d8 = (lane & 7) * 8;
        *(u32x4*)(O + (size_t)(NCTX + wrow0 + q) * 1024 + 256 + (wid >> 1) * 64 + kvh * 256 + d8) = *(LAS const u32x4*)(Ost + q * LP + d8); }
}
__device__ __forceinline__ void attn8_reference(unsigned char* ws, const float* gq, const float* gk) {
    if (blockIdx.x == 0 && threadIdx.x < 64) { float mq = fabsf(gq[threadIdx.x]), mk = fabsf(gk[threadIdx.x]);
#pragma unroll
        for (int o = 32; o; o >>= 1) { mq = fmaxf(mq, __shfl_xor(mq, o)); mk = fmaxf(mk, __shfl_xor(mk, o)); }
        if (threadIdx.x == 0) WSP(float, WS_CTL)[CW_CNT + 80] = 1.0625f * 1.0625f * 8.f * 1.4426950408889634f * mq * mk - 8.8f; }
}
__device__ __forceinline__ void phase_attention8(unsigned char* ws, LAS unsigned char* lds, LAS unsigned char* misc, unsigned* qword, const float* gq, const float* gk) {
    constexpr int NQB = SEQ / 128; const int nlat = NB * 3 * NQB;
    LAS int* slot = (LAS int*)(misc + 32);
    (void)gq; (void)gk;
    const float mref = __builtin_bit_cast(float, __builtin_amdgcn_readfirstlane((int)WSP(unsigned, WS_CTL)[CW_CNT + 80]));
    const bool sref = mref <= 8.f;
    for (;;) {
        __syncthreads();
        if (threadIdx.x == 0) *slot = (int)atomicAdd(qword, 1u);
        __syncthreads();
        const int u = *slot;
        if (u >= nlat) break;
        const int qb = u % NQB, kvh = (u / NQB) % 3, b = u / (NQB * 3);
        attn_unit8(ws + WS_R, WSP(bf16_t, WS_XN), lds, b, kvh, b * 8192 + qb * 128, sref, sref ? mref : 0.f);
    }
    __syncthreads();
}

__device__ __forceinline__ void phase_norm2_route(const Params& P, unsigned char* ws, LAS unsigned char* lds, int layer, int row_lo) {
    const int tid = threadIdx.x, lane = tid & 63, wid = tid >> 6, r32 = lane & 31, hh = lane >> 5;
    LAS float* xs = (LAS float*)(lds + wid * 12800);
    LAS float* lg = xs + 32 * 65;
    LAS float* rsd = lg + 32 * 33;
    LAS int* cnt_l = (LAS int*)(lds + 8 * 12800);
    LAS int* base_l = cnt_l + 32;
    const float* mods = WSP(float, WS_MODS) + (size_t)layer * 9 * 6144; const float* gff = P.in[layer ? 22 : 7];
    const bf16_t* GWH = WSP(bf16_t, WS_GW) + (size_t)layer * 9 * 32768; const bf16_t* GWL = GWH + (size_t)2 * 9 * 32 * 1024; const float* CB = WSP(float, WS_CB) + layer * 9 * 32;
    bf16_t* XN = WSP(bf16_t, WS_XN); int* tope = WSP(int, WS_TOPE); float* topg = WSP(float, WS_TOPG); int* rank = WSP(int, WS_RANK); int* rowtok = WSP(int, WS_ROWTOK);
    unsigned* gcnt = WSP(unsigned, WS_CTL) + CW_CNT + layer * 32;
    const float* xlat = P.out; const float* xctx = WSP(float, WS_HCTX);
    for (size_t i = (size_t)blockIdx.x * NTHREADS + tid; i < (size_t)MAXRB * 256; i += (size_t)gridDim.x * NTHREADS) rowtok[i] = row_lo;
    const int ngroups = (NTOK - row_lo) / 256;
    for (int grp = blockIdx.x; grp < ngroups; grp += gridDim.x) {
        const int R0 = row_lo + grp * 256 + wid * 32;
        const int rb = R0 < NCTX ? 8 : (R0 - NCTX) >> 13;
        const float* xb = R0 < NCTX ? xctx + (size_t)R0 * 1024 : xlat + (size_t)(R0 - NCTX) * 1024;
        __syncthreads();
        if (tid < 32) cnt_l[tid] = 0;
        f32x16 acc = F16ZERO; float ss = 0.f;
        const bf16_t* gwh = GWH + (size_t)rb * 32768 + (size_t)r32 * 1024 + 8 * hh; const bf16_t* gwl = GWL + (size_t)rb * 32768 + (size_t)r32 * 1024 + 8 * hh;
        const float* xr = xb + (size_t)r32 * 1024 + 8 * hh;
#pragma unroll 4
        for (int k0 = 0; k0 < 1024; k0 += 16) {
            const f32x4 a0 = *(const f32x4*)(xr + k0), a1 = *(const f32x4*)(xr + k0 + 4);
            const bf16x8 bh = *(const bf16x8*)(gwh + k0), bl = *(const bf16x8*)(gwl + k0);
            ss += a0[0] * a0[0] + a0[1] * a0[1] + a0[2] * a0[2] + a0[3] * a0[3] + a1[0] * a1[0] + a1[1] * a1[1] + a1[2] * a1[2] + a1[3] * a1[3];
            u32x4 hw, lw;
            hw.x = pk2(a0[0], a0[1]); hw.y = pk2(a0[2], a0[3]); hw.z = pk2(a1[0], a1[1]); hw.w = pk2(a1[2], a1[3]);
            lw.x = pk2(a0[0] - bflo(hw.x), a0[1] - bfhi(hw.x)); lw.y = pk2(a0[2] - bflo(hw.y), a0[3] - bfhi(hw.y)); lw.z = pk2(a1[0] - bflo(hw.z), a1[1] - bfhi(hw.z)); lw.w = pk2(a1[2] - bflo(hw.w), a1[3] - bfhi(hw.w));
            const bf16x8 ah = __builtin_bit_cast(bf16x8, hw), al = __builtin_bit_cast(bf16x8, lw);
            acc = __builtin_amdgcn_mfma_f32_32x32x16_bf16(ah, bh, acc, 0, 0, 0); acc = __builtin_amdgcn_mfma_f32_32x32x16_bf16(al, bh, acc, 0, 0, 0); acc = __builtin_amdgcn_mfma_f32_32x32x16_bf16(ah, bl, acc, 0, 0, 0);
        }
        ss += __shfl_xor(ss, 32);
        const float rstd = rsqrtf(ss * (1.f / 1024.f) + 1e-6f);
        if (hh == 0) rsd[r32] = rstd;
        const float cb = CB[rb * 32 + r32];
#pragma unroll
        for (int r = 0; r < 16; ++r) { const int row = crow(r, hh); lg[row * 33 + r32] = rsd[row] * acc[r] + cb; }
        int se[4] = {0, 0, 0, 0}, sr[4] = {0, 0, 0, 0}; float sg[4] = {0.f, 0.f, 0.f, 0.f};
        if (lane < 32) {
            float tv[4];
#pragma unroll
            for (int k = 0; k < 4; ++k) { float best = -3.0e38f; int bi = 0;
                for (int e = 0; e < 32; ++e) { const float v = lg[lane * 33 + e]; if (v > best) { best = v; bi = e; } }
                tv[k] = best; se[k] = bi; lg[lane * 33 + bi] = -3.0e38f; }
            const float e1 = __expf(tv[1] - tv[0]), e2 = __expf(tv[2] - tv[0]), e3 = __expf(tv[3] - tv[0]), inv = 1.f / (1.f + e1 + e2 + e3);
            sg[0] = inv; sg[1] = e1 * inv; sg[2] = e2 * inv; sg[3] = e3 * inv;
        }
        __syncthreads();
        if (lane < 32) {
#pragma unroll
            for (int k = 0; k < 4; ++k) sr[k] = lds_addi(&cnt_l[se[k]], 1);
        }
        __syncthreads();
        if (tid < 32) base_l[tid] = (int)atomicAdd(&gcnt[tid], (unsigned)cnt_l[tid]);
        __syncthreads();
        if (lane < 32) { const size_t row = (size_t)(R0 + lane);
#pragma unroll
            for (int k = 0; k < 4; ++k) { tope[row * 4 + k] = se[k]; topg[row * 4 + k] = sg[k]; rank[row * 4 + k] = base_l[se[k]] + sr[k]; } }
        const float* m = mods + (size_t)rb * 6144;
        f32x4 nx[4][4];
#pragma unroll
        for (int u = 0; u < 4; ++u)
#pragma unroll
            for (int q = 0; q < 4; ++q) nx[u][q] = *(const f32x4*)(xb + (size_t)u * 1024 + q * 256 + lane * 4);
        f32x4 ga[4], gb[4];
#pragma unroll
        for (int q = 0; q < 4; ++q) { const int k = q * 256 + lane * 4; ga[q] = *(const f32x4*)(gff + k) * (1.f + *(const f32x4*)(m + 4096 + k)); gb[q] = *(const f32x4*)(m + 3072 + k); }
        for (int i0 = 0; i0 < 32; i0 += 4) {
#pragma unroll
            for (int u = 0; u < 4; ++u) { const int i = i0 + u; const float rs_i = rsd[i]; f32x4 v[4];
#pragma unroll
                for (int q = 0; q < 4; ++q) v[q] = nx[u][q];
                if (i + 4 < 32) { const float* x = xb + (size_t)(i + 4) * 1024;
#pragma unroll
                    for (int q = 0; q < 4; ++q) nx[u][q] = *(const f32x4*)(x + q * 256 + lane * 4); }
#pragma unroll
                for (int q = 0; q < 4; ++q) { const int k = q * 256 + lane * 4;
                    const f32x4 o = v[q] * rs_i * ga[q] + gb[q];
                    *(unsigned*)((unsigned char*)XN + (size_t)(R0 + i) * 1024 + k) = pk4_fp8(o[0], o[1], o[2], o[3]); } } }
    }
    __syncthreads();
}
__device__ __forceinline__ void phase_moe_scatter(unsigned char* ws, const MoeTab& T, int row_lo) {
    const int* tope = WSP(int, WS_TOPE); const int* rank = WSP(int, WS_RANK); int* rowtok = WSP(int, WS_ROWTOK);
    for (size_t i = (size_t)blockIdx.x * NTHREADS + threadIdx.x + (size_t)row_lo * 4; i < (size_t)NTOK * 4; i += (size_t)gridDim.x * NTHREADS)
        rowtok[T.pad_start[tope[i]] + rank[i]] = (int)(i >> 2);
}
__device__ __forceinline__ void phase_moe_combine_norm(const Params& P, unsigned char* ws, const MoeTab& T, int layer, int row_lo) {
    const int lane = threadIdx.x & 63, gw = blockIdx.x * 8 + (threadIdx.x >> 6), nw = gridDim.x * 8;
    const int* tope = WSP(int, WS_TOPE); const int* rank = WSP(int, WS_RANK); const float* topg = WSP(float, WS_TOPG);
    const unsigned char* OUT = ws + WS_OUT; const float* mods = WSP(float, WS_MODS) + (size_t)layer * 9 * 6144; const float* mods1 = WSP(float, WS_MODS) + (size_t)9 * 6144;
    float* xlat = P.out; float* xctx = WSP(float, WS_HCTX); bf16_t* XN = WSP(bf16_t, WS_XN);
    const float* gn = layer ? P.in[43] : P.in[21];
    for (int row = row_lo + gw; row < NTOK; row += nw) {
        f32x4 a[4];
#pragma unroll
        for (int q = 0; q < 4; ++q) a[q] = (f32x4){0.f, 0.f, 0.f, 0.f};
#pragma unroll
        for (int k = 0; k < 4; ++k) { const int e = tope[(size_t)row * 4 + k], dest = T.pad_start[e] + rank[(size_t)row * 4 + k];
            const float g = topg[(size_t)row * 4 + k]; const unsigned char* o = OUT + (size_t)dest * 1024;
#pragma unroll
            for (int q = 0; q < 4; ++q) { const int w = *(const int*)(o + q * 256 + lane * 4); const f32x2 lo = __builtin_amdgcn_cvt_pk_f32_fp8(w, false), hi = __builtin_amdgcn_cvt_pk_f32_fp8(w, true);
                a[q][0] += g * lo.x; a[q][1] += g * lo.y; a[q][2] += g * hi.x; a[q][3] += g * hi.y; } }
        float* x; int r; if (row < NCTX) { x = xctx + (size_t)row * 1024; r = 8; } else { x = xlat + (size_t)(row - NCTX) * 1024; r = (row - NCTX) >> 13; }
        const float* gt = mods + (size_t)r * 6144 + 5120;
        float ss = 0.f;
#pragma unroll
        for (int q = 0; q < 4; ++q) { const int k = q * 256 + lane * 4; a[q] = *(const f32x4*)(x + k) + *(const f32x4*)(gt + k) * a[q]; ss += a[q][0] * a[q][0] + a[q][1] * a[q][1] + a[q][2] * a[q][2] + a[q][3] * a[q][3]; }
        ss = wave_sum(ss); const float rstd = rsqrtf(ss * (1.f / 1024.f) + 1e-6f);
        if (layer == 0) {
            const float* m = mods1 + (size_t)r * 6144;
#pragma unroll
            for (int q = 0; q < 4; ++q) { const int k = q * 256 + lane * 4; *(f32x4*)(x + k) = a[q];
                const f32x4 o = a[q] * rstd * *(const f32x4*)(gn + k) * (1.f + *(const f32x4*)(m + 1024 + k)) + *(const f32x4*)(m + k);
                *(unsigned*)((unsigned char*)XN + (size_t)row * 1024 + k) = pk4_fp8(o[0], o[1], o[2], o[3]); }
        } else {
#pragma unroll
            for (int q = 0; q < 4; ++q) { const int k = q * 256 + lane * 4; *(f32x4*)(x + k) = a[q] * rstd * *(const f32x4*)(gn + k); }
        }
    }
}

__device__ __forceinline__ void phase_s5_scan(unsigned char* ws) {
    const int gid = blockIdx.x * NTHREADS + threadIdx.x;
    if (gid >= NB * 16 * 2 * 64) return;
    const int p = gid & 63, dir = (gid >> 6) & 1, g = (gid >> 7) & 15, b = gid >> 11;
    const float* A64 = WSP(float, WS_S5A64); const float ar = A64[((dir * 16 + g) * 64 + p) * 2], ai = A64[((dir * 16 + g) * 64 + p) * 2 + 1];
    const float* Sl = (const float*)(ws + WS_R + R_SLOC) + (size_t)g * 1280 * 256 + dir * 128 + p;
    bf16_t* UX = (bf16_t*)(ws + WS_R + R_UX) + (size_t)g * 1280 * 1280 + 1024 + dir * 128 + p;
    float xr = 0.f, xi = 0.f;
    for (int i0 = 0; i0 < NCH; i0 += 12) {
        int nidx[12]; float sr[12], si[12];
#pragma unroll
        for (int q = 0; q < 12; ++q) { const int i = i0 + q; int c, n;
            if (i < 4) { c = dir ? 3 - i : i; n = 1024 + b * 4 + c; } else { c = dir ? 131 - i : i - 4; n = b * 128 + c; }
            nidx[q] = (i < 4) ? -1 - n : n; sr[q] = Sl[(size_t)n * 256]; si[q] = Sl[(size_t)n * 256 + 64]; }
#pragma unroll
        for (int q = 0; q < 12; ++q) {
            if (nidx[q] >= 0) { UX[(size_t)nidx[q] * 1280] = (bf16_t)f2bf(xr); UX[(size_t)nidx[q] * 1280 + 64] = (bf16_t)f2bf(xi); }
            const float nr = ar * xr - ai * xi + sr[q], ni = ar * xi + ai * xr + si[q]; xr = nr; xi = ni; }
    }
}

__device__ __forceinline__ void phase_final_norm(const Params& P) {
    const int lane = threadIdx.x & 63, gw = blockIdx.x * 8 + (threadIdx.x >> 6), nw = gridDim.x * 8; const float* g = P.in[43];
    for (int row = gw; row < NLAT; row += nw) { float* x = P.out + (size_t)row * 1024; f32x4 v[4]; float ss = 0.f;
#pragma unroll
        for (int i = 0; i < 4; ++i) { v[i] = *(const f32x4*)(x + i * 256 + lane * 4); ss += v[i][0] * v[i][0] + v[i][1] * v[i][1] + v[i][2] * v[i][2] + v[i][3] * v[i][3]; }
        ss = wave_sum(ss); const float rstd = rsqrtf(ss * (1.f / 1024.f) + 1e-6f);
#pragma unroll
        for (int i = 0; i < 4; ++i) *(f32x4*)(x + i * 256 + lane * 4) = v[i] * rstd * *(const f32x4*)(g + i * 256 + lane * 4); }
}

constexpr int NPHASE = 23;
__global__ void __launch_bounds__(NTHREADS, 2) hybrid_fwd(Params P) {
    extern __shared__ __attribute__((aligned(16))) unsigned char shm_raw[];
    LAS unsigned char* lds = (LAS unsigned char*)shm_raw;
    LAS unsigned char* misc = lds + LDS_STAGE;
    unsigned char* ws = P.ws; unsigned char* R = ws + WS_R;
    const int lo = P.ph_lo, hi = P.ph_hi;
    if (threadIdx.x == 0) *(LAS u32x4*)misc = (u32x4){0u, 0u, 0u, 0u};
    __syncthreads();
    XcdBarrier bar; bar.bar = WSP(unsigned, WS_CTL); bar.x = 0; bar.st = (volatile LAS unsigned*)misc;
    if (hi - lo > 1) bar = xcd_barrier_post(WSP(unsigned, WS_CTL), (volatile LAS unsigned*)misc);
    const MoeTab T = moe_tab(misc);
    const float* mods = WSP(float, WS_MODS);
#ifndef PHMASK
#define PHMASK 0x7fffffffull
#endif
#define IN(k) ((((PHMASK) >> (k)) & 1ull) != 0ull && lo <= (k) && (k) < hi)
#define SEAM(k) do { if (IN(k) && IN((k) + 1)) xcd_barrier(bar); } while (0)

    if (IN(0)) { attn8_reference(ws, P.in[35], P.in[36]); phase_mods(P, ws, lds); phase_convert_small(P, ws, lds); phase_convert_moe8(P, ws, lds, 0, true); if (REP(0)) phase_convert_moe8(P, ws, lds, 0); phase_s5_kernels(P, ws, lds); }
    SEAM(0);
    if (IN(1)) { phase_router_tables(P, ws, lds); phase_s5_tables(P, ws); if (REP(1)) phase_s5_tables(P, ws); phase_norm1(P, ws, 0, P.in[0], P.in[2]); if (REP(15)) phase_norm1(P, ws, 0, P.in[0], P.in[2]); }
    SEAM(1);
    if (IN(2)) { SchedPlain S; S.init(NTOK / 256, 12, 1); S.A = (const char*)(ws + WS_XN); S.Bt = (const char*)(ws + WS_WIN0T); S.lda_bytes = 2048; S.ldb_bytes = 2048; S.a_gstride = 0; S.b_gstride = 0;
        EpiInProj0 E; E.R = R; E.gate_bias = P.in[10]; pg8::gemm_phase(lds, S, E, 1024); if (REP(2)) pg8::gemm_phase(lds, S, E, 1024); }
    SEAM(2);
    if (IN(3)) { phase_qkv_prep(lds, (const bf16_t*)(R + R_KBR), 128, (const bf16_t*)(R + R_VBR), 128, (bf16_t*)(R + R_QB), 512, 2, 8, (bf16_t*)(R + R_KC0), (bf16_t*)(R + R_VT0), nullptr, nullptr, true);
        phase_mlstm_local2(ws, lds); if (REP(3)) phase_mlstm_local2(ws, lds); }
    SEAM(3);
    if (IN(4)) { phase_mlstm_scan(ws);
        AttnArgs A; A.Q = (const bf16_t*)(R + R_QB); A.qpitch = 512; A.Kc = (const bf16_t*)(R + R_KC0); A.VT = (const bf16_t*)(R + R_VT0); A.O = WSP(bf16_t, WS_XN); A.opitch = 1024; A.ocol0 = 512; A.HKV = 2; A.sink = P.in[12]; A.swa = 1;
        phase_attention_v1(A, lds, misc, WSP(unsigned, WS_CTL) + CW_Q0, true); if (REP(4)) phase_attention_v1(A, lds, misc, WSP(unsigned, WS_CTL) + CW_Q0 + 128, true); }
    SEAM(4);
    if (IN(5)) { phase_mlstm_out2(P, ws, lds); if (REP(5)) phase_mlstm_out2(P, ws, lds); }
    SEAM(5);
    if (IN(6)) { SchedPlain S; S.init(NTOK / 256, 4, 1); S.A = (const char*)(ws + WS_XN); S.Bt = (const char*)(ws + WS_WOUT0T); S.lda_bytes = 1024; S.ldb_bytes = 1024; S.a_gstride = 0; S.b_gstride = 0;
        EpiResid E; E.xin = P.in[0]; E.xout = P.out; E.hin = P.in[2]; E.hout = WSP(float, WS_HCTX); E.gate = mods + 2048; E.row_base = 0; E.scale = W8_INV; pg8::gemm_phase8(lds, S, E, 512); if (REP(6)) pg8::gemm_phase8(lds, S, E, 512); }
    SEAM(6);
#define MOE_LAYER(PH0, LAYER, ROWLO)                                                                                                                              \
    if (IN(PH0)) phase_norm2_route(P, ws, lds, LAYER, ROWLO);                                                                                                     \
    SEAM(PH0);                                                                                                                                                    \
    if (IN(PH0 + 1)) { moe_build_tab(WSP(unsigned, WS_CTL) + CW_CNT + LAYER * 32, T); phase_moe_scatter(ws, T, ROWLO); }                                          \
    SEAM(PH0 + 1);                                                                                                                                                \
    {   if (IN(PH0 + 2) || IN(PH0 + 3) || IN(PH0 + 4)) moe_build_tab(WSP(unsigned, WS_CTL) + CW_CNT + LAYER * 32, T);                                            \
        const int nrb = T.rb_start[NEXP];                                                                                                                         \
        if (IN(PH0 + 2)) { SchedMoe1 S; S.XN = (const char*)(ws + WS_XN); S.rowtok = WSP(int, WS_ROWTOK); S.W = (const char*)(ws + WS_WGU); S.T = T; S.rb_lo = 0; S.rb_hi = nrb; S.G = gridDim.x; S.c = blockIdx.x; S.ldb_bytes = 1024; \
            EpiSwiGLU E; E.ACT = ws + WS_ACT8; E.bgu = P.in[LAYER ? 40 : 16]; E.rb_lo = 0; pg8::gemm_phase8(lds, S, E, 512); if (REP(9)) pg8::gemm_phase8(lds, S, E, 512); }  \
        SEAM(PH0 + 2);                                                                                                                                            \
        if (IN(PH0 + 3)) { SchedMoe2 S; S.ACT = (const char*)(ws + WS_ACT8); S.W = (const char*)(ws + WS_WD); S.T = T; S.rb_lo = 0; S.rb_hi = nrb; S.G = gridDim.x; S.c = blockIdx.x; S.ldb_bytes = 1024; \
            EpiMoeOut E; E.OUT = ws + WS_OUT; E.bd = P.in[LAYER ? 42 : 18]; E.rb_lo = 0; pg8::gemm_phase8(lds, S, E, 512); if (REP(10)) pg8::gemm_phase8(lds, S, E, 512); }  \
        SEAM(PH0 + 3);                                                                                                                                            \
        if (IN(PH0 + 4)) { phase_moe_combine_norm(P, ws, T, LAYER, ROWLO); if (LAYER == 0) phase_convert_moe8(P, ws, lds, 1); }                                    \
    }
    MOE_LAYER(7, 0, 0)
    SEAM(11);
    if (IN(12)) { SchedPlain S; S.init(NTOK / 256, 6, 1); S.A = (const char*)(ws + WS_XN); S.Bt = (const char*)(ws + WS_WIN1T); S.lda_bytes = 1024; S.ldb_bytes = 1024; S.a_gstride = 0; S.b_gstride = 0;
        EpiInProj1 E; E.R = R; pg8::gemm_phase8(lds, S, E, 512); if (REP(16)) pg8::gemm_phase8(lds, S, E, 512); }
    SEAM(12);
    if (IN(13)) { phase_qkv_prep8(ws, lds, P.in[35], P.in[36]);
        SchedPlain S; S.init(5, 1, 16); S.A = (const char*)(R + R_UX); S.Bt = (const char*)(ws + WS_S5F); S.lda_bytes = 2560; S.ldb_bytes = 2048; S.a_gstride = (size_t)1280 * 2560; S.b_gstride = (size_t)256 * 2048;
        EpiS5F E; E.S = (float*)(R + R_SLOC); pg8::gemm_phase(lds, S, E, 1024); }
    SEAM(13);
    if (IN(14)) { phase_s5_scan(ws);
        phase_attention8(ws, lds, misc, WSP(unsigned, WS_CTL) + CW_Q0 + 64, P.in[35], P.in[36]); if (REP(18)) phase_attention8(ws, lds, misc, WSP(unsigned, WS_CTL) + CW_Q0 + 192, P.in[35], P.in[36]); }
    SEAM(14);
    if (IN(15)) { SchedPlain S; S.init(4, 4, 16); S.A = (const char*)(R + R_UX); S.Bt = (const char*)(ws + WS_S5TE); S.lda_bytes = 2560; S.ldb_bytes = 2560; S.a_gstride = (size_t)1280 * 2560; S.b_gstride = (size_t)1024 * 2560;
        EpiS5Y E; E.UX = (const bf16_t*)(R + R_UX); E.Yg = (bf16_t*)(R + R_YG); E.dskip = P.in[32]; pg8::gemm_phase(lds, S, E, 1280); if (REP(19)) pg8::gemm_phase(lds, S, E, 1280); }
    SEAM(15);
    if (IN(16)) { SchedPlain S; S.init(NLAT / 256, 1, 1); S.A = (const char*)(R + R_YG); S.Bt = (const char*)(ws + WS_WGLUT); S.lda_bytes = 512; S.ldb_bytes = 512; S.a_gstride = 0; S.b_gstride = 0;
        EpiGLU E; E.Yg = (const bf16_t*)(R + R_YG); E.MIX = WSP(bf16_t, WS_XN); E.bglu = P.in[34]; pg8::gemm_phase(lds, S, E, 256); if (REP(20)) pg8::gemm_phase(lds, S, E, 256); }
    SEAM(16);
    if (IN(17)) { SchedPlain S; S.init(NLAT / 256, 4, 1); S.A = (const char*)(ws + WS_XN) + (size_t)NCTX * 2048; S.Bt = (const char*)(ws + WS_WOUT1T); S.lda_bytes = 2048; S.ldb_bytes = 2048; S.a_gstride = 0; S.b_gstride = 0;
        EpiResid E; E.xin = P.out; E.xout = P.out; E.hin = WSP(float, WS_HCTX); E.hout = WSP(float, WS_HCTX); E.gate = mods + 9 * 6144 + 2048; E.row_base = NCTX; E.scale = 1.f; pg8::gemm_phase(lds, S, E, 1024); }
    SEAM(17);
    MOE_LAYER(18, 1, NCTX)
#undef IN
#undef SEAM
}

extern "C" void kernel_launch(void* const* d_in, const int* in_sizes, int n_in, void* d_out, int out_size, void* d_ws, size_t ws_size, hipStream_t stream) {
    (void)in_sizes; (void)out_size;
    if (n_in < 44 || ws_size < WS_END) { fprintf(stderr, "kernel_launch: n_in %d ws_size %zu need %zu\n", n_in, ws_size, (size_t)WS_END); return; }
    static int grid = 0;
    if (!grid) {
        int dev = 0, cus = 0, per_cu = 0;
        hipGetDevice(&dev);
        hipDeviceGetAttribute(&cus, hipDeviceAttributeMultiprocessorCount, dev);
        hipFuncSetAttribute((const void*)hybrid_fwd, hipFuncAttributeMaxDynamicSharedMemorySize, LDS_BYTES);
        hipOccupancyMaxActiveBlocksPerMultiprocessor(&per_cu, (const void*)hybrid_fwd, NTHREADS, LDS_BYTES);
        if (per_cu < 1) { fprintf(stderr, "kernel_launch: occupancy query says %d blocks per CU\n", per_cu); per_cu = 1; }
        grid = cus;
    }
    hipMemsetAsync(d_ws, 0, WS_ZERO_BYTES, stream);
    Params p{};
    for (int i = 0; i < 44; ++i) p.in[i] = (const float*)d_in[i];
    p.out = (float*)d_out; p.ws = (unsigned char*)d_ws;
#if MK_MULTI
    for (int ph = 0; ph < NPHASE; ++ph) { p.ph_lo = ph; p.ph_hi = ph + 1; hipLaunchKernelGGL(hybrid_fwd, dim3(grid), dim3(NTHREADS), LDS_BYTES, stream, p); }
#else
    p.ph_lo = 0; p.ph_hi = NPHASE;
    hipLaunchKernelGGL(hybrid_fwd, dim3(grid), dim3(NTHREADS), LDS_BYTES, stream, p);
#endif
}
```
